# Optimizing an MI355X kernel written in HIP

```python
import math
import jax
import jax.numpy as jnp
from jax import lax
import numpy as np

D_MODEL = 1024
BATCH = 1
SEQ = 16384
DEPTH = 2

GRID_W = 64
CTX_LEN = 256
Q_BLOCK = 128
EPS = 1e-6
ROPE_BASE = 10000.0
NEG_INF = -1e30

A_HEADS = 4
A_DQK = 64
A_DV = 2 * A_DQK
B_HEADS = 8
B_DH = 64
NA_WIN_H = 8
NA_WIN_W = 16
C_HEADS = 8
C_Q_LORA = 384
C_KV_LORA = 256
C_NOPE = 64
C_ROPE = 32
C_DV = 64
D_HEADS = 8
D_KV_HEADS = 2
D_DH = 64
D_WINDOW = 128
FFN_HIDDEN = 2816
CONV_W = 3

EVEN_SPLIT = (2 * A_HEADS * A_DQK, 2 * A_HEADS * A_DQK, A_HEADS * A_DV, B_HEADS * B_DH, B_HEADS * B_DH, B_HEADS * B_DH)
ODD_SPLIT = (C_Q_LORA, C_KV_LORA, C_ROPE, D_HEADS * D_DH, D_KV_HEADS * D_DH, D_KV_HEADS * D_DH)
EVEN_IN = sum(EVEN_SPLIT)
ODD_IN = sum(ODD_SPLIT)
EVEN_MIX = A_HEADS * A_DV + B_HEADS * B_DH
ODD_MIX = C_HEADS * C_DV + D_HEADS * D_DH
N_EVEN = (DEPTH + 1) // 2
N_ODD = DEPTH // 2

kernel_name = 'hybrid_diff_na_mla_swa_convffn_dit'


def rms_norm(x, g):
    xf = x.astype(jnp.float32)
    y = xf * lax.rsqrt(jnp.mean(xf * xf, axis=-1, keepdims=True) + EPS)
    return (y * g.astype(jnp.float32)).astype(x.dtype)


def modulate(h, shift, scale):
    return h * (1 + scale) + shift


def split_cols(p, sizes):
    return jnp.split(p, np.cumsum(sizes)[:-1].tolist(), axis=-1)


def axial_rope_tables(n_tokens, dim):
    t = jnp.arange(n_tokens, dtype=jnp.int32)
    row = (t // GRID_W).astype(jnp.float32)
    col = (t % GRID_W).astype(jnp.float32)
    quarter = dim // 4
    inv_freq = ROPE_BASE ** (-jnp.arange(quarter, dtype=jnp.float32) / quarter)
    ang = jnp.concatenate([row[:, None] * inv_freq, col[:, None] * inv_freq], axis=-1)
    return jnp.cos(ang), jnp.sin(ang)


def apply_rope(x, cos, sin):
    half = x.shape[-1] // 2
    x1, x2 = x[..., :half], x[..., half:]
    c = cos[None, :, None, :].astype(x.dtype)
    s = sin[None, :, None, :].astype(x.dtype)
    return jnp.concatenate([x1 * c - x2 * s, x1 * s + x2 * c], axis=-1)


def rope_tail(x, cos, sin):
    return jnp.concatenate([x[..., :C_NOPE], apply_rope(x[..., C_NOPE:], cos, sin)], axis=-1)


def sweep_query_blocks(fn, q):
    B, T = q.shape[:2]
    nb = T // Q_BLOCK
    qb = jnp.moveaxis(q.reshape((B, nb, Q_BLOCK) + q.shape[2:]), 1, 0)
    out = jnp.moveaxis(lax.map(fn, qb), 0, 1)
    return out.reshape((B, T) + out.shape[3:])


def softmax_attend(q, k, v, scale):
    s = jnp.einsum('bqhd,bkhd->bhqk', q, k, preferred_element_type=jnp.float32) * scale
    p = jax.nn.softmax(s, axis=-1).astype(v.dtype)
    return jnp.einsum('bhqk,bkhe->bqhe', p, v)


def diff_attend(q, k, v, lam, scale):
    s = jnp.einsum('bqhmd,bkhmd->bhmqk', q, k, preferred_element_type=jnp.float32) * scale
    p = jax.nn.softmax(s, axis=-1)
    w = p[:, :, 0] - lam * p[:, :, 1]
    return jnp.einsum('bhqk,bkhe->bqhe', w.astype(v.dtype), v)


def gqa_sink_attend(q, k, v, sink, scale, mask=None):
    s = jnp.einsum('bqhgd,bkhd->bhgqk', q, k, preferred_element_type=jnp.float32) * scale
    if mask is not None:
        s = jnp.where(mask, s, NEG_INF)
    Hk, G = q.shape[2], q.shape[3]
    sk = jnp.broadcast_to(sink.reshape(Hk, G)[None, :, :, None, None].astype(jnp.float32), s.shape[:-1] + (1,))
    p = jax.nn.softmax(jnp.concatenate([s, sk], axis=-1), axis=-1)[..., :-1]
    return jnp.einsum('bhgqk,bkhd->bqhgd', p.astype(v.dtype), v)


def neighbourhood_attend(q, k, v, k_ctx, v_ctx, rpb):
    B, T, H, dh = q.shape
    rows = T // GRID_W
    wh = min(NA_WIN_H, rows)
    ww = NA_WIN_W
    L = k_ctx.shape[1]
    scale = 1.0 / math.sqrt(dh)
    col_start = np.clip(np.arange(GRID_W) - ww // 2, 0, GRID_W - ww)
    col_idx = (col_start[:, None] + np.arange(ww)[None, :]).astype(np.int32)
    dc = (col_idx - np.arange(GRID_W)[:, None] + (NA_WIN_W - 1)).astype(np.int32)
    qg = q.reshape(B, rows, GRID_W, H, dh)
    kg = k.reshape(B, rows, GRID_W, H, dh)
    vg = v.reshape(B, rows, GRID_W, H, dh)

    def row_block(r):
        qr = lax.dynamic_index_in_dim(qg, r, axis=1, keepdims=False)
        rs = jnp.clip(r - wh // 2, 0, rows - wh)
        kn = lax.dynamic_slice_in_dim(kg, rs, wh, axis=1)[:, :, col_idx]
        vn = lax.dynamic_slice_in_dim(vg, rs, wh, axis=1)[:, :, col_idx]
        dr = rs + jnp.arange(wh) - r + (NA_WIN_H - 1)
        bias = jnp.transpose(rpb[:, dr[:, None, None], dc[None, :, :]], (0, 2, 1, 3))
        s_nb = jnp.einsum('bchd,brcwhd->bhcrw', qr, kn, preferred_element_type=jnp.float32) * scale + bias.astype(jnp.float32)
        s_ctx = jnp.einsum('bchd,blhd->bhcl', qr, k_ctx, preferred_element_type=jnp.float32) * scale
        p = jax.nn.softmax(jnp.concatenate([s_ctx, s_nb.reshape(B, H, GRID_W, wh * ww)], axis=-1), axis=-1).astype(v.dtype)
        p_ctx = p[..., :L]
        p_nb = p[..., L:].reshape(B, H, GRID_W, wh, ww)
        return jnp.einsum('bhcl,blhd->bchd', p_ctx, v_ctx) + jnp.einsum('bhcrw,brcwhd->bchd', p_nb, vn)

    out = lax.map(row_block, jnp.arange(rows))
    return jnp.moveaxis(out, 0, 1).reshape(B, T, H, dh)


def window_gqa_latent(q, k, v, k_ctx, v_ctx, sink):
    B, T = q.shape[:2]
    L = k_ctx.shape[1]
    span = Q_BLOCK + 2 * D_WINDOW
    scale = 1.0 / math.sqrt(D_DH)
    pad = ((0, 0), (D_WINDOW, D_WINDOW), (0, 0), (0, 0))
    kp = jnp.pad(k, pad)
    vp = jnp.pad(v, pad)
    ctx_ok = jnp.ones((Q_BLOCK, L), dtype=bool)

    def band_block(b):
        start = b * Q_BLOCK
        qi = lax.dynamic_slice_in_dim(q, start, Q_BLOCK, axis=1)
        ki = lax.dynamic_slice_in_dim(kp, start, span, axis=1)
        vi = lax.dynamic_slice_in_dim(vp, start, span, axis=1)
        qpos = start + jnp.arange(Q_BLOCK)
        kpos = start - D_WINDOW + jnp.arange(span)
        band = (jnp.abs(kpos[None, :] - qpos[:, None]) <= D_WINDOW) & (kpos >= 0)[None, :] & (kpos < T)[None, :]
        mask = jnp.concatenate([ctx_ok, band], axis=-1)
        return gqa_sink_attend(qi, jnp.concatenate([k_ctx, ki], axis=1), jnp.concatenate([v_ctx, vi], axis=1), sink, scale, mask)

    out = lax.map(band_block, jnp.arange(T // Q_BLOCK))
    return jnp.moveaxis(out, 0, 1).reshape(B, T, D_HEADS * D_DH)


def even_mixer(h, hc, w_in, w_out, a_q_norm, a_k_norm, a_lam_q1, a_lam_k1, a_lam_q2, a_lam_k2, a_subln,
               b_q_norm, b_k_norm, b_rpb, lam_init, with_ctx):
    B, T, _ = h.shape
    cos, sin = axial_rope_tables(T, A_DQK)
    scale_a = 1.0 / math.sqrt(A_DQK)

    def project(hh, use_rope, need_q):
        Bh, Th, _ = hh.shape
        qa, ka, va, qb, kb, vb = split_cols(hh @ w_in, EVEN_SPLIT)
        ka = rms_norm(ka.reshape(Bh, Th, 2 * A_HEADS, A_DQK), a_k_norm)
        kb = rms_norm(kb.reshape(Bh, Th, B_HEADS, B_DH), b_k_norm)
        if use_rope:
            ka = apply_rope(ka, cos, sin)
        ka = ka.reshape(Bh, Th, A_HEADS, 2, A_DQK)
        va = va.reshape(Bh, Th, A_HEADS, A_DV)
        vb = vb.reshape(Bh, Th, B_HEADS, B_DH)
        if need_q:
            qa = rms_norm(qa.reshape(Bh, Th, 2 * A_HEADS, A_DQK), a_q_norm)
            if use_rope:
                qa = apply_rope(qa, cos, sin)
            qa = qa.reshape(Bh, Th, A_HEADS, 2, A_DQK)
            qb = rms_norm(qb.reshape(Bh, Th, B_HEADS, B_DH), b_q_norm)
        else:
            qa = qb = None
        return qa, ka, va, qb, kb, vb

    lam = (jnp.exp(jnp.sum(a_lam_q1 * a_lam_k1).astype(jnp.float32))
           - jnp.exp(jnp.sum(a_lam_q2 * a_lam_k2).astype(jnp.float32)) + lam_init)
    qa, ka, va, qb, kb, vb = project(h, True, True)
    qa_c, ka_c, va_c, qb_c, kb_c, vb_c = project(hc, False, with_ctx)

    def merge(oa, ob):
        Bo, To = oa.shape[:2]
        oa = rms_norm(oa, a_subln) * (1.0 - lam_init)
        return jnp.concatenate([oa.reshape(Bo, To, -1), ob.reshape(Bo, To, -1)], axis=-1) @ w_out

    ka_all = jnp.concatenate([ka_c, ka], axis=1)
    va_all = jnp.concatenate([va_c, va], axis=1)
    oa = sweep_query_blocks(lambda qi: diff_attend(qi, ka_all, va_all, lam, scale_a), qa)
    ob = neighbourhood_attend(qb, kb, vb, kb_c, vb_c, b_rpb)
    y = merge(oa, ob)
    yc = None
    if with_ctx:
        yc = merge(diff_attend(qa_c, ka_c, va_c, lam, scale_a), softmax_attend(qb_c, kb_c, vb_c, 1.0 / math.sqrt(B_DH)))
    return y, yc


def odd_mixer(h, hc, w_in, w_out, c_q_a_norm, c_w_qb, c_kv_a_norm, c_w_kvb, c_q_norm, c_k_norm,
              d_q_norm, d_k_norm, d_sink, with_ctx):
    B, T, _ = h.shape
    cos_c, sin_c = axial_rope_tables(T, C_ROPE)
    cos_d, sin_d = axial_rope_tables(T, D_DH)
    scale_c = 1.0 / math.sqrt(C_NOPE + C_ROPE)

    def project(hh, use_rope, need_q):
        Bh, Th, _ = hh.shape
        cq, ckv, ckr, dq, dk, dv = split_cols(hh @ w_in, ODD_SPLIT)
        kv = (rms_norm(ckv, c_kv_a_norm) @ c_w_kvb).reshape(Bh, Th, C_HEADS, C_NOPE + C_DV)
        mk = jnp.concatenate([kv[..., :C_NOPE], jnp.broadcast_to(ckr[:, :, None, :], (Bh, Th, C_HEADS, C_ROPE))], axis=-1)
        mk = rms_norm(mk, c_k_norm)
        mv = kv[..., C_NOPE:]
        gk = rms_norm(dk.reshape(Bh, Th, D_KV_HEADS, D_DH), d_k_norm)
        gv = dv.reshape(Bh, Th, D_KV_HEADS, D_DH)
        if use_rope:
            mk = rope_tail(mk, cos_c, sin_c)
            gk = apply_rope(gk, cos_d, sin_d)
        mq = gq = None
        if need_q:
            mq = (rms_norm(cq, c_q_a_norm) @ c_w_qb).reshape(Bh, Th, C_HEADS, C_NOPE + C_ROPE)
            mq = rms_norm(mq, c_q_norm)
            gq = rms_norm(dq.reshape(Bh, Th, D_HEADS, D_DH), d_q_norm)
            if use_rope:
                mq = rope_tail(mq, cos_c, sin_c)
                gq = apply_rope(gq, cos_d, sin_d)
            gq = gq.reshape(Bh, Th, D_KV_HEADS, D_HEADS // D_KV_HEADS, D_DH)
        return mq, mk, mv, gq, gk, gv

    mq, mk, mv, gq, gk, gv = project(h, True, True)
    mq_c, mk_c, mv_c, gq_c, gk_c, gv_c = project(hc, False, with_ctx)

    mk_all = jnp.concatenate([mk_c, mk], axis=1)
    mv_all = jnp.concatenate([mv_c, mv], axis=1)
    om = sweep_query_blocks(lambda qi: softmax_attend(qi, mk_all, mv_all, scale_c), mq)
    og = window_gqa_latent(gq, gk, gv, gk_c, gv_c, d_sink)
    y = jnp.concatenate([om.reshape(B, T, -1), og], axis=-1) @ w_out
    yc = None
    if with_ctx:
        L = hc.shape[1]
        om_c = softmax_attend(mq_c, mk_c, mv_c, scale_c).reshape(B, L, -1)
        og_c = gqa_sink_attend(gq_c, gk_c, gv_c, d_sink, 1.0 / math.sqrt(D_DH)).reshape(B, L, -1)
        yc = jnp.concatenate([om_c, og_c], axis=-1) @ w_out
    return y, yc


def conv_ffn(h, w_up, conv_w, conv_b, w_down):
    T = h.shape[1]
    u = h @ w_up
    half = CONV_W // 2
    up = jnp.pad(u, ((0, 0), (half, half), (0, 0)))
    u = conv_b + up[:, 0:T] * conv_w[0]
    for j in range(1, CONV_W):
        u = u + up[:, j:j + T] * conv_w[j]
    a, g = jnp.split(u, 2, axis=-1)
    return (a * jax.nn.silu(g)) @ w_down


def setup_inputs(seed: int = 0) -> dict:
    key = jax.random.key(seed)
    ks = list(jax.random.split(key, 40))

    def nrm(shape, s):
        return s * jax.random.normal(ks.pop(), shape, jnp.float32)

    def gain(shape):
        return 1.0 + nrm(shape, 0.05)

    D, F = D_MODEL, FFN_HIDDEN
    return {
        'x': nrm((BATCH, SEQ, D), 1.0),
        'c': nrm((BATCH, D), 1.0),
        'ctx': nrm((BATCH, CTX_LEN, D), 1.0),
        'c_ctx': nrm((D,), 1.0),
        'ada_w': nrm((DEPTH, D, 6 * D), 0.5 * D ** -0.5),
        'ada_b': nrm((DEPTH, 6 * D), 0.01),
        'norm_mix': gain((DEPTH, D)),
        'norm_ffn': gain((DEPTH, D)),
        'ffn_up': nrm((DEPTH, D, 2 * F), D ** -0.5),
        'ffn_conv_w': nrm((DEPTH, CONV_W, 2 * F), CONV_W ** -0.5),
        'ffn_conv_b': nrm((DEPTH, 2 * F), 0.01),
        'ffn_down': nrm((DEPTH, F, D), F ** -0.5),
        'ev_w_in': nrm((N_EVEN, D, EVEN_IN), D ** -0.5),
        'ev_w_out': nrm((N_EVEN, EVEN_MIX, D), EVEN_MIX ** -0.5),
        'a_q_norm': gain((N_EVEN, A_DQK)),
        'a_k_norm': gain((N_EVEN, A_DQK)),
        'a_lam_q1': nrm((N_EVEN, A_DQK), 0.1),
        'a_lam_k1': nrm((N_EVEN, A_DQK), 0.1),
        'a_lam_q2': nrm((N_EVEN, A_DQK), 0.1),
        'a_lam_k2': nrm((N_EVEN, A_DQK), 0.1),
        'a_subln': gain((N_EVEN, A_DV)),
        'b_q_norm': gain((N_EVEN, B_DH)),
        'b_k_norm': gain((N_EVEN, B_DH)),
        'b_rpb': nrm((N_EVEN, B_HEADS, 2 * NA_WIN_H - 1, 2 * NA_WIN_W - 1), 0.1),
        'od_w_in': nrm((N_ODD, D, ODD_IN), D ** -0.5),
        'od_w_out': nrm((N_ODD, ODD_MIX, D), ODD_MIX ** -0.5),
        'c_q_a_norm': gain((N_ODD, C_Q_LORA)),
        'c_w_qb': nrm((N_ODD, C_Q_LORA, C_HEADS * (C_NOPE + C_ROPE)), C_Q_LORA ** -0.5),
        'c_kv_a_norm': gain((N_ODD, C_KV_LORA)),
        'c_w_kvb': nrm((N_ODD, C_KV_LORA, C_HEADS * (C_NOPE + C_DV)), C_KV_LORA ** -0.5),
        'c_q_norm': gain((N_ODD, C_NOPE + C_ROPE)),
        'c_k_norm': gain((N_ODD, C_NOPE + C_ROPE)),
        'd_q_norm': gain((N_ODD, D_DH)),
        'd_k_norm': gain((N_ODD, D_DH)),
        'd_sink': nrm((N_ODD, D_HEADS), 0.5),
    }


def reference(x, c, ctx, c_ctx, ada_w, ada_b, norm_mix, norm_ffn, ffn_up, ffn_conv_w, ffn_conv_b, ffn_down,
              ev_w_in, ev_w_out, a_q_norm, a_k_norm, a_lam_q1, a_lam_k1, a_lam_q2, a_lam_k2, a_subln,
              b_q_norm, b_k_norm, b_rpb, od_w_in, od_w_out, c_q_a_norm, c_w_qb, c_kv_a_norm, c_w_kvb,
              c_q_norm, c_k_norm, d_q_norm, d_k_norm, d_sink):
    xc = ctx
    for l in range(DEPTH):
        last = l == DEPTH - 1
        mod = (jax.nn.silu(c) @ ada_w[l] + ada_b[l])[:, None, :]
        modc = (jax.nn.silu(c_ctx) @ ada_w[l] + ada_b[l])[None, None, :]
        sh1, sc1, g1, sh2, sc2, g2 = jnp.split(mod, 6, axis=-1)
        csh1, csc1, cg1, csh2, csc2, cg2 = jnp.split(modc, 6, axis=-1)
        h = modulate(rms_norm(x, norm_mix[l]), sh1, sc1)
        hc = modulate(rms_norm(xc, norm_mix[l]), csh1, csc1)
        i = l // 2
        if l % 2 == 0:
            lam_init = 0.8 - 0.6 * math.exp(-0.3 * l)
            y, yc = even_mixer(h, hc, ev_w_in[i], ev_w_out[i], a_q_norm[i], a_k_norm[i], a_lam_q1[i], a_lam_k1[i],
                               a_lam_q2[i], a_lam_k2[i], a_subln[i], b_q_norm[i], b_k_norm[i], b_rpb[i],
                               lam_init, not last)
        else:
            y, yc = odd_mixer(h, hc, od_w_in[i], od_w_out[i], c_q_a_norm[i], c_w_qb[i], c_kv_a_norm[i], c_w_kvb[i],
                              c_q_norm[i], c_k_norm[i], d_q_norm[i], d_k_norm[i], d_sink[i], not last)
        x = x + g1 * y
        x = x + g2 * conv_ffn(modulate(rms_norm(x, norm_ffn[l]), sh2, sc2), ffn_up[l], ffn_conv_w[l], ffn_conv_b[l], ffn_down[l])
        if not last:
            xc = xc + cg1 * yc
            xc = xc + cg2 * conv_ffn(modulate(rms_norm(xc, norm_ffn[l]), csh2, csc2), ffn_up[l], ffn_conv_w[l], ffn_conv_b[l], ffn_down[l])
    return x
```

```cpp
#include <hip/hip_runtime.h>
#include <hip/hip_cooperative_groups.h>
#include <cstdint>
#include <cstdio>
#include <cmath>

typedef unsigned short bf16_t;
typedef unsigned int u32;
typedef u32 u32x4 __attribute__((ext_vector_type(4)));

#define NT 512
constexpr int T_ = 16384, L_ = 256, R_ = 16640, D_ = 1024, F_ = 2816, F2_ = 5632;
constexpr float EPS_ = 1e-6f;

constexpr size_t WS_CTL = 0;
constexpr size_t WS_MOD = 4096;
constexpr size_t WS_SCAL = WS_MOD + 2 * 2 * 6144 * 4;
constexpr size_t WS_ROPE = WS_SCAL + 256;
constexpr size_t WS_XC = WS_ROPE + 256 * 16 * 2 * 4;
constexpr size_t WS_H = WS_XC + 256 * 1024 * 4;
constexpr size_t WS_MIX = WS_H + (size_t)(R_ + 8) * 1024 * 2;
constexpr size_t WS_QKV = WS_MIX + (size_t)R_ * 1024 * 2;
constexpr size_t E_SEG = (size_t)512 * R_;
constexpr size_t O_QA = 0, O_KA = E_SEG, O_VAT = 2 * E_SEG, O_QB = 3 * E_SEG, O_KB = 4 * E_SEG, O_VBT = 5 * E_SEG;
constexpr size_t O_CQ = 0, O_CKV = O_CQ + (size_t)R_ * 384, O_CKR = O_CKV + (size_t)R_ * 256, O_MQ = O_CKR + (size_t)R_ * 32,
                 O_MK = O_MQ + (size_t)R_ * 768, O_MVT = O_MK + (size_t)R_ * 768, O_GQ = O_MVT + (size_t)R_ * 512,
                 O_GK = O_GQ + (size_t)R_ * 512, O_GVT = O_GK + (size_t)R_ * 128, O_L1END = O_GVT + (size_t)R_ * 128;
constexpr size_t WS_QKV_BYTES = O_L1END * 2;
constexpr size_t WS_END = WS_QKV + WS_QKV_BYTES;
static_assert(WS_END < (size_t)250 * 1024 * 1024, "ws");
static_assert((size_t)(R_ + 8) * F_ * 2 <= WS_QKV_BYTES, "act alias");

struct Params { const float* in[35]; float* out; char* ws; };
enum { I_X = 0, I_C, I_CTX, I_CCTX, I_ADAW, I_ADAB, I_NMIX, I_NFFN, I_FUP, I_FCW, I_FCB, I_FDOWN, I_EWIN, I_EWOUT, I_AQN, I_AKN,
       I_LQ1, I_LK1, I_LQ2, I_LK2, I_SUBLN, I_BQN, I_BKN, I_RPB, I_OWIN, I_OWOUT, I_CQAN, I_CWQB, I_CKVAN, I_CWKVB, I_CQN, I_CKN,
       I_DQN, I_DKN, I_SINK };

__device__ __forceinline__ float bf2f(bf16_t v) { return __uint_as_float(((u32)v) << 16); }
__device__ __forceinline__ bf16_t f2bf(float f) { u32 u = __float_as_uint(f); return (bf16_t)((u + 0x7fffu + ((u >> 16) & 1u)) >> 16); }
__device__ __forceinline__ float wave_sum(float v) {
#pragma unroll
    for (int o = 32; o > 0; o >>= 1) v += __shfl_xor(v, o);
    return v;
}
__device__ __forceinline__ int swap23(int p) { return (p & 3) | ((p & 4) << 1) | ((p & 8) >> 1); }
__device__ __forceinline__ int vpos(int key) { return (key & ~15) + swap23(key & 15); }
__device__ __forceinline__ void unpack8(u32x4 v, float (&a)[8]) {
    a[0] = __uint_as_float(v.x << 16); a[1] = __uint_as_float(v.x & 0xffff0000u);
    a[2] = __uint_as_float(v.y << 16); a[3] = __uint_as_float(v.y & 0xffff0000u);
    a[4] = __uint_as_float(v.z << 16); a[5] = __uint_as_float(v.z & 0xffff0000u);
    a[6] = __uint_as_float(v.w << 16); a[7] = __uint_as_float(v.w & 0xffff0000u);
}

struct Bufs {
    float* mod; float* scal; float* rope; float* xc; bf16_t* h; bf16_t* mix; bf16_t* qkv; bf16_t* act;
    __device__ Bufs(const Params& p) {
        mod = (float*)(p.ws + WS_MOD); scal = (float*)(p.ws + WS_SCAL); rope = (float*)(p.ws + WS_ROPE); xc = (float*)(p.ws + WS_XC);
        h = (bf16_t*)(p.ws + WS_H); mix = (bf16_t*)(p.ws + WS_MIX); qkv = (bf16_t*)(p.ws + WS_QKV); act = (bf16_t*)(p.ws + WS_QKV);
    }
};
__device__ __forceinline__ const float* modp(const Bufs& B, int l, int s, int chunk) { return B.mod + ((size_t)(l * 2 + s) * 6144) + chunk * 1024; }

__device__ void phase_prep(const Params& p, char* lds, int bid, int nblk) {
    Bufs B(p);
    float* red = (float*)lds;
    const int tid = threadIdx.x;
    for (int item = bid; item < 193; item += nblk) {
        if (item < 192) {
            const int l = item / 96, n0 = (item % 96) * 64, nn = tid & 63, kc = tid >> 6;
            const float* W = p.in[I_ADAW] + (size_t)l * 1024 * 6144 + n0 + nn;
            float a0 = 0.f, a1 = 0.f;
            for (int k = kc * 128; k < kc * 128 + 128; ++k) {
                const float w = W[(size_t)k * 6144];
                const float c0 = p.in[I_C][k], c1 = p.in[I_CCTX][k];
                a0 += (c0 / (1.f + __expf(-c0))) * w; a1 += (c1 / (1.f + __expf(-c1))) * w;
            }
            red[(kc * 64 + nn) * 2] = a0; red[(kc * 64 + nn) * 2 + 1] = a1;
            __syncthreads();
            if (tid < 128) {
                const int n = tid & 63, s = tid >> 6; float acc = 0.f;
                for (int k = 0; k < 8; ++k) acc += red[(k * 64 + n) * 2 + s];
                B.mod[(size_t)(l * 2 + s) * 6144 + n0 + n] = acc + p.in[I_ADAB][l * 6144 + n0 + n];
            }
            __syncthreads();
        } else {
            for (int e = tid; e < 256 * 16; e += NT) {
                const int pos = e >> 4, i = e & 15;
                const double f = pow(10000.0, -(double)i / 16.0), ang = (double)pos * f;
                B.rope[e * 2] = (float)cos(ang); B.rope[e * 2 + 1] = (float)sin(ang);
            }
            if (tid < 64) {
                const float s1 = wave_sum(p.in[I_LQ1][tid] * p.in[I_LK1][tid]), s2 = wave_sum(p.in[I_LQ2][tid] * p.in[I_LK2][tid]);
                if (tid == 0) B.scal[0] = expf(s1) - expf(s2) + 0.2f;
            }
        }
    }
}

__device__ void phase_norm(const Params& p, int l, int which, int bid, int nblk) {
    Bufs B(p);
    const int wid = threadIdx.x >> 6, lane = threadIdx.x & 63;
    const float* gamma = p.in[which ? I_NFFN : I_NMIX] + l * 1024;
    for (int item = bid; item < R_ / 8; item += nblk) {
        const int r = item * 8 + wid;
        const bool first = (l == 0 && which == 0);
        const float* src = r < 256 ? ((first ? p.in[I_CTX] : B.xc) + (size_t)r * 1024) : ((first ? p.in[I_X] : p.out) + (size_t)(r - 256) * 1024);
        const int s = r < 256 ? 1 : 0;
        const float* sh = modp(B, l, s, which ? 3 : 0); const float* sc = modp(B, l, s, which ? 4 : 1);
        float v[16]; float ss = 0.f;
#pragma unroll
        for (int i = 0; i < 4; ++i) { const float4 t = *(const float4*)(src + i * 256 + lane * 4); v[4 * i] = t.x; v[4 * i + 1] = t.y; v[4 * i + 2] = t.z; v[4 * i + 3] = t.w; ss += t.x * t.x + t.y * t.y + t.z * t.z + t.w * t.w; }
        ss = wave_sum(ss);
        const float rr = rsqrtf(ss * (1.f / 1024.f) + EPS_);
#pragma unroll
        for (int i = 0; i < 4; ++i) {
            const int k = i * 256 + lane * 4; bf16_t o[4];
#pragma unroll
            for (int j = 0; j < 4; ++j) o[j] = f2bf(v[4 * i + j] * rr * gamma[k + j] * (1.f + sc[k + j]) + sh[k + j]);
            *(uint2*)(B.h + (size_t)r * 1024 + k) = make_uint2((u32)o[0] | ((u32)o[1] << 16), (u32)o[2] | ((u32)o[3] << 16));
        }
    }
}

template <int RPG>
__device__ __forceinline__ void tile_linear(float (&acc)[RPG], int K, const bf16_t* const (&ap)[RPG], const float* __restrict__ W, int ldw, int wcol) {
#pragma unroll
    for (int i = 0; i < RPG; ++i) acc[i] = 0.f;
    if (wcol < 0) return;
    for (int k = 0; k < K; k += 8) {
        float w[8];
#pragma unroll
        for (int j = 0; j < 8; ++j) w[j] = W[(size_t)(k + j) * ldw + wcol];
#pragma unroll
        for (int i = 0; i < RPG; ++i) {
            if (ap[i]) { float a[8]; unpack8(*(const u32x4*)(ap[i] + k), a);
#pragma unroll
                for (int j = 0; j < 8; ++j) acc[i] += a[j] * w[j]; }
        }
    }
}
template <int RPG>
__device__ __forceinline__ void tile_linear_g(float (&acc)[RPG], int K, const bf16_t* const (&ap)[RPG], const float (&rs)[RPG], const float* __restrict__ g, const float* __restrict__ W, int ldw, int wcol) {
#pragma unroll
    for (int i = 0; i < RPG; ++i) acc[i] = 0.f;
    if (wcol < 0) return;
    for (int k = 0; k < K; k += 8) {
        float w[8];
#pragma unroll
        for (int j = 0; j < 8; ++j) w[j] = W[(size_t)(k + j) * ldw + wcol] * g[k + j];
#pragma unroll
        for (int i = 0; i < RPG; ++i) {
            if (ap[i]) { float a[8]; unpack8(*(const u32x4*)(ap[i] + k), a); float t = 0.f;
#pragma unroll
                for (int j = 0; j < 8; ++j) t += a[j] * w[j];
                acc[i] += t * rs[i]; }
        }
    }
}

__device__ __forceinline__ float2 rope64(const float* tab, int t, int i) { const int pos = i < 16 ? (t >> 6) : (t & 63); const int f = i & 15; return *(const float2*)(tab + (pos * 16 + f) * 2); }
__device__ __forceinline__ float2 rope32(const float* tab, int t, int i) { const int pos = i < 8 ? (t >> 6) : (t & 63); const int f = (i & 7) * 2; return *(const float2*)(tab + (pos * 16 + f) * 2); }

__device__ __forceinline__ void head64_norm_rope(const float* row, const float* g, bool rope, const float* tab, int t, bf16_t* dst, int lane) {
    const float v = row[lane];
    const float ss = wave_sum(v * v);
    const float rr = rsqrtf(ss * (1.f / 64.f) + EPS_);
    float y = v * rr * g[lane];
    if (rope) {
        const float yp = row[lane ^ 32] * rr * g[lane ^ 32];
        const float2 cs = rope64(tab, t, lane & 31);
        y = lane < 32 ? (y * cs.x - yp * cs.y) : (yp * cs.y + y * cs.x);
    }
    dst[lane] = f2bf(y);
}

__device__ void phase_qkv0(const Params& p, char* lds, int bid, int nblk) {
    Bufs B(p);
    float* tile = (float*)lds;
    const int tid = threadIdx.x, cc = tid & 127, rg = tid >> 7, wid = tid >> 6, lane = tid & 63;
    const float* W = p.in[I_EWIN];
    for (int item = bid; item < (R_ / 16) * 24; item += nblk) {
        const int rt = item / 24, ct = item % 24, row0 = rt * 16, col0 = ct * 128;
        const bf16_t* ap[4];
#pragma unroll
        for (int i = 0; i < 4; ++i) ap[i] = B.h + (size_t)(row0 + rg * 4 + i) * 1024;
        float acc[4];
        tile_linear<4>(acc, 1024, ap, W, 3072, col0 + cc);
#pragma unroll
        for (int i = 0; i < 4; ++i) tile[(rg * 4 + i) * 128 + cc] = acc[i];
        __syncthreads();
        const int seg = col0 / 512, cin = col0 % 512;
        if (seg == 2 || seg == 5) {
            for (int e = tid; e < 16 * 128; e += NT) {
                const int c = e >> 4, rr = e & 15, r = row0 + rr;
                bf16_t* dst;
                if (seg == 2) dst = B.qkv + O_VAT + ((size_t)(cin / 128) * 128 + c) * R_;
                else dst = B.qkv + O_VBT + ((size_t)((cin + c) / 64) * 64 + (c & 63)) * R_;
                dst[vpos(r)] = f2bf(tile[rr * 128 + c]);
            }
        } else {
            for (int q = wid * 4; q < wid * 4 + 4; ++q) {
                const int rr = q >> 1, hh = q & 1, r = row0 + rr, head = cin / 64 + hh;
                const float* g = p.in[seg == 0 ? I_AQN : seg == 1 ? I_AKN : seg == 3 ? I_BQN : I_BKN];
                bf16_t* dst = B.qkv + (seg == 0 ? O_QA : seg == 1 ? O_KA : seg == 3 ? O_QB : O_KB) + ((size_t)head * R_ + r) * 64;
                head64_norm_rope(tile + rr * 128 + hh * 64, g, (seg < 2) && r >= 256, B.rope, r - 256, dst, lane);
            }
        }
        __syncthreads();
    }
}

__device__ __forceinline__ float dot8p(u32x4 k, u32 q0, u32 q1, u32 q2, u32 q3) {
    float t = __uint_as_float(k.x << 16) * __uint_as_float(q0 << 16);
    t += __uint_as_float(k.x & 0xffff0000u) * __uint_as_float(q0 & 0xffff0000u);
    t += __uint_as_float(k.y << 16) * __uint_as_float(q1 << 16);
    t += __uint_as_float(k.y & 0xffff0000u) * __uint_as_float(q1 & 0xffff0000u);
    t += __uint_as_float(k.z << 16) * __uint_as_float(q2 << 16);
    t += __uint_as_float(k.z & 0xffff0000u) * __uint_as_float(q2 & 0xffff0000u);
    t += __uint_as_float(k.w << 16) * __uint_as_float(q3 << 16);
    t += __uint_as_float(k.w & 0xffff0000u) * __uint_as_float(q3 & 0xffff0000u);
    return t;
}
template <int DQK, int DVT>
__device__ __forceinline__ void naive_dense(const bf16_t* __restrict__ q, const bf16_t* __restrict__ Kb, const bf16_t* __restrict__ VT, int nk, float scale, float (&O)[DVT], float& lsum) {
    u32x4 qp[DQK / 8];
#pragma unroll
    for (int i = 0; i < DQK / 8; ++i) qp[i] = *(const u32x4*)(q + i * 8);
#pragma unroll
    for (int d = 0; d < DVT; ++d) O[d] = 0.f;
    float m = -1e30f, l = 0.f;
    for (int c = 0; c < nk; c += 8) {
        float s[8];
#pragma unroll
        for (int j = 0; j < 8; ++j) {
            const int key = (c & ~15) + swap23((c & 15) + j);
            const bf16_t* kr = Kb + (size_t)key * DQK; float t = 0.f;
#pragma unroll
            for (int i = 0; i < DQK / 8; ++i) t += dot8p(*(const u32x4*)(kr + i * 8), qp[i].x, qp[i].y, qp[i].z, qp[i].w);
            s[j] = t * scale;
        }
        float cm = s[0];
#pragma unroll
        for (int j = 1; j < 8; ++j) cm = fmaxf(cm, s[j]);
        const float mn = fmaxf(m, cm), alpha = __expf(m - mn);
        float ps = 0.f;
#pragma unroll
        for (int j = 0; j < 8; ++j) { s[j] = __expf(s[j] - mn); ps += s[j]; }
        l = l * alpha + ps; m = mn;
#pragma unroll
        for (int d = 0; d < DVT; ++d) {
            float a[8]; unpack8(*(const u32x4*)(VT + (size_t)d * R_ + c), a);
            float t = O[d] * alpha;
#pragma unroll
            for (int j = 0; j < 8; ++j) t += s[j] * a[j];
            O[d] = t;
            if ((d & 7) == 7) __builtin_amdgcn_sched_barrier(0);
        }
    }
    lsum = l;
}

__device__ void phase_attn0(const Params& p, char* lds, int bid, int nblk) {
    Bufs B(p);
    const int tid = threadIdx.x;
    float* xch = (float*)lds;
    const float lam = B.scal[0];
    for (int item = bid; item < 780; item += nblk) {
        if (item < 520) {
            const int head = item / 130, chunk = item % 130, role = tid >> 7, m = role >> 1, half = role & 1, qi = tid & 127, r = chunk * 128 + qi, sub = head * 2 + m;
            const int nk = chunk < 2 ? 256 : R_;
            float O[64]; float l;
            naive_dense<64, 64>(B.qkv + O_QA + ((size_t)sub * R_ + r) * 64, B.qkv + O_KA + (size_t)sub * R_ * 64, B.qkv + O_VAT + ((size_t)head * 128 + half * 64) * R_, nk, 0.125f, O, l);
            const float inv = 1.f / l;
#pragma unroll
            for (int d = 0; d < 64; ++d) O[d] *= inv;
            float* xh = xch + (half * 128 + qi) * 33;
#pragma unroll
            for (int ch = 0; ch < 2; ++ch) {
                __syncthreads();
                if (m == 1) {
#pragma unroll
                    for (int d = 0; d < 32; ++d) xh[d] = O[ch * 32 + d];
                }
                __syncthreads();
                if (m == 0) {
#pragma unroll
                    for (int d = 0; d < 32; ++d) O[ch * 32 + d] -= lam * xh[d];
                }
            }
            __syncthreads();
            float ss = 0.f;
#pragma unroll
            for (int d = 0; d < 64; ++d) ss += O[d] * O[d];
            if (m == 0) xh[0] = ss;
            __syncthreads();
            if (m == 0) {
                const float tot = xch[(0 * 128 + qi) * 33] + xch[(1 * 128 + qi) * 33];
                const float rr = rsqrtf(tot * (1.f / 128.f) + EPS_) * 0.8f;
                bf16_t* dst = B.mix + (size_t)r * 1024 + head * 128 + half * 64;
                const float* g = p.in[I_SUBLN] + half * 64;
#pragma unroll
                for (int d = 0; d < 64; d += 2) *(u32*)(dst + d) = (u32)f2bf(O[d] * rr * g[d]) | ((u32)f2bf(O[d + 1] * rr * g[d + 1]) << 16);
            }
            __syncthreads();
        } else {
            const int idx = (item - 520) * NT + tid, h = idx / R_, r = idx % R_;
            const bf16_t* q = B.qkv + O_QB + ((size_t)h * R_ + r) * 64;
            const bf16_t* Kb = B.qkv + O_KB + (size_t)h * R_ * 64;
            const bf16_t* VT = B.qkv + O_VBT + (size_t)h * 64 * R_;
            float qf[64];
#pragma unroll
            for (int i = 0; i < 8; ++i) { float a[8]; unpack8(*(const u32x4*)(q + i * 8), a);
#pragma unroll
                for (int j = 0; j < 8; ++j) qf[i * 8 + j] = a[j] * 0.125f; }
            float O[64];
#pragma unroll
            for (int d = 0; d < 64; ++d) O[d] = 0.f;
            float m = -1e30f, l = 0.f;
            const int t = r - 256, row = t >> 6, col = t & 63;
            const int rs = min(max(row - 4, 0), 248), cs = min(max(col - 8, 0), 48);
            const int nkeys = r < 256 ? 256 : 384;
            for (int kk = 0; kk < nkeys; ++kk) {
                int key; float bias = 0.f;
                if (kk < 256) key = kk;
                else { const int w = kk - 256, kr = rs + (w >> 4), kc = cs + (w & 15); key = 256 + kr * 64 + kc; bias = p.in[I_RPB][(h * 15 + (kr - row + 7)) * 31 + (kc - col + 15)]; }
                const bf16_t* krow = Kb + (size_t)key * 64; float s = bias;
#pragma unroll
                for (int i = 0; i < 8; ++i) { float a[8]; unpack8(*(const u32x4*)(krow + i * 8), a);
#pragma unroll
                    for (int j = 0; j < 8; ++j) s += a[j] * qf[i * 8 + j]; }
                const float mn = fmaxf(m, s), alpha = __expf(m - mn), pp = __expf(s - mn);
                l = l * alpha + pp; m = mn;
                const int vp = vpos(key);
#pragma unroll
                for (int d = 0; d < 64; ++d) O[d] = O[d] * alpha + pp * bf2f(VT[(size_t)d * R_ + vp]);
            }
            const float inv = 1.f / l;
            bf16_t* dst = B.mix + (size_t)r * 1024 + 512 + h * 64;
#pragma unroll
            for (int d = 0; d < 64; d += 2) *(u32*)(dst + d) = (u32)f2bf(O[d] * inv) | ((u32)f2bf(O[d + 1] * inv) << 16);
        }
    }
}

__device__ void phase_out(const Params& p, int l, int bid, int nblk) {
    Bufs B(p);
    const int tid = threadIdx.x, cc = tid & 127, rg = tid >> 7;
    const float* W = p.in[l == 0 ? I_EWOUT : I_OWOUT];
    const int rt0 = l == 0 ? 0 : 16, nrt = R_ / 16 - rt0;
    for (int item = bid; item < nrt * 8; item += nblk) {
        const int rt = rt0 + item / 8, ct = item % 8, row0 = rt * 16, col = ct * 128 + cc;
        const bf16_t* ap[4];
#pragma unroll
        for (int i = 0; i < 4; ++i) ap[i] = B.mix + (size_t)(row0 + rg * 4 + i) * 1024;
        float acc[4];
        tile_linear<4>(acc, 1024, ap, W, 1024, col);
#pragma unroll
        for (int i = 0; i < 4; ++i) {
            const int r = row0 + rg * 4 + i;
            if (r < 256) B.xc[(size_t)r * 1024 + col] = p.in[I_CTX][(size_t)r * 1024 + col] + modp(B, l, 1, 2)[col] * acc[i];
            else { const size_t o = (size_t)(r - 256) * 1024 + col; p.out[o] = (l == 0 ? p.in[I_X][o] : p.out[o]) + modp(B, l, 0, 2)[col] * acc[i]; }
        }
    }
}

__device__ void phase_up(const Params& p, int l, char* lds, int bid, int nblk) {
    Bufs B(p);
    float* tile = (float*)lds;
    const int tid = threadIdx.x, cc = tid & 127, rg = tid >> 7;
    const float* W = p.in[I_FUP] + (size_t)l * 1024 * F2_;
    const float* cw = p.in[I_FCW] + (size_t)l * 3 * F2_; const float* cb = p.in[I_FCB] + (size_t)l * F2_;
    const int rt0 = l == 0 ? 0 : 16, nrt = R_ / 16 - rt0;
    for (int item = bid; item < nrt * 44; item += nblk) {
        const int rt = rt0 + item / 44, ct = item % 44, row0 = rt * 16, c0 = ct * 64;
        const int lo = row0 < 256 ? 0 : 256, hi = row0 < 256 ? 256 : R_;
        const int wcol = cc < 64 ? c0 + cc : F_ + c0 + (cc - 64);
        const bf16_t* ap[5];
#pragma unroll
        for (int i = 0; i < 5; ++i) { const int rr = rg * 5 + i, r = row0 - 1 + rr; ap[i] = (rr < 18 && r >= lo && r < hi) ? B.h + (size_t)r * 1024 : nullptr; }
        float acc[5];
        tile_linear<5>(acc, 1024, ap, W, F2_, wcol);
#pragma unroll
        for (int i = 0; i < 5; ++i) tile[(rg * 5 + i) * 128 + cc] = acc[i];
        __syncthreads();
        for (int e = tid; e < 16 * 64; e += NT) {
            const int rr = e >> 6, c = e & 63, ca = c0 + c, cg = F_ + c0 + c;
            const float a = cb[ca] + tile[rr * 128 + c] * cw[ca] + tile[(rr + 1) * 128 + c] * cw[F2_ + ca] + tile[(rr + 2) * 128 + c] * cw[2 * F2_ + ca];
            const float g = cb[cg] + tile[rr * 128 + 64 + c] * cw[cg] + tile[(rr + 1) * 128 + 64 + c] * cw[F2_ + cg] + tile[(rr + 2) * 128 + 64 + c] * cw[2 * F2_ + cg];
            B.act[(size_t)(row0 + rr) * F_ + ca] = f2bf(a * (g / (1.f + __expf(-g))));
        }
        __syncthreads();
    }
}

__device__ void phase_down(const Params& p, int l, int bid, int nblk) {
    Bufs B(p);
    const int tid = threadIdx.x, cc = tid & 127, rg = tid >> 7;
    const float* W = p.in[I_FDOWN] + (size_t)l * F_ * 1024;
    const int rt0 = l == 0 ? 0 : 16, nrt = R_ / 16 - rt0;
    for (int item = bid; item < nrt * 8; item += nblk) {
        const int rt = rt0 + item / 8, ct = item % 8, row0 = rt * 16, col = ct * 128 + cc;
        const bf16_t* ap[4];
#pragma unroll
        for (int i = 0; i < 4; ++i) ap[i] = B.act + (size_t)(row0 + rg * 4 + i) * F_;
        float acc[4];
        tile_linear<4>(acc, F_, ap, W, 1024, col);
#pragma unroll
        for (int i = 0; i < 4; ++i) {
            const int r = row0 + rg * 4 + i;
            if (r < 256) B.xc[(size_t)r * 1024 + col] += modp(B, l, 1, 5)[col] * acc[i];
            else p.out[(size_t)(r - 256) * 1024 + col] += modp(B, l, 0, 5)[col] * acc[i];
        }
    }
}

__device__ void phase_qkv1a(const Params& p, char* lds, int bid, int nblk) {
    Bufs B(p);
    float* tile = (float*)lds;
    const int tid = threadIdx.x, cc = tid & 127, rg = tid >> 7, wid = tid >> 6, lane = tid & 63;
    const float* W = p.in[I_OWIN];
    for (int item = bid; item < (R_ / 16) * 12; item += nblk) {
        const int rt = item / 12, ct = item % 12, row0 = rt * 16, v0 = ct * 128;
        const int v = v0 + cc;
        int wcol;
        if (v < 640) wcol = v; else if (v < 1152) wcol = 672 + (v - 640); else if (v < 1280) wcol = 1184 + (v - 1152); else if (v < 1408) wcol = 1312 + (v - 1280);
        else if (v < 1440) wcol = 640 + (v - 1408); else wcol = -1;
        const bf16_t* ap[4];
#pragma unroll
        for (int i = 0; i < 4; ++i) ap[i] = B.h + (size_t)(row0 + rg * 4 + i) * 1024;
        float acc[4];
        tile_linear<4>(acc, 1024, ap, W, 1440, wcol);
#pragma unroll
        for (int i = 0; i < 4; ++i) tile[(rg * 4 + i) * 128 + cc] = acc[i];
        __syncthreads();
        if (ct < 5) {
            for (int e = tid; e < 16 * 128; e += NT) {
                const int rr = e >> 7, c = e & 127, r = row0 + rr;
                if (ct < 3) B.qkv[O_CQ + (size_t)r * 384 + v0 + c] = f2bf(tile[e]);
                else B.qkv[O_CKV + (size_t)r * 256 + (v0 - 384) + c] = f2bf(tile[e]);
            }
        } else if (ct < 10) {
            for (int q = wid * 4; q < wid * 4 + 4; ++q) {
                const int rr = q >> 1, hh = q & 1, r = row0 + rr;
                if (ct < 9) head64_norm_rope(tile + rr * 128 + hh * 64, p.in[I_DQN], r >= 256, B.rope, r - 256, B.qkv + O_GQ + ((size_t)((ct - 5) * 2 + hh) * R_ + r) * 64, lane);
                else head64_norm_rope(tile + rr * 128 + hh * 64, p.in[I_DKN], r >= 256, B.rope, r - 256, B.qkv + O_GK + ((size_t)hh * R_ + r) * 64, lane);
            }
        } else if (ct == 10) {
            for (int e = tid; e < 16 * 128; e += NT) {
                const int c = e >> 4, rr = e & 15, r = row0 + rr;
                B.qkv[O_GVT + ((size_t)(c >> 6) * 64 + (c & 63)) * R_ + vpos(r)] = f2bf(tile[rr * 128 + c]);
            }
        } else {
            for (int e = tid; e < 16 * 32; e += NT) { const int rr = e >> 5, c = e & 31; B.qkv[O_CKR + (size_t)(row0 + rr) * 32 + c] = f2bf(tile[rr * 128 + c]); }
        }
        __syncthreads();
    }
}

__device__ __forceinline__ void head96_norm_rope(const float* row, const float* g, bool rope, const float* tab, int t, bf16_t* dst, int lane) {
    const float v0 = row[lane], v1 = lane < 32 ? row[64 + lane] : 0.f;
    const float ss = wave_sum(v0 * v0 + v1 * v1);
    const float rr = rsqrtf(ss * (1.f / 96.f) + EPS_);
    dst[lane] = f2bf(v0 * rr * g[lane]);
    if (lane < 32) {
        float y = v1 * rr * g[64 + lane];
        if (rope) {
            const float yp = row[64 + (lane ^ 16)] * rr * g[64 + (lane ^ 16)];
            const float2 cs = rope32(tab, t, lane & 15);
            y = lane < 16 ? (y * cs.x - yp * cs.y) : (yp * cs.y + y * cs.x);
        }
        dst[64 + lane] = f2bf(y);
    }
}

__device__ void phase_qkv1b(const Params& p, char* lds, int bid, int nblk) {
    Bufs B(p);
    float* tile = (float*)lds;
    float* rsl = (float*)lds + 16 * 128;
    const int tid = threadIdx.x, cc = tid & 127, rg = tid >> 7, wid = tid >> 6, lane = tid & 63;
    for (int item = bid; item < (R_ / 16) * 16; item += nblk) {
        const int rt = item / 16, ht = item % 16, row0 = rt * 16;
        const bool isq = ht < 8; const int head = ht & 7;
        const int K = isq ? 384 : 256;
        const bf16_t* src = B.qkv + (isq ? O_CQ : O_CKV);
        for (int rr = wid * 2; rr < wid * 2 + 2; ++rr) {
            float ss = 0.f;
            for (int k = lane; k < K; k += 64) { const float v = bf2f(src[(size_t)(row0 + rr) * K + k]); ss += v * v; }
            ss = wave_sum(ss);
            if (lane == 0) rsl[rr] = rsqrtf(ss / (float)K + EPS_);
        }
        __syncthreads();
        const bf16_t* ap[4]; float rs[4];
#pragma unroll
        for (int i = 0; i < 4; ++i) { ap[i] = src + (size_t)(row0 + rg * 4 + i) * K; rs[i] = rsl[rg * 4 + i]; }
        float acc[4];
        if (isq) tile_linear_g<4>(acc, 384, ap, rs, p.in[I_CQAN], p.in[I_CWQB], 768, cc < 96 ? head * 96 + cc : -1);
        else tile_linear_g<4>(acc, 256, ap, rs, p.in[I_CKVAN], p.in[I_CWKVB], 1024, head * 128 + cc);
#pragma unroll
        for (int i = 0; i < 4; ++i) tile[(rg * 4 + i) * 128 + cc] = acc[i];
        __syncthreads();
        if (isq) {
            for (int rr = wid * 2; rr < wid * 2 + 2; ++rr) { const int r = row0 + rr;
                head96_norm_rope(tile + rr * 128, p.in[I_CQN], r >= 256, B.rope, r - 256, B.qkv + O_MQ + ((size_t)head * R_ + r) * 96, lane); }
        } else {
            for (int e = tid; e < 16 * 64; e += NT) { const int d = e >> 4, rr = e & 15; B.qkv[O_MVT + ((size_t)head * 64 + d) * R_ + vpos(row0 + rr)] = f2bf(tile[rr * 128 + 64 + d]); }
            __syncthreads();
            for (int e = tid; e < 16 * 32; e += NT) { const int rr = e >> 5, c = e & 31; tile[rr * 128 + 64 + c] = bf2f(B.qkv[O_CKR + (size_t)(row0 + rr) * 32 + c]); }
            __syncthreads();
            for (int rr = wid * 2; rr < wid * 2 + 2; ++rr) { const int r = row0 + rr;
                head96_norm_rope(tile + rr * 128, p.in[I_CKN], r >= 256, B.rope, r - 256, B.qkv + O_MK + ((size_t)head * R_ + r) * 96, lane); }
        }
        __syncthreads();
    }
}

__device__ void phase_attn1(const Params& p, int bid, int nblk) {
    Bufs B(p);
    const int tid = threadIdx.x;
    for (int item = bid; item < 1024; item += nblk) {
        if (item < 512) {
            const int head = item / 64, half = tid >> 8, r = 256 + (item % 64) * 256 + (tid & 255);
            float O[32]; float l;
            naive_dense<96, 32>(B.qkv + O_MQ + ((size_t)head * R_ + r) * 96, B.qkv + O_MK + (size_t)head * R_ * 96, B.qkv + O_MVT + ((size_t)head * 64 + half * 32) * R_, R_, 0.10206207261596575f, O, l);
            const float inv = 1.f / l;
            bf16_t* dst = B.mix + (size_t)r * 1024 + head * 64 + half * 32;
#pragma unroll
            for (int d = 0; d < 32; d += 2) *(u32*)(dst + d) = (u32)f2bf(O[d] * inv) | ((u32)f2bf(O[d + 1] * inv) << 16);
        } else {
            const int idx = (item - 512) * NT + tid, half = idx / (8 * T_), hq = (idx / T_) & 7, t = idx % T_, r = 256 + t, kvh = hq >> 2;
            const bf16_t* q = B.qkv + O_GQ + ((size_t)hq * R_ + r) * 64;
            const bf16_t* Kb = B.qkv + O_GK + (size_t)kvh * R_ * 64;
            const bf16_t* VT = B.qkv + O_GVT + ((size_t)kvh * 64 + half * 32) * R_;
            u32x4 qp[8];
#pragma unroll
            for (int i = 0; i < 8; ++i) qp[i] = *(const u32x4*)(q + i * 8);
            float O[32];
#pragma unroll
            for (int d = 0; d < 32; ++d) O[d] = 0.f;
            float m = -1e30f, l = 0.f;
            const int j0 = max(t - 128, 0), j1 = min(t + 128, T_ - 1);
            const int nkeys = 256 + (j1 - j0 + 1);
            for (int kk = 0; kk < nkeys; ++kk) {
                const int key = kk < 256 ? kk : 256 + j0 + (kk - 256);
                const bf16_t* krow = Kb + (size_t)key * 64; float s = 0.f;
#pragma unroll
                for (int i = 0; i < 8; ++i) s += dot8p(*(const u32x4*)(krow + i * 8), qp[i].x, qp[i].y, qp[i].z, qp[i].w);
                s *= 0.125f;
                const float mn = fmaxf(m, s), alpha = __expf(m - mn), pp = __expf(s - mn);
                l = l * alpha + pp; m = mn;
                const int vp = vpos(key);
#pragma unroll
                for (int d = 0; d < 32; ++d) O[d] = O[d] * alpha + pp * bf2f(VT[(size_t)d * R_ + vp]);
            }
            { const float s = p.in[I_SINK][hq]; const float mn = fmaxf(m, s), alpha = __expf(m - mn); l = l * alpha + __expf(s - mn);
#pragma unroll
              for (int d = 0; d < 32; ++d) O[d] *= alpha; }
            const float inv = 1.f / l;
            bf16_t* dst = B.mix + (size_t)r * 1024 + 512 + hq * 64 + half * 32;
#pragma unroll
            for (int d = 0; d < 32; d += 2) *(u32*)(dst + d) = (u32)f2bf(O[d] * inv) | ((u32)f2bf(O[d + 1] * inv) << 16);
        }
    }
}

constexpr int NPHASE = 16;
__device__ __forceinline__ void run_phase(int ph, const Params& p, char* lds, int bid, int nblk) {
    switch (ph) {
        case 0: phase_prep(p, lds, bid, nblk); break;
        case 1: phase_norm(p, 0, 0, bid, nblk); break;
        case 2: phase_qkv0(p, lds, bid, nblk); break;
        case 3: phase_attn0(p, lds, bid, nblk); break;
        case 4: phase_out(p, 0, bid, nblk); break;
        case 5: phase_norm(p, 0, 1, bid, nblk); break;
        case 6: phase_up(p, 0, lds, bid, nblk); break;
        case 7: phase_down(p, 0, bid, nblk); break;
        case 8: phase_norm(p, 1, 0, bid, nblk); break;
        case 9: phase_qkv1a(p, lds, bid, nblk); break;
        case 10: phase_qkv1b(p, lds, bid, nblk); break;
        case 11: phase_attn1(p, bid, nblk); break;
        case 12: phase_out(p, 1, bid, nblk); break;
        case 13: phase_norm(p, 1, 1, bid, nblk); break;
        case 14: phase_up(p, 1, lds, bid, nblk); break;
        case 15: phase_down(p, 1, bid, nblk); break;
    }
}

template <int PH>
__global__ void __launch_bounds__(NT) k_phase(Params p) {
    __shared__ __attribute__((aligned(16))) char smem[40 * 1024];
    run_phase(PH, p, smem, blockIdx.x, gridDim.x);
}

template <int PH> static void launch_phase(const Params& p, int grid, hipStream_t s) { hipLaunchKernelGGL(k_phase<PH>, dim3(grid), dim3(NT), 0, s, p); }

extern "C" void kernel_launch(void* const* d_in, const int* in_sizes, int n_in, void* d_out, int out_size, void* d_ws, size_t ws_size, hipStream_t stream) {
    Params p{};
    for (int i = 0; i < 35; ++i) p.in[i] = (const float*)d_in[i];
    p.out = (float*)d_out; p.ws = (char*)d_ws;
    if (ws_size < WS_END) { fprintf(stderr, "ws too small: %zu < %zu\n", ws_size, (size_t)WS_END); return; }
    const int G = 2048;
    launch_phase<0>(p, 193, stream);
    launch_phase<1>(p, G, stream);
    launch_phase<2>(p, G, stream);
    launch_phase<3>(p, 780, stream);
    launch_phase<4>(p, G, stream);
    launch_phase<5>(p, G, stream);
    launch_phase<6>(p, G, stream);
    launch_phase<7>(p, G, stream);
    launch_phase<8>(p, G, stream);
    launch_phase<9>(p, G, stream);
    launch_phase<10>(p, G, stream);
    launch_phase<11>(p, 1024, stream);
    launch_phase<12>(p, G, stream);
    launch_phase<13>(p, G, stream);
    launch_phase<14>(p, G, stream);
    launch_phase<15>(p, G, stream);
}
```

```cpp
#include <hip/hip_runtime.h>
#include <hip/hip_cooperative_groups.h>
#include <cstdint>
#include <cstdio>
#include <cmath>

typedef unsigned short bf16_t;
typedef unsigned int u32;
typedef u32 u32x4 __attribute__((ext_vector_type(4)));

#define NT 512
constexpr int T_ = 16384, L_ = 256, R_ = 16640, D_ = 1024, F_ = 2816, F2_ = 5632;
constexpr float EPS_ = 1e-6f;

constexpr size_t WS_CTL = 0;
constexpr size_t WS_MOD = 4096;
constexpr size_t WS_SCAL = WS_MOD + 2 * 2 * 6144 * 4;
constexpr size_t WS_ROPE = WS_SCAL + 256;
constexpr size_t WS_XC = WS_ROPE + 256 * 16 * 2 * 4;
constexpr size_t WS_H = WS_XC + 256 * 1024 * 4;
constexpr size_t WS_MIX = WS_H + (size_t)(R_ + 8) * 1024 * 2;
constexpr size_t WS_QKV = WS_MIX + (size_t)R_ * 1024 * 2;
constexpr size_t E_SEG = (size_t)512 * R_;
constexpr size_t O_QA = 0, O_KA = E_SEG, O_VAT = 2 * E_SEG, O_QB = 3 * E_SEG, O_KB = 4 * E_SEG, O_VBT = 5 * E_SEG;
constexpr size_t O_CQ = 0, O_CKV = O_CQ + (size_t)R_ * 384, O_CKR = O_CKV + (size_t)R_ * 256, O_MQ = O_CKR + (size_t)R_ * 32,
                 O_MK = O_MQ + (size_t)R_ * 768, O_MVT = O_MK + (size_t)R_ * 768, O_GQ = O_MVT + (size_t)R_ * 512,
                 O_GK = O_GQ + (size_t)R_ * 512, O_GVT = O_GK + (size_t)R_ * 128, O_L1END = O_GVT + (size_t)R_ * 128;
constexpr size_t WS_QKV_BYTES = O_L1END * 2;
constexpr size_t WS_END = WS_QKV + WS_QKV_BYTES;
static_assert(WS_END < (size_t)250 * 1024 * 1024, "ws");
static_assert((size_t)(R_ + 8) * F_ * 2 <= WS_QKV_BYTES, "act alias");

struct Params { const float* in[35]; float* out; char* ws; };
enum { I_X = 0, I_C, I_CTX, I_CCTX, I_ADAW, I_ADAB, I_NMIX, I_NFFN, I_FUP, I_FCW, I_FCB, I_FDOWN, I_EWIN, I_EWOUT, I_AQN, I_AKN,
       I_LQ1, I_LK1, I_LQ2, I_LK2, I_SUBLN, I_BQN, I_BKN, I_RPB, I_OWIN, I_OWOUT, I_CQAN, I_CWQB, I_CKVAN, I_CWKVB, I_CQN, I_CKN,
       I_DQN, I_DKN, I_SINK };

__device__ __forceinline__ float bf2f(bf16_t v) { return __uint_as_float(((u32)v) << 16); }
__device__ __forceinline__ bf16_t f2bf(float f) { u32 u = __float_as_uint(f); return (bf16_t)((u + 0x7fffu + ((u >> 16) & 1u)) >> 16); }
__device__ __forceinline__ float wave_sum(float v) {
#pragma unroll
    for (int o = 32; o > 0; o >>= 1) v += __shfl_xor(v, o);
    return v;
}
__device__ __forceinline__ int swap23(int p) { return (p & 3) | ((p & 4) << 1) | ((p & 8) >> 1); }
__device__ __forceinline__ int vpos(int key) { return (key & ~15) + swap23(key & 15); }
__device__ __forceinline__ void unpack8(u32x4 v, float (&a)[8]) {
    a[0] = __uint_as_float(v.x << 16); a[1] = __uint_as_float(v.x & 0xffff0000u);
    a[2] = __uint_as_float(v.y << 16); a[3] = __uint_as_float(v.y & 0xffff0000u);
    a[4] = __uint_as_float(v.z << 16); a[5] = __uint_as_float(v.z & 0xffff0000u);
    a[6] = __uint_as_float(v.w << 16); a[7] = __uint_as_float(v.w & 0xffff0000u);
}

struct Bufs {
    float* mod; float* scal; float* rope; float* xc; bf16_t* h; bf16_t* mix; bf16_t* qkv; bf16_t* act;
    __device__ Bufs(const Params& p) {
        mod = (float*)(p.ws + WS_MOD); scal = (float*)(p.ws + WS_SCAL); rope = (float*)(p.ws + WS_ROPE); xc = (float*)(p.ws + WS_XC);
        h = (bf16_t*)(p.ws + WS_H); mix = (bf16_t*)(p.ws + WS_MIX); qkv = (bf16_t*)(p.ws + WS_QKV); act = (bf16_t*)(p.ws + WS_QKV);
    }
};
__device__ __forceinline__ const float* modp(const Bufs& B, int l, int s, int chunk) { return B.mod + ((size_t)(l * 2 + s) * 6144) + chunk * 1024; }

__device__ void phase_prep(const Params& p, char* lds, int bid, int nblk) {
    Bufs B(p);
    float* red = (float*)lds;
    const int tid = threadIdx.x;
    for (int item = bid; item < 193; item += nblk) {
        if (item < 192) {
            const int l = item / 96, n0 = (item % 96) * 64, nn = tid & 63, kc = tid >> 6;
            const float* W = p.in[I_ADAW] + (size_t)l * 1024 * 6144 + n0 + nn;
            float a0 = 0.f, a1 = 0.f;
            for (int k = kc * 128; k < kc * 128 + 128; ++k) {
                const float w = W[(size_t)k * 6144];
                const float c0 = p.in[I_C][k], c1 = p.in[I_CCTX][k];
                a0 += (c0 / (1.f + __expf(-c0))) * w; a1 += (c1 / (1.f + __expf(-c1))) * w;
            }
            red[(kc * 64 + nn) * 2] = a0; red[(kc * 64 + nn) * 2 + 1] = a1;
            __syncthreads();
            if (tid < 128) {
                const int n = tid & 63, s = tid >> 6; float acc = 0.f;
                for (int k = 0; k < 8; ++k) acc += red[(k * 64 + n) * 2 + s];
                B.mod[(size_t)(l * 2 + s) * 6144 + n0 + n] = acc + p.in[I_ADAB][l * 6144 + n0 + n];
            }
            __syncthreads();
        } else {
            for (int e = tid; e < 256 * 16; e += NT) {
                const int pos = e >> 4, i = e & 15;
                const double f = pow(10000.0, -(double)i / 16.0), ang = (double)pos * f;
                B.rope[e * 2] = (float)cos(ang); B.rope[e * 2 + 1] = (float)sin(ang);
            }
            if (tid < 64) {
                const float s1 = wave_sum(p.in[I_LQ1][tid] * p.in[I_LK1][tid]), s2 = wave_sum(p.in[I_LQ2][tid] * p.in[I_LK2][tid]);
                if (tid == 0) B.scal[0] = expf(s1) - expf(s2) + 0.2f;
            }
        }
    }
}

__device__ void phase_norm(const Params& p, int l, int which, int bid, int nblk) {
    Bufs B(p);
    const int wid = threadIdx.x >> 6, lane = threadIdx.x & 63;
    const float* gamma = p.in[which ? I_NFFN : I_NMIX] + l * 1024;
    for (int item = bid; item < R_ / 8; item += nblk) {
        const int r = item * 8 + wid;
        const bool first = (l == 0 && which == 0);
        const float* src = r < 256 ? ((first ? p.in[I_CTX] : B.xc) + (size_t)r * 1024) : ((first ? p.in[I_X] : p.out) + (size_t)(r - 256) * 1024);
        const int s = r < 256 ? 1 : 0;
        const float* sh = modp(B, l, s, which ? 3 : 0); const float* sc = modp(B, l, s, which ? 4 : 1);
        float v[16]; float ss = 0.f;
#pragma unroll
        for (int i = 0; i < 4; ++i) { const float4 t = *(const float4*)(src + i * 256 + lane * 4); v[4 * i] = t.x; v[4 * i + 1] = t.y; v[4 * i + 2] = t.z; v[4 * i + 3] = t.w; ss += t.x * t.x + t.y * t.y + t.z * t.z + t.w * t.w; }
        ss = wave_sum(ss);
        const float rr = rsqrtf(ss * (1.f / 1024.f) + EPS_);
#pragma unroll
        for (int i = 0; i < 4; ++i) {
            const int k = i * 256 + lane * 4; bf16_t o[4];
#pragma unroll
            for (int j = 0; j < 4; ++j) o[j] = f2bf(v[4 * i + j] * rr * gamma[k + j] * (1.f + sc[k + j]) + sh[k + j]);
            *(uint2*)(B.h + (size_t)r * 1024 + k) = make_uint2((u32)o[0] | ((u32)o[1] << 16), (u32)o[2] | ((u32)o[3] << 16));
        }
    }
}

template <int RPG>
__device__ __forceinline__ void tile_linear(float (&acc)[RPG], int K, const bf16_t* const (&ap)[RPG], const float* __restrict__ W, int ldw, int wcol) {
#pragma unroll
    for (int i = 0; i < RPG; ++i) acc[i] = 0.f;
    if (wcol < 0) return;
    for (int k = 0; k < K; k += 8) {
        float w[8];
#pragma unroll
        for (int j = 0; j < 8; ++j) w[j] = W[(size_t)(k + j) * ldw + wcol];
#pragma unroll
        for (int i = 0; i < RPG; ++i) {
            if (ap[i]) { float a[8]; unpack8(*(const u32x4*)(ap[i] + k), a);
#pragma unroll
                for (int j = 0; j < 8; ++j) acc[i] += a[j] * w[j]; }
        }
    }
}
template <int RPG>
__device__ __forceinline__ void tile_linear_g(float (&acc)[RPG], int K, const bf16_t* const (&ap)[RPG], const float (&rs)[RPG], const float* __restrict__ g, const float* __restrict__ W, int ldw, int wcol) {
#pragma unroll
    for (int i = 0; i < RPG; ++i) acc[i] = 0.f;
    if (wcol < 0) return;
    for (int k = 0; k < K; k += 8) {
        float w[8];
#pragma unroll
        for (int j = 0; j < 8; ++j) w[j] = W[(size_t)(k + j) * ldw + wcol] * g[k + j];
#pragma unroll
        for (int i = 0; i < RPG; ++i) {
            if (ap[i]) { float a[8]; unpack8(*(const u32x4*)(ap[i] + k), a); float t = 0.f;
#pragma unroll
                for (int j = 0; j < 8; ++j) t += a[j] * w[j];
                acc[i] += t * rs[i]; }
        }
    }
}

__device__ __forceinline__ float2 rope64(const float* tab, int t, int i) { const int pos = i < 16 ? (t >> 6) : (t & 63); const int f = i & 15; return *(const float2*)(tab + (pos * 16 + f) * 2); }
__device__ __forceinline__ float2 rope32(const float* tab, int t, int i) { const int pos = i < 8 ? (t >> 6) : (t & 63); const int f = (i & 7) * 2; return *(const float2*)(tab + (pos * 16 + f) * 2); }

__device__ __forceinline__ void head64_norm_rope(const float* row, const float* g, bool rope, const float* tab, int t, bf16_t* dst, int lane) {
    const float v = row[lane];
    const float ss = wave_sum(v * v);
    const float rr = rsqrtf(ss * (1.f / 64.f) + EPS_);
    float y = v * rr * g[lane];
    if (rope) {
        const float yp = row[lane ^ 32] * rr * g[lane ^ 32];
        const float2 cs = rope64(tab, t, lane & 31);
        y = lane < 32 ? (y * cs.x - yp * cs.y) : (yp * cs.y + y * cs.x);
    }
    dst[lane] = f2bf(y);
}

__device__ void phase_qkv0(const Params& p, char* lds, int bid, int nblk) {
    Bufs B(p);
    float* tile = (float*)lds;
    const int tid = threadIdx.x, cc = tid & 127, rg = tid >> 7, wid = tid >> 6, lane = tid & 63;
    const float* W = p.in[I_EWIN];
    for (int item = bid; item < (R_ / 16) * 24; item += nblk) {
        const int rt = item / 24, ct = item % 24, row0 = rt * 16, col0 = ct * 128;
        const bf16_t* ap[4];
#pragma unroll
        for (int i = 0; i < 4; ++i) ap[i] = B.h + (size_t)(row0 + rg * 4 + i) * 1024;
        float acc[4];
        tile_linear<4>(acc, 1024, ap, W, 3072, col0 + cc);
#pragma unroll
        for (int i = 0; i < 4; ++i) tile[(rg * 4 + i) * 128 + cc] = acc[i];
        __syncthreads();
        const int seg = col0 / 512, cin = col0 % 512;
        if (seg == 2 || seg == 5) {
            for (int e = tid; e < 16 * 128; e += NT) {
                const int c = e >> 4, rr = e & 15, r = row0 + rr;
                bf16_t* dst;
                if (seg == 2) dst = B.qkv + O_VAT + ((size_t)(cin / 128) * 128 + c) * R_;
                else dst = B.qkv + O_VBT + ((size_t)((cin + c) / 64) * 64 + (c & 63)) * R_;
                dst[vpos(r)] = f2bf(tile[rr * 128 + c]);
            }
        } else {
            for (int q = wid * 4; q < wid * 4 + 4; ++q) {
                const int rr = q >> 1, hh = q & 1, r = row0 + rr, head = cin / 64 + hh;
                const float* g = p.in[seg == 0 ? I_AQN : seg == 1 ? I_AKN : seg == 3 ? I_BQN : I_BKN];
                bf16_t* dst = B.qkv + (seg == 0 ? O_QA : seg == 1 ? O_KA : seg == 3 ? O_QB : O_KB) + ((size_t)head * R_ + r) * 64;
                head64_norm_rope(tile + rr * 128 + hh * 64, g, (seg < 2) && r >= 256, B.rope, r - 256, dst, lane);
            }
        }
        __syncthreads();
    }
}

__device__ __forceinline__ float dot8p(u32x4 k, u32 q0, u32 q1, u32 q2, u32 q3) {
    float t = __uint_as_float(k.x << 16) * __uint_as_float(q0 << 16);
    t += __uint_as_float(k.x & 0xffff0000u) * __uint_as_float(q0 & 0xffff0000u);
    t += __uint_as_float(k.y << 16) * __uint_as_float(q1 << 16);
    t += __uint_as_float(k.y & 0xffff0000u) * __uint_as_float(q1 & 0xffff0000u);
    t += __uint_as_float(k.z << 16) * __uint_as_float(q2 << 16);
    t += __uint_as_float(k.z & 0xffff0000u) * __uint_as_float(q2 & 0xffff0000u);
    t += __uint_as_float(k.w << 16) * __uint_as_float(q3 << 16);
    t += __uint_as_float(k.w & 0xffff0000u) * __uint_as_float(q3 & 0xffff0000u);
    return t;
}
template <int DQK, int DVT>
__device__ __forceinline__ void naive_dense(const bf16_t* __restrict__ q, const bf16_t* __restrict__ Kb, const bf16_t* __restrict__ VT, int nk, float scale, float (&O)[DVT], float& lsum) {
    u32x4 qp[DQK / 8];
#pragma unroll
    for (int i = 0; i < DQK / 8; ++i) qp[i] = *(const u32x4*)(q + i * 8);
#pragma unroll
    for (int d = 0; d < DVT; ++d) O[d] = 0.f;
    float m = -1e30f, l = 0.f;
    for (int c = 0; c < nk; c += 8) {
        float s[8];
#pragma unroll
        for (int j = 0; j < 8; ++j) {
            const int key = (c & ~15) + swap23((c & 15) + j);
            const bf16_t* kr = Kb + (size_t)key * DQK; float t = 0.f;
#pragma unroll
            for (int i = 0; i < DQK / 8; ++i) t += dot8p(*(const u32x4*)(kr + i * 8), qp[i].x, qp[i].y, qp[i].z, qp[i].w);
            s[j] = t * scale;
        }
        float cm = s[0];
#pragma unroll
        for (int j = 1; j < 8; ++j) cm = fmaxf(cm, s[j]);
        const float mn = fmaxf(m, cm), alpha = __expf(m - mn);
        float ps = 0.f;
#pragma unroll
        for (int j = 0; j < 8; ++j) { s[j] = __expf(s[j] - mn); ps += s[j]; }
        l = l * alpha + ps; m = mn;
#pragma unroll
        for (int d = 0; d < DVT; ++d) {
            float a[8]; unpack8(*(const u32x4*)(VT + (size_t)d * R_ + c), a);
            float t = O[d] * alpha;
#pragma unroll
            for (int j = 0; j < 8; ++j) t += s[j] * a[j];
            O[d] = t;
            if ((d & 7) == 7) __builtin_amdgcn_sched_barrier(0);
        }
    }
    lsum = l;
}

__device__ void phase_attn0(const Params& p, char* lds, int bid, int nblk) {
    Bufs B(p);
    const int tid = threadIdx.x;
    float* xch = (float*)lds;
    const float lam = B.scal[0];
    for (int item = bid; item < 1300; item += nblk) {
        if (item < 1040) {
            const int head = item / 260, chunk = item % 260, role = tid >> 6, m = role >> 2, qt = role & 3, qi = tid & 63, r = chunk * 64 + qi, sub = head * 2 + m;
            const int nk = chunk < 4 ? 256 : R_;
            float O[32]; float l;
            naive_dense<64, 32>(B.qkv + O_QA + ((size_t)sub * R_ + r) * 64, B.qkv + O_KA + (size_t)sub * R_ * 64, B.qkv + O_VAT + ((size_t)head * 128 + qt * 32) * R_, nk, 0.125f, O, l);
            const float inv = 1.f / l;
#pragma unroll
            for (int d = 0; d < 32; ++d) O[d] *= inv;
            float* xh = xch + (qt * 64 + qi) * 33;
            __syncthreads();
            if (m == 1) {
#pragma unroll
                for (int d = 0; d < 32; ++d) xh[d] = O[d];
            }
            __syncthreads();
            if (m == 0) {
#pragma unroll
                for (int d = 0; d < 32; ++d) O[d] -= lam * xh[d];
            }
            __syncthreads();
            float ss = 0.f;
#pragma unroll
            for (int d = 0; d < 32; ++d) ss += O[d] * O[d];
            if (m == 0) xh[0] = ss;
            __syncthreads();
            if (m == 0) {
                const float tot = xch[(0 * 64 + qi) * 33] + xch[(1 * 64 + qi) * 33] + xch[(2 * 64 + qi) * 33] + xch[(3 * 64 + qi) * 33];
                const float rr = rsqrtf(tot * (1.f / 128.f) + EPS_) * 0.8f;
                bf16_t* dst = B.mix + (size_t)r * 1024 + head * 128 + qt * 32;
                const float* g = p.in[I_SUBLN] + qt * 32;
#pragma unroll
                for (int d = 0; d < 32; d += 2) *(u32*)(dst + d) = (u32)f2bf(O[d] * rr * g[d]) | ((u32)f2bf(O[d + 1] * rr * g[d + 1]) << 16);
            }
            __syncthreads();
        } else {
            const int idx = (item - 1040) * NT + tid, h = idx / R_, r = idx % R_;
            const bf16_t* q = B.qkv + O_QB + ((size_t)h * R_ + r) * 64;
            const bf16_t* Kb = B.qkv + O_KB + (size_t)h * R_ * 64;
            const bf16_t* VT = B.qkv + O_VBT + (size_t)h * 64 * R_;
            float qf[64];
#pragma unroll
            for (int i = 0; i < 8; ++i) { float a[8]; unpack8(*(const u32x4*)(q + i * 8), a);
#pragma unroll
                for (int j = 0; j < 8; ++j) qf[i * 8 + j] = a[j] * 0.125f; }
            float O[64];
#pragma unroll
            for (int d = 0; d < 64; ++d) O[d] = 0.f;
            float m = -1e30f, l = 0.f;
            const int t = r - 256, row = t >> 6, col = t & 63;
            const int rs = min(max(row - 4, 0), 248), cs = min(max(col - 8, 0), 48);
            const int nkeys = r < 256 ? 256 : 384;
            for (int kk = 0; kk < nkeys; ++kk) {
                int key; float bias = 0.f;
                if (kk < 256) key = kk;
                else { const int w = kk - 256, kr = rs + (w >> 4), kc = cs + (w & 15); key = 256 + kr * 64 + kc; bias = p.in[I_RPB][(h * 15 + (kr - row + 7)) * 31 + (kc - col + 15)]; }
                const bf16_t* krow = Kb + (size_t)key * 64; float s = bias;
#pragma unroll
                for (int i = 0; i < 8; ++i) { float a[8]; unpack8(*(const u32x4*)(krow + i * 8), a);
#pragma unroll
                    for (int j = 0; j < 8; ++j) s += a[j] * qf[i * 8 + j]; }
                const float mn = fmaxf(m, s), alpha = __expf(m - mn), pp = __expf(s - mn);
                l = l * alpha + pp; m = mn;
                const int vp = vpos(key);
#pragma unroll
                for (int d = 0; d < 64; ++d) O[d] = O[d] * alpha + pp * bf2f(VT[(size_t)d * R_ + vp]);
            }
            const float inv = 1.f / l;
            bf16_t* dst = B.mix + (size_t)r * 1024 + 512 + h * 64;
#pragma unroll
            for (int d = 0; d < 64; d += 2) *(u32*)(dst + d) = (u32)f2bf(O[d] * inv) | ((u32)f2bf(O[d + 1] * inv) << 16);
        }
    }
}

__device__ void phase_out(const Params& p, int l, int bid, int nblk) {
    Bufs B(p);
    const int tid = threadIdx.x, cc = tid & 127, rg = tid >> 7;
    const float* W = p.in[l == 0 ? I_EWOUT : I_OWOUT];
    const int rt0 = l == 0 ? 0 : 16, nrt = R_ / 16 - rt0;
    for (int item = bid; item < nrt * 8; item += nblk) {
        const int rt = rt0 + item / 8, ct = item % 8, row0 = rt * 16, col = ct * 128 + cc;
        const bf16_t* ap[4];
#pragma unroll
        for (int i = 0; i < 4; ++i) ap[i] = B.mix + (size_t)(row0 + rg * 4 + i) * 1024;
        float acc[4];
        tile_linear<4>(acc, 1024, ap, W, 1024, col);
#pragma unroll
        for (int i = 0; i < 4; ++i) {
            const int r = row0 + rg * 4 + i;
            if (r < 256) B.xc[(size_t)r * 1024 + col] = p.in[I_CTX][(size_t)r * 1024 + col] + modp(B, l, 1, 2)[col] * acc[i];
            else { const size_t o = (size_t)(r - 256) * 1024 + col; p.out[o] = (l == 0 ? p.in[I_X][o] : p.out[o]) + modp(B, l, 0, 2)[col] * acc[i]; }
        }
    }
}

__device__ void phase_up(const Params& p, int l, char* lds, int bid, int nblk) {
    Bufs B(p);
    float* tile = (float*)lds;
    const int tid = threadIdx.x, cc = tid & 127, rg = tid >> 7;
    const float* W = p.in[I_FUP] + (size_t)l * 1024 * F2_;
    const float* cw = p.in[I_FCW] + (size_t)l * 3 * F2_; const float* cb = p.in[I_FCB] + (size_t)l * F2_;
    const int rt0 = l == 0 ? 0 : 16, nrt = R_ / 16 - rt0;
    for (int item = bid; item < nrt * 44; item += nblk) {
        const int rt = rt0 + item / 44, ct = item % 44, row0 = rt * 16, c0 = ct * 64;
        const int lo = row0 < 256 ? 0 : 256, hi = row0 < 256 ? 256 : R_;
        const int wcol = cc < 64 ? c0 + cc : F_ + c0 + (cc - 64);
        const bf16_t* ap[5];
#pragma unroll
        for (int i = 0; i < 5; ++i) { const int rr = rg * 5 + i, r = row0 - 1 + rr; ap[i] = (rr < 18 && r >= lo && r < hi) ? B.h + (size_t)r * 1024 : nullptr; }
        float acc[5];
        tile_linear<5>(acc, 1024, ap, W, F2_, wcol);
#pragma unroll
        for (int i = 0; i < 5; ++i) tile[(rg * 5 + i) * 128 + cc] = acc[i];
        __syncthreads();
        for (int e = tid; e < 16 * 64; e += NT) {
            const int rr = e >> 6, c = e & 63, ca = c0 + c, cg = F_ + c0 + c;
            const float a = cb[ca] + tile[rr * 128 + c] * cw[ca] + tile[(rr + 1) * 128 + c] * cw[F2_ + ca] + tile[(rr + 2) * 128 + c] * cw[2 * F2_ + ca];
            const float g = cb[cg] + tile[rr * 128 + 64 + c] * cw[cg] + tile[(rr + 1) * 128 + 64 + c] * cw[F2_ + cg] + tile[(rr + 2) * 128 + 64 + c] * cw[2 * F2_ + cg];
            B.act[(size_t)(row0 + rr) * F_ + ca] = f2bf(a * (g / (1.f + __expf(-g))));
        }
        __syncthreads();
    }
}

__device__ void phase_down(const Params& p, int l, int bid, int nblk) {
    Bufs B(p);
    const int tid = threadIdx.x, cc = tid & 127, rg = tid >> 7;
    const float* W = p.in[I_FDOWN] + (size_t)l * F_ * 1024;
    const int rt0 = l == 0 ? 0 : 16, nrt = R_ / 16 - rt0;
    for (int item = bid; item < nrt * 8; item += nblk) {
        const int rt = rt0 + item / 8, ct = item % 8, row0 = rt * 16, col = ct * 128 + cc;
        const bf16_t* ap[4];
#pragma unroll
        for (int i = 0; i < 4; ++i) ap[i] = B.act + (size_t)(row0 + rg * 4 + i) * F_;
        float acc[4];
        tile_linear<4>(acc, F_, ap, W, 1024, col);
#pragma unroll
        for (int i = 0; i < 4; ++i) {
            const int r = row0 + rg * 4 + i;
            if (r < 256) B.xc[(size_t)r * 1024 + col] += modp(B, l, 1, 5)[col] * acc[i];
            else p.out[(size_t)(r - 256) * 1024 + col] += modp(B, l, 0, 5)[col] * acc[i];
        }
    }
}

__device__ void phase_qkv1a(const Params& p, char* lds, int bid, int nblk) {
    Bufs B(p);
    float* tile = (float*)lds;
    const int tid = threadIdx.x, cc = tid & 127, rg = tid >> 7, wid = tid >> 6, lane = tid & 63;
    const float* W = p.in[I_OWIN];
    for (int item = bid; item < (R_ / 16) * 12; item += nblk) {
        const int rt = item / 12, ct = item % 12, row0 = rt * 16, v0 = ct * 128;
        const int v = v0 + cc;
        int wcol;
        if (v < 640) wcol = v; else if (v < 1152) wcol = 672 + (v - 640); else if (v < 1280) wcol = 1184 + (v - 1152); else if (v < 1408) wcol = 1312 + (v - 1280);
        else if (v < 1440) wcol = 640 + (v - 1408); else wcol = -1;
        const bf16_t* ap[4];
#pragma unroll
        for (int i = 0; i < 4; ++i) ap[i] = B.h + (size_t)(row0 + rg * 4 + i) * 1024;
        float acc[4];
        tile_linear<4>(acc, 1024, ap, W, 1440, wcol);
#pragma unroll
        for (int i = 0; i < 4; ++i) tile[(rg * 4 + i) * 128 + cc] = acc[i];
        __syncthreads();
        if (ct < 5) {
            for (int e = tid; e < 16 * 128; e += NT) {
                const int rr = e >> 7, c = e & 127, r = row0 + rr;
                if (ct < 3) B.qkv[O_CQ + (size_t)r * 384 + v0 + c] = f2bf(tile[e]);
                else B.qkv[O_CKV + (size_t)r * 256 + (v0 - 384) + c] = f2bf(tile[e]);
            }
        } else if (ct < 10) {
            for (int q = wid * 4; q < wid * 4 + 4; ++q) {
                const int rr = q >> 1, hh = q & 1, r = row0 + rr;
                if (ct < 9) head64_norm_rope(tile + rr * 128 + hh * 64, p.in[I_DQN], r >= 256, B.rope, r - 256, B.qkv + O_GQ + ((size_t)((ct - 5) * 2 + hh) * R_ + r) * 64, lane);
                else head64_norm_rope(tile + rr * 128 + hh * 64, p.in[I_DKN], r >= 256, B.rope, r - 256, B.qkv + O_GK + ((size_t)hh * R_ + r) * 64, lane);
            }
        } else if (ct == 10) {
            for (int e = tid; e < 16 * 128; e += NT) {
                const int c = e >> 4, rr = e & 15, r = row0 + rr;
                B.qkv[O_GVT + ((size_t)(c >> 6) * 64 + (c & 63)) * R_ + vpos(r)] = f2bf(tile[rr * 128 + c]);
            }
        } else {
            for (int e = tid; e < 16 * 32; e += NT) { const int rr = e >> 5, c = e & 31; B.qkv[O_CKR + (size_t)(row0 + rr) * 32 + c] = f2bf(tile[rr * 128 + c]); }
        }
        __syncthreads();
    }
}

__device__ __forceinline__ void head96_norm_rope(const float* row, const float* g, bool rope, const float* tab, int t, bf16_t* dst, int lane) {
    const float v0 = row[lane], v1 = lane < 32 ? row[64 + lane] : 0.f;
    const float ss = wave_sum(v0 * v0 + v1 * v1);
    const float rr = rsqrtf(ss * (1.f / 96.f) + EPS_);
    dst[lane] = f2bf(v0 * rr * g[lane]);
    if (lane < 32) {
        float y = v1 * rr * g[64 + lane];
        if (rope) {
            const float yp = row[64 + (lane ^ 16)] * rr * g[64 + (lane ^ 16)];
            const float2 cs = rope32(tab, t, lane & 15);
            y = lane < 16 ? (y * cs.x - yp * cs.y) : (yp * cs.y + y * cs.x);
        }
        dst[64 + lane] = f2bf(y);
    }
}

__device__ void phase_qkv1b(const Params& p, char* lds, int bid, int nblk) {
    Bufs B(p);
    float* tile = (float*)lds;
    float* rsl = (float*)lds + 16 * 128;
    const int tid = threadIdx.x, cc = tid & 127, rg = tid >> 7, wid = tid >> 6, lane = tid & 63;
    for (int item = bid; item < (R_ / 16) * 16; item += nblk) {
        const int rt = item / 16, ht = item % 16, row0 = rt * 16;
        const bool isq = ht < 8; const int head = ht & 7;
        const int K = isq ? 384 : 256;
        const bf16_t* src = B.qkv + (isq ? O_CQ : O_CKV);
        for (int rr = wid * 2; rr < wid * 2 + 2; ++rr) {
            float ss = 0.f;
            for (int k = lane; k < K; k += 64) { const float v = bf2f(src[(size_t)(row0 + rr) * K + k]); ss += v * v; }
            ss = wave_sum(ss);
            if (lane == 0) rsl[rr] = rsqrtf(ss / (float)K + EPS_);
        }
        __syncthreads();
        const bf16_t* ap[4]; float rs[4];
#pragma unroll
        for (int i = 0; i < 4; ++i) { ap[i] = src + (size_t)(row0 + rg * 4 + i) * K; rs[i] = rsl[rg * 4 + i]; }
        float acc[4];
        if (isq) tile_linear_g<4>(acc, 384, ap, rs, p.in[I_CQAN], p.in[I_CWQB], 768, cc < 96 ? head * 96 + cc : -1);
        else tile_linear_g<4>(acc, 256, ap, rs, p.in[I_CKVAN], p.in[I_CWKVB], 1024, head * 128 + cc);
#pragma unroll
        for (int i = 0; i < 4; ++i) tile[(rg * 4 + i) * 128 + cc] = acc[i];
        __syncthreads();
        if (isq) {
            for (int rr = wid * 2; rr < wid * 2 + 2; ++rr) { const int r = row0 + rr;
                head96_norm_rope(tile + rr * 128, p.in[I_CQN], r >= 256, B.rope, r - 256, B.qkv + O_MQ + ((size_t)head * R_ + r) * 96, lane); }
        } else {
            for (int e = tid; e < 16 * 64; e += NT) { const int d = e >> 4, rr = e & 15; B.qkv[O_MVT + ((size_t)head * 64 + d) * R_ + vpos(row0 + rr)] = f2bf(tile[rr * 128 + 64 + d]); }
            __syncthreads();
            for (int e = tid; e < 16 * 32; e += NT) { const int rr = e >> 5, c = e & 31; tile[rr * 128 + 64 + c] = bf2f(B.qkv[O_CKR + (size_t)(row0 + rr) * 32 + c]); }
            __syncthreads();
            for (int rr = wid * 2; rr < wid * 2 + 2; ++rr) { const int r = row0 + rr;
                head96_norm_rope(tile + rr * 128, p.in[I_CKN], r >= 256, B.rope, r - 256, B.qkv + O_MK + ((size_t)head * R_ + r) * 96, lane); }
        }
        __syncthreads();
    }
}

__device__ void phase_attn1(const Params& p, int bid, int nblk) {
    Bufs B(p);
    const int tid = threadIdx.x;
    for (int item = bid; item < 1024; item += nblk) {
        if (item < 512) {
            const int head = item / 64, half = tid >> 8, r = 256 + (item % 64) * 256 + (tid & 255);
            float O[32]; float l;
            naive_dense<96, 32>(B.qkv + O_MQ + ((size_t)head * R_ + r) * 96, B.qkv + O_MK + (size_t)head * R_ * 96, B.qkv + O_MVT + ((size_t)head * 64 + half * 32) * R_, R_, 0.10206207261596575f, O, l);
            const float inv = 1.f / l;
            bf16_t* dst = B.mix + (size_t)r * 1024 + head * 64 + half * 32;
#pragma unroll
            for (int d = 0; d < 32; d += 2) *(u32*)(dst + d) = (u32)f2bf(O[d] * inv) | ((u32)f2bf(O[d + 1] * inv) << 16);
        } else {
            const int idx = (item - 512) * NT + tid, half = idx / (8 * T_), hq = (idx / T_) & 7, t = idx % T_, r = 256 + t, kvh = hq >> 2;
            const bf16_t* q = B.qkv + O_GQ + ((size_t)hq * R_ + r) * 64;
            const bf16_t* Kb = B.qkv + O_GK + (size_t)kvh * R_ * 64;
            const bf16_t* VT = B.qkv + O_GVT + ((size_t)kvh * 64 + half * 32) * R_;
            u32x4 qp[8];
#pragma unroll
            for (int i = 0; i < 8; ++i) qp[i] = *(const u32x4*)(q + i * 8);
            float O[32];
#pragma unroll
            for (int d = 0; d < 32; ++d) O[d] = 0.f;
            float m = -1e30f, l = 0.f;
            const int j0 = max(t - 128, 0), j1 = min(t + 128, T_ - 1);
            const int nkeys = 256 + (j1 - j0 + 1);
            for (int kk = 0; kk < nkeys; ++kk) {
                const int key = kk < 256 ? kk : 256 + j0 + (kk - 256);
                const bf16_t* krow = Kb + (size_t)key * 64; float s = 0.f;
#pragma unroll
                for (int i = 0; i < 8; ++i) s += dot8p(*(const u32x4*)(krow + i * 8), qp[i].x, qp[i].y, qp[i].z, qp[i].w);
                s *= 0.125f;
                const float mn = fmaxf(m, s), alpha = __expf(m - mn), pp = __expf(s - mn);
                l = l * alpha + pp; m = mn;
                const int vp = vpos(key);
#pragma unroll
                for (int d = 0; d < 32; ++d) O[d] = O[d] * alpha + pp * bf2f(VT[(size_t)d * R_ + vp]);
            }
            { const float s = p.in[I_SINK][hq]; const float mn = fmaxf(m, s), alpha = __expf(m - mn); l = l * alpha + __expf(s - mn);
#pragma unroll
              for (int d = 0; d < 32; ++d) O[d] *= alpha; }
            const float inv = 1.f / l;
            bf16_t* dst = B.mix + (size_t)r * 1024 + 512 + hq * 64 + half * 32;
#pragma unroll
            for (int d = 0; d < 32; d += 2) *(u32*)(dst + d) = (u32)f2bf(O[d] * inv) | ((u32)f2bf(O[d + 1] * inv) << 16);
        }
    }
}

constexpr int NPHASE = 16;
__device__ __forceinline__ void run_phase(int ph, const Params& p, char* lds, int bid, int nblk) {
    switch (ph) {
        case 0: phase_prep(p, lds, bid, nblk); break;
        case 1: phase_norm(p, 0, 0, bid, nblk); break;
        case 2: phase_qkv0(p, lds, bid, nblk); break;
        case 3: phase_attn0(p, lds, bid, nblk); break;
        case 4: phase_out(p, 0, bid, nblk); break;
        case 5: phase_norm(p, 0, 1, bid, nblk); break;
        case 6: phase_up(p, 0, lds, bid, nblk); break;
        case 7: phase_down(p, 0, bid, nblk); break;
        case 8: phase_norm(p, 1, 0, bid, nblk); break;
        case 9: phase_qkv1a(p, lds, bid, nblk); break;
        case 10: phase_qkv1b(p, lds, bid, nblk); break;
        case 11: phase_attn1(p, bid, nblk); break;
        case 12: phase_out(p, 1, bid, nblk); break;
        case 13: phase_norm(p, 1, 1, bid, nblk); break;
        case 14: phase_up(p, 1, lds, bid, nblk); break;
        case 15: phase_down(p, 1, bid, nblk); break;
    }
}

template <int PH>
__global__ void __launch_bounds__(NT) k_phase(Params p) {
    __shared__ __attribute__((aligned(16))) char smem[40 * 1024];
    run_phase(PH, p, smem, blockIdx.x, gridDim.x);
}

template <int PH> static void launch_phase(const Params& p, int grid, hipStream_t s) { hipLaunchKernelGGL(k_phase<PH>, dim3(grid), dim3(NT), 0, s, p); }

namespace cg = cooperative_groups;
__global__ void __launch_bounds__(NT) k_mega(Params p) {
    __shared__ __attribute__((aligned(16))) char smem[40 * 1024];
    cg::grid_group grid = cg::this_grid();
    const int bid = blockIdx.x, nblk = gridDim.x;
#define PH(n) run_phase(n, p, smem, bid, nblk)
    PH(0); grid.sync(); PH(1); grid.sync(); PH(2); grid.sync(); PH(3); grid.sync(); PH(4); grid.sync(); PH(5); grid.sync(); PH(6); grid.sync(); PH(7); grid.sync();
    PH(8); grid.sync(); PH(9); grid.sync(); PH(10); grid.sync(); PH(11); grid.sync(); PH(12); grid.sync(); PH(13); grid.sync(); PH(14); grid.sync(); PH(15);
#undef PH
}

#ifndef MEGA
#define MEGA 1
#endif

extern "C" void kernel_launch(void* const* d_in, const int* in_sizes, int n_in, void* d_out, int out_size, void* d_ws, size_t ws_size, hipStream_t stream) {
    Params p{};
    for (int i = 0; i < 35; ++i) p.in[i] = (const float*)d_in[i];
    p.out = (float*)d_out; p.ws = (char*)d_ws;
    if (ws_size < WS_END) { fprintf(stderr, "ws too small: %zu < %zu\n", ws_size, (size_t)WS_END); return; }
#if MEGA
    static int grid_blocks = 0;
    if (!grid_blocks) {
        int dev = 0, cus = 0, per_cu = 0;
        hipGetDevice(&dev);
        hipDeviceGetAttribute(&cus, hipDeviceAttributeMultiprocessorCount, dev);
        hipOccupancyMaxActiveBlocksPerMultiprocessor(&per_cu, (const void*)k_mega, NT, 0);
        if (per_cu < 1) { fprintf(stderr, "occupancy query returned %d\n", per_cu); per_cu = 1; }
        if (per_cu > 1) per_cu = 1;
        grid_blocks = cus * per_cu;
    }
    void* args[] = {&p};
    hipError_t e = hipLaunchCooperativeKernel((const void*)k_mega, dim3(grid_blocks), dim3(NT), args, 0, stream);
    if (e != hipSuccess) fprintf(stderr, "cooperative launch failed: %s (grid %d)\n", hipGetErrorString(e), grid_blocks);
#else
    const int G = 2048;
    launch_phase<0>(p, 193, stream);
    launch_phase<1>(p, G, stream);
    launch_phase<2>(p, G, stream);
    launch_phase<3>(p, 1300, stream);
    launch_phase<4>(p, G, stream);
    launch_phase<5>(p, G, stream);
    launch_phase<6>(p, G, stream);
    launch_phase<7>(p, G, stream);
    launch_phase<8>(p, G, stream);
    launch_phase<9>(p, G, stream);
    launch_phase<10>(p, G, stream);
    launch_phase<11>(p, 1024, stream);
    launch_phase<12>(p, G, stream);
    launch_phase<13>(p, G, stream);
    launch_phase<14>(p, G, stream);
    launch_phase<15>(p, G, stream);
#endif
}
```

```cpp
#include <hip/hip_runtime.h>
#include <hip/hip_cooperative_groups.h>
#include <cstdint>
#include <cstdio>
#include <cmath>

typedef unsigned short bf16_t;
typedef unsigned int u32;
typedef u32 u32x4 __attribute__((ext_vector_type(4)));

#define NT 512
constexpr int T_ = 16384, L_ = 256, R_ = 16640, D_ = 1024, F_ = 2816, F2_ = 5632;
constexpr float EPS_ = 1e-6f;

constexpr size_t WS_CTL = 0;
constexpr size_t WS_MOD = 4096;
constexpr size_t WS_SCAL = WS_MOD + 2 * 2 * 6144 * 4;
constexpr size_t WS_GT = WS_SCAL + 256;
constexpr size_t WS_ROPE = WS_GT + 6 * 64 * 4;
constexpr size_t WS_XC = WS_ROPE + 256 * 16 * 2 * 4;
constexpr size_t WS_H = WS_XC + 256 * 1024 * 4;
constexpr int HROWS = R_ + 144;
constexpr size_t WS_MIX = WS_H + (size_t)HROWS * 1024 * 2;
constexpr size_t WS_QKV = WS_MIX + (size_t)R_ * 1024 * 2;
constexpr size_t E_SEG = (size_t)512 * R_;
constexpr size_t O_QA = 0, O_KA = E_SEG, O_VAT = 2 * E_SEG, O_QB = 3 * E_SEG, O_KB = 4 * E_SEG, O_VBT = 5 * E_SEG;
constexpr size_t O_CQ = 0, O_CKV = O_CQ + (size_t)R_ * 384, O_CKR = O_CKV + (size_t)R_ * 256, O_MQ = O_CKR + (size_t)R_ * 32,
                 O_MK = O_MQ + (size_t)R_ * 768, O_MVT = O_MK + (size_t)R_ * 768, O_GQ = O_MVT + (size_t)R_ * 512,
                 O_GK = O_GQ + (size_t)R_ * 512, O_GVT = O_GK + (size_t)R_ * 128, O_L1END = O_GVT + (size_t)R_ * 128;
constexpr size_t WS_QKV_BYTES = O_L1END * 2;
constexpr size_t WS_PART = WS_QKV + WS_QKV_BYTES;
constexpr size_t WS_WT = WS_PART + (size_t)R_ * 12 * 4;
constexpr size_t W_EIN = 0, W_EOUT = W_EIN + (size_t)3072 * 1024, W_UP = W_EOUT + (size_t)1024 * 1024, W_DOWN = W_UP + (size_t)2 * 5632 * 1024,
                 W_OIN = W_DOWN + (size_t)2 * 1024 * 2816, W_OOUT = W_OIN + (size_t)1536 * 1024, W_QB = W_OOUT + (size_t)1024 * 1024,
                 W_KVB = W_QB + (size_t)1024 * 384, W_END = W_KVB + (size_t)1024 * 256;
constexpr size_t WS_END = WS_WT + W_END * 2;
static_assert(WS_END < (size_t)255 * 1024 * 1024, "ws");
static_assert((size_t)(R_ + 8) * F_ * 2 <= WS_QKV_BYTES, "act alias");

struct Params { const float* in[35]; float* out; char* ws; };
enum { I_X = 0, I_C, I_CTX, I_CCTX, I_ADAW, I_ADAB, I_NMIX, I_NFFN, I_FUP, I_FCW, I_FCB, I_FDOWN, I_EWIN, I_EWOUT, I_AQN, I_AKN,
       I_LQ1, I_LK1, I_LQ2, I_LK2, I_SUBLN, I_BQN, I_BKN, I_RPB, I_OWIN, I_OWOUT, I_CQAN, I_CWQB, I_CKVAN, I_CWKVB, I_CQN, I_CKN,
       I_DQN, I_DKN, I_SINK };

__device__ __forceinline__ float bf2f(bf16_t v) { return __uint_as_float(((u32)v) << 16); }
__device__ __forceinline__ bf16_t f2bf(float f) { u32 u = __float_as_uint(f); return (bf16_t)((u + 0x7fffu + ((u >> 16) & 1u)) >> 16); }
__device__ __forceinline__ float wave_sum(float v) {
#pragma unroll
    for (int o = 32; o > 0; o >>= 1) v += __shfl_xor(v, o);
    return v;
}
__device__ __forceinline__ int swap23(int p) { return (p & 3) | ((p & 4) << 1) | ((p & 8) >> 1); }
__device__ __forceinline__ int hrow(int r) { return r < 256 ? r + 1 : r + 2; }
__device__ __forceinline__ int vpos(int key) { return (key & ~15) + swap23(key & 15); }
__device__ __forceinline__ void unpack8(u32x4 v, float (&a)[8]) {
    a[0] = __uint_as_float(v.x << 16); a[1] = __uint_as_float(v.x & 0xffff0000u);
    a[2] = __uint_as_float(v.y << 16); a[3] = __uint_as_float(v.y & 0xffff0000u);
    a[4] = __uint_as_float(v.z << 16); a[5] = __uint_as_float(v.z & 0xffff0000u);
    a[6] = __uint_as_float(v.w << 16); a[7] = __uint_as_float(v.w & 0xffff0000u);
}

struct Bufs {
    float* mod; float* scal; float* rope; float* xc; bf16_t* h; bf16_t* mix; bf16_t* qkv; bf16_t* act; float* part; bf16_t* wt; float* gt;
    __device__ Bufs(const Params& p) {
        mod = (float*)(p.ws + WS_MOD); scal = (float*)(p.ws + WS_SCAL); rope = (float*)(p.ws + WS_ROPE); xc = (float*)(p.ws + WS_XC);
        h = (bf16_t*)(p.ws + WS_H); mix = (bf16_t*)(p.ws + WS_MIX); qkv = (bf16_t*)(p.ws + WS_QKV); act = (bf16_t*)(p.ws + WS_QKV);
        part = (float*)(p.ws + WS_PART); wt = (bf16_t*)(p.ws + WS_WT); gt = (float*)(p.ws + WS_GT);
    }
};
__device__ __forceinline__ const float* modp(const Bufs& B, int l, int s, int chunk) { return B.mod + ((size_t)(l * 2 + s) * 6144) + chunk * 1024; }

__device__ void phase_prep(const Params& p, char* lds, int bid, int nblk) {
    Bufs B(p);
    float* red = (float*)lds;
    const int tid = threadIdx.x;
    for (int item = bid; item < 193; item += nblk) {
        if (item < 192) {
            const int l = item / 96, n0 = (item % 96) * 64, nn = tid & 63, kc = tid >> 6;
            const float* W = p.in[I_ADAW] + (size_t)l * 1024 * 6144 + n0 + nn;
            float a0 = 0.f, a1 = 0.f;
            for (int k = kc * 128; k < kc * 128 + 128; ++k) {
                const float w = W[(size_t)k * 6144];
                const float c0 = p.in[I_C][k], c1 = p.in[I_CCTX][k];
                a0 += (c0 / (1.f + __expf(-c0))) * w; a1 += (c1 / (1.f + __expf(-c1))) * w;
            }
            red[(kc * 64 + nn) * 2] = a0; red[(kc * 64 + nn) * 2 + 1] = a1;
            __syncthreads();
            if (tid < 128) {
                const int n = tid & 63, s = tid >> 6; float acc = 0.f;
                for (int k = 0; k < 8; ++k) acc += red[(k * 64 + n) * 2 + s];
                B.mod[(size_t)(l * 2 + s) * 6144 + n0 + n] = acc + p.in[I_ADAB][l * 6144 + n0 + n];
            }
            __syncthreads();
        } else {
            for (int e = tid; e < 256 * 16; e += NT) {
                const int pos = e >> 4, i = e & 15;
                const double f = pow(10000.0, -(double)i / 16.0), ang = (double)pos * f;
                B.rope[e * 2] = (float)cos(ang); B.rope[e * 2 + 1] = (float)sin(ang);
            }
            if (tid < 64) {
                B.gt[tid] = p.in[I_AQN][tid]; B.gt[64 + tid] = p.in[I_AKN][tid]; B.gt[128 + tid] = p.in[I_BQN][tid]; B.gt[192 + tid] = p.in[I_BKN][tid];
                B.gt[256 + tid] = p.in[I_DQN][tid]; B.gt[320 + tid] = p.in[I_DKN][tid];
                const float s1 = wave_sum(p.in[I_LQ1][tid] * p.in[I_LK1][tid]), s2 = wave_sum(p.in[I_LQ2][tid] * p.in[I_LK2][tid]);
                if (tid == 0) B.scal[0] = expf(s1) - expf(s2) + 0.2f;
            }
        }
    }
}

__device__ void phase_norm(const Params& p, int l, int which, int bid, int nblk) {
    Bufs B(p);
    const int wid = threadIdx.x >> 6, lane = threadIdx.x & 63;
    const float* gamma = p.in[which ? I_NFFN : I_NMIX] + l * 1024;
    for (int item = bid; item < R_ / 8; item += nblk) {
        const int r = item * 8 + wid;
        const bool first = (l == 0 && which == 0);
        const float* src = r < 256 ? ((first ? p.in[I_CTX] : B.xc) + (size_t)r * 1024) : ((first ? p.in[I_X] : p.out) + (size_t)(r - 256) * 1024);
        const int s = r < 256 ? 1 : 0;
        const float* sh = modp(B, l, s, which ? 3 : 0); const float* sc = modp(B, l, s, which ? 4 : 1);
        float v[16]; float ss = 0.f;
#pragma unroll
        for (int i = 0; i < 4; ++i) { const float4 t = *(const float4*)(src + i * 256 + lane * 4); v[4 * i] = t.x; v[4 * i + 1] = t.y; v[4 * i + 2] = t.z; v[4 * i + 3] = t.w; ss += t.x * t.x + t.y * t.y + t.z * t.z + t.w * t.w; }
        ss = wave_sum(ss);
        const float rr = rsqrtf(ss * (1.f / 1024.f) + EPS_);
#pragma unroll
        for (int i = 0; i < 4; ++i) {
            const int k = i * 256 + lane * 4; bf16_t o[4];
#pragma unroll
            for (int j = 0; j < 4; ++j) o[j] = f2bf(v[4 * i + j] * rr * gamma[k + j] * (1.f + sc[k + j]) + sh[k + j]);
            *(uint2*)(B.h + (size_t)hrow(r) * 1024 + k) = make_uint2((u32)o[0] | ((u32)o[1] << 16), (u32)o[2] | ((u32)o[3] << 16));
        }
    }
}

template <int RPG>
__device__ __forceinline__ void tile_linear(float (&acc)[RPG], int K, const bf16_t* const (&ap)[RPG], const float* __restrict__ W, int ldw, int wcol) {
#pragma unroll
    for (int i = 0; i < RPG; ++i) acc[i] = 0.f;
    if (wcol < 0) return;
    for (int k = 0; k < K; k += 8) {
        float w[8];
#pragma unroll
        for (int j = 0; j < 8; ++j) w[j] = W[(size_t)(k + j) * ldw + wcol];
#pragma unroll
        for (int i = 0; i < RPG; ++i) {
            if (ap[i]) { float a[8]; unpack8(*(const u32x4*)(ap[i] + k), a);
#pragma unroll
                for (int j = 0; j < 8; ++j) acc[i] += a[j] * w[j]; }
        }
    }
}
template <int RPG>
__device__ __forceinline__ void tile_linear_g(float (&acc)[RPG], int K, const bf16_t* const (&ap)[RPG], const float (&rs)[RPG], const float* __restrict__ g, const float* __restrict__ W, int ldw, int wcol) {
#pragma unroll
    for (int i = 0; i < RPG; ++i) acc[i] = 0.f;
    if (wcol < 0) return;
    for (int k = 0; k < K; k += 8) {
        float w[8];
#pragma unroll
        for (int j = 0; j < 8; ++j) w[j] = W[(size_t)(k + j) * ldw + wcol] * g[k + j];
#pragma unroll
        for (int i = 0; i < RPG; ++i) {
            if (ap[i]) { float a[8]; unpack8(*(const u32x4*)(ap[i] + k), a); float t = 0.f;
#pragma unroll
                for (int j = 0; j < 8; ++j) t += a[j] * w[j];
                acc[i] += t * rs[i]; }
        }
    }
}

__device__ __forceinline__ float2 rope64(const float* tab, int t, int i) { const int pos = i < 16 ? (t >> 6) : (t & 63); const int f = i & 15; return *(const float2*)(tab + (pos * 16 + f) * 2); }
__device__ __forceinline__ float2 rope32(const float* tab, int t, int i) { const int pos = i < 8 ? (t >> 6) : (t & 63); const int f = (i & 7) * 2; return *(const float2*)(tab + (pos * 16 + f) * 2); }

__device__ __forceinline__ void head64_norm_rope(const float* row, const float* g, bool rope, const float* tab, int t, bf16_t* dst, int lane) {
    const float v = row[lane];
    const float ss = wave_sum(v * v);
    const float rr = rsqrtf(ss * (1.f / 64.f) + EPS_);
    float y = v * rr * g[lane];
    if (rope) {
        const float yp = row[lane ^ 32] * rr * g[lane ^ 32];
        const float2 cs = rope64(tab, t, lane & 31);
        y = lane < 32 ? (y * cs.x - yp * cs.y) : (yp * cs.y + y * cs.x);
    }
    dst[lane] = f2bf(y);
}

__device__ void phase_qkv0(const Params& p, char* lds, int bid, int nblk) {
    Bufs B(p);
    float* tile = (float*)lds;
    const int tid = threadIdx.x, cc = tid & 127, rg = tid >> 7, wid = tid >> 6, lane = tid & 63;
    const float* W = p.in[I_EWIN];
    for (int item = bid; item < (R_ / 16) * 24; item += nblk) {
        const int rt = item / 24, ct = item % 24, row0 = rt * 16, col0 = ct * 128;
        const bf16_t* ap[4];
#pragma unroll
        for (int i = 0; i < 4; ++i) ap[i] = B.h + (size_t)hrow(row0 + rg * 4 + i) * 1024;
        float acc[4];
        tile_linear<4>(acc, 1024, ap, W, 3072, col0 + cc);
#pragma unroll
        for (int i = 0; i < 4; ++i) tile[(rg * 4 + i) * 128 + cc] = acc[i];
        __syncthreads();
        const int seg = col0 / 512, cin = col0 % 512;
        if (seg == 2 || seg == 5) {
            for (int e = tid; e < 16 * 128; e += NT) {
                const int c = e >> 4, rr = e & 15, r = row0 + rr;
                bf16_t* dst;
                if (seg == 2) dst = B.qkv + O_VAT + ((size_t)(cin / 128) * 128 + c) * R_;
                else dst = B.qkv + O_VBT + ((size_t)((cin + c) / 64) * 64 + (c & 63)) * R_;
                dst[vpos(r)] = f2bf(tile[rr * 128 + c]);
            }
        } else {
            for (int q = wid * 4; q < wid * 4 + 4; ++q) {
                const int rr = q >> 1, hh = q & 1, r = row0 + rr, head = cin / 64 + hh;
                const float* g = p.in[seg == 0 ? I_AQN : seg == 1 ? I_AKN : seg == 3 ? I_BQN : I_BKN];
                bf16_t* dst = B.qkv + (seg == 0 ? O_QA : seg == 1 ? O_KA : seg == 3 ? O_QB : O_KB) + ((size_t)head * R_ + r) * 64;
                head64_norm_rope(tile + rr * 128 + hh * 64, g, (seg < 2) && r >= 256, B.rope, r - 256, dst, lane);
            }
        }
        __syncthreads();
    }
}

__device__ __forceinline__ float dot8p(u32x4 k, u32 q0, u32 q1, u32 q2, u32 q3) {
    float t = __uint_as_float(k.x << 16) * __uint_as_float(q0 << 16);
    t += __uint_as_float(k.x & 0xffff0000u) * __uint_as_float(q0 & 0xffff0000u);
    t += __uint_as_float(k.y << 16) * __uint_as_float(q1 << 16);
    t += __uint_as_float(k.y & 0xffff0000u) * __uint_as_float(q1 & 0xffff0000u);
    t += __uint_as_float(k.z << 16) * __uint_as_float(q2 << 16);
    t += __uint_as_float(k.z & 0xffff0000u) * __uint_as_float(q2 & 0xffff0000u);
    t += __uint_as_float(k.w << 16) * __uint_as_float(q3 << 16);
    t += __uint_as_float(k.w & 0xffff0000u) * __uint_as_float(q3 & 0xffff0000u);
    return t;
}
template <int DQK, int DVT>
__device__ __forceinline__ void naive_dense(const bf16_t* __restrict__ q, const bf16_t* __restrict__ Kb, const bf16_t* __restrict__ VT, int nk, float scale, float (&O)[DVT], float& lsum) {
    u32x4 qp[DQK / 8];
#pragma unroll
    for (int i = 0; i < DQK / 8; ++i) qp[i] = *(const u32x4*)(q + i * 8);
#pragma unroll
    for (int d = 0; d < DVT; ++d) O[d] = 0.f;
    float m = -1e30f, l = 0.f;
    for (int c = 0; c < nk; c += 8) {
        float s[8];
#pragma unroll
        for (int j = 0; j < 8; ++j) {
            const int key = (c & ~15) + swap23((c & 15) + j);
            const bf16_t* kr = Kb + (size_t)key * DQK; float t = 0.f;
#pragma unroll
            for (int i = 0; i < DQK / 8; ++i) t += dot8p(*(const u32x4*)(kr + i * 8), qp[i].x, qp[i].y, qp[i].z, qp[i].w);
            s[j] = t * scale;
        }
        float cm = s[0];
#pragma unroll
        for (int j = 1; j < 8; ++j) cm = fmaxf(cm, s[j]);
        const float mn = fmaxf(m, cm), alpha = __expf(m - mn);
        float ps = 0.f;
#pragma unroll
        for (int j = 0; j < 8; ++j) { s[j] = __expf(s[j] - mn); ps += s[j]; }
        l = l * alpha + ps; m = mn;
#pragma unroll
        for (int d = 0; d < DVT; ++d) {
            float a[8]; unpack8(*(const u32x4*)(VT + (size_t)d * R_ + c), a);
            float t = O[d] * alpha;
#pragma unroll
            for (int j = 0; j < 8; ++j) t += s[j] * a[j];
            O[d] = t;
            if ((d & 7) == 7) __builtin_amdgcn_sched_barrier(0);
        }
    }
    lsum = l;
}

__device__ void phase_attn0(const Params& p, char* lds, int bid, int nblk) {
    Bufs B(p);
    const int tid = threadIdx.x;
    float* xch = (float*)lds;
    const float lam = B.scal[0];
    for (int item = bid; item < 1300; item += nblk) {
        if (item < 1040) {
            const int head = item / 260, chunk = item % 260, role = tid >> 6, m = role >> 2, qt = role & 3, qi = tid & 63, r = chunk * 64 + qi, sub = head * 2 + m;
            const int nk = chunk < 4 ? 256 : R_;
            float O[32]; float l;
            naive_dense<64, 32>(B.qkv + O_QA + ((size_t)sub * R_ + r) * 64, B.qkv + O_KA + (size_t)sub * R_ * 64, B.qkv + O_VAT + ((size_t)head * 128 + qt * 32) * R_, nk, 0.125f, O, l);
            const float inv = 1.f / l;
#pragma unroll
            for (int d = 0; d < 32; ++d) O[d] *= inv;
            float* xh = xch + (qt * 64 + qi) * 33;
            __syncthreads();
            if (m == 1) {
#pragma unroll
                for (int d = 0; d < 32; ++d) xh[d] = O[d];
            }
            __syncthreads();
            if (m == 0) {
#pragma unroll
                for (int d = 0; d < 32; ++d) O[d] -= lam * xh[d];
            }
            __syncthreads();
            float ss = 0.f;
#pragma unroll
            for (int d = 0; d < 32; ++d) ss += O[d] * O[d];
            if (m == 0) xh[0] = ss;
            __syncthreads();
            if (m == 0) {
                const float tot = xch[(0 * 64 + qi) * 33] + xch[(1 * 64 + qi) * 33] + xch[(2 * 64 + qi) * 33] + xch[(3 * 64 + qi) * 33];
                const float rr = rsqrtf(tot * (1.f / 128.f) + EPS_) * 0.8f;
                bf16_t* dst = B.mix + (size_t)r * 1024 + head * 128 + qt * 32;
                const float* g = p.in[I_SUBLN] + qt * 32;
#pragma unroll
                for (int d = 0; d < 32; d += 2) *(u32*)(dst + d) = (u32)f2bf(O[d] * rr * g[d]) | ((u32)f2bf(O[d + 1] * rr * g[d + 1]) << 16);
            }
            __syncthreads();
        } else {
            const int idx = (item - 1040) * NT + tid, h = idx / R_, r = idx % R_;
            const bf16_t* q = B.qkv + O_QB + ((size_t)h * R_ + r) * 64;
            const bf16_t* Kb = B.qkv + O_KB + (size_t)h * R_ * 64;
            const bf16_t* VT = B.qkv + O_VBT + (size_t)h * 64 * R_;
            float qf[64];
#pragma unroll
            for (int i = 0; i < 8; ++i) { float a[8]; unpack8(*(const u32x4*)(q + i * 8), a);
#pragma unroll
                for (int j = 0; j < 8; ++j) qf[i * 8 + j] = a[j] * 0.125f; }
            float O[64];
#pragma unroll
            for (int d = 0; d < 64; ++d) O[d] = 0.f;
            float m = -1e30f, l = 0.f;
            const int t = r - 256, row = t >> 6, col = t & 63;
            const int rs = min(max(row - 4, 0), 248), cs = min(max(col - 8, 0), 48);
            const int nkeys = r < 256 ? 256 : 384;
            for (int kk = 0; kk < nkeys; ++kk) {
                int key; float bias = 0.f;
                if (kk < 256) key = kk;
                else { const int w = kk - 256, kr = rs + (w >> 4), kc = cs + (w & 15); key = 256 + kr * 64 + kc; bias = p.in[I_RPB][(h * 15 + (kr - row + 7)) * 31 + (kc - col + 15)]; }
                const bf16_t* krow = Kb + (size_t)key * 64; float s = bias;
#pragma unroll
                for (int i = 0; i < 8; ++i) { float a[8]; unpack8(*(const u32x4*)(krow + i * 8), a);
#pragma unroll
                    for (int j = 0; j < 8; ++j) s += a[j] * qf[i * 8 + j]; }
                const float mn = fmaxf(m, s), alpha = __expf(m - mn), pp = __expf(s - mn);
                l = l * alpha + pp; m = mn;
                const int vp = vpos(key);
#pragma unroll
                for (int d = 0; d < 64; ++d) O[d] = O[d] * alpha + pp * bf2f(VT[(size_t)d * R_ + vp]);
            }
            const float inv = 1.f / l;
            bf16_t* dst = B.mix + (size_t)r * 1024 + 512 + h * 64;
#pragma unroll
            for (int d = 0; d < 64; d += 2) *(u32*)(dst + d) = (u32)f2bf(O[d] * inv) | ((u32)f2bf(O[d + 1] * inv) << 16);
        }
    }
}

__device__ void phase_out(const Params& p, int l, int bid, int nblk) {
    Bufs B(p);
    const int tid = threadIdx.x, cc = tid & 127, rg = tid >> 7;
    const float* W = p.in[l == 0 ? I_EWOUT : I_OWOUT];
    const int rt0 = l == 0 ? 0 : 16, nrt = R_ / 16 - rt0;
    for (int item = bid; item < nrt * 8; item += nblk) {
        const int rt = rt0 + item / 8, ct = item % 8, row0 = rt * 16, col = ct * 128 + cc;
        const bf16_t* ap[4];
#pragma unroll
        for (int i = 0; i < 4; ++i) ap[i] = B.mix + (size_t)(row0 + rg * 4 + i) * 1024;
        float acc[4];
        tile_linear<4>(acc, 1024, ap, W, 1024, col);
#pragma unroll
        for (int i = 0; i < 4; ++i) {
            const int r = row0 + rg * 4 + i;
            if (r < 256) B.xc[(size_t)r * 1024 + col] = p.in[I_CTX][(size_t)r * 1024 + col] + modp(B, l, 1, 2)[col] * acc[i];
            else { const size_t o = (size_t)(r - 256) * 1024 + col; p.out[o] = (l == 0 ? p.in[I_X][o] : p.out[o]) + modp(B, l, 0, 2)[col] * acc[i]; }
        }
    }
}

__device__ void phase_up(const Params& p, int l, char* lds, int bid, int nblk) {
    Bufs B(p);
    float* tile = (float*)lds;
    const int tid = threadIdx.x, cc = tid & 127, rg = tid >> 7;
    const float* W = p.in[I_FUP] + (size_t)l * 1024 * F2_;
    const float* cw = p.in[I_FCW] + (size_t)l * 3 * F2_; const float* cb = p.in[I_FCB] + (size_t)l * F2_;
    const int rt0 = l == 0 ? 0 : 16, nrt = R_ / 16 - rt0;
    for (int item = bid; item < nrt * 44; item += nblk) {
        const int rt = rt0 + item / 44, ct = item % 44, row0 = rt * 16, c0 = ct * 64;
        const int lo = row0 < 256 ? 0 : 256, hi = row0 < 256 ? 256 : R_;
        const int wcol = cc < 64 ? c0 + cc : F_ + c0 + (cc - 64);
        const bf16_t* ap[5];
#pragma unroll
        for (int i = 0; i < 5; ++i) { const int rr = rg * 5 + i, r = row0 - 1 + rr; ap[i] = (rr < 18 && r >= lo && r < hi) ? B.h + (size_t)hrow(r) * 1024 : nullptr; }
        float acc[5];
        tile_linear<5>(acc, 1024, ap, W, F2_, wcol);
#pragma unroll
        for (int i = 0; i < 5; ++i) tile[(rg * 5 + i) * 128 + cc] = acc[i];
        __syncthreads();
        for (int e = tid; e < 16 * 64; e += NT) {
            const int rr = e >> 6, c = e & 63, ca = c0 + c, cg = F_ + c0 + c;
            const float a = cb[ca] + tile[rr * 128 + c] * cw[ca] + tile[(rr + 1) * 128 + c] * cw[F2_ + ca] + tile[(rr + 2) * 128 + c] * cw[2 * F2_ + ca];
            const float g = cb[cg] + tile[rr * 128 + 64 + c] * cw[cg] + tile[(rr + 1) * 128 + 64 + c] * cw[F2_ + cg] + tile[(rr + 2) * 128 + 64 + c] * cw[2 * F2_ + cg];
            B.act[(size_t)(row0 + rr) * F_ + ca] = f2bf(a * (g / (1.f + __expf(-g))));
        }
        __syncthreads();
    }
}

__device__ void phase_down(const Params& p, int l, int bid, int nblk) {
    Bufs B(p);
    const int tid = threadIdx.x, cc = tid & 127, rg = tid >> 7;
    const float* W = p.in[I_FDOWN] + (size_t)l * F_ * 1024;
    const int rt0 = l == 0 ? 0 : 16, nrt = R_ / 16 - rt0;
    for (int item = bid; item < nrt * 8; item += nblk) {
        const int rt = rt0 + item / 8, ct = item % 8, row0 = rt * 16, col = ct * 128 + cc;
        const bf16_t* ap[4];
#pragma unroll
        for (int i = 0; i < 4; ++i) ap[i] = B.act + (size_t)(row0 + rg * 4 + i) * F_;
        float acc[4];
        tile_linear<4>(acc, F_, ap, W, 1024, col);
#pragma unroll
        for (int i = 0; i < 4; ++i) {
            const int r = row0 + rg * 4 + i;
            if (r < 256) B.xc[(size_t)r * 1024 + col] += modp(B, l, 1, 5)[col] * acc[i];
            else p.out[(size_t)(r - 256) * 1024 + col] += modp(B, l, 0, 5)[col] * acc[i];
        }
    }
}

__device__ void phase_qkv1a(const Params& p, char* lds, int bid, int nblk) {
    Bufs B(p);
    float* tile = (float*)lds;
    const int tid = threadIdx.x, cc = tid & 127, rg = tid >> 7, wid = tid >> 6, lane = tid & 63;
    const float* W = p.in[I_OWIN];
    for (int item = bid; item < (R_ / 16) * 12; item += nblk) {
        const int rt = item / 12, ct = item % 12, row0 = rt * 16, v0 = ct * 128;
        const int v = v0 + cc;
        int wcol;
        if (v < 640) wcol = v; else if (v < 1152) wcol = 672 + (v - 640); else if (v < 1280) wcol = 1184 + (v - 1152); else if (v < 1408) wcol = 1312 + (v - 1280);
        else if (v < 1440) wcol = 640 + (v - 1408); else wcol = -1;
        const bf16_t* ap[4];
#pragma unroll
        for (int i = 0; i < 4; ++i) ap[i] = B.h + (size_t)hrow(row0 + rg * 4 + i) * 1024;
        float acc[4];
        tile_linear<4>(acc, 1024, ap, W, 1440, wcol);
#pragma unroll
        for (int i = 0; i < 4; ++i) tile[(rg * 4 + i) * 128 + cc] = acc[i];
        __syncthreads();
        if (ct < 5) {
            for (int e = tid; e < 16 * 128; e += NT) {
                const int rr = e >> 7, c = e & 127, r = row0 + rr;
                if (ct < 3) B.qkv[O_CQ + (size_t)r * 384 + v0 + c] = f2bf(tile[e]);
                else B.qkv[O_CKV + (size_t)r * 256 + (v0 - 384) + c] = f2bf(tile[e]);
            }
        } else if (ct < 10) {
            for (int q = wid * 4; q < wid * 4 + 4; ++q) {
                const int rr = q >> 1, hh = q & 1, r = row0 + rr;
                if (ct < 9) head64_norm_rope(tile + rr * 128 + hh * 64, p.in[I_DQN], r >= 256, B.rope, r - 256, B.qkv + O_GQ + ((size_t)((ct - 5) * 2 + hh) * R_ + r) * 64, lane);
                else head64_norm_rope(tile + rr * 128 + hh * 64, p.in[I_DKN], r >= 256, B.rope, r - 256, B.qkv + O_GK + ((size_t)hh * R_ + r) * 64, lane);
            }
        } else if (ct == 10) {
            for (int e = tid; e < 16 * 128; e += NT) {
                const int c = e >> 4, rr = e & 15, r = row0 + rr;
                B.qkv[O_GVT + ((size_t)(c >> 6) * 64 + (c & 63)) * R_ + vpos(r)] = f2bf(tile[rr * 128 + c]);
            }
        } else {
            for (int e = tid; e < 16 * 32; e += NT) { const int rr = e >> 5, c = e & 31; B.qkv[O_CKR + (size_t)(row0 + rr) * 32 + c] = f2bf(tile[rr * 128 + c]); }
        }
        __syncthreads();
    }
}

__device__ __forceinline__ void head96_norm_rope(const float* row, const float* g, bool rope, const float* tab, int t, bf16_t* dst, int lane) {
    const float v0 = row[lane], v1 = lane < 32 ? row[64 + lane] : 0.f;
    const float ss = wave_sum(v0 * v0 + v1 * v1);
    const float rr = rsqrtf(ss * (1.f / 96.f) + EPS_);
    dst[lane] = f2bf(v0 * rr * g[lane]);
    if (lane < 32) {
        float y = v1 * rr * g[64 + lane];
        if (rope) {
            const float yp = row[64 + (lane ^ 16)] * rr * g[64 + (lane ^ 16)];
            const float2 cs = rope32(tab, t, lane & 15);
            y = lane < 16 ? (y * cs.x - yp * cs.y) : (yp * cs.y + y * cs.x);
        }
        dst[64 + lane] = f2bf(y);
    }
}

__device__ void phase_qkv1b(const Params& p, char* lds, int bid, int nblk) {
    Bufs B(p);
    float* tile = (float*)lds;
    float* rsl = (float*)lds + 16 * 128;
    const int tid = threadIdx.x, cc = tid & 127, rg = tid >> 7, wid = tid >> 6, lane = tid & 63;
    for (int item = bid; item < (R_ / 16) * 16; item += nblk) {
        const int rt = item / 16, ht = item % 16, row0 = rt * 16;
        const bool isq = ht < 8; const int head = ht & 7;
        const int K = isq ? 384 : 256;
        const bf16_t* src = B.qkv + (isq ? O_CQ : O_CKV);
        for (int rr = wid * 2; rr < wid * 2 + 2; ++rr) {
            float ss = 0.f;
            for (int k = lane; k < K; k += 64) { const float v = bf2f(src[(size_t)(row0 + rr) * K + k]); ss += v * v; }
            ss = wave_sum(ss);
            if (lane == 0) rsl[rr] = rsqrtf(ss / (float)K + EPS_);
        }
        __syncthreads();
        const bf16_t* ap[4]; float rs[4];
#pragma unroll
        for (int i = 0; i < 4; ++i) { ap[i] = src + (size_t)(row0 + rg * 4 + i) * K; rs[i] = rsl[rg * 4 + i]; }
        float acc[4];
        if (isq) tile_linear_g<4>(acc, 384, ap, rs, p.in[I_CQAN], p.in[I_CWQB], 768, cc < 96 ? head * 96 + cc : -1);
        else tile_linear_g<4>(acc, 256, ap, rs, p.in[I_CKVAN], p.in[I_CWKVB], 1024, head * 128 + cc);
#pragma unroll
        for (int i = 0; i < 4; ++i) tile[(rg * 4 + i) * 128 + cc] = acc[i];
        __syncthreads();
        if (isq) {
            for (int rr = wid * 2; rr < wid * 2 + 2; ++rr) { const int r = row0 + rr;
                head96_norm_rope(tile + rr * 128, p.in[I_CQN], r >= 256, B.rope, r - 256, B.qkv + O_MQ + ((size_t)head * R_ + r) * 96, lane); }
        } else {
            for (int e = tid; e < 16 * 64; e += NT) { const int d = e >> 4, rr = e & 15; B.qkv[O_MVT + ((size_t)head * 64 + d) * R_ + vpos(row0 + rr)] = f2bf(tile[rr * 128 + 64 + d]); }
            __syncthreads();
            for (int e = tid; e < 16 * 32; e += NT) { const int rr = e >> 5, c = e & 31; tile[rr * 128 + 64 + c] = bf2f(B.qkv[O_CKR + (size_t)(row0 + rr) * 32 + c]); }
            __syncthreads();
            for (int rr = wid * 2; rr < wid * 2 + 2; ++rr) { const int r = row0 + rr;
                head96_norm_rope(tile + rr * 128, p.in[I_CKN], r >= 256, B.rope, r - 256, B.qkv + O_MK + ((size_t)head * R_ + r) * 96, lane); }
        }
        __syncthreads();
    }
}

__device__ void phase_attn1(const Params& p, int bid, int nblk) {
    Bufs B(p);
    const int tid = threadIdx.x;
    for (int item = bid; item < 1024; item += nblk) {
        if (item < 512) {
            const int head = item / 64, half = tid >> 8, r = 256 + (item % 64) * 256 + (tid & 255);
            float O[32]; float l;
            naive_dense<96, 32>(B.qkv + O_MQ + ((size_t)head * R_ + r) * 96, B.qkv + O_MK + (size_t)head * R_ * 96, B.qkv + O_MVT + ((size_t)head * 64 + half * 32) * R_, R_, 0.10206207261596575f, O, l);
            const float inv = 1.f / l;
            bf16_t* dst = B.mix + (size_t)r * 1024 + head * 64 + half * 32;
#pragma unroll
            for (int d = 0; d < 32; d += 2) *(u32*)(dst + d) = (u32)f2bf(O[d] * inv) | ((u32)f2bf(O[d + 1] * inv) << 16);
        } else {
            const int idx = (item - 512) * NT + tid, half = idx / (8 * T_), hq = (idx / T_) & 7, t = idx % T_, r = 256 + t, kvh = hq >> 2;
            const bf16_t* q = B.qkv + O_GQ + ((size_t)hq * R_ + r) * 64;
            const bf16_t* Kb = B.qkv + O_GK + (size_t)kvh * R_ * 64;
            const bf16_t* VT = B.qkv + O_GVT + ((size_t)kvh * 64 + half * 32) * R_;
            u32x4 qp[8];
#pragma unroll
            for (int i = 0; i < 8; ++i) qp[i] = *(const u32x4*)(q + i * 8);
            float O[32];
#pragma unroll
            for (int d = 0; d < 32; ++d) O[d] = 0.f;
            float m = -1e30f, l = 0.f;
            const int j0 = max(t - 128, 0), j1 = min(t + 128, T_ - 1);
            const int nkeys = 256 + (j1 - j0 + 1);
            for (int kk = 0; kk < nkeys; ++kk) {
                const int key = kk < 256 ? kk : 256 + j0 + (kk - 256);
                const bf16_t* krow = Kb + (size_t)key * 64; float s = 0.f;
#pragma unroll
                for (int i = 0; i < 8; ++i) s += dot8p(*(const u32x4*)(krow + i * 8), qp[i].x, qp[i].y, qp[i].z, qp[i].w);
                s *= 0.125f;
                const float mn = fmaxf(m, s), alpha = __expf(m - mn), pp = __expf(s - mn);
                l = l * alpha + pp; m = mn;
                const int vp = vpos(key);
#pragma unroll
                for (int d = 0; d < 32; ++d) O[d] = O[d] * alpha + pp * bf2f(VT[(size_t)d * R_ + vp]);
            }
            { const float s = p.in[I_SINK][hq]; const float mn = fmaxf(m, s), alpha = __expf(m - mn); l = l * alpha + __expf(s - mn);
#pragma unroll
              for (int d = 0; d < 32; ++d) O[d] *= alpha; }
            const float inv = 1.f / l;
            bf16_t* dst = B.mix + (size_t)r * 1024 + 512 + hq * 64 + half * 32;
#pragma unroll
            for (int d = 0; d < 32; d += 2) *(u32*)(dst + d) = (u32)f2bf(O[d] * inv) | ((u32)f2bf(O[d + 1] * inv) << 16);
        }
    }
}

#define LAS __attribute__((address_space(3)))
typedef short bf16x8 __attribute__((ext_vector_type(8)));
typedef float f32x4 __attribute__((ext_vector_type(4)));
constexpr int LDS_STAGE = 131072, LDS_XCH = LDS_STAGE, LDS_BYTES = 147456;

__device__ __forceinline__ u32 pk2(float lo, float hi) { return (u32)f2bf(lo) | ((u32)f2bf(hi) << 16); }

namespace pg8 {
constexpr int BM = 256, BK = 64, HALF = 128, HTB = HALF * BK * 2, NXCD = 8, WGM = 8;
__host__ __device__ __forceinline__ int lds_byte(int r, int c) { const int st = (r >> 4) * 2 + (c >> 5), rr = r & 15, cc = c & 31, ob = rr * 64 + cc * 2; return st * 1024 + (ob ^ (((ob >> 9) & 1) << 5)); }
__host__ __device__ __forceinline__ void stage_rc(int b, int& R, int& C) { const int st = b / 1024, sb = b % 1024, swz = sb ^ (((sb >> 9) & 1) << 5); R = (st >> 1) * 16 + swz / 64; C = (st & 1) * 32 + (swz % 64) / 2; }
struct Unit { int pm, pn; };
struct Gemm { const bf16_t* A; const bf16_t* Bt; int K; };
struct Order {
    int nM, nN, nwg, G, c, pm0, amode;
    __device__ void init(int nM_, int nN_, int G_, int c_, int pm0_, int amode_) { nM = nM_; nN = nN_; nwg = nM * nN; G = G_; c = c_; pm0 = pm0_; amode = amode_; }
    __device__ bool next(int i, Unit& u) const {
        const long L = (long)i * G + c; if (L >= nwg) return false;
        int wgid = (int)L; { const int q = nwg / NXCD, r = nwg % NXCD, xcd = wgid % NXCD, off = wgid / NXCD; wgid = (xcd < r ? xcd * (q + 1) : r * (q + 1) + (xcd - r) * q) + off; }
        const int nig = WGM * nN, gid = wgid / nig, fm = gid * WGM, gsz = (nM - fm) < WGM ? (nM - fm) : WGM;
        u.pm = pm0 + fm + ((wgid % nig) % gsz); u.pn = (wgid % nig) / gsz; return true;
    }
    __device__ __forceinline__ int arow(int pm) const { return amode == 0 ? 256 * pm : amode == 1 ? (pm == 0 ? 1 : 2 + 256 * pm) : (pm < 2 ? 254 * pm : 257 + 254 * (pm - 2)); }
    __device__ __forceinline__ void a_ready(const Unit&) const {}
    __device__ __forceinline__ void done(const Unit&) const {}
};

template <class Epi, class Sched, bool ALIGN_EPI, bool SP2>
__device__ __forceinline__ void gemm_phase(LAS unsigned char* lds, const Gemm g, const Sched& S, const Epi& E) {
    const int tid = threadIdx.x, wid = __builtin_amdgcn_readfirstlane(tid >> 6), lane = tid & 63, wr = wid >> 2, wc = wid & 3, fr = lane & 15, fq = lane >> 4;
    int K_ = g.K; asm volatile("" : "+s"(K_));
    const int K = K_, nt = K / BK;
    unsigned voffA[2], voffB[2];
#pragma unroll
    for (int i = 0; i < 2; ++i) { int R, C; stage_rc(tid * 16 + i * 8192, R, C); voffA[i] = (unsigned)(R * K + C) * 2u; voffB[i] = (unsigned)(R * K + C) * 2u; }
    const size_t kstep = (size_t)(BK * 2);
    const size_t hstep = (size_t)HALF * K * 2;
    const size_t tstep = 2 * hstep;
    const size_t rstep = (size_t)K * 2;
    const unsigned ldsw = (unsigned)wid * 1024u;
    const int aoff = lds_byte(wr * 64 + fr, fq * 8), boff = lds_byte(wc * 32 + fr, fq * 8);
#define PG8_SA(b, h) (((b) * 2 + (h)) * HTB)
#define PG8_SB(b, h) ((4 + (b) * 2 + (h)) * HTB)
#define PG8_STAGE(bufoff, gbase, voff) do { _Pragma("unroll") for (int _i = 0; _i < 2; ++_i) \
        __builtin_amdgcn_global_load_lds((const unsigned*)((const char*)(gbase) + (voff)[_i]), (LAS unsigned*)(lds + (bufoff) + ldsw + _i * 8192), 16, 0, 0); } while (0)
#define PG8_LDA(dst, b, h) do { _Pragma("unroll") for (int m = 0; m < 4; ++m) _Pragma("unroll") for (int k = 0; k < 2; ++k) dst[m][k] = *(const LAS bf16x8*)(lds + PG8_SA(b, h) + aoff + m * 2048 + k * 1024); } while (0)
#define PG8_LDB(dst, b, h) do { _Pragma("unroll") for (int n = 0; n < 2; ++n) _Pragma("unroll") for (int k = 0; k < 2; ++k) dst[n][k] = *(const LAS bf16x8*)(lds + PG8_SB(b, h) + boff + n * 2048 + k * 1024); } while (0)
#define PG8_MMA(ai, bj, At, Bt) do { __builtin_amdgcn_s_setprio(1); _Pragma("unroll") for (int m = 0; m < 4; ++m) _Pragma("unroll") for (int n = 0; n < 2; ++n) _Pragma("unroll") for (int k = 0; k < 2; ++k) \
        acc[ai][bj][m][n] = __builtin_amdgcn_mfma_f32_16x16x32_bf16(Bt[n][k], At[m][k], acc[ai][bj][m][n], 0, 0, 0); __builtin_amdgcn_s_setprio(0); } while (0)
#define PG8_WAIT_V(n) asm volatile("s_waitcnt vmcnt(" #n ")" ::: "memory")
#define PG8_WAIT_L(n) asm volatile("s_waitcnt lgkmcnt(" #n ")" ::: "memory")
#define PG8_BAR __builtin_amdgcn_s_barrier()
#define PG8_SCHED __builtin_amdgcn_sched_barrier(0)
    Unit cur, nxt; int ui = 0;
    if (!S.next(0, cur)) return;
    f32x4 acc[2][2][4][2];
#pragma unroll
    for (int a = 0; a < 2; ++a)
#pragma unroll
        for (int b = 0; b < 2; ++b)
#pragma unroll
            for (int m = 0; m < 4; ++m)
#pragma unroll
                for (int n = 0; n < 2; ++n) acc[a][b][m][n] = (f32x4){0.f, 0.f, 0.f, 0.f};
    bf16x8 At[4][2], B0[2][2], B1[2][2];
    const char* cA = (const char*)g.A + (size_t)S.arow(cur.pm) * rstep; const char* cB = (const char*)g.Bt + (size_t)cur.pn * tstep;
    S.a_ready(cur);
    if constexpr (SP2) {
        PG8_STAGE(PG8_SB(0, 0), cB, voffB); PG8_STAGE(PG8_SB(0, 1), cB + hstep, voffB); PG8_STAGE(PG8_SA(0, 0), cA, voffA); PG8_STAGE(PG8_SA(0, 1), cA + hstep, voffA);
        if (wr == 1) PG8_BAR;
        PG8_WAIT_V(2); PG8_BAR;
        PG8_STAGE(PG8_SB(1, 0), cB + kstep, voffB); PG8_STAGE(PG8_SA(1, 0), cA + kstep, voffA); PG8_STAGE(PG8_SB(1, 1), cB + hstep + kstep, voffB);
        PG8_WAIT_V(6); PG8_BAR;
    } else {
        PG8_STAGE(PG8_SB(0, 0), cB, voffB); PG8_STAGE(PG8_SA(0, 0), cA, voffA); PG8_STAGE(PG8_SB(0, 1), cB + hstep, voffB); PG8_STAGE(PG8_SA(0, 1), cA + hstep, voffA);
        if (wr == 1) PG8_BAR;
        PG8_WAIT_V(4); PG8_BAR;
        PG8_STAGE(PG8_SB(1, 0), cB + kstep, voffB); PG8_STAGE(PG8_SA(1, 0), cA + kstep, voffA); PG8_STAGE(PG8_SB(1, 1), cB + hstep + kstep, voffB);
        PG8_WAIT_V(6); PG8_BAR;
    }
    for (;;) {
        const bool has_next = S.next(ui + 1, nxt);
        const char* nA = has_next ? (const char*)g.A + (size_t)S.arow(nxt.pm) * rstep : cA; const char* nB = has_next ? (const char*)g.Bt + (size_t)nxt.pn * tstep : cB;
        for (int t = 0; t < nt; t += 2) {
            const bool last = (t == nt - 2);
            const char* a1 = cA + (size_t)(t + 1) * kstep;
            const char* a2 = last ? nA : cA + (size_t)(t + 2) * kstep; const char* b2 = last ? nB : cB + (size_t)(t + 2) * kstep;
            const char* a3 = a2 + kstep; const char* b3 = b2 + kstep;
            if (last && has_next) S.a_ready(nxt);
            if constexpr (SP2) {
            PG8_LDB(B0, 0, 0); PG8_LDB(B1, 0, 1); PG8_SCHED; PG8_LDA(At, 0, 0); PG8_STAGE(PG8_SA(1, 1), a1 + hstep, voffA);
            PG8_WAIT_V(8); PG8_WAIT_L(0); PG8_BAR; PG8_MMA(0, 0, At, B0); PG8_MMA(0, 1, At, B1); PG8_BAR; PG8_SCHED;
            PG8_LDA(At, 0, 1); PG8_STAGE(PG8_SB(0, 0), b2, voffB); PG8_STAGE(PG8_SB(0, 1), b2 + hstep, voffB); PG8_STAGE(PG8_SA(0, 0), a2, voffA);
            PG8_WAIT_V(8); PG8_WAIT_L(0); PG8_BAR; PG8_MMA(1, 0, At, B0); PG8_MMA(1, 1, At, B1); PG8_BAR; PG8_SCHED;
            PG8_LDB(B0, 1, 0); PG8_LDB(B1, 1, 1); PG8_SCHED; PG8_LDA(At, 1, 0); PG8_STAGE(PG8_SA(0, 1), a2 + hstep, voffA);
            PG8_WAIT_V(8); PG8_WAIT_L(0); PG8_BAR; PG8_MMA(0, 0, At, B0); PG8_MMA(0, 1, At, B1); PG8_BAR; PG8_SCHED;
            PG8_LDA(At, 1, 1); PG8_STAGE(PG8_SB(1, 0), b3, voffB); PG8_STAGE(PG8_SB(1, 1), b3 + hstep, voffB); PG8_STAGE(PG8_SA(1, 0), a3, voffA);
            PG8_WAIT_V(8); PG8_WAIT_L(0); PG8_BAR; PG8_MMA(1, 0, At, B0); PG8_MMA(1, 1, At, B1); PG8_BAR; PG8_SCHED;
            } else {
            PG8_LDB(B0, 0, 0); PG8_SCHED; PG8_LDA(At, 0, 0); PG8_STAGE(PG8_SA(1, 1), a1 + hstep, voffA);
            PG8_WAIT_L(8); PG8_BAR; PG8_WAIT_L(0); PG8_MMA(0, 0, At, B0); PG8_BAR; PG8_SCHED;
            PG8_LDB(B1, 0, 1); PG8_STAGE(PG8_SB(0, 0), b2, voffB);
            PG8_BAR; PG8_WAIT_L(0); PG8_MMA(0, 1, At, B1); PG8_BAR;
            PG8_LDA(At, 0, 1); PG8_STAGE(PG8_SA(0, 0), a2, voffA);
            PG8_BAR; PG8_WAIT_L(0); PG8_MMA(1, 0, At, B0); PG8_BAR; PG8_SCHED;
            PG8_STAGE(PG8_SB(0, 1), b2 + hstep, voffB);
            PG8_WAIT_V(6); PG8_BAR; PG8_MMA(1, 1, At, B1); PG8_BAR;
            PG8_LDB(B0, 1, 0); PG8_SCHED; PG8_LDA(At, 1, 0); PG8_STAGE(PG8_SA(0, 1), a2 + hstep, voffA);
            PG8_WAIT_L(8); PG8_BAR; PG8_WAIT_L(0); PG8_MMA(0, 0, At, B0); PG8_BAR; PG8_SCHED;
            PG8_LDB(B1, 1, 1); PG8_STAGE(PG8_SB(1, 0), b3, voffB);
            PG8_BAR; PG8_WAIT_L(0); PG8_MMA(0, 1, At, B1); PG8_BAR;
            PG8_LDA(At, 1, 1); PG8_STAGE(PG8_SA(1, 0), a3, voffA);
            PG8_BAR; PG8_WAIT_L(0); PG8_MMA(1, 0, At, B0); PG8_BAR; PG8_SCHED;
            PG8_STAGE(PG8_SB(1, 1), b3 + hstep, voffB);
            PG8_WAIT_V(6); PG8_BAR; PG8_MMA(1, 1, At, B1); PG8_BAR;
            }
        }
        if constexpr (ALIGN_EPI) { if (wr == 0) PG8_BAR; }
        E(acc, cur, wr, wc, fr, fq); S.done(cur);
        if (!has_next) break;
#pragma unroll
        for (int a = 0; a < 2; ++a)
#pragma unroll
            for (int b = 0; b < 2; ++b)
#pragma unroll
                for (int m = 0; m < 4; ++m)
#pragma unroll
                    for (int n = 0; n < 2; ++n) acc[a][b][m][n] = (f32x4){0.f, 0.f, 0.f, 0.f};
        cur = nxt; cA = nA; cB = nB; ++ui;
        if constexpr (ALIGN_EPI) { if (wr == 1) PG8_BAR; }
    }
    PG8_WAIT_V(0);
    if constexpr (!ALIGN_EPI) { if (wr == 0) PG8_BAR; }
    PG8_BAR;
#undef PG8_SA
#undef PG8_SB
#undef PG8_STAGE
#undef PG8_LDA
#undef PG8_LDB
#undef PG8_MMA
#undef PG8_WAIT_V
#undef PG8_WAIT_L
#undef PG8_BAR
#undef PG8_SCHED
}
}

typedef f32x4 AccT[2][2][4][2];
__device__ __forceinline__ const float* launder(const float* p) { asm volatile("" : "+s"(p)); return p; }
#define EPI_IDS() int t_ = threadIdx.x; asm volatile("" : "+v"(t_)); const int fr = t_ & 15, fq = (t_ >> 4) & 3; const int wid_ = __builtin_amdgcn_readfirstlane(t_ >> 6), wr = wid_ >> 2, wc = wid_ & 3; (void)wr; (void)wc; (void)fr; (void)fq
#define ITER_FENCE() do { asm volatile("" ::: "memory"); __builtin_amdgcn_sched_barrier(0); } while (0)
#define EPI_BARRIER() do { asm volatile("s_waitcnt lgkmcnt(0)" ::: "memory"); __builtin_amdgcn_s_barrier(); asm volatile("" ::: "memory"); } while (0)

__device__ __forceinline__ int vcol_of_row(int J) { const int pn = J >> 8, j = J & 255, bj = j >> 7, wc = (j >> 5) & 3, n = (j >> 4) & 1, fq = (j >> 2) & 3, e = j & 3; return 256 * pn + 64 * wc + 32 * bj + 8 * fq + 4 * n + e; }
__device__ __forceinline__ int gmap(int map, int v) {
    if (map == 0) return v;
    if (map == 1) { const int pn = v >> 8, wc = (v >> 6) & 3, bj = (v >> 5) & 1, x = v & 31, h = 128 * pn + 32 * wc + x; return bj ? F_ + h : h; }
    if (map == 2) { if (v < 384) return v; if (v < 512) return 1184 + (v - 384); if (v < 768) return 384 + (v - 512); if (v < 1280) return 672 + (v - 768);
                    if (v < 1408) return 1312 + (v - 1280); if (v < 1440) return 640 + (v - 1408); return -1; }
    { const int hh = v >> 7, y = v & 127; if (y < 64) return hh * 96 + y; const int x = y - 64; if (x >= 32) return -1; const int fq = x >> 3, n = (x >> 2) & 1, e = x & 3; return hh * 96 + 64 + 16 * n + 4 * fq + e; }
}
__device__ __forceinline__ void prep_item(const float* __restrict__ W, int K, int ldw, bf16_t* Bt, int NV, int map, const float* kscale, float* scr, int item, int lane) {
    const int nb32 = NV / 32, kb = item / nb32, nb = item % nb32, k0 = 64 * kb, J0 = 32 * nb;
    const int col = gmap(map, vcol_of_row(J0 + (lane & 31)));
#pragma unroll 8
    for (int i = 0; i < 32; ++i) { const int kk = 2 * i + (lane >> 5); float v = col >= 0 ? W[(size_t)(k0 + kk) * ldw + col] : 0.f; if (kscale) v *= kscale[k0 + kk]; scr[kk * 33 + (lane & 31)] = v; }
    __builtin_amdgcn_wave_barrier();
    asm volatile("s_waitcnt lgkmcnt(0)" ::: "memory");
    const int c = lane & 7;
#pragma unroll
    for (int j = 0; j < 4; ++j) { const int n = (lane >> 3) + 8 * j; const float* s = scr + (8 * c) * 33 + n;
        u32x4 o; o.x = pk2(s[0 * 33], s[1 * 33]); o.y = pk2(s[2 * 33], s[3 * 33]); o.z = pk2(s[4 * 33], s[5 * 33]); o.w = pk2(s[6 * 33], s[7 * 33]);
        *(u32x4*)(Bt + (size_t)(J0 + n) * K + k0 + 8 * c) = o; }
    asm volatile("s_waitcnt lgkmcnt(0)" ::: "memory");
    __builtin_amdgcn_wave_barrier();
}
__device__ void phase_prep_weights(const Params& p, char* lds, int bid, int nblk) {
    Bufs B(p);
    const int wid = threadIdx.x >> 6, lane = threadIdx.x & 63;
    float* scr = (float*)lds + wid * (64 * 33 + 16);
    constexpr int I0 = 16 * 96, I1 = 16 * 32, I2 = 16 * 176, I3 = 44 * 32, I4 = 16 * 48, I5 = 16 * 32, I6 = 6 * 32, I7 = 4 * 32;
    constexpr int NIT = I0 + I1 + 2 * I2 + 2 * I3 + I4 + I5 + I6 + I7;
    for (int it = bid * 8 + wid; it < NIT; it += nblk * 8) {
        int r = it;
        if (r < I0) { prep_item(p.in[I_EWIN], 1024, 3072, B.wt + W_EIN, 3072, 0, nullptr, scr, r, lane); continue; } r -= I0;
        if (r < I1) { prep_item(p.in[I_EWOUT], 1024, 1024, B.wt + W_EOUT, 1024, 0, nullptr, scr, r, lane); continue; } r -= I1;
        if (r < 2 * I2) { const int l = r / I2; prep_item(p.in[I_FUP] + (size_t)l * 1024 * F2_, 1024, F2_, B.wt + W_UP + (size_t)l * F2_ * 1024, F2_, 1, nullptr, scr, r % I2, lane); continue; } r -= 2 * I2;
        if (r < 2 * I3) { const int l = r / I3; prep_item(p.in[I_FDOWN] + (size_t)l * F_ * 1024, F_, 1024, B.wt + W_DOWN + (size_t)l * 1024 * F_, 1024, 0, nullptr, scr, r % I3, lane); continue; } r -= 2 * I3;
        if (r < I4) { prep_item(p.in[I_OWIN], 1024, 1440, B.wt + W_OIN, 1536, 2, nullptr, scr, r, lane); continue; } r -= I4;
        if (r < I5) { prep_item(p.in[I_OWOUT], 1024, 1024, B.wt + W_OOUT, 1024, 0, nullptr, scr, r, lane); continue; } r -= I5;
        if (r < I6) { prep_item(p.in[I_CWQB], 384, 768, B.wt + W_QB, 1024, 3, p.in[I_CQAN], scr, r, lane); continue; } r -= I6;
        prep_item(p.in[I_CWKVB], 256, 1024, B.wt + W_KVB, 1024, 0, p.in[I_CKVAN], scr, r, lane);
    }
    for (int e = bid * NT + threadIdx.x; e < (2 + HROWS - (R_ + 2)) * 128; e += nblk * NT) {
        const int rr = e >> 7, c = e & 127; const int rho = rr == 0 ? 0 : rr == 1 ? 257 : R_ + 2 + (rr - 2);
        *(u32x4*)(B.h + (size_t)rho * 1024 + c * 8) = (u32x4){0u, 0u, 0u, 0u};
    }
}

__device__ __forceinline__ void head64_epi(const AccT& acc, int ai, int m, const float (&gn)[2][2][4], bool rope, const float* tab, int t, int fq, bf16_t* dst) {
    float ss = 0.f;
#pragma unroll
    for (int bj = 0; bj < 2; ++bj)
#pragma unroll
        for (int n = 0; n < 2; ++n)
#pragma unroll
            for (int e = 0; e < 4; ++e) { const float v = acc[ai][bj][m][n][e]; ss += v * v; }
    ss += __shfl_xor(ss, 16); ss += __shfl_xor(ss, 32);
    const float rr = rsqrtf(ss * (1.f / 64.f) + EPS_);
    float y[2][2][4];
#pragma unroll
    for (int bj = 0; bj < 2; ++bj)
#pragma unroll
        for (int n = 0; n < 2; ++n)
#pragma unroll
            for (int e = 0; e < 4; ++e) y[bj][n][e] = acc[ai][bj][m][n][e] * rr * gn[bj][n][e];
    if (rope) {
        const int pos = fq < 2 ? (t >> 6) : (t & 63);
        const float4* cs = (const float4*)(tab + (pos * 16 + 8 * (fq & 1)) * 2);
#pragma unroll
        for (int n = 0; n < 2; ++n) {
            const float4 c0 = cs[2 * n], c1 = cs[2 * n + 1];
            const float cv[4] = {c0.x, c0.z, c1.x, c1.z}, sv[4] = {c0.y, c0.w, c1.y, c1.w};
#pragma unroll
            for (int e = 0; e < 4; ++e) { const float x1 = y[0][n][e], x2 = y[1][n][e]; y[0][n][e] = x1 * cv[e] - x2 * sv[e]; y[1][n][e] = x1 * sv[e] + x2 * cv[e]; }
        }
    }
#pragma unroll
    for (int bj = 0; bj < 2; ++bj) {
        u32x4 w; w.x = pk2(y[bj][0][0], y[bj][0][1]); w.y = pk2(y[bj][0][2], y[bj][0][3]); w.z = pk2(y[bj][1][0], y[bj][1][1]); w.w = pk2(y[bj][1][2], y[bj][1][3]);
        *(u32x4*)(dst + 32 * bj + 8 * fq) = w;
    }
}
__device__ __forceinline__ void load_gain64(float (&gn)[2][2][4], const float* g, int fq) {
#pragma unroll
    for (int bj = 0; bj < 2; ++bj)
#pragma unroll
        for (int n = 0; n < 2; ++n) { const float4 t = *(const float4*)(g + 32 * bj + 8 * fq + 4 * n); gn[bj][n][0] = t.x; gn[bj][n][1] = t.y; gn[bj][n][2] = t.z; gn[bj][n][3] = t.w; }
}
__device__ __forceinline__ void vt_store(const AccT& acc, int ai, int m, float scale, bf16_t* vt, int fq, int r) {
    const int pos = vpos(r);
#pragma unroll
    for (int bj = 0; bj < 2; ++bj)
#pragma unroll
        for (int n = 0; n < 2; ++n)
#pragma unroll
            for (int e = 0; e < 4; ++e) vt[(size_t)(32 * bj + 8 * fq + 4 * n + e) * R_ + pos] = f2bf(acc[ai][bj][m][n][e] * scale);
}
__device__ __forceinline__ float raw_store(const AccT& acc, int ai, int m, bf16_t* dst, int fq) {
    float ss = 0.f;
#pragma unroll
    for (int bj = 0; bj < 2; ++bj) {
        u32x4 w; const f32x4 a = acc[ai][bj][m][0], b = acc[ai][bj][m][1];
        w.x = pk2(a[0], a[1]); w.y = pk2(a[2], a[3]); w.z = pk2(b[0], b[1]); w.w = pk2(b[2], b[3]);
        *(u32x4*)(dst + 32 * bj + 8 * fq) = w;
        float t[8]; unpack8(w, t);
#pragma unroll
        for (int j = 0; j < 8; ++j) ss += t[j] * t[j];
    }
    return ss;
}

struct EpiQKV0 {
    bf16_t* qkv; const float* rope; const float* gt;
    __device__ __forceinline__ void operator()(const AccT& acc, const pg8::Unit& u, int, int, int, int) const {
        EPI_IDS();
        const int seg = u.pn >> 1, r0 = u.pm * 256 + wr * 64 + fr;
        if (seg == 2 || seg == 5) {
            const size_t vo = seg == 2 ? O_VAT + ((size_t)((u.pn & 1) * 2 + (wc >> 1)) * 128 + 64 * (wc & 1)) * R_ : O_VBT + (size_t)((u.pn & 1) * 4 + wc) * 64 * R_;
            bf16_t* vt = qkv + vo;
#pragma unroll
            for (int ai = 0; ai < 2; ++ai)
#pragma unroll
                for (int m = 0; m < 4; ++m) { vt_store(acc, ai, m, 1.f, vt, fq, r0 + 128 * ai + 16 * m); ITER_FENCE(); }
        } else {
            float gn[2][2][4]; load_gain64(gn, gt + 64 * (seg < 2 ? seg : seg - 1), fq);
            const int head = (u.pn & 1) * 4 + wc;
            const size_t bo = (seg == 0 ? O_QA : seg == 1 ? O_KA : seg == 3 ? O_QB : O_KB) + (size_t)head * R_ * 64;
            bf16_t* base = qkv + bo;
            const bool rp = seg < 2 && u.pm > 0;
#pragma unroll
            for (int ai = 0; ai < 2; ++ai)
#pragma unroll
                for (int m = 0; m < 4; ++m) { const int r = r0 + 128 * ai + 16 * m; head64_epi(acc, ai, m, gn, rp, rope, r - 256, fq, base + (size_t)r * 64); ITER_FENCE(); }
        }
    }
};

struct EpiResid {
    const float* resid_lat; float* dst_lat; const float* resid_ctx; float* dst_ctx; const float* gate_lat; const float* gate_ctx;
    __device__ __forceinline__ void rows(const AccT& acc, const float* __restrict__ resid, float* dst, const float* __restrict__ gate, int row0, int col0) const {
        f32x4 gt[2][2];
#pragma unroll
        for (int bj = 0; bj < 2; ++bj)
#pragma unroll
            for (int n = 0; n < 2; ++n) gt[bj][n] = *(const f32x4*)(gate + col0 + 32 * bj + 4 * n);
#pragma unroll
        for (int ai = 0; ai < 2; ++ai)
#pragma unroll
            for (int m = 0; m < 4; ++m) {
                const size_t ro = (size_t)(row0 + 128 * ai + 16 * m) * 1024 + col0;
#pragma unroll
                for (int bj = 0; bj < 2; ++bj)
#pragma unroll
                    for (int n = 0; n < 2; ++n) { const f32x4 x = *(const f32x4*)(resid + ro + 32 * bj + 4 * n); *(f32x4*)(dst + ro + 32 * bj + 4 * n) = x + gt[bj][n] * acc[ai][bj][m][n]; }
                ITER_FENCE();
            }
    }
    __device__ __forceinline__ void operator()(const AccT& acc, const pg8::Unit& u, int, int, int, int) const {
        EPI_IDS();
        const int col0 = u.pn * 256 + wc * 64 + 8 * fq, rl = 64 * wr + fr;
        if (u.pm == 0) rows(acc, resid_ctx, dst_ctx, gate_ctx, rl, col0);
        else rows(acc, resid_lat, dst_lat, gate_lat, (u.pm - 1) * 256 + rl, col0);
    }
};

#ifndef USE_DPP
#define USE_DPP 0
#endif
__device__ __forceinline__ float rot_prev(float x, int lane) {
#if USE_DPP
    return __builtin_bit_cast(float, __builtin_amdgcn_update_dpp(0, __builtin_bit_cast(int, x), 0x121, 0xf, 0xf, false));
#else
    return __shfl(x, (lane & 48) | ((lane - 1) & 15));
#endif
}
__device__ __forceinline__ float rot_next(float x, int lane) {
#if USE_DPP
    return __builtin_bit_cast(float, __builtin_amdgcn_update_dpp(0, __builtin_bit_cast(int, x), 0x12F, 0xf, 0xf, false));
#else
    return __shfl(x, (lane & 48) | ((lane + 1) & 15));
#endif
}
struct EpiUp {
    bf16_t* act; const float* cw; const float* cb; LAS float* xch;
    __device__ __forceinline__ int xidx(int c, int which, int wc, int fq, int bj, int n) const { return (((c * 2 + which) * 4 + wc) * 64) + fq * 16 + bj * 8 + n * 4; }
    __device__ __forceinline__ void operator()(const AccT& acc, const pg8::Unit& u, int, int, int, int) const {
        EPI_IDS();
        const int lane = fq * 16 + fr;
        if (fr == 0) {
#pragma unroll
            for (int ai = 0; ai < 2; ++ai)
#pragma unroll
                for (int bj = 0; bj < 2; ++bj)
#pragma unroll
                    for (int n = 0; n < 2; ++n) *(LAS f32x4*)(xch + xidx(2 * ai + wr, 0, wc, fq, bj, n)) = acc[ai][bj][0][n];
        }
        if (fr == 15) {
#pragma unroll
            for (int ai = 0; ai < 2; ++ai)
#pragma unroll
                for (int bj = 0; bj < 2; ++bj)
#pragma unroll
                    for (int n = 0; n < 2; ++n) *(LAS f32x4*)(xch + xidx(2 * ai + wr, 1, wc, fq, bj, n)) = acc[ai][bj][3][n];
        }
        EPI_BARRIER();
        const bool isctx = u.pm < 2;
        const int seq0 = isctx ? 254 * u.pm : 254 * (u.pm - 2), lim = isctx ? 256 : T_, rbase = isctx ? 0 : 256;
#pragma unroll
        for (int n = 0; n < 2; ++n) {
            const int h0 = 128 * u.pn + 32 * wc + 8 * fq + 4 * n;
            f32x4 w0[2], w1[2], w2[2], bb[2];
#pragma unroll
            for (int bj = 0; bj < 2; ++bj) { const int c = bj * F_ + h0; w0[bj] = *(const f32x4*)(cw + c); w1[bj] = *(const f32x4*)(cw + F2_ + c); w2[bj] = *(const f32x4*)(cw + 2 * F2_ + c); bb[bj] = *(const f32x4*)(cb + c); }
#pragma unroll
            for (int ai = 0; ai < 2; ++ai) {
                const int c = 2 * ai + wr;
                f32x4 eup[2], edn[2];
#pragma unroll
                for (int bj = 0; bj < 2; ++bj) {
                    eup[bj] = c > 0 ? *(const LAS f32x4*)(xch + xidx(c - 1, 1, wc, fq, bj, n)) : (f32x4){0.f, 0.f, 0.f, 0.f};
                    edn[bj] = c < 3 ? *(const LAS f32x4*)(xch + xidx(c + 1, 0, wc, fq, bj, n)) : (f32x4){0.f, 0.f, 0.f, 0.f};
                }
#pragma unroll
                for (int m = 0; m < 4; ++m) {
                    f32x4 cv[2];
#pragma unroll
                    for (int bj = 0; bj < 2; ++bj) {
                        const f32x4 x = acc[ai][bj][m][n];
                        f32x4 up, dn;
#pragma unroll
                        for (int e = 0; e < 4; ++e) {
                            const float ps = rot_prev(x[e], lane), ns = rot_next(x[e], lane);
                            float pe, ne;
                            if (m > 0) pe = rot_prev(acc[ai][bj][m > 0 ? m - 1 : 0][n][e], lane); else pe = eup[bj][e];
                            if (m < 3) ne = rot_next(acc[ai][bj][m < 3 ? m + 1 : 3][n][e], lane); else ne = edn[bj][e];
                            up[e] = fr == 0 ? pe : ps; dn[e] = fr == 15 ? ne : ns;
                        }
                        cv[bj] = bb[bj] + w0[bj] * up + w1[bj] * x + w2[bj] * dn;
                    }
                    const int j = 128 * ai + 64 * wr + 16 * m + fr, sr = seq0 + j - 1;
                    if (j >= 1 && j <= 254 && sr < lim) {
                        float o[4];
#pragma unroll
                        for (int e = 0; e < 4; ++e) { const float gg = cv[1][e]; o[e] = cv[0][e] * (gg / (1.f + __expf(-gg))); }
                        *(uint2*)(act + (size_t)(rbase + sr) * F_ + h0) = make_uint2(pk2(o[0], o[1]), pk2(o[2], o[3]));
                    }
                    ITER_FENCE();
                }
            }
        }
    }
};

struct EpiQKV1A {
    bf16_t* qkv; float* part; const float* rope; const float* gt;
    __device__ __forceinline__ void operator()(const AccT& acc, const pg8::Unit& u, int, int, int, int) const {
        EPI_IDS();
        const int r0 = u.pm * 256 + wr * 64 + fr, pn = u.pn;
        const bool rp = u.pm > 0;
        if (pn == 0 || (pn == 1 && wc < 2) || pn == 2) {
            const int chunk = pn == 0 ? wc : pn == 1 ? 4 + wc : wc;
            const size_t bo = pn == 2 ? O_CKV + 64 * wc : O_CQ + 64 * chunk;
            bf16_t* base = qkv + bo;
            const int ld = pn == 2 ? 256 : 384;
            float* pp = part + (pn == 2 ? 8 : 0) + chunk;
#pragma unroll
            for (int ai = 0; ai < 2; ++ai)
#pragma unroll
                for (int m = 0; m < 4; ++m) {
                    const int r = r0 + 128 * ai + 16 * m;
                    float ss = raw_store(acc, ai, m, base + (size_t)r * ld, fq);
                    ss += __shfl_xor(ss, 16); ss += __shfl_xor(ss, 32);
                    if (fq == 0) pp[(size_t)r * 12] = ss;
                    ITER_FENCE();
                }
        } else if (pn == 1 || pn == 3 || pn == 4) {
            const bool isk = pn == 1;
            float gn[2][2][4]; load_gain64(gn, gt + (isk ? 320 : 256), fq);
            const size_t bo = isk ? O_GK + (size_t)(wc - 2) * R_ * 64 : O_GQ + (size_t)(4 * (pn - 3) + wc) * R_ * 64;
            bf16_t* base = qkv + bo;
#pragma unroll
            for (int ai = 0; ai < 2; ++ai)
#pragma unroll
                for (int m = 0; m < 4; ++m) { const int r = r0 + 128 * ai + 16 * m; head64_epi(acc, ai, m, gn, rp, rope, r - 256, fq, base + (size_t)r * 64); ITER_FENCE(); }
        } else {
            if (wc < 2) {
                bf16_t* vt = qkv + O_GVT + (size_t)wc * 64 * R_;
#pragma unroll
                for (int ai = 0; ai < 2; ++ai)
#pragma unroll
                    for (int m = 0; m < 4; ++m) { vt_store(acc, ai, m, 1.f, vt, fq, r0 + 128 * ai + 16 * m); ITER_FENCE(); }
            } else if (wc == 2) {
#pragma unroll
                for (int ai = 0; ai < 2; ++ai)
#pragma unroll
                    for (int m = 0; m < 4; ++m) {
                        const int r = r0 + 128 * ai + 16 * m; const f32x4 a = acc[ai][0][m][0], b = acc[ai][0][m][1];
                        u32x4 w; w.x = pk2(a[0], a[1]); w.y = pk2(a[2], a[3]); w.z = pk2(b[0], b[1]); w.w = pk2(b[2], b[3]);
                        *(u32x4*)(qkv + O_CKR + (size_t)r * 32 + 8 * fq) = w;
                    }
            }
        }
    }
};

struct EpiQB {
    bf16_t* qkv; const float* part; const float* rope; const float* gq; LAS float* xch;
    __device__ __forceinline__ void operator()(const AccT& acc, const pg8::Unit& u, int, int, int, int) const {
        EPI_IDS();
        const int wid = wr * 4 + wc, head = 2 * u.pn + (wc >> 1), role = wc & 1, r0 = u.pm * 256 + wr * 64 + fr;
        const bool rp = u.pm > 0;
        float ssp[2][4];
#pragma unroll
        for (int ai = 0; ai < 2; ++ai)
#pragma unroll
            for (int m = 0; m < 4; ++m) {
                float ss = 0.f;
#pragma unroll
                for (int bj = 0; bj < 2; ++bj)
#pragma unroll
                    for (int n = 0; n < 2; ++n)
#pragma unroll
                        for (int e = 0; e < 4; ++e) { const float v = acc[ai][bj][m][n][e]; ss += v * v; }
                ss += __shfl_xor(ss, 16); ss += __shfl_xor(ss, 32);
                ssp[ai][m] = ss;
                if (fq == 0) xch[wid * 128 + ai * 64 + m * 16 + fr] = ss;
            }
        EPI_BARRIER();
        float g0[2][2][4];
        const float* gql = launder(gq);
        if (role == 0) load_gain64(g0, gql, fq);
        else {
#pragma unroll
            for (int n = 0; n < 2; ++n) { const float4 t = *(const float4*)(gql + 64 + 16 * n + 4 * fq); g0[0][n][0] = t.x; g0[0][n][1] = t.y; g0[0][n][2] = t.z; g0[0][n][3] = t.w; }
        }
#pragma unroll
        for (int ai = 0; ai < 2; ++ai)
#pragma unroll
            for (int m = 0; m < 4; ++m) {
                const int r = r0 + 128 * ai + 16 * m;
                const float so = xch[(wid ^ 1) * 128 + ai * 64 + m * 16 + fr];
                const float* pp = part + (size_t)r * 12;
                const float rq = rsqrtf((pp[0] + pp[1] + pp[2] + pp[3] + pp[4] + pp[5]) * (1.f / 384.f) + EPS_);
                const float sc = rq * rsqrtf(rq * rq * (ssp[ai][m] + so) * (1.f / 96.f) + EPS_);
                bf16_t* dst = qkv + O_MQ + ((size_t)head * R_ + r) * 96;
                if (role == 0) {
#pragma unroll
                    for (int bj = 0; bj < 2; ++bj) {
                        const f32x4 a = acc[ai][bj][m][0], b = acc[ai][bj][m][1];
                        u32x4 w; w.x = pk2(a[0] * sc * g0[bj][0][0], a[1] * sc * g0[bj][0][1]); w.y = pk2(a[2] * sc * g0[bj][0][2], a[3] * sc * g0[bj][0][3]);
                        w.z = pk2(b[0] * sc * g0[bj][1][0], b[1] * sc * g0[bj][1][1]); w.w = pk2(b[2] * sc * g0[bj][1][2], b[3] * sc * g0[bj][1][3]);
                        *(u32x4*)(dst + 32 * bj + 8 * fq) = w;
                    }
                } else {
                    float y1[4], y2[4];
#pragma unroll
                    for (int e = 0; e < 4; ++e) { y1[e] = acc[ai][0][m][0][e] * sc * g0[0][0][e]; y2[e] = acc[ai][0][m][1][e] * sc * g0[0][1][e]; }
                    if (rp) {
                        const int t = r - 256, pos = fq < 2 ? (t >> 6) : (t & 63);
                        const float* tb = rope + (pos * 16 + 8 * (fq & 1)) * 2;
#pragma unroll
                        for (int e = 0; e < 4; ++e) { const float2 cs = *(const float2*)(tb + 4 * e); const float a = y1[e], b = y2[e]; y1[e] = a * cs.x - b * cs.y; y2[e] = a * cs.y + b * cs.x; }
                    }
                    *(uint2*)(dst + 64 + 4 * fq) = make_uint2(pk2(y1[0], y1[1]), pk2(y1[2], y1[3]));
                    *(uint2*)(dst + 80 + 4 * fq) = make_uint2(pk2(y2[0], y2[1]), pk2(y2[2], y2[3]));
                }
                ITER_FENCE();
            }
        EPI_BARRIER();
    }
};

struct EpiKVB {
    bf16_t* qkv; const float* part; const float* rope; const float* gk;
    __device__ __forceinline__ void operator()(const AccT& acc, const pg8::Unit& u, int, int, int, int) const {
        EPI_IDS();
        const int head = 2 * u.pn + (wc >> 1), role = wc & 1, r0 = u.pm * 256 + wr * 64 + fr;
        const bool rp = u.pm > 0;
        if (role == 1) {
            bf16_t* vt = qkv + O_MVT + (size_t)head * 64 * R_;
#pragma unroll
            for (int ai = 0; ai < 2; ++ai)
#pragma unroll
                for (int m = 0; m < 4; ++m) {
                    const int r = r0 + 128 * ai + 16 * m; const float* pp = part + (size_t)r * 12 + 8;
                    const float rk = rsqrtf((pp[0] + pp[1] + pp[2] + pp[3]) * (1.f / 256.f) + EPS_);
                    vt_store(acc, ai, m, rk, vt, fq, r);
                    ITER_FENCE();
                }
        } else {
            const float* gkl = launder(gk);
            float gn[2][2][4]; load_gain64(gn, gkl, fq);
            float gr[2][4];
#pragma unroll
            for (int n = 0; n < 2; ++n) { const float4 t = *(const float4*)(gkl + 64 + 16 * n + 4 * fq); gr[n][0] = t.x; gr[n][1] = t.y; gr[n][2] = t.z; gr[n][3] = t.w; }
#pragma unroll
            for (int ai = 0; ai < 2; ++ai)
#pragma unroll
                for (int m = 0; m < 4; ++m) {
                    const int r = r0 + 128 * ai + 16 * m; const float* pp = part + (size_t)r * 12 + 8;
                    const float rk = rsqrtf((pp[0] + pp[1] + pp[2] + pp[3]) * (1.f / 256.f) + EPS_);
                    const uint2 c1 = *(const uint2*)(qkv + O_CKR + (size_t)r * 32 + 4 * fq), c2 = *(const uint2*)(qkv + O_CKR + (size_t)r * 32 + 16 + 4 * fq);
                    float y1[4] = {__uint_as_float(c1.x << 16), __uint_as_float(c1.x & 0xffff0000u), __uint_as_float(c1.y << 16), __uint_as_float(c1.y & 0xffff0000u)};
                    float y2[4] = {__uint_as_float(c2.x << 16), __uint_as_float(c2.x & 0xffff0000u), __uint_as_float(c2.y << 16), __uint_as_float(c2.y & 0xffff0000u)};
                    float ss = 0.f;
#pragma unroll
                    for (int bj = 0; bj < 2; ++bj)
#pragma unroll
                        for (int n = 0; n < 2; ++n)
#pragma unroll
                            for (int e = 0; e < 4; ++e) { const float v = acc[ai][bj][m][n][e] * rk; ss += v * v; }
#pragma unroll
                    for (int e = 0; e < 4; ++e) ss += y1[e] * y1[e] + y2[e] * y2[e];
                    ss += __shfl_xor(ss, 16); ss += __shfl_xor(ss, 32);
                    const float rr = rsqrtf(ss * (1.f / 96.f) + EPS_), sc = rk * rr;
                    bf16_t* dst = qkv + O_MK + ((size_t)head * R_ + r) * 96;
#pragma unroll
                    for (int bj = 0; bj < 2; ++bj) {
                        const f32x4 a = acc[ai][bj][m][0], b = acc[ai][bj][m][1];
                        u32x4 w; w.x = pk2(a[0] * sc * gn[bj][0][0], a[1] * sc * gn[bj][0][1]); w.y = pk2(a[2] * sc * gn[bj][0][2], a[3] * sc * gn[bj][0][3]);
                        w.z = pk2(b[0] * sc * gn[bj][1][0], b[1] * sc * gn[bj][1][1]); w.w = pk2(b[2] * sc * gn[bj][1][2], b[3] * sc * gn[bj][1][3]);
                        *(u32x4*)(dst + 32 * bj + 8 * fq) = w;
                    }
#pragma unroll
                    for (int e = 0; e < 4; ++e) { y1[e] *= rr * gr[0][e]; y2[e] *= rr * gr[1][e]; }
                    if (rp) {
                        const int t = r - 256, pos = fq < 2 ? (t >> 6) : (t & 63);
                        const float* tb = rope + (pos * 16 + 8 * (fq & 1)) * 2;
#pragma unroll
                        for (int e = 0; e < 4; ++e) { const float2 cs = *(const float2*)(tb + 4 * e); const float a = y1[e], b = y2[e]; y1[e] = a * cs.x - b * cs.y; y2[e] = a * cs.y + b * cs.x; }
                    }
                    *(uint2*)(dst + 64 + 4 * fq) = make_uint2(pk2(y1[0], y1[1]), pk2(y1[2], y1[3]));
                    *(uint2*)(dst + 80 + 4 * fq) = make_uint2(pk2(y2[0], y2[1]), pk2(y2[2], y2[3]));
                    ITER_FENCE();
                }
        }
    }
};

__device__ __forceinline__ void g_qkv0(const Params& p, LAS unsigned char* lds) {
    Bufs B(p);
    pg8::Gemm g{B.h, B.wt + W_EIN, 1024}; pg8::Order S; S.init(65, 12, gridDim.x, blockIdx.x, 0, 1);
    EpiQKV0 E{B.qkv, B.rope, B.gt};
    pg8::gemm_phase<EpiQKV0, pg8::Order, true, true>(lds, g, S, E);
}
__device__ __forceinline__ void g_out(const Params& p, int l, LAS unsigned char* lds) {
    Bufs B(p);
    pg8::Gemm g{B.mix, B.wt + (l == 0 ? W_EOUT : W_OOUT), 1024}; pg8::Order S; S.init(l == 0 ? 65 : 64, 4, gridDim.x, blockIdx.x, l == 0 ? 0 : 1, 0);
    EpiResid E{l == 0 ? p.in[I_X] : p.out, p.out, p.in[I_CTX], B.xc, modp(B, l, 0, 2), modp(B, l, 1, 2)};
    pg8::gemm_phase<EpiResid, pg8::Order, true, true>(lds, g, S, E);
}
__device__ __forceinline__ void g_up(const Params& p, int l, LAS unsigned char* lds) {
    Bufs B(p);
    pg8::Gemm g{B.h, B.wt + W_UP + (size_t)l * F2_ * 1024, 1024}; pg8::Order S; S.init(l == 0 ? 67 : 65, 22, gridDim.x, blockIdx.x, l == 0 ? 0 : 2, 2);
    EpiUp E{B.act, p.in[I_FCW] + (size_t)l * 3 * F2_, p.in[I_FCB] + (size_t)l * F2_, (LAS float*)(lds + LDS_XCH)};
    pg8::gemm_phase<EpiUp, pg8::Order, true, true>(lds, g, S, E);
}
__device__ __forceinline__ void g_down(const Params& p, int l, LAS unsigned char* lds) {
    Bufs B(p);
    pg8::Gemm g{B.act, B.wt + W_DOWN + (size_t)l * 1024 * F_, F_}; pg8::Order S; S.init(l == 0 ? 65 : 64, 4, gridDim.x, blockIdx.x, l == 0 ? 0 : 1, 0);
    EpiResid E{p.out, p.out, B.xc, B.xc, modp(B, l, 0, 5), modp(B, l, 1, 5)};
    pg8::gemm_phase<EpiResid, pg8::Order, true, true>(lds, g, S, E);
}
__device__ __forceinline__ void g_qkv1a(const Params& p, LAS unsigned char* lds) {
    Bufs B(p);
    pg8::Gemm g{B.h, B.wt + W_OIN, 1024}; pg8::Order S; S.init(65, 6, gridDim.x, blockIdx.x, 0, 1);
    EpiQKV1A E{B.qkv, B.part, B.rope, B.gt};
    pg8::gemm_phase<EpiQKV1A, pg8::Order, true, true>(lds, g, S, E);
}
__device__ __forceinline__ void g_qkv1b(const Params& p, LAS unsigned char* lds) {
    Bufs B(p);
    { pg8::Gemm g{B.qkv + O_CQ, B.wt + W_QB, 384}; pg8::Order S; S.init(64, 4, gridDim.x, blockIdx.x, 1, 0);
      EpiQB E{B.qkv, B.part, B.rope, p.in[I_CQN], (LAS float*)(lds + LDS_XCH)};
      pg8::gemm_phase<EpiQB, pg8::Order, true, true>(lds, g, S, E); }
    { pg8::Gemm g{B.qkv + O_CKV, B.wt + W_KVB, 256}; pg8::Order S; S.init(65, 4, gridDim.x, blockIdx.x, 0, 0);
      EpiKVB E{B.qkv, B.part, B.rope, p.in[I_CKN]};
      pg8::gemm_phase<EpiKVB, pg8::Order, true, true>(lds, g, S, E); }
}

#ifndef OPTG
#define OPTG 0x7f
#endif
constexpr int NPHASE = 16;
__device__ __forceinline__ void run_phase(int ph, const Params& p, char* lds, int bid, int nblk) {
    LAS unsigned char* l3 = (LAS unsigned char*)lds;
    switch (ph) {
        case 0: phase_prep(p, lds, bid, nblk); if (OPTG) phase_prep_weights(p, lds, bid, nblk); break;
        case 1: phase_norm(p, 0, 0, bid, nblk); break;
        case 2: if (OPTG & 1) g_qkv0(p, l3); else phase_qkv0(p, lds, bid, nblk); break;
        case 3: phase_attn0(p, lds, bid, nblk); break;
        case 4: if (OPTG & 2) g_out(p, 0, l3); else phase_out(p, 0, bid, nblk); break;
        case 5: phase_norm(p, 0, 1, bid, nblk); break;
        case 6: if (OPTG & 4) g_up(p, 0, l3); else phase_up(p, 0, lds, bid, nblk); break;
        case 7: if (OPTG & 8) g_down(p, 0, l3); else phase_down(p, 0, bid, nblk); break;
        case 8: phase_norm(p, 1, 0, bid, nblk); break;
        case 9: if (OPTG & 16) g_qkv1a(p, l3); else phase_qkv1a(p, lds, bid, nblk); break;
        case 10: if (OPTG & 32) g_qkv1b(p, l3); else phase_qkv1b(p, lds, bid, nblk); break;
        case 11: phase_attn1(p, bid, nblk); break;
        case 12: if (OPTG & 2) g_out(p, 1, l3); else phase_out(p, 1, bid, nblk); break;
        case 13: phase_norm(p, 1, 1, bid, nblk); break;
        case 14: if (OPTG & 4) g_up(p, 1, l3); else phase_up(p, 1, lds, bid, nblk); break;
        case 15: if (OPTG & 8) g_down(p, 1, l3); else phase_down(p, 1, bid, nblk); break;
    }
}

namespace cg = cooperative_groups;
__global__ void __launch_bounds__(NT, 2) k_mega(Params p) {
    extern __shared__ __attribute__((aligned(16))) char smem[];
    cg::grid_group grid = cg::this_grid();
    const int bid = blockIdx.x, nblk = gridDim.x;
#define PH(n) run_phase(n, p, smem, bid, nblk)
    PH(0); grid.sync(); PH(1); grid.sync(); PH(2); grid.sync(); PH(3); grid.sync(); PH(4); grid.sync(); PH(5); grid.sync(); PH(6); grid.sync(); PH(7); grid.sync();
    PH(8); grid.sync(); PH(9); grid.sync(); PH(10); grid.sync(); PH(11); grid.sync(); PH(12); grid.sync(); PH(13); grid.sync(); PH(14); grid.sync(); PH(15);
#undef PH
}

extern "C" void kernel_launch(void* const* d_in, const int* in_sizes, int n_in, void* d_out, int out_size, void* d_ws, size_t ws_size, hipStream_t stream) {
    Params p{};
    for (int i = 0; i < 35; ++i) p.in[i] = (const float*)d_in[i];
    p.out = (float*)d_out; p.ws = (char*)d_ws;
    if (ws_size < WS_END) { fprintf(stderr, "ws too small: %zu < %zu\n", ws_size, (size_t)WS_END); return; }
    static int grid_blocks = 0;
    if (!grid_blocks) {
        int dev = 0, cus = 0, per_cu = 0;
        hipGetDevice(&dev);
        hipDeviceGetAttribute(&cus, hipDeviceAttributeMultiprocessorCount, dev);
        if (hipFuncSetAttribute((const void*)k_mega, hipFuncAttributeMaxDynamicSharedMemorySize, LDS_BYTES) != hipSuccess) fprintf(stderr, "hipFuncSetAttribute failed\n");
        hipOccupancyMaxActiveBlocksPerMultiprocessor(&per_cu, (const void*)k_mega, NT, LDS_BYTES);
        if (per_cu < 1) { fprintf(stderr, "occupancy query returned %d\n", per_cu); per_cu = 1; }
        if (per_cu > 1) per_cu = 1;
        grid_blocks = cus * per_cu;
    }
    void* args[] = {&p};
    hipError_t e = hipLaunchCooperativeKernel((const void*)k_mega, dim3(grid_blocks), dim3(NT), args, LDS_BYTES, stream);
    if (e != hipSuccess) fprintf(stderr, "cooperative launch failed: %s (grid %d)\n", hipGetErrorString(e), grid_blocks);
}
```

```cpp
#include <hip/hip_runtime.h>
#include <hip/hip_cooperative_groups.h>
#include <cstdint>
#include <cstdio>
#include <cmath>

typedef unsigned short bf16_t;
typedef unsigned int u32;
typedef u32 u32x4 __attribute__((ext_vector_type(4)));

#define NT 512
#ifndef OPTA
#define OPTA 3
#endif
constexpr int T_ = 16384, L_ = 256, R_ = 16640, D_ = 1024, F_ = 2816, F2_ = 5632;
constexpr float EPS_ = 1e-6f;

constexpr size_t WS_CTL = 0;
constexpr size_t WS_MOD = 4096;
constexpr size_t WS_SCAL = WS_MOD + 2 * 2 * 6144 * 4;
constexpr size_t WS_GT = WS_SCAL + 256;
constexpr size_t WS_ROPE = WS_GT + 6 * 64 * 4;
constexpr size_t WS_XC = WS_ROPE + 256 * 16 * 2 * 4;
constexpr size_t WS_H = WS_XC + 256 * 1024 * 4;
constexpr int HROWS = R_ + 144;
constexpr size_t WS_MIX = WS_H + (size_t)HROWS * 1024 * 2;
constexpr size_t WS_QKV = WS_MIX + (size_t)R_ * 1024 * 2;
constexpr size_t E_SEG = (size_t)512 * R_;
constexpr size_t O_QA = 0, O_KA = E_SEG, O_VAT = 2 * E_SEG, O_QB = 3 * E_SEG, O_KB = 4 * E_SEG, O_VBT = 5 * E_SEG;
constexpr size_t O_CQ = 0, O_CKV = O_CQ + (size_t)R_ * 384, O_CKR = O_CKV + (size_t)R_ * 256, O_MQ = O_CKR + (size_t)R_ * 32,
                 O_MK = O_MQ + (size_t)R_ * 768, O_MVT = O_MK + (size_t)R_ * 768, O_GQ = O_MVT + (size_t)R_ * 512,
                 O_GK = O_GQ + (size_t)R_ * 512, O_GVT = O_GK + (size_t)R_ * 128, O_L1END = O_GVT + (size_t)R_ * 128;
constexpr size_t WS_QKV_BYTES = O_L1END * 2;
constexpr size_t WS_PART = WS_QKV + WS_QKV_BYTES;
constexpr size_t WS_WT = WS_PART + (size_t)R_ * 12 * 4;
constexpr size_t W_EIN = 0, W_EOUT = W_EIN + (size_t)3072 * 1024, W_UP = W_EOUT + (size_t)1024 * 1024, W_DOWN = W_UP + (size_t)2 * 5632 * 1024,
                 W_OIN = W_DOWN + (size_t)2 * 1024 * 2816, W_OOUT = W_OIN + (size_t)1536 * 1024, W_QB = W_OOUT + (size_t)1024 * 1024,
                 W_KVB = W_QB + (size_t)1024 * 384, W_END = W_KVB + (size_t)1024 * 256;
constexpr size_t WS_END = WS_WT + W_END * 2;
static_assert(WS_END < (size_t)255 * 1024 * 1024, "ws");
static_assert((size_t)(R_ + 8) * F_ * 2 <= WS_QKV_BYTES, "act alias");

struct Params { const float* in[35]; float* out; char* ws; };
enum { I_X = 0, I_C, I_CTX, I_CCTX, I_ADAW, I_ADAB, I_NMIX, I_NFFN, I_FUP, I_FCW, I_FCB, I_FDOWN, I_EWIN, I_EWOUT, I_AQN, I_AKN,
       I_LQ1, I_LK1, I_LQ2, I_LK2, I_SUBLN, I_BQN, I_BKN, I_RPB, I_OWIN, I_OWOUT, I_CQAN, I_CWQB, I_CKVAN, I_CWKVB, I_CQN, I_CKN,
       I_DQN, I_DKN, I_SINK };

__device__ __forceinline__ float bf2f(bf16_t v) { return __uint_as_float(((u32)v) << 16); }
__device__ __forceinline__ bf16_t f2bf(float f) { u32 u = __float_as_uint(f); return (bf16_t)((u + 0x7fffu + ((u >> 16) & 1u)) >> 16); }
__device__ __forceinline__ float wave_sum(float v) {
#pragma unroll
    for (int o = 32; o > 0; o >>= 1) v += __shfl_xor(v, o);
    return v;
}
__device__ __forceinline__ int swap23(int p) { return (p & 3) | ((p & 4) << 1) | ((p & 8) >> 1); }
__device__ __forceinline__ int hrow(int r) { return r < 256 ? r + 1 : r + 2; }
__device__ __forceinline__ int vpos(int key) { return (key & ~15) + swap23(key & 15); }
__device__ __forceinline__ void unpack8(u32x4 v, float (&a)[8]) {
    a[0] = __uint_as_float(v.x << 16); a[1] = __uint_as_float(v.x & 0xffff0000u);
    a[2] = __uint_as_float(v.y << 16); a[3] = __uint_as_float(v.y & 0xffff0000u);
    a[4] = __uint_as_float(v.z << 16); a[5] = __uint_as_float(v.z & 0xffff0000u);
    a[6] = __uint_as_float(v.w << 16); a[7] = __uint_as_float(v.w & 0xffff0000u);
}

struct Bufs {
    float* mod; float* scal; float* rope; float* xc; bf16_t* h; bf16_t* mix; bf16_t* qkv; bf16_t* act; float* part; bf16_t* wt; float* gt;
    __device__ Bufs(const Params& p) {
        mod = (float*)(p.ws + WS_MOD); scal = (float*)(p.ws + WS_SCAL); rope = (float*)(p.ws + WS_ROPE); xc = (float*)(p.ws + WS_XC);
        h = (bf16_t*)(p.ws + WS_H); mix = (bf16_t*)(p.ws + WS_MIX); qkv = (bf16_t*)(p.ws + WS_QKV); act = (bf16_t*)(p.ws + WS_QKV);
        part = (float*)(p.ws + WS_PART); wt = (bf16_t*)(p.ws + WS_WT); gt = (float*)(p.ws + WS_GT);
    }
};
__device__ __forceinline__ const float* modp(const Bufs& B, int l, int s, int chunk) { return B.mod + ((size_t)(l * 2 + s) * 6144) + chunk * 1024; }

__device__ void phase_prep(const Params& p, char* lds, int bid, int nblk) {
    Bufs B(p);
    float* red = (float*)lds;
    const int tid = threadIdx.x;
    for (int item = bid; item < 193; item += nblk) {
        if (item < 192) {
            const int l = item / 96, n0 = (item % 96) * 64, nn = tid & 63, kc = tid >> 6;
            const float* W = p.in[I_ADAW] + (size_t)l * 1024 * 6144 + n0 + nn;
            float a0 = 0.f, a1 = 0.f;
            for (int k = kc * 128; k < kc * 128 + 128; ++k) {
                const float w = W[(size_t)k * 6144];
                const float c0 = p.in[I_C][k], c1 = p.in[I_CCTX][k];
                a0 += (c0 / (1.f + __expf(-c0))) * w; a1 += (c1 / (1.f + __expf(-c1))) * w;
            }
            red[(kc * 64 + nn) * 2] = a0; red[(kc * 64 + nn) * 2 + 1] = a1;
            __syncthreads();
            if (tid < 128) {
                const int n = tid & 63, s = tid >> 6; float acc = 0.f;
                for (int k = 0; k < 8; ++k) acc += red[(k * 64 + n) * 2 + s];
                B.mod[(size_t)(l * 2 + s) * 6144 + n0 + n] = acc + p.in[I_ADAB][l * 6144 + n0 + n];
            }
            __syncthreads();
        } else {
            for (int e = tid; e < 256 * 16; e += NT) {
                const int pos = e >> 4, i = e & 15;
                const double f = pow(10000.0, -(double)i / 16.0), ang = (double)pos * f;
                B.rope[e * 2] = (float)cos(ang); B.rope[e * 2 + 1] = (float)sin(ang);
            }
            if (tid < 64) {
                B.gt[tid] = p.in[I_AQN][tid]; B.gt[64 + tid] = p.in[I_AKN][tid]; B.gt[128 + tid] = p.in[I_BQN][tid]; B.gt[192 + tid] = p.in[I_BKN][tid];
                B.gt[256 + tid] = p.in[I_DQN][tid]; B.gt[320 + tid] = p.in[I_DKN][tid];
                const float s1 = wave_sum(p.in[I_LQ1][tid] * p.in[I_LK1][tid]), s2 = wave_sum(p.in[I_LQ2][tid] * p.in[I_LK2][tid]);
                if (tid == 0) B.scal[0] = expf(s1) - expf(s2) + 0.2f;
                float ma = fabsf(p.in[I_AQN][tid]), mb = fabsf(p.in[I_AKN][tid]), mc = fmaxf(fabsf(p.in[I_CQN][tid]), tid < 32 ? fabsf(p.in[I_CQN][64 + tid]) : 0.f),
                      md = fmaxf(fabsf(p.in[I_CKN][tid]), tid < 32 ? fabsf(p.in[I_CKN][64 + tid]) : 0.f);
#pragma unroll
                for (int o = 32; o > 0; o >>= 1) { ma = fmaxf(ma, __shfl_xor(ma, o)); mb = fmaxf(mb, __shfl_xor(mb, o)); mc = fmaxf(mc, __shfl_xor(mc, o)); md = fmaxf(md, __shfl_xor(md, o)); }
                if (tid == 0) { B.scal[1] = 8.f * ma * mb * 1.4426950408889634f; B.scal[2] = 9.797958971132712f * mc * md * 1.4426950408889634f; }
            }
        }
    }
}

__device__ void phase_norm(const Params& p, int l, int which, int bid, int nblk) {
    Bufs B(p);
    const int wid = threadIdx.x >> 6, lane = threadIdx.x & 63;
    const float* gamma = p.in[which ? I_NFFN : I_NMIX] + l * 1024;
    for (int e = bid * NT + threadIdx.x; e < (2 + HROWS - (R_ + 2)) * 128; e += nblk * NT) {
        const int rr = e >> 7, c = e & 127; const int rho = rr == 0 ? 0 : rr == 1 ? 257 : R_ + 2 + (rr - 2);
        *(u32x4*)(B.h + (size_t)rho * 1024 + c * 8) = (u32x4){0u, 0u, 0u, 0u};
    }
    for (int item = bid; item < R_ / 8; item += nblk) {
        const int r = item * 8 + wid;
        const bool first = (l == 0 && which == 0);
        const float* src = r < 256 ? ((first ? p.in[I_CTX] : B.xc) + (size_t)r * 1024) : ((first ? p.in[I_X] : p.out) + (size_t)(r - 256) * 1024);
        const int s = r < 256 ? 1 : 0;
        const float* sh = modp(B, l, s, which ? 3 : 0); const float* sc = modp(B, l, s, which ? 4 : 1);
        float v[16]; float ss = 0.f;
#pragma unroll
        for (int i = 0; i < 4; ++i) { const float4 t = *(const float4*)(src + i * 256 + lane * 4); v[4 * i] = t.x; v[4 * i + 1] = t.y; v[4 * i + 2] = t.z; v[4 * i + 3] = t.w; ss += t.x * t.x + t.y * t.y + t.z * t.z + t.w * t.w; }
        ss = wave_sum(ss);
        const float rr = rsqrtf(ss * (1.f / 1024.f) + EPS_);
#pragma unroll
        for (int i = 0; i < 4; ++i) {
            const int k = i * 256 + lane * 4; bf16_t o[4];
#pragma unroll
            for (int j = 0; j < 4; ++j) o[j] = f2bf(v[4 * i + j] * rr * gamma[k + j] * (1.f + sc[k + j]) + sh[k + j]);
            *(uint2*)(B.h + (size_t)hrow(r) * 1024 + k) = make_uint2((u32)o[0] | ((u32)o[1] << 16), (u32)o[2] | ((u32)o[3] << 16));
        }
    }
}

template <int RPG>
__device__ __forceinline__ void tile_linear(float (&acc)[RPG], int K, const bf16_t* const (&ap)[RPG], const float* __restrict__ W, int ldw, int wcol) {
#pragma unroll
    for (int i = 0; i < RPG; ++i) acc[i] = 0.f;
    if (wcol < 0) return;
    for (int k = 0; k < K; k += 8) {
        float w[8];
#pragma unroll
        for (int j = 0; j < 8; ++j) w[j] = W[(size_t)(k + j) * ldw + wcol];
#pragma unroll
        for (int i = 0; i < RPG; ++i) {
            if (ap[i]) { float a[8]; unpack8(*(const u32x4*)(ap[i] + k), a);
#pragma unroll
                for (int j = 0; j < 8; ++j) acc[i] += a[j] * w[j]; }
        }
    }
}
template <int RPG>
__device__ __forceinline__ void tile_linear_g(float (&acc)[RPG], int K, const bf16_t* const (&ap)[RPG], const float (&rs)[RPG], const float* __restrict__ g, const float* __restrict__ W, int ldw, int wcol) {
#pragma unroll
    for (int i = 0; i < RPG; ++i) acc[i] = 0.f;
    if (wcol < 0) return;
    for (int k = 0; k < K; k += 8) {
        float w[8];
#pragma unroll
        for (int j = 0; j < 8; ++j) w[j] = W[(size_t)(k + j) * ldw + wcol] * g[k + j];
#pragma unroll
        for (int i = 0; i < RPG; ++i) {
            if (ap[i]) { float a[8]; unpack8(*(const u32x4*)(ap[i] + k), a); float t = 0.f;
#pragma unroll
                for (int j = 0; j < 8; ++j) t += a[j] * w[j];
                acc[i] += t * rs[i]; }
        }
    }
}

__device__ __forceinline__ float2 rope64(const float* tab, int t, int i) { const int pos = i < 16 ? (t >> 6) : (t & 63); const int f = i & 15; return *(const float2*)(tab + (pos * 16 + f) * 2); }
__device__ __forceinline__ float2 rope32(const float* tab, int t, int i) { const int pos = i < 8 ? (t >> 6) : (t & 63); const int f = (i & 7) * 2; return *(const float2*)(tab + (pos * 16 + f) * 2); }

__device__ __forceinline__ void head64_norm_rope(const float* row, const float* g, bool rope, const float* tab, int t, bf16_t* dst, int lane) {
    const float v = row[lane];
    const float ss = wave_sum(v * v);
    const float rr = rsqrtf(ss * (1.f / 64.f) + EPS_);
    float y = v * rr * g[lane];
    if (rope) {
        const float yp = row[lane ^ 32] * rr * g[lane ^ 32];
        const float2 cs = rope64(tab, t, lane & 31);
        y = lane < 32 ? (y * cs.x - yp * cs.y) : (yp * cs.y + y * cs.x);
    }
    dst[lane] = f2bf(y);
}

__device__ void phase_qkv0(const Params& p, char* lds, int bid, int nblk) {
    Bufs B(p);
    float* tile = (float*)lds;
    const int tid = threadIdx.x, cc = tid & 127, rg = tid >> 7, wid = tid >> 6, lane = tid & 63;
    const float* W = p.in[I_EWIN];
    for (int item = bid; item < (R_ / 16) * 24; item += nblk) {
        const int rt = item / 24, ct = item % 24, row0 = rt * 16, col0 = ct * 128;
        const bf16_t* ap[4];
#pragma unroll
        for (int i = 0; i < 4; ++i) ap[i] = B.h + (size_t)hrow(row0 + rg * 4 + i) * 1024;
        float acc[4];
        tile_linear<4>(acc, 1024, ap, W, 3072, col0 + cc);
#pragma unroll
        for (int i = 0; i < 4; ++i) tile[(rg * 4 + i) * 128 + cc] = acc[i];
        __syncthreads();
        const int seg = col0 / 512, cin = col0 % 512;
        if (seg == 2 || seg == 5) {
            for (int e = tid; e < 16 * 128; e += NT) {
                const int c = e >> 4, rr = e & 15, r = row0 + rr;
                bf16_t* dst;
                if (seg == 2) dst = B.qkv + O_VAT + ((size_t)(cin / 128) * 128 + c) * R_;
                else dst = B.qkv + O_VBT + ((size_t)((cin + c) / 64) * 64 + (c & 63)) * R_;
                dst[vpos(r)] = f2bf(tile[rr * 128 + c]);
            }
        } else {
            for (int q = wid * 4; q < wid * 4 + 4; ++q) {
                const int rr = q >> 1, hh = q & 1, r = row0 + rr, head = cin / 64 + hh;
                const float* g = p.in[seg == 0 ? I_AQN : seg == 1 ? I_AKN : seg == 3 ? I_BQN : I_BKN];
                bf16_t* dst = B.qkv + (seg == 0 ? O_QA : seg == 1 ? O_KA : seg == 3 ? O_QB : O_KB) + ((size_t)head * R_ + r) * 64;
                head64_norm_rope(tile + rr * 128 + hh * 64, g, (seg < 2) && r >= 256, B.rope, r - 256, dst, lane);
            }
        }
        __syncthreads();
    }
}

__device__ __forceinline__ float dot8p(u32x4 k, u32 q0, u32 q1, u32 q2, u32 q3) {
    float t = __uint_as_float(k.x << 16) * __uint_as_float(q0 << 16);
    t += __uint_as_float(k.x & 0xffff0000u) * __uint_as_float(q0 & 0xffff0000u);
    t += __uint_as_float(k.y << 16) * __uint_as_float(q1 << 16);
    t += __uint_as_float(k.y & 0xffff0000u) * __uint_as_float(q1 & 0xffff0000u);
    t += __uint_as_float(k.z << 16) * __uint_as_float(q2 << 16);
    t += __uint_as_float(k.z & 0xffff0000u) * __uint_as_float(q2 & 0xffff0000u);
    t += __uint_as_float(k.w << 16) * __uint_as_float(q3 << 16);
    t += __uint_as_float(k.w & 0xffff0000u) * __uint_as_float(q3 & 0xffff0000u);
    return t;
}
template <int DQK, int DVT>
__device__ __forceinline__ void naive_dense(const bf16_t* __restrict__ q, const bf16_t* __restrict__ Kb, const bf16_t* __restrict__ VT, int nk, float scale, float (&O)[DVT], float& lsum) {
    u32x4 qp[DQK / 8];
#pragma unroll
    for (int i = 0; i < DQK / 8; ++i) qp[i] = *(const u32x4*)(q + i * 8);
#pragma unroll
    for (int d = 0; d < DVT; ++d) O[d] = 0.f;
    float m = -1e30f, l = 0.f;
    for (int c = 0; c < nk; c += 8) {
        float s[8];
#pragma unroll
        for (int j = 0; j < 8; ++j) {
            const int key = (c & ~15) + swap23((c & 15) + j);
            const bf16_t* kr = Kb + (size_t)key * DQK; float t = 0.f;
#pragma unroll
            for (int i = 0; i < DQK / 8; ++i) t += dot8p(*(const u32x4*)(kr + i * 8), qp[i].x, qp[i].y, qp[i].z, qp[i].w);
            s[j] = t * scale;
        }
        float cm = s[0];
#pragma unroll
        for (int j = 1; j < 8; ++j) cm = fmaxf(cm, s[j]);
        const float mn = fmaxf(m, cm), alpha = __expf(m - mn);
        float ps = 0.f;
#pragma unroll
        for (int j = 0; j < 8; ++j) { s[j] = __expf(s[j] - mn); ps += s[j]; }
        l = l * alpha + ps; m = mn;
#pragma unroll
        for (int d = 0; d < DVT; ++d) {
            float a[8]; unpack8(*(const u32x4*)(VT + (size_t)d * R_ + c), a);
            float t = O[d] * alpha;
#pragma unroll
            for (int j = 0; j < 8; ++j) t += s[j] * a[j];
            O[d] = t;
            if ((d & 7) == 7) __builtin_amdgcn_sched_barrier(0);
        }
    }
    lsum = l;
}

__device__ void phase_attn0(const Params& p, char* lds, int bid, int nblk) {
    Bufs B(p);
    const int tid = threadIdx.x;
    float* xch = (float*)lds;
    const float lam = B.scal[0];
    for (int item = bid + ((OPTA & 1) ? 1040 : 0); item < 1300; item += nblk) {
        if (item < 1040) {
            const int head = item / 260, chunk = item % 260, role = tid >> 6, m = role >> 2, qt = role & 3, qi = tid & 63, r = chunk * 64 + qi, sub = head * 2 + m;
            const int nk = chunk < 4 ? 256 : R_;
            float O[32]; float l;
            naive_dense<64, 32>(B.qkv + O_QA + ((size_t)sub * R_ + r) * 64, B.qkv + O_KA + (size_t)sub * R_ * 64, B.qkv + O_VAT + ((size_t)head * 128 + qt * 32) * R_, nk, 0.125f, O, l);
            const float inv = 1.f / l;
#pragma unroll
            for (int d = 0; d < 32; ++d) O[d] *= inv;
            float* xh = xch + (qt * 64 + qi) * 33;
            __syncthreads();
            if (m == 1) {
#pragma unroll
                for (int d = 0; d < 32; ++d) xh[d] = O[d];
            }
            __syncthreads();
            if (m == 0) {
#pragma unroll
                for (int d = 0; d < 32; ++d) O[d] -= lam * xh[d];
            }
            __syncthreads();
            float ss = 0.f;
#pragma unroll
            for (int d = 0; d < 32; ++d) ss += O[d] * O[d];
            if (m == 0) xh[0] = ss;
            __syncthreads();
            if (m == 0) {
                const float tot = xch[(0 * 64 + qi) * 33] + xch[(1 * 64 + qi) * 33] + xch[(2 * 64 + qi) * 33] + xch[(3 * 64 + qi) * 33];
                const float rr = rsqrtf(tot * (1.f / 128.f) + EPS_) * 0.8f;
                bf16_t* dst = B.mix + (size_t)r * 1024 + head * 128 + qt * 32;
                const float* g = p.in[I_SUBLN] + qt * 32;
#pragma unroll
                for (int d = 0; d < 32; d += 2) *(u32*)(dst + d) = (u32)f2bf(O[d] * rr * g[d]) | ((u32)f2bf(O[d + 1] * rr * g[d + 1]) << 16);
            }
            __syncthreads();
        } else {
            const int idx = (item - 1040) * NT + tid, h = idx / R_, r = idx % R_;
            const bf16_t* q = B.qkv + O_QB + ((size_t)h * R_ + r) * 64;
            const bf16_t* Kb = B.qkv + O_KB + (size_t)h * R_ * 64;
            const bf16_t* VT = B.qkv + O_VBT + (size_t)h * 64 * R_;
            float qf[64];
#pragma unroll
            for (int i = 0; i < 8; ++i) { float a[8]; unpack8(*(const u32x4*)(q + i * 8), a);
#pragma unroll
                for (int j = 0; j < 8; ++j) qf[i * 8 + j] = a[j] * 0.125f; }
            float O[64];
#pragma unroll
            for (int d = 0; d < 64; ++d) O[d] = 0.f;
            float m = -1e30f, l = 0.f;
            const int t = r - 256, row = t >> 6, col = t & 63;
            const int rs = min(max(row - 4, 0), 248), cs = min(max(col - 8, 0), 48);
            const int nkeys = r < 256 ? 256 : 384;
            for (int kk = 0; kk < nkeys; ++kk) {
                int key; float bias = 0.f;
                if (kk < 256) key = kk;
                else { const int w = kk - 256, kr = rs + (w >> 4), kc = cs + (w & 15); key = 256 + kr * 64 + kc; bias = p.in[I_RPB][(h * 15 + (kr - row + 7)) * 31 + (kc - col + 15)]; }
                const bf16_t* krow = Kb + (size_t)key * 64; float s = bias;
#pragma unroll
                for (int i = 0; i < 8; ++i) { float a[8]; unpack8(*(const u32x4*)(krow + i * 8), a);
#pragma unroll
                    for (int j = 0; j < 8; ++j) s += a[j] * qf[i * 8 + j]; }
                const float mn = fmaxf(m, s), alpha = __expf(m - mn), pp = __expf(s - mn);
                l = l * alpha + pp; m = mn;
                const int vp = vpos(key);
#pragma unroll
                for (int d = 0; d < 64; ++d) O[d] = O[d] * alpha + pp * bf2f(VT[(size_t)d * R_ + vp]);
            }
            const float inv = 1.f / l;
            bf16_t* dst = B.mix + (size_t)r * 1024 + 512 + h * 64;
#pragma unroll
            for (int d = 0; d < 64; d += 2) *(u32*)(dst + d) = (u32)f2bf(O[d] * inv) | ((u32)f2bf(O[d + 1] * inv) << 16);
        }
    }
}

__device__ void phase_out(const Params& p, int l, int bid, int nblk) {
    Bufs B(p);
    const int tid = threadIdx.x, cc = tid & 127, rg = tid >> 7;
    const float* W = p.in[l == 0 ? I_EWOUT : I_OWOUT];
    const int rt0 = l == 0 ? 0 : 16, nrt = R_ / 16 - rt0;
    for (int item = bid; item < nrt * 8; item += nblk) {
        const int rt = rt0 + item / 8, ct = item % 8, row0 = rt * 16, col = ct * 128 + cc;
        const bf16_t* ap[4];
#pragma unroll
        for (int i = 0; i < 4; ++i) ap[i] = B.mix + (size_t)(row0 + rg * 4 + i) * 1024;
        float acc[4];
        tile_linear<4>(acc, 1024, ap, W, 1024, col);
#pragma unroll
        for (int i = 0; i < 4; ++i) {
            const int r = row0 + rg * 4 + i;
            if (r < 256) B.xc[(size_t)r * 1024 + col] = p.in[I_CTX][(size_t)r * 1024 + col] + modp(B, l, 1, 2)[col] * acc[i];
            else { const size_t o = (size_t)(r - 256) * 1024 + col; p.out[o] = (l == 0 ? p.in[I_X][o] : p.out[o]) + modp(B, l, 0, 2)[col] * acc[i]; }
        }
    }
}

__device__ void phase_up(const Params& p, int l, char* lds, int bid, int nblk) {
    Bufs B(p);
    float* tile = (float*)lds;
    const int tid = threadIdx.x, cc = tid & 127, rg = tid >> 7;
    const float* W = p.in[I_FUP] + (size_t)l * 1024 * F2_;
    const float* cw = p.in[I_FCW] + (size_t)l * 3 * F2_; const float* cb = p.in[I_FCB] + (size_t)l * F2_;
    const int rt0 = l == 0 ? 0 : 16, nrt = R_ / 16 - rt0;
    for (int item = bid; item < nrt * 44; item += nblk) {
        const int rt = rt0 + item / 44, ct = item % 44, row0 = rt * 16, c0 = ct * 64;
        const int lo = row0 < 256 ? 0 : 256, hi = row0 < 256 ? 256 : R_;
        const int wcol = cc < 64 ? c0 + cc : F_ + c0 + (cc - 64);
        const bf16_t* ap[5];
#pragma unroll
        for (int i = 0; i < 5; ++i) { const int rr = rg * 5 + i, r = row0 - 1 + rr; ap[i] = (rr < 18 && r >= lo && r < hi) ? B.h + (size_t)hrow(r) * 1024 : nullptr; }
        float acc[5];
        tile_linear<5>(acc, 1024, ap, W, F2_, wcol);
#pragma unroll
        for (int i = 0; i < 5; ++i) tile[(rg * 5 + i) * 128 + cc] = acc[i];
        __syncthreads();
        for (int e = tid; e < 16 * 64; e += NT) {
            const int rr = e >> 6, c = e & 63, ca = c0 + c, cg = F_ + c0 + c;
            const float a = cb[ca] + tile[rr * 128 + c] * cw[ca] + tile[(rr + 1) * 128 + c] * cw[F2_ + ca] + tile[(rr + 2) * 128 + c] * cw[2 * F2_ + ca];
            const float g = cb[cg] + tile[rr * 128 + 64 + c] * cw[cg] + tile[(rr + 1) * 128 + 64 + c] * cw[F2_ + cg] + tile[(rr + 2) * 128 + 64 + c] * cw[2 * F2_ + cg];
            B.act[(size_t)(row0 + rr) * F_ + ca] = f2bf(a * (g / (1.f + __expf(-g))));
        }
        __syncthreads();
    }
}

__device__ void phase_down(const Params& p, int l, int bid, int nblk) {
    Bufs B(p);
    const int tid = threadIdx.x, cc = tid & 127, rg = tid >> 7;
    const float* W = p.in[I_FDOWN] + (size_t)l * F_ * 1024;
    const int rt0 = l == 0 ? 0 : 16, nrt = R_ / 16 - rt0;
    for (int item = bid; item < nrt * 8; item += nblk) {
        const int rt = rt0 + item / 8, ct = item % 8, row0 = rt * 16, col = ct * 128 + cc;
        const bf16_t* ap[4];
#pragma unroll
        for (int i = 0; i < 4; ++i) ap[i] = B.act + (size_t)(row0 + rg * 4 + i) * F_;
        float acc[4];
        tile_linear<4>(acc, F_, ap, W, 1024, col);
#pragma unroll
        for (int i = 0; i < 4; ++i) {
            const int r = row0 + rg * 4 + i;
            if (r < 256) B.xc[(size_t)r * 1024 + col] += modp(B, l, 1, 5)[col] * acc[i];
            else p.out[(size_t)(r - 256) * 1024 + col] += modp(B, l, 0, 5)[col] * acc[i];
        }
    }
}

__device__ void phase_qkv1a(const Params& p, char* lds, int bid, int nblk) {
    Bufs B(p);
    float* tile = (float*)lds;
    const int tid = threadIdx.x, cc = tid & 127, rg = tid >> 7, wid = tid >> 6, lane = tid & 63;
    const float* W = p.in[I_OWIN];
    for (int item = bid; item < (R_ / 16) * 12; item += nblk) {
        const int rt = item / 12, ct = item % 12, row0 = rt * 16, v0 = ct * 128;
        const int v = v0 + cc;
        int wcol;
        if (v < 640) wcol = v; else if (v < 1152) wcol = 672 + (v - 640); else if (v < 1280) wcol = 1184 + (v - 1152); else if (v < 1408) wcol = 1312 + (v - 1280);
        else if (v < 1440) wcol = 640 + (v - 1408); else wcol = -1;
        const bf16_t* ap[4];
#pragma unroll
        for (int i = 0; i < 4; ++i) ap[i] = B.h + (size_t)hrow(row0 + rg * 4 + i) * 1024;
        float acc[4];
        tile_linear<4>(acc, 1024, ap, W, 1440, wcol);
#pragma unroll
        for (int i = 0; i < 4; ++i) tile[(rg * 4 + i) * 128 + cc] = acc[i];
        __syncthreads();
        if (ct < 5) {
            for (int e = tid; e < 16 * 128; e += NT) {
                const int rr = e >> 7, c = e & 127, r = row0 + rr;
                if (ct < 3) B.qkv[O_CQ + (size_t)r * 384 + v0 + c] = f2bf(tile[e]);
                else B.qkv[O_CKV + (size_t)r * 256 + (v0 - 384) + c] = f2bf(tile[e]);
            }
        } else if (ct < 10) {
            for (int q = wid * 4; q < wid * 4 + 4; ++q) {
                const int rr = q >> 1, hh = q & 1, r = row0 + rr;
                if (ct < 9) head64_norm_rope(tile + rr * 128 + hh * 64, p.in[I_DQN], r >= 256, B.rope, r - 256, B.qkv + O_GQ + ((size_t)((ct - 5) * 2 + hh) * R_ + r) * 64, lane);
                else head64_norm_rope(tile + rr * 128 + hh * 64, p.in[I_DKN], r >= 256, B.rope, r - 256, B.qkv + O_GK + ((size_t)hh * R_ + r) * 64, lane);
            }
        } else if (ct == 10) {
            for (int e = tid; e < 16 * 128; e += NT) {
                const int c = e >> 4, rr = e & 15, r = row0 + rr;
                B.qkv[O_GVT + ((size_t)(c >> 6) * 64 + (c & 63)) * R_ + vpos(r)] = f2bf(tile[rr * 128 + c]);
            }
        } else {
            for (int e = tid; e < 16 * 32; e += NT) { const int rr = e >> 5, c = e & 31; B.qkv[O_CKR + (size_t)(row0 + rr) * 32 + c] = f2bf(tile[rr * 128 + c]); }
        }
        __syncthreads();
    }
}

__device__ __forceinline__ void head96_norm_rope(const float* row, const float* g, bool rope, const float* tab, int t, bf16_t* dst, int lane) {
    const float v0 = row[lane], v1 = lane < 32 ? row[64 + lane] : 0.f;
    const float ss = wave_sum(v0 * v0 + v1 * v1);
    const float rr = rsqrtf(ss * (1.f / 96.f) + EPS_);
    dst[lane] = f2bf(v0 * rr * g[lane]);
    if (lane < 32) {
        float y = v1 * rr * g[64 + lane];
        if (rope) {
            const float yp = row[64 + (lane ^ 16)] * rr * g[64 + (lane ^ 16)];
            const float2 cs = rope32(tab, t, lane & 15);
            y = lane < 16 ? (y * cs.x - yp * cs.y) : (yp * cs.y + y * cs.x);
        }
        dst[64 + lane] = f2bf(y);
    }
}

__device__ void phase_qkv1b(const Params& p, char* lds, int bid, int nblk) {
    Bufs B(p);
    float* tile = (float*)lds;
    float* rsl = (float*)lds + 16 * 128;
    const int tid = threadIdx.x, cc = tid & 127, rg = tid >> 7, wid = tid >> 6, lane = tid & 63;
    for (int item = bid; item < (R_ / 16) * 16; item += nblk) {
        const int rt = item / 16, ht = item % 16, row0 = rt * 16;
        const bool isq = ht < 8; const int head = ht & 7;
        const int K = isq ? 384 : 256;
        const bf16_t* src = B.qkv + (isq ? O_CQ : O_CKV);
        for (int rr = wid * 2; rr < wid * 2 + 2; ++rr) {
            float ss = 0.f;
            for (int k = lane; k < K; k += 64) { const float v = bf2f(src[(size_t)(row0 + rr) * K + k]); ss += v * v; }
            ss = wave_sum(ss);
            if (lane == 0) rsl[rr] = rsqrtf(ss / (float)K + EPS_);
        }
        __syncthreads();
        const bf16_t* ap[4]; float rs[4];
#pragma unroll
        for (int i = 0; i < 4; ++i) { ap[i] = src + (size_t)(row0 + rg * 4 + i) * K; rs[i] = rsl[rg * 4 + i]; }
        float acc[4];
        if (isq) tile_linear_g<4>(acc, 384, ap, rs, p.in[I_CQAN], p.in[I_CWQB], 768, cc < 96 ? head * 96 + cc : -1);
        else tile_linear_g<4>(acc, 256, ap, rs, p.in[I_CKVAN], p.in[I_CWKVB], 1024, head * 128 + cc);
#pragma unroll
        for (int i = 0; i < 4; ++i) tile[(rg * 4 + i) * 128 + cc] = acc[i];
        __syncthreads();
        if (isq) {
            for (int rr = wid * 2; rr < wid * 2 + 2; ++rr) { const int r = row0 + rr;
                head96_norm_rope(tile + rr * 128, p.in[I_CQN], r >= 256, B.rope, r - 256, B.qkv + O_MQ + ((size_t)head * R_ + r) * 96, lane); }
        } else {
            for (int e = tid; e < 16 * 64; e += NT) { const int d = e >> 4, rr = e & 15; B.qkv[O_MVT + ((size_t)head * 64 + d) * R_ + vpos(row0 + rr)] = f2bf(tile[rr * 128 + 64 + d]); }
            __syncthreads();
            for (int e = tid; e < 16 * 32; e += NT) { const int rr = e >> 5, c = e & 31; tile[rr * 128 + 64 + c] = bf2f(B.qkv[O_CKR + (size_t)(row0 + rr) * 32 + c]); }
            __syncthreads();
            for (int rr = wid * 2; rr < wid * 2 + 2; ++rr) { const int r = row0 + rr;
                head96_norm_rope(tile + rr * 128, p.in[I_CKN], r >= 256, B.rope, r - 256, B.qkv + O_MK + ((size_t)head * R_ + r) * 96, lane); }
        }
        __syncthreads();
    }
}

__device__ void phase_attn1(const Params& p, int bid, int nblk) {
    Bufs B(p);
    const int tid = threadIdx.x;
    for (int item = bid + ((OPTA & 2) ? 512 : 0); item < 1024; item += nblk) {
        if (item < 512) {
            const int head = item / 64, half = tid >> 8, r = 256 + (item % 64) * 256 + (tid & 255);
            float O[32]; float l;
            naive_dense<96, 32>(B.qkv + O_MQ + ((size_t)head * R_ + r) * 96, B.qkv + O_MK + (size_t)head * R_ * 96, B.qkv + O_MVT + ((size_t)head * 64 + half * 32) * R_, R_, 0.10206207261596575f, O, l);
            const float inv = 1.f / l;
            bf16_t* dst = B.mix + (size_t)r * 1024 + head * 64 + half * 32;
#pragma unroll
            for (int d = 0; d < 32; d += 2) *(u32*)(dst + d) = (u32)f2bf(O[d] * inv) | ((u32)f2bf(O[d + 1] * inv) << 16);
        } else {
            const int idx = (item - 512) * NT + tid, half = idx / (8 * T_), hq = (idx / T_) & 7, t = idx % T_, r = 256 + t, kvh = hq >> 2;
            const bf16_t* q = B.qkv + O_GQ + ((size_t)hq * R_ + r) * 64;
            const bf16_t* Kb = B.qkv + O_GK + (size_t)kvh * R_ * 64;
            const bf16_t* VT = B.qkv + O_GVT + ((size_t)kvh * 64 + half * 32) * R_;
            u32x4 qp[8];
#pragma unroll
            for (int i = 0; i < 8; ++i) qp[i] = *(const u32x4*)(q + i * 8);
            float O[32];
#pragma unroll
            for (int d = 0; d < 32; ++d) O[d] = 0.f;
            float m = -1e30f, l = 0.f;
            const int j0 = max(t - 128, 0), j1 = min(t + 128, T_ - 1);
            const int nkeys = 256 + (j1 - j0 + 1);
            for (int kk = 0; kk < nkeys; ++kk) {
                const int key = kk < 256 ? kk : 256 + j0 + (kk - 256);
                const bf16_t* krow = Kb + (size_t)key * 64; float s = 0.f;
#pragma unroll
                for (int i = 0; i < 8; ++i) s += dot8p(*(const u32x4*)(krow + i * 8), qp[i].x, qp[i].y, qp[i].z, qp[i].w);
                s *= 0.125f;
                const float mn = fmaxf(m, s), alpha = __expf(m - mn), pp = __expf(s - mn);
                l = l * alpha + pp; m = mn;
                const int vp = vpos(key);
#pragma unroll
                for (int d = 0; d < 32; ++d) O[d] = O[d] * alpha + pp * bf2f(VT[(size_t)d * R_ + vp]);
            }
            { const float s = p.in[I_SINK][hq]; const float mn = fmaxf(m, s), alpha = __expf(m - mn); l = l * alpha + __expf(s - mn);
#pragma unroll
              for (int d = 0; d < 32; ++d) O[d] *= alpha; }
            const float inv = 1.f / l;
            bf16_t* dst = B.mix + (size_t)r * 1024 + 512 + hq * 64 + half * 32;
#pragma unroll
            for (int d = 0; d < 32; d += 2) *(u32*)(dst + d) = (u32)f2bf(O[d] * inv) | ((u32)f2bf(O[d + 1] * inv) << 16);
        }
    }
}

#define LAS __attribute__((address_space(3)))
typedef short bf16x8 __attribute__((ext_vector_type(8)));
typedef float f32x4 __attribute__((ext_vector_type(4)));
constexpr int LDS_STAGE = 131072, LDS_XCH = LDS_STAGE, LDS_BYTES = 147456;

__device__ __forceinline__ u32 pk2(float lo, float hi) { return (u32)f2bf(lo) | ((u32)f2bf(hi) << 16); }

namespace pg8 {
constexpr int BM = 256, BK = 64, HALF = 128, HTB = HALF * BK * 2, NXCD = 8, WGM = 8;
__host__ __device__ __forceinline__ int lds_byte(int r, int c) { const int st = (r >> 4) * 2 + (c >> 5), rr = r & 15, cc = c & 31, ob = rr * 64 + cc * 2; return st * 1024 + (ob ^ (((ob >> 9) & 1) << 5)); }
__host__ __device__ __forceinline__ void stage_rc(int b, int& R, int& C) { const int st = b / 1024, sb = b % 1024, swz = sb ^ (((sb >> 9) & 1) << 5); R = (st >> 1) * 16 + swz / 64; C = (st & 1) * 32 + (swz % 64) / 2; }
struct Unit { int pm, pn; };
struct Gemm { const bf16_t* A; const bf16_t* Bt; int K; };
struct Order {
    int nM, nN, nwg, G, c, pm0, amode;
    __device__ void init(int nM_, int nN_, int G_, int c_, int pm0_, int amode_) { nM = nM_; nN = nN_; nwg = nM * nN; G = G_; c = c_; pm0 = pm0_; amode = amode_; }
    __device__ bool next(int i, Unit& u) const {
        const long L = (long)i * G + c; if (L >= nwg) return false;
        int wgid = (int)L; { const int q = nwg / NXCD, r = nwg % NXCD, xcd = wgid % NXCD, off = wgid / NXCD; wgid = (xcd < r ? xcd * (q + 1) : r * (q + 1) + (xcd - r) * q) + off; }
        const int nig = WGM * nN, gid = wgid / nig, fm = gid * WGM, gsz = (nM - fm) < WGM ? (nM - fm) : WGM;
        u.pm = pm0 + fm + ((wgid % nig) % gsz); u.pn = (wgid % nig) / gsz; return true;
    }
    __device__ __forceinline__ int arow(int pm) const { return amode == 0 ? 256 * pm : amode == 1 ? (pm == 0 ? 1 : 2 + 256 * pm) : (pm < 2 ? 254 * pm : 257 + 254 * (pm - 2)); }
    __device__ __forceinline__ void a_ready(const Unit&) const {}
    __device__ __forceinline__ void done(const Unit&) const {}
};

template <class Epi, class Sched, bool ALIGN_EPI, bool SP2>
__device__ __forceinline__ void gemm_phase(LAS unsigned char* lds, const Gemm g, const Sched& S, const Epi& E) {
    const int tid = threadIdx.x, wid = __builtin_amdgcn_readfirstlane(tid >> 6), lane = tid & 63, wr = wid >> 2, wc = wid & 3, fr = lane & 15, fq = lane >> 4;
    int K_ = g.K; asm volatile("" : "+s"(K_));
    const int K = K_, nt = K / BK;
    unsigned voffA[2], voffB[2];
#pragma unroll
    for (int i = 0; i < 2; ++i) { int R, C; stage_rc(tid * 16 + i * 8192, R, C); voffA[i] = (unsigned)(R * K + C) * 2u; voffB[i] = (unsigned)(R * K + C) * 2u; }
    const size_t kstep = (size_t)(BK * 2);
    const size_t hstep = (size_t)HALF * K * 2;
    const size_t tstep = 2 * hstep;
    const size_t rstep = (size_t)K * 2;
    const unsigned ldsw = (unsigned)wid * 1024u;
    const int aoff = lds_byte(wr * 64 + fr, fq * 8), boff = lds_byte(wc * 32 + fr, fq * 8);
#define PG8_SA(b, h) (((b) * 2 + (h)) * HTB)
#define PG8_SB(b, h) ((4 + (b) * 2 + (h)) * HTB)
#define PG8_STAGE(bufoff, gbase, voff) do { _Pragma("unroll") for (int _i = 0; _i < 2; ++_i) \
        __builtin_amdgcn_global_load_lds((const unsigned*)((const char*)(gbase) + (voff)[_i]), (LAS unsigned*)(lds + (bufoff) + ldsw + _i * 8192), 16, 0, 0); } while (0)
#define PG8_LDA(dst, b, h) do { _Pragma("unroll") for (int m = 0; m < 4; ++m) _Pragma("unroll") for (int k = 0; k < 2; ++k) dst[m][k] = *(const LAS bf16x8*)(lds + PG8_SA(b, h) + aoff + m * 2048 + k * 1024); } while (0)
#define PG8_LDB(dst, b, h) do { _Pragma("unroll") for (int n = 0; n < 2; ++n) _Pragma("unroll") for (int k = 0; k < 2; ++k) dst[n][k] = *(const LAS bf16x8*)(lds + PG8_SB(b, h) + boff + n * 2048 + k * 1024); } while (0)
#define PG8_MMA(ai, bj, At, Bt) do { __builtin_amdgcn_s_setprio(1); _Pragma("unroll") for (int m = 0; m < 4; ++m) _Pragma("unroll") for (int n = 0; n < 2; ++n) _Pragma("unroll") for (int k = 0; k < 2; ++k) \
        acc[ai][bj][m][n] = __builtin_amdgcn_mfma_f32_16x16x32_bf16(Bt[n][k], At[m][k], acc[ai][bj][m][n], 0, 0, 0); __builtin_amdgcn_s_setprio(0); } while (0)
#define PG8_WAIT_V(n) asm volatile("s_waitcnt vmcnt(" #n ")" ::: "memory")
#define PG8_WAIT_L(n) asm volatile("s_waitcnt lgkmcnt(" #n ")" ::: "memory")
#define PG8_BAR __builtin_amdgcn_s_barrier()
#define PG8_SCHED __builtin_amdgcn_sched_barrier(0)
    Unit cur, nxt; int ui = 0;
    if (!S.next(0, cur)) return;
    f32x4 acc[2][2][4][2];
#pragma unroll
    for (int a = 0; a < 2; ++a)
#pragma unroll
        for (int b = 0; b < 2; ++b)
#pragma unroll
            for (int m = 0; m < 4; ++m)
#pragma unroll
                for (int n = 0; n < 2; ++n) acc[a][b][m][n] = (f32x4){0.f, 0.f, 0.f, 0.f};
    bf16x8 At[4][2], B0[2][2], B1[2][2];
    const char* cA = (const char*)g.A + (size_t)S.arow(cur.pm) * rstep; const char* cB = (const char*)g.Bt + (size_t)cur.pn * tstep;
    S.a_ready(cur);
    if constexpr (SP2) {
        PG8_STAGE(PG8_SB(0, 0), cB, voffB); PG8_STAGE(PG8_SB(0, 1), cB + hstep, voffB); PG8_STAGE(PG8_SA(0, 0), cA, voffA); PG8_STAGE(PG8_SA(0, 1), cA + hstep, voffA);
        if (wr == 1) PG8_BAR;
        PG8_WAIT_V(2); PG8_BAR;
        PG8_STAGE(PG8_SB(1, 0), cB + kstep, voffB); PG8_STAGE(PG8_SA(1, 0), cA + kstep, voffA); PG8_STAGE(PG8_SB(1, 1), cB + hstep + kstep, voffB);
        PG8_WAIT_V(6); PG8_BAR;
    } else {
        PG8_STAGE(PG8_SB(0, 0), cB, voffB); PG8_STAGE(PG8_SA(0, 0), cA, voffA); PG8_STAGE(PG8_SB(0, 1), cB + hstep, voffB); PG8_STAGE(PG8_SA(0, 1), cA + hstep, voffA);
        if (wr == 1) PG8_BAR;
        PG8_WAIT_V(4); PG8_BAR;
        PG8_STAGE(PG8_SB(1, 0), cB + kstep, voffB); PG8_STAGE(PG8_SA(1, 0), cA + kstep, voffA); PG8_STAGE(PG8_SB(1, 1), cB + hstep + kstep, voffB);
        PG8_WAIT_V(6); PG8_BAR;
    }
    for (;;) {
        const bool has_next = S.next(ui + 1, nxt);
        const char* nA = has_next ? (const char*)g.A + (size_t)S.arow(nxt.pm) * rstep : cA; const char* nB = has_next ? (const char*)g.Bt + (size_t)nxt.pn * tstep : cB;
        for (int t = 0; t < nt; t += 2) {
            const bool last = (t == nt - 2);
            const char* a1 = cA + (size_t)(t + 1) * kstep;
            const char* a2 = last ? nA : cA + (size_t)(t + 2) * kstep; const char* b2 = last ? nB : cB + (size_t)(t + 2) * kstep;
            const char* a3 = a2 + kstep; const char* b3 = b2 + kstep;
            if (last && has_next) S.a_ready(nxt);
            if constexpr (SP2) {
            PG8_LDB(B0, 0, 0); PG8_LDB(B1, 0, 1); PG8_SCHED; PG8_LDA(At, 0, 0); PG8_STAGE(PG8_SA(1, 1), a1 + hstep, voffA);
            PG8_WAIT_V(8); PG8_WAIT_L(0); PG8_BAR; PG8_MMA(0, 0, At, B0); PG8_MMA(0, 1, At, B1); PG8_BAR; PG8_SCHED;
            PG8_LDA(At, 0, 1); PG8_STAGE(PG8_SB(0, 0), b2, voffB); PG8_STAGE(PG8_SB(0, 1), b2 + hstep, voffB); PG8_STAGE(PG8_SA(0, 0), a2, voffA);
            PG8_WAIT_V(8); PG8_WAIT_L(0); PG8_BAR; PG8_MMA(1, 0, At, B0); PG8_MMA(1, 1, At, B1); PG8_BAR; PG8_SCHED;
            PG8_LDB(B0, 1, 0); PG8_LDB(B1, 1, 1); PG8_SCHED; PG8_LDA(At, 1, 0); PG8_STAGE(PG8_SA(0, 1), a2 + hstep, voffA);
            PG8_WAIT_V(8); PG8_WAIT_L(0); PG8_BAR; PG8_MMA(0, 0, At, B0); PG8_MMA(0, 1, At, B1); PG8_BAR; PG8_SCHED;
            PG8_LDA(At, 1, 1); PG8_STAGE(PG8_SB(1, 0), b3, voffB); PG8_STAGE(PG8_SB(1, 1), b3 + hstep, voffB); PG8_STAGE(PG8_SA(1, 0), a3, voffA);
            PG8_WAIT_V(8); PG8_WAIT_L(0); PG8_BAR; PG8_MMA(1, 0, At, B0); PG8_MMA(1, 1, At, B1); PG8_BAR; PG8_SCHED;
            } else {
            PG8_LDB(B0, 0, 0); PG8_SCHED; PG8_LDA(At, 0, 0); PG8_STAGE(PG8_SA(1, 1), a1 + hstep, voffA);
            PG8_WAIT_L(8); PG8_BAR; PG8_WAIT_L(0); PG8_MMA(0, 0, At, B0); PG8_BAR; PG8_SCHED;
            PG8_LDB(B1, 0, 1); PG8_STAGE(PG8_SB(0, 0), b2, voffB);
            PG8_BAR; PG8_WAIT_L(0); PG8_MMA(0, 1, At, B1); PG8_BAR;
            PG8_LDA(At, 0, 1); PG8_STAGE(PG8_SA(0, 0), a2, voffA);
            PG8_BAR; PG8_WAIT_L(0); PG8_MMA(1, 0, At, B0); PG8_BAR; PG8_SCHED;
            PG8_STAGE(PG8_SB(0, 1), b2 + hstep, voffB);
            PG8_WAIT_V(6); PG8_BAR; PG8_MMA(1, 1, At, B1); PG8_BAR;
            PG8_LDB(B0, 1, 0); PG8_SCHED; PG8_LDA(At, 1, 0); PG8_STAGE(PG8_SA(0, 1), a2 + hstep, voffA);
            PG8_WAIT_L(8); PG8_BAR; PG8_WAIT_L(0); PG8_MMA(0, 0, At, B0); PG8_BAR; PG8_SCHED;
            PG8_LDB(B1, 1, 1); PG8_STAGE(PG8_SB(1, 0), b3, voffB);
            PG8_BAR; PG8_WAIT_L(0); PG8_MMA(0, 1, At, B1); PG8_BAR;
            PG8_LDA(At, 1, 1); PG8_STAGE(PG8_SA(1, 0), a3, voffA);
            PG8_BAR; PG8_WAIT_L(0); PG8_MMA(1, 0, At, B0); PG8_BAR; PG8_SCHED;
            PG8_STAGE(PG8_SB(1, 1), b3 + hstep, voffB);
            PG8_WAIT_V(6); PG8_BAR; PG8_MMA(1, 1, At, B1); PG8_BAR;
            }
        }
        if constexpr (ALIGN_EPI) { if (wr == 0) PG8_BAR; }
        E(acc, cur, wr, wc, fr, fq); S.done(cur);
        if (!has_next) break;
#pragma unroll
        for (int a = 0; a < 2; ++a)
#pragma unroll
            for (int b = 0; b < 2; ++b)
#pragma unroll
                for (int m = 0; m < 4; ++m)
#pragma unroll
                    for (int n = 0; n < 2; ++n) acc[a][b][m][n] = (f32x4){0.f, 0.f, 0.f, 0.f};
        cur = nxt; cA = nA; cB = nB; ++ui;
        if constexpr (ALIGN_EPI) { if (wr == 1) PG8_BAR; }
    }
    PG8_WAIT_V(0);
    if constexpr (!ALIGN_EPI) { if (wr == 0) PG8_BAR; }
    PG8_BAR;
#undef PG8_SA
#undef PG8_SB
#undef PG8_STAGE
#undef PG8_LDA
#undef PG8_LDB
#undef PG8_MMA
#undef PG8_WAIT_V
#undef PG8_WAIT_L
#undef PG8_BAR
#undef PG8_SCHED
}
}

typedef f32x4 AccT[2][2][4][2];
__device__ __forceinline__ const float* launder(const float* p) { asm volatile("" : "+s"(p)); return p; }
#define EPI_IDS() int t_ = threadIdx.x; asm volatile("" : "+v"(t_)); const int fr = t_ & 15, fq = (t_ >> 4) & 3; const int wid_ = __builtin_amdgcn_readfirstlane(t_ >> 6), wr = wid_ >> 2, wc = wid_ & 3; (void)wr; (void)wc; (void)fr; (void)fq
#define ITER_FENCE() do { asm volatile("" ::: "memory"); __builtin_amdgcn_sched_barrier(0); } while (0)
#define EPI_BARRIER() do { asm volatile("s_waitcnt lgkmcnt(0)" ::: "memory"); __builtin_amdgcn_s_barrier(); asm volatile("" ::: "memory"); } while (0)

__device__ __forceinline__ int vcol_of_row(int J) { const int pn = J >> 8, j = J & 255, bj = j >> 7, wc = (j >> 5) & 3, n = (j >> 4) & 1, fq = (j >> 2) & 3, e = j & 3; return 256 * pn + 64 * wc + 32 * bj + 8 * fq + 4 * n + e; }
__device__ __forceinline__ int gmap(int map, int v) {
    if (map == 0) return v;
    if (map == 1) { const int pn = v >> 8, wc = (v >> 6) & 3, bj = (v >> 5) & 1, x = v & 31, h = 128 * pn + 32 * wc + x; return bj ? F_ + h : h; }
    if (map == 2) { if (v < 384) return v; if (v < 512) return 1184 + (v - 384); if (v < 768) return 384 + (v - 512); if (v < 1280) return 672 + (v - 768);
                    if (v < 1408) return 1312 + (v - 1280); if (v < 1440) return 640 + (v - 1408); return -1; }
    { const int hh = v >> 7, y = v & 127; if (y < 64) return hh * 96 + y; const int x = y - 64; if (x >= 32) return -1; const int fq = x >> 3, n = (x >> 2) & 1, e = x & 3; return hh * 96 + 64 + 16 * n + 4 * fq + e; }
}
__device__ __forceinline__ void prep_item(const float* __restrict__ W, int K, int ldw, bf16_t* Bt, int NV, int map, const float* kscale, float* scr, int item, int lane) {
    const int nb32 = NV / 32, kb = item / nb32, nb = item % nb32, k0 = 64 * kb, J0 = 32 * nb;
    const int col = gmap(map, vcol_of_row(J0 + (lane & 31)));
#pragma unroll 8
    for (int i = 0; i < 32; ++i) { const int kk = 2 * i + (lane >> 5); float v = col >= 0 ? W[(size_t)(k0 + kk) * ldw + col] : 0.f; if (kscale) v *= kscale[k0 + kk]; scr[kk * 33 + (lane & 31)] = v; }
    __builtin_amdgcn_wave_barrier();
    asm volatile("s_waitcnt lgkmcnt(0)" ::: "memory");
    const int c = lane & 7;
#pragma unroll
    for (int j = 0; j < 4; ++j) { const int n = (lane >> 3) + 8 * j; const float* s = scr + (8 * c) * 33 + n;
        u32x4 o; o.x = pk2(s[0 * 33], s[1 * 33]); o.y = pk2(s[2 * 33], s[3 * 33]); o.z = pk2(s[4 * 33], s[5 * 33]); o.w = pk2(s[6 * 33], s[7 * 33]);
        *(u32x4*)(Bt + (size_t)(J0 + n) * K + k0 + 8 * c) = o; }
    asm volatile("s_waitcnt lgkmcnt(0)" ::: "memory");
    __builtin_amdgcn_wave_barrier();
}
__device__ void phase_prep_weights(const Params& p, char* lds, int bid, int nblk) {
    Bufs B(p);
    const int wid = threadIdx.x >> 6, lane = threadIdx.x & 63;
    float* scr = (float*)lds + wid * (64 * 33 + 16);
    constexpr int I0 = 16 * 96, I1 = 16 * 32, I2 = 16 * 176, I3 = 44 * 32, I4 = 16 * 48, I5 = 16 * 32, I6 = 6 * 32, I7 = 4 * 32;
    constexpr int NIT = I0 + I1 + 2 * I2 + 2 * I3 + I4 + I5 + I6 + I7;
    for (int it = bid * 8 + wid; it < NIT; it += nblk * 8) {
        int r = it;
        if (r < I0) { prep_item(p.in[I_EWIN], 1024, 3072, B.wt + W_EIN, 3072, 0, nullptr, scr, r, lane); continue; } r -= I0;
        if (r < I1) { prep_item(p.in[I_EWOUT], 1024, 1024, B.wt + W_EOUT, 1024, 0, nullptr, scr, r, lane); continue; } r -= I1;
        if (r < 2 * I2) { const int l = r / I2; prep_item(p.in[I_FUP] + (size_t)l * 1024 * F2_, 1024, F2_, B.wt + W_UP + (size_t)l * F2_ * 1024, F2_, 1, nullptr, scr, r % I2, lane); continue; } r -= 2 * I2;
        if (r < 2 * I3) { const int l = r / I3; prep_item(p.in[I_FDOWN] + (size_t)l * F_ * 1024, F_, 1024, B.wt + W_DOWN + (size_t)l * 1024 * F_, 1024, 0, nullptr, scr, r % I3, lane); continue; } r -= 2 * I3;
        if (r < I4) { prep_item(p.in[I_OWIN], 1024, 1440, B.wt + W_OIN, 1536, 2, nullptr, scr, r, lane); continue; } r -= I4;
        if (r < I5) { prep_item(p.in[I_OWOUT], 1024, 1024, B.wt + W_OOUT, 1024, 0, nullptr, scr, r, lane); continue; } r -= I5;
        if (r < I6) { prep_item(p.in[I_CWQB], 384, 768, B.wt + W_QB, 1024, 3, p.in[I_CQAN], scr, r, lane); continue; } r -= I6;
        prep_item(p.in[I_CWKVB], 256, 1024, B.wt + W_KVB, 1024, 0, p.in[I_CKVAN], scr, r, lane);
    }
}

__device__ __forceinline__ void head64_epi(const AccT& acc, int ai, int m, const float (&gn)[2][2][4], bool rope, const float* tab, int t, int fq, bf16_t* dst) {
    float ss = 0.f;
#pragma unroll
    for (int bj = 0; bj < 2; ++bj)
#pragma unroll
        for (int n = 0; n < 2; ++n)
#pragma unroll
            for (int e = 0; e < 4; ++e) { const float v = acc[ai][bj][m][n][e]; ss += v * v; }
    ss += __shfl_xor(ss, 16); ss += __shfl_xor(ss, 32);
    const float rr = rsqrtf(ss * (1.f / 64.f) + EPS_);
    float y[2][2][4];
#pragma unroll
    for (int bj = 0; bj < 2; ++bj)
#pragma unroll
        for (int n = 0; n < 2; ++n)
#pragma unroll
            for (int e = 0; e < 4; ++e) y[bj][n][e] = acc[ai][bj][m][n][e] * rr * gn[bj][n][e];
    if (rope) {
        const int pos = fq < 2 ? (t >> 6) : (t & 63);
        const float4* cs = (const float4*)(tab + (pos * 16 + 8 * (fq & 1)) * 2);
#pragma unroll
        for (int n = 0; n < 2; ++n) {
            const float4 c0 = cs[2 * n], c1 = cs[2 * n + 1];
            const float cv[4] = {c0.x, c0.z, c1.x, c1.z}, sv[4] = {c0.y, c0.w, c1.y, c1.w};
#pragma unroll
            for (int e = 0; e < 4; ++e) { const float x1 = y[0][n][e], x2 = y[1][n][e]; y[0][n][e] = x1 * cv[e] - x2 * sv[e]; y[1][n][e] = x1 * sv[e] + x2 * cv[e]; }
        }
    }
#pragma unroll
    for (int bj = 0; bj < 2; ++bj) {
        u32x4 w; w.x = pk2(y[bj][0][0], y[bj][0][1]); w.y = pk2(y[bj][0][2], y[bj][0][3]); w.z = pk2(y[bj][1][0], y[bj][1][1]); w.w = pk2(y[bj][1][2], y[bj][1][3]);
        *(u32x4*)(dst + 32 * bj + 8 * fq) = w;
    }
}
__device__ __forceinline__ void load_gain64(float (&gn)[2][2][4], const float* g, int fq) {
#pragma unroll
    for (int bj = 0; bj < 2; ++bj)
#pragma unroll
        for (int n = 0; n < 2; ++n) { const float4 t = *(const float4*)(g + 32 * bj + 8 * fq + 4 * n); gn[bj][n][0] = t.x; gn[bj][n][1] = t.y; gn[bj][n][2] = t.z; gn[bj][n][3] = t.w; }
}
__device__ __forceinline__ void vt_store(const AccT& acc, int ai, int m, float scale, bf16_t* vt, int fq, int r) {
    const int pos = vpos(r);
#pragma unroll
    for (int bj = 0; bj < 2; ++bj)
#pragma unroll
        for (int n = 0; n < 2; ++n)
#pragma unroll
            for (int e = 0; e < 4; ++e) vt[(size_t)(32 * bj + 8 * fq + 4 * n + e) * R_ + pos] = f2bf(acc[ai][bj][m][n][e] * scale);
}
__device__ __forceinline__ float raw_store(const AccT& acc, int ai, int m, bf16_t* dst, int fq) {
    float ss = 0.f;
#pragma unroll
    for (int bj = 0; bj < 2; ++bj) {
        u32x4 w; const f32x4 a = acc[ai][bj][m][0], b = acc[ai][bj][m][1];
        w.x = pk2(a[0], a[1]); w.y = pk2(a[2], a[3]); w.z = pk2(b[0], b[1]); w.w = pk2(b[2], b[3]);
        *(u32x4*)(dst + 32 * bj + 8 * fq) = w;
        float t[8]; unpack8(w, t);
#pragma unroll
        for (int j = 0; j < 8; ++j) ss += t[j] * t[j];
    }
    return ss;
}

struct EpiQKV0 {
    bf16_t* qkv; const float* rope; const float* gt;
    __device__ __forceinline__ void operator()(const AccT& acc, const pg8::Unit& u, int, int, int, int) const {
        EPI_IDS();
        const int seg = u.pn >> 1, r0 = u.pm * 256 + wr * 64 + fr;
        if (seg == 2 || seg == 5) {
            const size_t vo = seg == 2 ? O_VAT + ((size_t)((u.pn & 1) * 2 + (wc >> 1)) * 128 + 64 * (wc & 1)) * R_ : O_VBT + (size_t)((u.pn & 1) * 4 + wc) * 64 * R_;
            bf16_t* vt = qkv + vo;
#pragma unroll
            for (int ai = 0; ai < 2; ++ai)
#pragma unroll
                for (int m = 0; m < 4; ++m) { vt_store(acc, ai, m, 1.f, vt, fq, r0 + 128 * ai + 16 * m); ITER_FENCE(); }
        } else {
            float gn[2][2][4]; load_gain64(gn, gt + 64 * (seg < 2 ? seg : seg - 1), fq);
            const int head = (u.pn & 1) * 4 + wc;
            const size_t bo = (seg == 0 ? O_QA : seg == 1 ? O_KA : seg == 3 ? O_QB : O_KB) + (size_t)head * R_ * 64;
            bf16_t* base = qkv + bo;
            const bool rp = seg < 2 && u.pm > 0;
#pragma unroll
            for (int ai = 0; ai < 2; ++ai)
#pragma unroll
                for (int m = 0; m < 4; ++m) { const int r = r0 + 128 * ai + 16 * m; head64_epi(acc, ai, m, gn, rp, rope, r - 256, fq, base + (size_t)r * 64); ITER_FENCE(); }
        }
    }
};

struct EpiResid {
    const float* resid_lat; float* dst_lat; const float* resid_ctx; float* dst_ctx; const float* gate_lat; const float* gate_ctx;
    __device__ __forceinline__ void rows(const AccT& acc, const float* __restrict__ resid, float* dst, const float* __restrict__ gate, int row0, int col0) const {
        f32x4 gt[2][2];
#pragma unroll
        for (int bj = 0; bj < 2; ++bj)
#pragma unroll
            for (int n = 0; n < 2; ++n) gt[bj][n] = *(const f32x4*)(gate + col0 + 32 * bj + 4 * n);
#pragma unroll
        for (int ai = 0; ai < 2; ++ai)
#pragma unroll
            for (int m = 0; m < 4; ++m) {
                const size_t ro = (size_t)(row0 + 128 * ai + 16 * m) * 1024 + col0;
#pragma unroll
                for (int bj = 0; bj < 2; ++bj)
#pragma unroll
                    for (int n = 0; n < 2; ++n) { const f32x4 x = *(const f32x4*)(resid + ro + 32 * bj + 4 * n); *(f32x4*)(dst + ro + 32 * bj + 4 * n) = x + gt[bj][n] * acc[ai][bj][m][n]; }
                ITER_FENCE();
            }
    }
    __device__ __forceinline__ void operator()(const AccT& acc, const pg8::Unit& u, int, int, int, int) const {
        EPI_IDS();
        const int col0 = u.pn * 256 + wc * 64 + 8 * fq, rl = 64 * wr + fr;
        if (u.pm == 0) rows(acc, resid_ctx, dst_ctx, gate_ctx, rl, col0);
        else rows(acc, resid_lat, dst_lat, gate_lat, (u.pm - 1) * 256 + rl, col0);
    }
};

#ifndef USE_DPP
#define USE_DPP 0
#endif
__device__ __forceinline__ float rot_prev(float x, int lane) {
#if USE_DPP
    return __builtin_bit_cast(float, __builtin_amdgcn_update_dpp(0, __builtin_bit_cast(int, x), 0x121, 0xf, 0xf, false));
#else
    return __shfl(x, (lane & 48) | ((lane - 1) & 15));
#endif
}
__device__ __forceinline__ float rot_next(float x, int lane) {
#if USE_DPP
    return __builtin_bit_cast(float, __builtin_amdgcn_update_dpp(0, __builtin_bit_cast(int, x), 0x12F, 0xf, 0xf, false));
#else
    return __shfl(x, (lane & 48) | ((lane + 1) & 15));
#endif
}
struct EpiUp {
    bf16_t* act; const float* cw; const float* cb; LAS float* xch;
    __device__ __forceinline__ int xidx(int c, int which, int wc, int fq, int bj, int n) const { return (((c * 2 + which) * 4 + wc) * 64) + fq * 16 + bj * 8 + n * 4; }
    __device__ __forceinline__ void operator()(const AccT& acc, const pg8::Unit& u, int, int, int, int) const {
        EPI_IDS();
        const int lane = fq * 16 + fr;
        if (fr == 0) {
#pragma unroll
            for (int ai = 0; ai < 2; ++ai)
#pragma unroll
                for (int bj = 0; bj < 2; ++bj)
#pragma unroll
                    for (int n = 0; n < 2; ++n) *(LAS f32x4*)(xch + xidx(2 * ai + wr, 0, wc, fq, bj, n)) = acc[ai][bj][0][n];
        }
        if (fr == 15) {
#pragma unroll
            for (int ai = 0; ai < 2; ++ai)
#pragma unroll
                for (int bj = 0; bj < 2; ++bj)
#pragma unroll
                    for (int n = 0; n < 2; ++n) *(LAS f32x4*)(xch + xidx(2 * ai + wr, 1, wc, fq, bj, n)) = acc[ai][bj][3][n];
        }
        EPI_BARRIER();
        const bool isctx = u.pm < 2;
        const int seq0 = isctx ? 254 * u.pm : 254 * (u.pm - 2), lim = isctx ? 256 : T_, rbase = isctx ? 0 : 256;
#pragma unroll
        for (int n = 0; n < 2; ++n) {
            const int h0 = 128 * u.pn + 32 * wc + 8 * fq + 4 * n;
            f32x4 w0[2], w1[2], w2[2], bb[2];
#pragma unroll
            for (int bj = 0; bj < 2; ++bj) { const int c = bj * F_ + h0; w0[bj] = *(const f32x4*)(cw + c); w1[bj] = *(const f32x4*)(cw + F2_ + c); w2[bj] = *(const f32x4*)(cw + 2 * F2_ + c); bb[bj] = *(const f32x4*)(cb + c); }
#pragma unroll
            for (int ai = 0; ai < 2; ++ai) {
                const int c = 2 * ai + wr;
                f32x4 eup[2], edn[2];
#pragma unroll
                for (int bj = 0; bj < 2; ++bj) {
                    eup[bj] = c > 0 ? *(const LAS f32x4*)(xch + xidx(c - 1, 1, wc, fq, bj, n)) : (f32x4){0.f, 0.f, 0.f, 0.f};
                    edn[bj] = c < 3 ? *(const LAS f32x4*)(xch + xidx(c + 1, 0, wc, fq, bj, n)) : (f32x4){0.f, 0.f, 0.f, 0.f};
                }
#pragma unroll
                for (int m = 0; m < 4; ++m) {
                    f32x4 cv[2];
#pragma unroll
                    for (int bj = 0; bj < 2; ++bj) {
                        const f32x4 x = acc[ai][bj][m][n];
                        f32x4 up, dn;
#pragma unroll
                        for (int e = 0; e < 4; ++e) {
                            const float ps = rot_prev(x[e], lane), ns = rot_next(x[e], lane);
                            float pe, ne;
                            if (m > 0) pe = rot_prev(acc[ai][bj][m > 0 ? m - 1 : 0][n][e], lane); else pe = eup[bj][e];
                            if (m < 3) ne = rot_next(acc[ai][bj][m < 3 ? m + 1 : 3][n][e], lane); else ne = edn[bj][e];
                            up[e] = fr == 0 ? pe : ps; dn[e] = fr == 15 ? ne : ns;
                        }
                        cv[bj] = bb[bj] + w0[bj] * up + w1[bj] * x + w2[bj] * dn;
                    }
                    const int j = 128 * ai + 64 * wr + 16 * m + fr, sr = seq0 + j - 1;
                    if (j >= 1 && j <= 254 && sr < lim) {
                        float o[4];
#pragma unroll
                        for (int e = 0; e < 4; ++e) { const float gg = cv[1][e]; o[e] = cv[0][e] * (gg / (1.f + __expf(-gg))); }
                        *(uint2*)(act + (size_t)(rbase + sr) * F_ + h0) = make_uint2(pk2(o[0], o[1]), pk2(o[2], o[3]));
                    }
                    ITER_FENCE();
                }
            }
        }
    }
};

struct EpiQKV1A {
    bf16_t* qkv; float* part; const float* rope; const float* gt;
    __device__ __forceinline__ void operator()(const AccT& acc, const pg8::Unit& u, int, int, int, int) const {
        EPI_IDS();
        const int r0 = u.pm * 256 + wr * 64 + fr, pn = u.pn;
        const bool rp = u.pm > 0;
        if (pn == 0 || (pn == 1 && wc < 2) || pn == 2) {
            const int chunk = pn == 0 ? wc : pn == 1 ? 4 + wc : wc;
            const size_t bo = pn == 2 ? O_CKV + 64 * wc : O_CQ + 64 * chunk;
            bf16_t* base = qkv + bo;
            const int ld = pn == 2 ? 256 : 384;
            float* pp = part + (pn == 2 ? 8 : 0) + chunk;
#pragma unroll
            for (int ai = 0; ai < 2; ++ai)
#pragma unroll
                for (int m = 0; m < 4; ++m) {
                    const int r = r0 + 128 * ai + 16 * m;
                    float ss = raw_store(acc, ai, m, base + (size_t)r * ld, fq);
                    ss += __shfl_xor(ss, 16); ss += __shfl_xor(ss, 32);
                    if (fq == 0) pp[(size_t)r * 12] = ss;
                    ITER_FENCE();
                }
        } else if (pn == 1 || pn == 3 || pn == 4) {
            const bool isk = pn == 1;
            float gn[2][2][4]; load_gain64(gn, gt + (isk ? 320 : 256), fq);
            const size_t bo = isk ? O_GK + (size_t)(wc - 2) * R_ * 64 : O_GQ + (size_t)(4 * (pn - 3) + wc) * R_ * 64;
            bf16_t* base = qkv + bo;
#pragma unroll
            for (int ai = 0; ai < 2; ++ai)
#pragma unroll
                for (int m = 0; m < 4; ++m) { const int r = r0 + 128 * ai + 16 * m; head64_epi(acc, ai, m, gn, rp, rope, r - 256, fq, base + (size_t)r * 64); ITER_FENCE(); }
        } else {
            if (wc < 2) {
                bf16_t* vt = qkv + O_GVT + (size_t)wc * 64 * R_;
#pragma unroll
                for (int ai = 0; ai < 2; ++ai)
#pragma unroll
                    for (int m = 0; m < 4; ++m) { vt_store(acc, ai, m, 1.f, vt, fq, r0 + 128 * ai + 16 * m); ITER_FENCE(); }
            } else if (wc == 2) {
#pragma unroll
                for (int ai = 0; ai < 2; ++ai)
#pragma unroll
                    for (int m = 0; m < 4; ++m) {
                        const int r = r0 + 128 * ai + 16 * m; const f32x4 a = acc[ai][0][m][0], b = acc[ai][0][m][1];
                        u32x4 w; w.x = pk2(a[0], a[1]); w.y = pk2(a[2], a[3]); w.z = pk2(b[0], b[1]); w.w = pk2(b[2], b[3]);
                        *(u32x4*)(qkv + O_CKR + (size_t)r * 32 + 8 * fq) = w;
                    }
            }
        }
    }
};

struct EpiQB {
    bf16_t* qkv; const float* part; const float* rope; const float* gq; LAS float* xch;
    __device__ __forceinline__ void operator()(const AccT& acc, const pg8::Unit& u, int, int, int, int) const {
        EPI_IDS();
        const int wid = wr * 4 + wc, head = 2 * u.pn + (wc >> 1), role = wc & 1, r0 = u.pm * 256 + wr * 64 + fr;
        const bool rp = u.pm > 0;
        float ssp[2][4];
#pragma unroll
        for (int ai = 0; ai < 2; ++ai)
#pragma unroll
            for (int m = 0; m < 4; ++m) {
                float ss = 0.f;
#pragma unroll
                for (int bj = 0; bj < 2; ++bj)
#pragma unroll
                    for (int n = 0; n < 2; ++n)
#pragma unroll
                        for (int e = 0; e < 4; ++e) { const float v = acc[ai][bj][m][n][e]; ss += v * v; }
                ss += __shfl_xor(ss, 16); ss += __shfl_xor(ss, 32);
                ssp[ai][m] = ss;
                if (fq == 0) xch[wid * 128 + ai * 64 + m * 16 + fr] = ss;
            }
        EPI_BARRIER();
        float g0[2][2][4];
        const float* gql = launder(gq);
        if (role == 0) load_gain64(g0, gql, fq);
        else {
#pragma unroll
            for (int n = 0; n < 2; ++n) { const float4 t = *(const float4*)(gql + 64 + 16 * n + 4 * fq); g0[0][n][0] = t.x; g0[0][n][1] = t.y; g0[0][n][2] = t.z; g0[0][n][3] = t.w; }
        }
#pragma unroll
        for (int ai = 0; ai < 2; ++ai)
#pragma unroll
            for (int m = 0; m < 4; ++m) {
                const int r = r0 + 128 * ai + 16 * m;
                const float so = xch[(wid ^ 1) * 128 + ai * 64 + m * 16 + fr];
                const float* pp = part + (size_t)r * 12;
                const float rq = rsqrtf((pp[0] + pp[1] + pp[2] + pp[3] + pp[4] + pp[5]) * (1.f / 384.f) + EPS_);
                const float sc = rq * rsqrtf(rq * rq * (ssp[ai][m] + so) * (1.f / 96.f) + EPS_);
                bf16_t* dst = qkv + O_MQ + ((size_t)head * R_ + r) * 96;
                if (role == 0) {
#pragma unroll
                    for (int bj = 0; bj < 2; ++bj) {
                        const f32x4 a = acc[ai][bj][m][0], b = acc[ai][bj][m][1];
                        u32x4 w; w.x = pk2(a[0] * sc * g0[bj][0][0], a[1] * sc * g0[bj][0][1]); w.y = pk2(a[2] * sc * g0[bj][0][2], a[3] * sc * g0[bj][0][3]);
                        w.z = pk2(b[0] * sc * g0[bj][1][0], b[1] * sc * g0[bj][1][1]); w.w = pk2(b[2] * sc * g0[bj][1][2], b[3] * sc * g0[bj][1][3]);
                        *(u32x4*)(dst + 32 * bj + 8 * fq) = w;
                    }
                } else {
                    float y1[4], y2[4];
#pragma unroll
                    for (int e = 0; e < 4; ++e) { y1[e] = acc[ai][0][m][0][e] * sc * g0[0][0][e]; y2[e] = acc[ai][0][m][1][e] * sc * g0[0][1][e]; }
                    if (rp) {
                        const int t = r - 256, pos = fq < 2 ? (t >> 6) : (t & 63);
                        const float* tb = rope + (pos * 16 + 8 * (fq & 1)) * 2;
#pragma unroll
                        for (int e = 0; e < 4; ++e) { const float2 cs = *(const float2*)(tb + 4 * e); const float a = y1[e], b = y2[e]; y1[e] = a * cs.x - b * cs.y; y2[e] = a * cs.y + b * cs.x; }
                    }
                    *(uint2*)(dst + 64 + 4 * fq) = make_uint2(pk2(y1[0], y1[1]), pk2(y1[2], y1[3]));
                    *(uint2*)(dst + 80 + 4 * fq) = make_uint2(pk2(y2[0], y2[1]), pk2(y2[2], y2[3]));
                }
                ITER_FENCE();
            }
        EPI_BARRIER();
    }
};

struct EpiKVB {
    bf16_t* qkv; const float* part; const float* rope; const float* gk;
    __device__ __forceinline__ void operator()(const AccT& acc, const pg8::Unit& u, int, int, int, int) const {
        EPI_IDS();
        const int head = 2 * u.pn + (wc >> 1), role = wc & 1, r0 = u.pm * 256 + wr * 64 + fr;
        const bool rp = u.pm > 0;
        if (role == 1) {
            bf16_t* vt = qkv + O_MVT + (size_t)head * 64 * R_;
#pragma unroll
            for (int ai = 0; ai < 2; ++ai)
#pragma unroll
                for (int m = 0; m < 4; ++m) {
                    const int r = r0 + 128 * ai + 16 * m; const float* pp = part + (size_t)r * 12 + 8;
                    const float rk = rsqrtf((pp[0] + pp[1] + pp[2] + pp[3]) * (1.f / 256.f) + EPS_);
                    vt_store(acc, ai, m, rk, vt, fq, r);
                    ITER_FENCE();
                }
        } else {
            const float* gkl = launder(gk);
            float gn[2][2][4]; load_gain64(gn, gkl, fq);
            float gr[2][4];
#pragma unroll
            for (int n = 0; n < 2; ++n) { const float4 t = *(const float4*)(gkl + 64 + 16 * n + 4 * fq); gr[n][0] = t.x; gr[n][1] = t.y; gr[n][2] = t.z; gr[n][3] = t.w; }
#pragma unroll
            for (int ai = 0; ai < 2; ++ai)
#pragma unroll
                for (int m = 0; m < 4; ++m) {
                    const int r = r0 + 128 * ai + 16 * m; const float* pp = part + (size_t)r * 12 + 8;
                    const float rk = rsqrtf((pp[0] + pp[1] + pp[2] + pp[3]) * (1.f / 256.f) + EPS_);
                    const uint2 c1 = *(const uint2*)(qkv + O_CKR + (size_t)r * 32 + 4 * fq), c2 = *(const uint2*)(qkv + O_CKR + (size_t)r * 32 + 16 + 4 * fq);
                    float y1[4] = {__uint_as_float(c1.x << 16), __uint_as_float(c1.x & 0xffff0000u), __uint_as_float(c1.y << 16), __uint_as_float(c1.y & 0xffff0000u)};
                    float y2[4] = {__uint_as_float(c2.x << 16), __uint_as_float(c2.x & 0xffff0000u), __uint_as_float(c2.y << 16), __uint_as_float(c2.y & 0xffff0000u)};
                    float ss = 0.f;
#pragma unroll
                    for (int bj = 0; bj < 2; ++bj)
#pragma unroll
                        for (int n = 0; n < 2; ++n)
#pragma unroll
                            for (int e = 0; e < 4; ++e) { const float v = acc[ai][bj][m][n][e] * rk; ss += v * v; }
#pragma unroll
                    for (int e = 0; e < 4; ++e) ss += y1[e] * y1[e] + y2[e] * y2[e];
                    ss += __shfl_xor(ss, 16); ss += __shfl_xor(ss, 32);
                    const float rr = rsqrtf(ss * (1.f / 96.f) + EPS_), sc = rk * rr;
                    bf16_t* dst = qkv + O_MK + ((size_t)head * R_ + r) * 96;
#pragma unroll
                    for (int bj = 0; bj < 2; ++bj) {
                        const f32x4 a = acc[ai][bj][m][0], b = acc[ai][bj][m][1];
                        u32x4 w; w.x = pk2(a[0] * sc * gn[bj][0][0], a[1] * sc * gn[bj][0][1]); w.y = pk2(a[2] * sc * gn[bj][0][2], a[3] * sc * gn[bj][0][3]);
                        w.z = pk2(b[0] * sc * gn[bj][1][0], b[1] * sc * gn[bj][1][1]); w.w = pk2(b[2] * sc * gn[bj][1][2], b[3] * sc * gn[bj][1][3]);
                        *(u32x4*)(dst + 32 * bj + 8 * fq) = w;
                    }
#pragma unroll
                    for (int e = 0; e < 4; ++e) { y1[e] *= rr * gr[0][e]; y2[e] *= rr * gr[1][e]; }
                    if (rp) {
                        const int t = r - 256, pos = fq < 2 ? (t >> 6) : (t & 63);
                        const float* tb = rope + (pos * 16 + 8 * (fq & 1)) * 2;
#pragma unroll
                        for (int e = 0; e < 4; ++e) { const float2 cs = *(const float2*)(tb + 4 * e); const float a = y1[e], b = y2[e]; y1[e] = a * cs.x - b * cs.y; y2[e] = a * cs.y + b * cs.x; }
                    }
                    *(uint2*)(dst + 64 + 4 * fq) = make_uint2(pk2(y1[0], y1[1]), pk2(y1[2], y1[3]));
                    *(uint2*)(dst + 80 + 4 * fq) = make_uint2(pk2(y2[0], y2[1]), pk2(y2[2], y2[3]));
                    ITER_FENCE();
                }
        }
    }
};

__device__ __forceinline__ void g_qkv0(const Params& p, LAS unsigned char* lds) {
    Bufs B(p);
    pg8::Gemm g{B.h, B.wt + W_EIN, 1024}; pg8::Order S; S.init(65, 12, gridDim.x, blockIdx.x, 0, 1);
    EpiQKV0 E{B.qkv, B.rope, B.gt};
    pg8::gemm_phase<EpiQKV0, pg8::Order, true, true>(lds, g, S, E);
}
__device__ __forceinline__ void g_out(const Params& p, int l, LAS unsigned char* lds) {
    Bufs B(p);
    pg8::Gemm g{B.mix, B.wt + (l == 0 ? W_EOUT : W_OOUT), 1024}; pg8::Order S; S.init(l == 0 ? 65 : 64, 4, gridDim.x, blockIdx.x, l == 0 ? 0 : 1, 0);
    EpiResid E{l == 0 ? p.in[I_X] : p.out, p.out, p.in[I_CTX], B.xc, modp(B, l, 0, 2), modp(B, l, 1, 2)};
    pg8::gemm_phase<EpiResid, pg8::Order, true, true>(lds, g, S, E);
}
__device__ __forceinline__ void g_up(const Params& p, int l, LAS unsigned char* lds) {
    Bufs B(p);
    pg8::Gemm g{B.h, B.wt + W_UP + (size_t)l * F2_ * 1024, 1024}; pg8::Order S; S.init(l == 0 ? 67 : 65, 22, gridDim.x, blockIdx.x, l == 0 ? 0 : 2, 2);
    EpiUp E{B.act, p.in[I_FCW] + (size_t)l * 3 * F2_, p.in[I_FCB] + (size_t)l * F2_, (LAS float*)(lds + LDS_XCH)};
    pg8::gemm_phase<EpiUp, pg8::Order, true, true>(lds, g, S, E);
}
__device__ __forceinline__ void g_down(const Params& p, int l, LAS unsigned char* lds) {
    Bufs B(p);
    pg8::Gemm g{B.act, B.wt + W_DOWN + (size_t)l * 1024 * F_, F_}; pg8::Order S; S.init(l == 0 ? 65 : 64, 4, gridDim.x, blockIdx.x, l == 0 ? 0 : 1, 0);
    EpiResid E{p.out, p.out, B.xc, B.xc, modp(B, l, 0, 5), modp(B, l, 1, 5)};
    pg8::gemm_phase<EpiResid, pg8::Order, true, true>(lds, g, S, E);
}
__device__ __forceinline__ void g_qkv1a(const Params& p, LAS unsigned char* lds) {
    Bufs B(p);
    pg8::Gemm g{B.h, B.wt + W_OIN, 1024}; pg8::Order S; S.init(65, 6, gridDim.x, blockIdx.x, 0, 1);
    EpiQKV1A E{B.qkv, B.part, B.rope, B.gt};
    pg8::gemm_phase<EpiQKV1A, pg8::Order, true, true>(lds, g, S, E);
}
__device__ __forceinline__ void g_qkv1b(const Params& p, LAS unsigned char* lds) {
    Bufs B(p);
    { pg8::Gemm g{B.qkv + O_CQ, B.wt + W_QB, 384}; pg8::Order S; S.init(64, 4, gridDim.x, blockIdx.x, 1, 0);
      EpiQB E{B.qkv, B.part, B.rope, p.in[I_CQN], (LAS float*)(lds + LDS_XCH)};
      pg8::gemm_phase<EpiQB, pg8::Order, true, true>(lds, g, S, E); }
    { pg8::Gemm g{B.qkv + O_CKV, B.wt + W_KVB, 256}; pg8::Order S; S.init(65, 4, gridDim.x, blockIdx.x, 0, 0);
      EpiKVB E{B.qkv, B.part, B.rope, p.in[I_CKN]};
      pg8::gemm_phase<EpiKVB, pg8::Order, true, true>(lds, g, S, E); }
}

typedef float f32x16 __attribute__((ext_vector_type(16)));
typedef __bf16 bf16x2_t __attribute__((ext_vector_type(2)));
typedef float f32x2_t __attribute__((ext_vector_type(2)));
__device__ __forceinline__ u32 cvtpk(float lo, float hi) { const f32x2_t v = {lo, hi}; const bf16x2_t b = __builtin_convertvector(v, bf16x2_t); return __builtin_bit_cast(u32, b); }

template <int DQK, int DV>
struct FlashGeom {
    static constexpr int KP = DQK * 2 + 16, VP = 144, KBYTES = 64 * KP, VBYTES = DV * VP, STAGE = KBYTES + VBYTES;
    static constexpr int KCH = DQK / 8, KN = (64 * KCH + NT - 1) / NT, VN = DV * 8 / NT;
};

template <int DQK, int DV>
__device__ __forceinline__ void flash_dense(LAS char* lds, const bf16_t* __restrict__ qptr, const bf16_t* __restrict__ Kb, const bf16_t* __restrict__ VT, int ntiles, float c1, float c2,
                                            f32x16 (&O)[DV / 32], float& lsum) {
    typedef FlashGeom<DQK, DV> G;
    const int tid = threadIdx.x, lane = tid & 63, r = lane & 31, h = lane >> 5;
    bf16x8 qf[DQK / 16];
#pragma unroll
    for (int ks = 0; ks < DQK / 16; ++ks) qf[ks] = *(const bf16x8*)(qptr + 16 * ks + 8 * h);
#pragma unroll
    for (int dt = 0; dt < DV / 32; ++dt)
#pragma unroll
        for (int i = 0; i < 16; ++i) O[dt][i] = 0.f;
    float l = 0.f;
    u32x4 kreg[G::KN], vreg[G::VN];
    auto load_tile = [&](int t) {
#pragma unroll
        for (int i = 0; i < G::KN; ++i) { const int q = tid + NT * i; if (q < 64 * G::KCH) kreg[i] = *(const u32x4*)(Kb + (size_t)t * 64 * DQK + q * 8); }
#pragma unroll
        for (int i = 0; i < G::VN; ++i) { const int q = tid + NT * i; vreg[i] = *(const u32x4*)(VT + (size_t)(q >> 3) * R_ + t * 64 + (q & 7) * 8); }
    };
    auto store_tile = [&](int buf) {
        LAS char* kb = lds + buf * G::STAGE; LAS char* vb = kb + G::KBYTES;
#pragma unroll
        for (int i = 0; i < G::KN; ++i) { const int q = tid + NT * i; if (q < 64 * G::KCH) *(LAS u32x4*)(kb + (q / G::KCH) * G::KP + (q % G::KCH) * 16) = kreg[i]; }
#pragma unroll
        for (int i = 0; i < G::VN; ++i) { const int q = tid + NT * i; *(LAS u32x4*)(vb + (q >> 3) * G::VP + (q & 7) * 16) = vreg[i]; }
    };
    load_tile(0); store_tile(0);
    if (ntiles > 1) load_tile(1);
    __syncthreads();
    for (int t = 0; t < ntiles; ++t) {
        if (t + 1 < ntiles) store_tile((t + 1) & 1);
        if (t + 2 < ntiles) load_tile(t + 2);
        const LAS char* kb = lds + (t & 1) * G::STAGE; const LAS char* vb = kb + G::KBYTES;
#pragma unroll
        for (int kt = 0; kt < 2; ++kt) {
            f32x16 S;
#pragma unroll
            for (int i = 0; i < 16; ++i) S[i] = 0.f;
#pragma unroll
            for (int ks = 0; ks < DQK / 16; ++ks) {
                const bf16x8 a = *(const LAS bf16x8*)(kb + (32 * kt + r) * G::KP + (16 * ks + 8 * h) * 2);
                S = __builtin_amdgcn_mfma_f32_32x32x16_bf16(a, qf[ks], S, 0, 0, 0);
            }
            float p[16];
#pragma unroll
            for (int i = 0; i < 16; ++i) { p[i] = __builtin_amdgcn_exp2f(S[i] * c1 - c2); l += p[i]; }
#pragma unroll
            for (int s = 0; s < 2; ++s) {
                u32x4 pw; pw.x = cvtpk(p[8 * s], p[8 * s + 1]); pw.y = cvtpk(p[8 * s + 2], p[8 * s + 3]); pw.z = cvtpk(p[8 * s + 4], p[8 * s + 5]); pw.w = cvtpk(p[8 * s + 6], p[8 * s + 7]);
                const bf16x8 pf = __builtin_bit_cast(bf16x8, pw);
#pragma unroll
                for (int dt = 0; dt < DV / 32; ++dt) {
                    const bf16x8 a = *(const LAS bf16x8*)(vb + (32 * dt + r) * G::VP + (16 * (2 * kt + s) + 8 * h) * 2);
                    O[dt] = __builtin_amdgcn_mfma_f32_32x32x16_bf16(a, pf, O[dt], 0, 0, 0);
                }
            }
        }
        __syncthreads();
    }
    lsum = l + __shfl_xor(l, 32);
}

__device__ __forceinline__ void diff_unit(const Params& p, const Bufs& B, LAS char* lds, int head, int qb) {
    const int tid = threadIdx.x, wid = tid >> 6, lane = tid & 63, c = lane & 31, h = lane >> 5;
    const int r = qb * 256 + wid * 32 + c, nt = qb == 0 ? 4 : R_ / 64;
    const float lam = B.scal[0], c1 = 0.125f * 1.4426950408889634f, c2 = B.scal[1];
    float* tmp = (float*)B.h + ((size_t)r * 4 + head) * 128 + 4 * h;
    f32x16 O[4]; float l;
    flash_dense<64, 128>(lds, B.qkv + O_QA + ((size_t)(2 * head) * R_ + r) * 64, B.qkv + O_KA + (size_t)(2 * head) * R_ * 64, B.qkv + O_VAT + (size_t)head * 128 * R_, nt, c1, c2, O, l);
    {
        const float inv = 1.f / l;
#pragma unroll
        for (int dt = 0; dt < 4; ++dt)
#pragma unroll
            for (int q = 0; q < 4; ++q) *(f32x4*)(tmp + 32 * dt + 8 * q) = (f32x4){O[dt][4 * q] * inv, O[dt][4 * q + 1] * inv, O[dt][4 * q + 2] * inv, O[dt][4 * q + 3] * inv};
    }
    flash_dense<64, 128>(lds, B.qkv + O_QA + ((size_t)(2 * head + 1) * R_ + r) * 64, B.qkv + O_KA + (size_t)(2 * head + 1) * R_ * 64, B.qkv + O_VAT + (size_t)head * 128 * R_, nt, c1, c2, O, l);
    {
        const float inv = lam / l; float ss = 0.f;
#pragma unroll
        for (int dt = 0; dt < 4; ++dt)
#pragma unroll
            for (int q = 0; q < 4; ++q) {
                const f32x4 o1 = *(const f32x4*)(tmp + 32 * dt + 8 * q);
#pragma unroll
                for (int e = 0; e < 4; ++e) { const float d = o1[e] - O[dt][4 * q + e] * inv; O[dt][4 * q + e] = d; ss += d * d; }
            }
        ss += __shfl_xor(ss, 32);
        const float rr = rsqrtf(ss * (1.f / 128.f) + EPS_) * 0.8f;
        bf16_t* dst = B.mix + (size_t)r * 1024 + head * 128 + 4 * h;
        const float* g = p.in[I_SUBLN] + 4 * h;
#pragma unroll
        for (int dt = 0; dt < 4; ++dt)
#pragma unroll
            for (int q = 0; q < 4; ++q) {
                const f32x4 gg = *(const f32x4*)(g + 32 * dt + 8 * q);
                *(uint2*)(dst + 32 * dt + 8 * q) = make_uint2(cvtpk(O[dt][4 * q] * rr * gg[0], O[dt][4 * q + 1] * rr * gg[1]), cvtpk(O[dt][4 * q + 2] * rr * gg[2], O[dt][4 * q + 3] * rr * gg[3]));
            }
    }
}
__device__ __forceinline__ void mla_unit(const Params& p, const Bufs& B, LAS char* lds, int head, int qb) {
    const int tid = threadIdx.x, wid = tid >> 6, lane = tid & 63, c = lane & 31, h = lane >> 5;
    const int r = qb * 256 + wid * 32 + c;
    const float c1 = 0.10206207261596575f * 1.4426950408889634f, c2 = B.scal[2];
    f32x16 O[2]; float l;
    flash_dense<96, 64>(lds, B.qkv + O_MQ + ((size_t)head * R_ + r) * 96, B.qkv + O_MK + (size_t)head * R_ * 96, B.qkv + O_MVT + (size_t)head * 64 * R_, R_ / 64, c1, c2, O, l);
    const float inv = 1.f / l;
    bf16_t* dst = B.mix + (size_t)r * 1024 + head * 64 + 4 * h;
#pragma unroll
    for (int dt = 0; dt < 2; ++dt)
#pragma unroll
        for (int q = 0; q < 4; ++q)
            *(uint2*)(dst + 32 * dt + 8 * q) = make_uint2(cvtpk(O[dt][4 * q] * inv, O[dt][4 * q + 1] * inv), cvtpk(O[dt][4 * q + 2] * inv, O[dt][4 * q + 3] * inv));
}
__device__ void phase_attn0_dense(const Params& p, LAS char* lds, int bid, int nblk) {
    Bufs B(p);
    for (int u = bid; u < 260; u += nblk) {
        int head, qb;
        if (u < 256) { const int x = u & 7; head = x >> 1; qb = 1 + (u >> 3) * 2 + (x & 1); } else { head = u - 256; qb = 0; }
        diff_unit(p, B, lds, head, qb);
    }
}
__device__ void phase_attn1_dense(const Params& p, LAS char* lds, int bid, int nblk) {
    Bufs B(p);
    for (int u = bid; u < 512; u += nblk) mla_unit(p, B, lds, u & 7, 1 + (u >> 3));
}

#ifndef OPTG
#define OPTG 0x7f
#endif
constexpr int NPHASE = 16;
__device__ __forceinline__ void run_phase(int ph, const Params& p, char* lds, int bid, int nblk) {
    LAS unsigned char* l3 = (LAS unsigned char*)lds;
    switch (ph) {
        case 0: phase_prep(p, lds, bid, nblk); if (OPTG) phase_prep_weights(p, lds, bid, nblk); break;
        case 1: phase_norm(p, 0, 0, bid, nblk); break;
        case 2: if (OPTG & 1) g_qkv0(p, l3); else phase_qkv0(p, lds, bid, nblk); break;
        case 3: if (OPTA & 1) phase_attn0_dense(p, (LAS char*)lds, bid, nblk); phase_attn0(p, lds, bid, nblk); break;
        case 4: if (OPTG & 2) g_out(p, 0, l3); else phase_out(p, 0, bid, nblk); break;
        case 5: phase_norm(p, 0, 1, bid, nblk); break;
        case 6: if (OPTG & 4) g_up(p, 0, l3); else phase_up(p, 0, lds, bid, nblk); break;
        case 7: if (OPTG & 8) g_down(p, 0, l3); else phase_down(p, 0, bid, nblk); break;
        case 8: phase_norm(p, 1, 0, bid, nblk); break;
        case 9: if (OPTG & 16) g_qkv1a(p, l3); else phase_qkv1a(p, lds, bid, nblk); break;
        case 10: if (OPTG & 32) g_qkv1b(p, l3); else phase_qkv1b(p, lds, bid, nblk); break;
        case 11: if (OPTA & 2) phase_attn1_dense(p, (LAS char*)lds, bid, nblk); phase_attn1(p, bid, nblk); break;
        case 12: if (OPTG & 2) g_out(p, 1, l3); else phase_out(p, 1, bid, nblk); break;
        case 13: phase_norm(p, 1, 1, bid, nblk); break;
        case 14: if (OPTG & 4) g_up(p, 1, l3); else phase_up(p, 1, lds, bid, nblk); break;
        case 15: if (OPTG & 8) g_down(p, 1, l3); else phase_down(p, 1, bid, nblk); break;
    }
}

namespace cg = cooperative_groups;
__global__ void __launch_bounds__(NT, 2) k_mega(Params p) {
    extern __shared__ __attribute__((aligned(16))) char smem[];
    cg::grid_group grid = cg::this_grid();
    const int bid = blockIdx.x, nblk = gridDim.x;
#define PH(n) run_phase(n, p, smem, bid, nblk)
    PH(0); grid.sync(); PH(1); grid.sync(); PH(2); grid.sync(); PH(3); grid.sync(); PH(4); grid.sync(); PH(5); grid.sync(); PH(6); grid.sync(); PH(7); grid.sync();
    PH(8); grid.sync(); PH(9); grid.sync(); PH(10); grid.sync(); PH(11); grid.sync(); PH(12); grid.sync(); PH(13); grid.sync(); PH(14); grid.sync(); PH(15);
#undef PH
}

extern "C" void kernel_launch(void* const* d_in, const int* in_sizes, int n_in, void* d_out, int out_size, void* d_ws, size_t ws_size, hipStream_t stream) {
    Params p{};
    for (int i = 0; i < 35; ++i) p.in[i] = (const float*)d_in[i];
    p.out = (float*)d_out; p.ws = (char*)d_ws;
    if (ws_size < WS_END) { fprintf(stderr, "ws too small: %zu < %zu\n", ws_size, (size_t)WS_END); return; }
    static int grid_blocks = 0;
    if (!grid_blocks) {
        int dev = 0, cus = 0, per_cu = 0;
        hipGetDevice(&dev);
        hipDeviceGetAttribute(&cus, hipDeviceAttributeMultiprocessorCount, dev);
        if (hipFuncSetAttribute((const void*)k_mega, hipFuncAttributeMaxDynamicSharedMemorySize, LDS_BYTES) != hipSuccess) fprintf(stderr, "hipFuncSetAttribute failed\n");
        hipOccupancyMaxActiveBlocksPerMultiprocessor(&per_cu, (const void*)k_mega, NT, LDS_BYTES);
        if (per_cu < 1) { fprintf(stderr, "occupancy query returned %d\n", per_cu); per_cu = 1; }
        if (per_cu > 1) per_cu = 1;
        grid_blocks = cus * per_cu;
    }
    void* args[] = {&p};
    hipError_t e = hipLaunchCooperativeKernel((const void*)k_mega, dim3(grid_blocks), dim3(NT), args, LDS_BYTES, stream);
    if (e != hipSuccess) fprintf(stderr, "cooperative launch failed: %s (grid %d)\n", hipGetErrorString(e), grid_blocks);
}
```

```cpp
#include <hip/hip_runtime.h>
#include <hip/hip_cooperative_groups.h>
#include <cstdint>
#include <cstdio>
#include <cmath>

typedef unsigned short bf16_t;
typedef unsigned int u32;
typedef u32 u32x4 __attribute__((ext_vector_type(4)));

#define NT 512
#ifndef OPTA
#define OPTA 15
#endif
constexpr int T_ = 16384, L_ = 256, R_ = 16640, D_ = 1024, F_ = 2816, F2_ = 5632;
constexpr float EPS_ = 1e-6f;

constexpr size_t WS_CTL = 0;
constexpr size_t WS_MOD = 4096;
constexpr size_t WS_SCAL = WS_MOD + 2 * 2 * 6144 * 4;
constexpr size_t WS_GT = WS_SCAL + 256;
constexpr size_t WS_ROPE = WS_GT + 6 * 64 * 4;
constexpr size_t WS_XC = WS_ROPE + 256 * 16 * 2 * 4;
constexpr size_t WS_H = WS_XC + 256 * 1024 * 4;
constexpr int HROWS = R_ + 144;
constexpr size_t WS_MIX = WS_H + (size_t)HROWS * 1024 * 2;
constexpr size_t WS_QKV = WS_MIX + (size_t)R_ * 1024 * 2;
constexpr size_t E_SEG = (size_t)512 * R_;
constexpr size_t O_QA = 0, O_KA = E_SEG, O_VAT = 2 * E_SEG, O_QB = 3 * E_SEG, O_KB = 4 * E_SEG, O_VBT = 5 * E_SEG;
constexpr size_t O_CQ = 0, O_CKV = O_CQ + (size_t)R_ * 384, O_CKR = O_CKV + (size_t)R_ * 256, O_MQ = O_CKR + (size_t)R_ * 32,
                 O_MK = O_MQ + (size_t)R_ * 768, O_MVT = O_MK + (size_t)R_ * 768, O_GQ = O_MVT + (size_t)R_ * 512,
                 O_GK = O_GQ + (size_t)R_ * 512, O_GVT = O_GK + (size_t)R_ * 128, O_L1END = O_GVT + (size_t)R_ * 128;
constexpr size_t WS_QKV_BYTES = O_L1END * 2;
constexpr size_t WS_PART = WS_QKV + WS_QKV_BYTES;
constexpr size_t WS_WT = WS_PART + (size_t)R_ * 12 * 4;
constexpr size_t W_EIN = 0, W_EOUT = W_EIN + (size_t)3072 * 1024, W_UP = W_EOUT + (size_t)1024 * 1024, W_DOWN = W_UP + (size_t)2 * 5632 * 1024,
                 W_OIN = W_DOWN + (size_t)2 * 1024 * 2816, W_OOUT = W_OIN + (size_t)1536 * 1024, W_QB = W_OOUT + (size_t)1024 * 1024,
                 W_KVB = W_QB + (size_t)1024 * 384, W_END = W_KVB + (size_t)1024 * 256;
constexpr size_t WS_END = WS_WT + W_END * 2;
static_assert(WS_END < (size_t)255 * 1024 * 1024, "ws");
static_assert((size_t)(R_ + 8) * F_ * 2 <= WS_QKV_BYTES, "act alias");

struct Params { const float* in[35]; float* out; char* ws; };
enum { I_X = 0, I_C, I_CTX, I_CCTX, I_ADAW, I_ADAB, I_NMIX, I_NFFN, I_FUP, I_FCW, I_FCB, I_FDOWN, I_EWIN, I_EWOUT, I_AQN, I_AKN,
       I_LQ1, I_LK1, I_LQ2, I_LK2, I_SUBLN, I_BQN, I_BKN, I_RPB, I_OWIN, I_OWOUT, I_CQAN, I_CWQB, I_CKVAN, I_CWKVB, I_CQN, I_CKN,
       I_DQN, I_DKN, I_SINK };

__device__ __forceinline__ float bf2f(bf16_t v) { return __uint_as_float(((u32)v) << 16); }
__device__ __forceinline__ bf16_t f2bf(float f) { u32 u = __float_as_uint(f); return (bf16_t)((u + 0x7fffu + ((u >> 16) & 1u)) >> 16); }
__device__ __forceinline__ float wave_sum(float v) {
#pragma unroll
    for (int o = 32; o > 0; o >>= 1) v += __shfl_xor(v, o);
    return v;
}
__device__ __forceinline__ int swap23(int p) { return (p & 3) | ((p & 4) << 1) | ((p & 8) >> 1); }
__device__ __forceinline__ int hrow(int r) { return r < 256 ? r + 1 : r + 2; }
__device__ __forceinline__ int vpos(int key) { return (key & ~15) + swap23(key & 15); }
__device__ __forceinline__ void unpack8(u32x4 v, float (&a)[8]) {
    a[0] = __uint_as_float(v.x << 16); a[1] = __uint_as_float(v.x & 0xffff0000u);
    a[2] = __uint_as_float(v.y << 16); a[3] = __uint_as_float(v.y & 0xffff0000u);
    a[4] = __uint_as_float(v.z << 16); a[5] = __uint_as_float(v.z & 0xffff0000u);
    a[6] = __uint_as_float(v.w << 16); a[7] = __uint_as_float(v.w & 0xffff0000u);
}

struct Bufs {
    float* mod; float* scal; float* rope; float* xc; bf16_t* h; bf16_t* mix; bf16_t* qkv; bf16_t* act; float* part; bf16_t* wt; float* gt;
    __device__ Bufs(const Params& p) {
        mod = (float*)(p.ws + WS_MOD); scal = (float*)(p.ws + WS_SCAL); rope = (float*)(p.ws + WS_ROPE); xc = (float*)(p.ws + WS_XC);
        h = (bf16_t*)(p.ws + WS_H); mix = (bf16_t*)(p.ws + WS_MIX); qkv = (bf16_t*)(p.ws + WS_QKV); act = (bf16_t*)(p.ws + WS_QKV);
        part = (float*)(p.ws + WS_PART); wt = (bf16_t*)(p.ws + WS_WT); gt = (float*)(p.ws + WS_GT);
    }
};
__device__ __forceinline__ const float* modp(const Bufs& B, int l, int s, int chunk) { return B.mod + ((size_t)(l * 2 + s) * 6144) + chunk * 1024; }

__device__ void phase_prep(const Params& p, char* lds, int bid, int nblk) {
    Bufs B(p);
    float* red = (float*)lds;
    const int tid = threadIdx.x;
    for (int item = bid; item < 193; item += nblk) {
        if (item < 192) {
            const int l = item / 96, n0 = (item % 96) * 64, nn = tid & 63, kc = tid >> 6;
            const float* W = p.in[I_ADAW] + (size_t)l * 1024 * 6144 + n0 + nn;
            float a0 = 0.f, a1 = 0.f;
            for (int k = kc * 128; k < kc * 128 + 128; ++k) {
                const float w = W[(size_t)k * 6144];
                const float c0 = p.in[I_C][k], c1 = p.in[I_CCTX][k];
                a0 += (c0 / (1.f + __expf(-c0))) * w; a1 += (c1 / (1.f + __expf(-c1))) * w;
            }
            red[(kc * 64 + nn) * 2] = a0; red[(kc * 64 + nn) * 2 + 1] = a1;
            __syncthreads();
            if (tid < 128) {
                const int n = tid & 63, s = tid >> 6; float acc = 0.f;
                for (int k = 0; k < 8; ++k) acc += red[(k * 64 + n) * 2 + s];
                B.mod[(size_t)(l * 2 + s) * 6144 + n0 + n] = acc + p.in[I_ADAB][l * 6144 + n0 + n];
            }
            __syncthreads();
        } else {
            for (int e = tid; e < 256 * 16; e += NT) {
                const int pos = e >> 4, i = e & 15;
                const double f = pow(10000.0, -(double)i / 16.0), ang = (double)pos * f;
                B.rope[e * 2] = (float)cos(ang); B.rope[e * 2 + 1] = (float)sin(ang);
            }
            if (tid < 64) {
                B.gt[tid] = p.in[I_AQN][tid]; B.gt[64 + tid] = p.in[I_AKN][tid]; B.gt[128 + tid] = p.in[I_BQN][tid]; B.gt[192 + tid] = p.in[I_BKN][tid];
                B.gt[256 + tid] = p.in[I_DQN][tid]; B.gt[320 + tid] = p.in[I_DKN][tid];
                const float s1 = wave_sum(p.in[I_LQ1][tid] * p.in[I_LK1][tid]), s2 = wave_sum(p.in[I_LQ2][tid] * p.in[I_LK2][tid]);
                if (tid == 0) B.scal[0] = expf(s1) - expf(s2) + 0.2f;
                float ma = fabsf(p.in[I_AQN][tid]), mb = fabsf(p.in[I_AKN][tid]), mc = fmaxf(fabsf(p.in[I_CQN][tid]), tid < 32 ? fabsf(p.in[I_CQN][64 + tid]) : 0.f),
                      md = fmaxf(fabsf(p.in[I_CKN][tid]), tid < 32 ? fabsf(p.in[I_CKN][64 + tid]) : 0.f);
#pragma unroll
                for (int o = 32; o > 0; o >>= 1) { ma = fmaxf(ma, __shfl_xor(ma, o)); mb = fmaxf(mb, __shfl_xor(mb, o)); mc = fmaxf(mc, __shfl_xor(mc, o)); md = fmaxf(md, __shfl_xor(md, o)); }
                if (tid == 0) { B.scal[1] = 8.f * ma * mb * 1.4426950408889634f; B.scal[2] = 9.797958971132712f * mc * md * 1.4426950408889634f; }
                float na = fabsf(p.in[I_BQN][tid]), nb = fabsf(p.in[I_BKN][tid]), nc = fabsf(p.in[I_DQN][tid]), nd = fabsf(p.in[I_DKN][tid]), nr = 0.f, ns = tid < 8 ? p.in[I_SINK][tid] : -1e30f;
                for (int e = tid; e < 8 * 465; e += 64) nr = fmaxf(nr, fabsf(p.in[I_RPB][e]));
#pragma unroll
                for (int o = 32; o > 0; o >>= 1) { na = fmaxf(na, __shfl_xor(na, o)); nb = fmaxf(nb, __shfl_xor(nb, o)); nc = fmaxf(nc, __shfl_xor(nc, o)); nd = fmaxf(nd, __shfl_xor(nd, o));
                                                   nr = fmaxf(nr, __shfl_xor(nr, o)); ns = fmaxf(ns, __shfl_xor(ns, o)); }
                if (tid == 0) { B.scal[3] = (8.f * na * nb + nr) * 1.4426950408889634f; B.scal[4] = fmaxf(8.f * nc * nd, ns) * 1.4426950408889634f; }
            }
        }
    }
}

__device__ void phase_norm(const Params& p, int l, int which, int bid, int nblk) {
    Bufs B(p);
    const int wid = threadIdx.x >> 6, lane = threadIdx.x & 63;
    const float* gamma = p.in[which ? I_NFFN : I_NMIX] + l * 1024;
    for (int e = bid * NT + threadIdx.x; e < (2 + HROWS - (R_ + 2)) * 128; e += nblk * NT) {
        const int rr = e >> 7, c = e & 127; const int rho = rr == 0 ? 0 : rr == 1 ? 257 : R_ + 2 + (rr - 2);
        *(u32x4*)(B.h + (size_t)rho * 1024 + c * 8) = (u32x4){0u, 0u, 0u, 0u};
    }
    for (int item = bid; item < R_ / 8; item += nblk) {
        const int r = item * 8 + wid;
        const bool first = (l == 0 && which == 0);
        const float* src = r < 256 ? ((first ? p.in[I_CTX] : B.xc) + (size_t)r * 1024) : ((first ? p.in[I_X] : p.out) + (size_t)(r - 256) * 1024);
        const int s = r < 256 ? 1 : 0;
        const float* sh = modp(B, l, s, which ? 3 : 0); const float* sc = modp(B, l, s, which ? 4 : 1);
        float v[16]; float ss = 0.f;
#pragma unroll
        for (int i = 0; i < 4; ++i) { const float4 t = *(const float4*)(src + i * 256 + lane * 4); v[4 * i] = t.x; v[4 * i + 1] = t.y; v[4 * i + 2] = t.z; v[4 * i + 3] = t.w; ss += t.x * t.x + t.y * t.y + t.z * t.z + t.w * t.w; }
        ss = wave_sum(ss);
        const float rr = rsqrtf(ss * (1.f / 1024.f) + EPS_);
#pragma unroll
        for (int i = 0; i < 4; ++i) {
            const int k = i * 256 + lane * 4; bf16_t o[4];
#pragma unroll
            for (int j = 0; j < 4; ++j) o[j] = f2bf(v[4 * i + j] * rr * gamma[k + j] * (1.f + sc[k + j]) + sh[k + j]);
            *(uint2*)(B.h + (size_t)hrow(r) * 1024 + k) = make_uint2((u32)o[0] | ((u32)o[1] << 16), (u32)o[2] | ((u32)o[3] << 16));
        }
    }
}

template <int RPG>
__device__ __forceinline__ void tile_linear(float (&acc)[RPG], int K, const bf16_t* const (&ap)[RPG], const float* __restrict__ W, int ldw, int wcol) {
#pragma unroll
    for (int i = 0; i < RPG; ++i) acc[i] = 0.f;
    if (wcol < 0) return;
    for (int k = 0; k < K; k += 8) {
        float w[8];
#pragma unroll
        for (int j = 0; j < 8; ++j) w[j] = W[(size_t)(k + j) * ldw + wcol];
#pragma unroll
        for (int i = 0; i < RPG; ++i) {
            if (ap[i]) { float a[8]; unpack8(*(const u32x4*)(ap[i] + k), a);
#pragma unroll
                for (int j = 0; j < 8; ++j) acc[i] += a[j] * w[j]; }
        }
    }
}
template <int RPG>
__device__ __forceinline__ void tile_linear_g(float (&acc)[RPG], int K, const bf16_t* const (&ap)[RPG], const float (&rs)[RPG], const float* __restrict__ g, const float* __restrict__ W, int ldw, int wcol) {
#pragma unroll
    for (int i = 0; i < RPG; ++i) acc[i] = 0.f;
    if (wcol < 0) return;
    for (int k = 0; k < K; k += 8) {
        float w[8];
#pragma unroll
        for (int j = 0; j < 8; ++j) w[j] = W[(size_t)(k + j) * ldw + wcol] * g[k + j];
#pragma unroll
        for (int i = 0; i < RPG; ++i) {
            if (ap[i]) { float a[8]; unpack8(*(const u32x4*)(ap[i] + k), a); float t = 0.f;
#pragma unroll
                for (int j = 0; j < 8; ++j) t += a[j] * w[j];
                acc[i] += t * rs[i]; }
        }
    }
}

__device__ __forceinline__ float2 rope64(const float* tab, int t, int i) { const int pos = i < 16 ? (t >> 6) : (t & 63); const int f = i & 15; return *(const float2*)(tab + (pos * 16 + f) * 2); }
__device__ __forceinline__ float2 rope32(const float* tab, int t, int i) { const int pos = i < 8 ? (t >> 6) : (t & 63); const int f = (i & 7) * 2; return *(const float2*)(tab + (pos * 16 + f) * 2); }

__device__ __forceinline__ void head64_norm_rope(const float* row, const float* g, bool rope, const float* tab, int t, bf16_t* dst, int lane) {
    const float v = row[lane];
    const float ss = wave_sum(v * v);
    const float rr = rsqrtf(ss * (1.f / 64.f) + EPS_);
    float y = v * rr * g[lane];
    if (rope) {
        const float yp = row[lane ^ 32] * rr * g[lane ^ 32];
        const float2 cs = rope64(tab, t, lane & 31);
        y = lane < 32 ? (y * cs.x - yp * cs.y) : (yp * cs.y + y * cs.x);
    }
    dst[lane] = f2bf(y);
}

__device__ void phase_qkv0(const Params& p, char* lds, int bid, int nblk) {
    Bufs B(p);
    float* tile = (float*)lds;
    const int tid = threadIdx.x, cc = tid & 127, rg = tid >> 7, wid = tid >> 6, lane = tid & 63;
    const float* W = p.in[I_EWIN];
    for (int item = bid; item < (R_ / 16) * 24; item += nblk) {
        const int rt = item / 24, ct = item % 24, row0 = rt * 16, col0 = ct * 128;
        const bf16_t* ap[4];
#pragma unroll
        for (int i = 0; i < 4; ++i) ap[i] = B.h + (size_t)hrow(row0 + rg * 4 + i) * 1024;
        float acc[4];
        tile_linear<4>(acc, 1024, ap, W, 3072, col0 + cc);
#pragma unroll
        for (int i = 0; i < 4; ++i) tile[(rg * 4 + i) * 128 + cc] = acc[i];
        __syncthreads();
        const int seg = col0 / 512, cin = col0 % 512;
        if (seg == 2 || seg == 5) {
            for (int e = tid; e < 16 * 128; e += NT) {
                const int c = e >> 4, rr = e & 15, r = row0 + rr;
                bf16_t* dst;
                if (seg == 2) dst = B.qkv + O_VAT + ((size_t)(cin / 128) * 128 + c) * R_;
                else dst = B.qkv + O_VBT + ((size_t)((cin + c) / 64) * 64 + (c & 63)) * R_;
                dst[vpos(r)] = f2bf(tile[rr * 128 + c]);
            }
        } else {
            for (int q = wid * 4; q < wid * 4 + 4; ++q) {
                const int rr = q >> 1, hh = q & 1, r = row0 + rr, head = cin / 64 + hh;
                const float* g = p.in[seg == 0 ? I_AQN : seg == 1 ? I_AKN : seg == 3 ? I_BQN : I_BKN];
                bf16_t* dst = B.qkv + (seg == 0 ? O_QA : seg == 1 ? O_KA : seg == 3 ? O_QB : O_KB) + ((size_t)head * R_ + r) * 64;
                head64_norm_rope(tile + rr * 128 + hh * 64, g, (seg < 2) && r >= 256, B.rope, r - 256, dst, lane);
            }
        }
        __syncthreads();
    }
}

__device__ __forceinline__ float dot8p(u32x4 k, u32 q0, u32 q1, u32 q2, u32 q3) {
    float t = __uint_as_float(k.x << 16) * __uint_as_float(q0 << 16);
    t += __uint_as_float(k.x & 0xffff0000u) * __uint_as_float(q0 & 0xffff0000u);
    t += __uint_as_float(k.y << 16) * __uint_as_float(q1 << 16);
    t += __uint_as_float(k.y & 0xffff0000u) * __uint_as_float(q1 & 0xffff0000u);
    t += __uint_as_float(k.z << 16) * __uint_as_float(q2 << 16);
    t += __uint_as_float(k.z & 0xffff0000u) * __uint_as_float(q2 & 0xffff0000u);
    t += __uint_as_float(k.w << 16) * __uint_as_float(q3 << 16);
    t += __uint_as_float(k.w & 0xffff0000u) * __uint_as_float(q3 & 0xffff0000u);
    return t;
}
template <int DQK, int DVT>
__device__ __forceinline__ void naive_dense(const bf16_t* __restrict__ q, const bf16_t* __restrict__ Kb, const bf16_t* __restrict__ VT, int nk, float scale, float (&O)[DVT], float& lsum) {
    u32x4 qp[DQK / 8];
#pragma unroll
    for (int i = 0; i < DQK / 8; ++i) qp[i] = *(const u32x4*)(q + i * 8);
#pragma unroll
    for (int d = 0; d < DVT; ++d) O[d] = 0.f;
    float m = -1e30f, l = 0.f;
    for (int c = 0; c < nk; c += 8) {
        float s[8];
#pragma unroll
        for (int j = 0; j < 8; ++j) {
            const int key = (c & ~15) + swap23((c & 15) + j);
            const bf16_t* kr = Kb + (size_t)key * DQK; float t = 0.f;
#pragma unroll
            for (int i = 0; i < DQK / 8; ++i) t += dot8p(*(const u32x4*)(kr + i * 8), qp[i].x, qp[i].y, qp[i].z, qp[i].w);
            s[j] = t * scale;
        }
        float cm = s[0];
#pragma unroll
        for (int j = 1; j < 8; ++j) cm = fmaxf(cm, s[j]);
        const float mn = fmaxf(m, cm), alpha = __expf(m - mn);
        float ps = 0.f;
#pragma unroll
        for (int j = 0; j < 8; ++j) { s[j] = __expf(s[j] - mn); ps += s[j]; }
        l = l * alpha + ps; m = mn;
#pragma unroll
        for (int d = 0; d < DVT; ++d) {
            float a[8]; unpack8(*(const u32x4*)(VT + (size_t)d * R_ + c), a);
            float t = O[d] * alpha;
#pragma unroll
            for (int j = 0; j < 8; ++j) t += s[j] * a[j];
            O[d] = t;
            if ((d & 7) == 7) __builtin_amdgcn_sched_barrier(0);
        }
    }
    lsum = l;
}

__device__ void phase_attn0(const Params& p, char* lds, int bid, int nblk) {
    Bufs B(p);
    const int tid = threadIdx.x;
    float* xch = (float*)lds;
    const float lam = B.scal[0];
    for (int item = bid + ((OPTA & 1) ? 1040 : 0); item < ((OPTA & 4) ? 1040 : 1300); item += nblk) {
        if (item < 1040) {
            const int head = item / 260, chunk = item % 260, role = tid >> 6, m = role >> 2, qt = role & 3, qi = tid & 63, r = chunk * 64 + qi, sub = head * 2 + m;
            const int nk = chunk < 4 ? 256 : R_;
            float O[32]; float l;
            naive_dense<64, 32>(B.qkv + O_QA + ((size_t)sub * R_ + r) * 64, B.qkv + O_KA + (size_t)sub * R_ * 64, B.qkv + O_VAT + ((size_t)head * 128 + qt * 32) * R_, nk, 0.125f, O, l);
            const float inv = 1.f / l;
#pragma unroll
            for (int d = 0; d < 32; ++d) O[d] *= inv;
            float* xh = xch + (qt * 64 + qi) * 33;
            __syncthreads();
            if (m == 1) {
#pragma unroll
                for (int d = 0; d < 32; ++d) xh[d] = O[d];
            }
            __syncthreads();
            if (m == 0) {
#pragma unroll
                for (int d = 0; d < 32; ++d) O[d] -= lam * xh[d];
            }
            __syncthreads();
            float ss = 0.f;
#pragma unroll
            for (int d = 0; d < 32; ++d) ss += O[d] * O[d];
            if (m == 0) xh[0] = ss;
            __syncthreads();
            if (m == 0) {
                const float tot = xch[(0 * 64 + qi) * 33] + xch[(1 * 64 + qi) * 33] + xch[(2 * 64 + qi) * 33] + xch[(3 * 64 + qi) * 33];
                const float rr = rsqrtf(tot * (1.f / 128.f) + EPS_) * 0.8f;
                bf16_t* dst = B.mix + (size_t)r * 1024 + head * 128 + qt * 32;
                const float* g = p.in[I_SUBLN] + qt * 32;
#pragma unroll
                for (int d = 0; d < 32; d += 2) *(u32*)(dst + d) = (u32)f2bf(O[d] * rr * g[d]) | ((u32)f2bf(O[d + 1] * rr * g[d + 1]) << 16);
            }
            __syncthreads();
        } else {
            const int idx = (item - 1040) * NT + tid, h = idx / R_, r = idx % R_;
            const bf16_t* q = B.qkv + O_QB + ((size_t)h * R_ + r) * 64;
            const bf16_t* Kb = B.qkv + O_KB + (size_t)h * R_ * 64;
            const bf16_t* VT = B.qkv + O_VBT + (size_t)h * 64 * R_;
            float qf[64];
#pragma unroll
            for (int i = 0; i < 8; ++i) { float a[8]; unpack8(*(const u32x4*)(q + i * 8), a);
#pragma unroll
                for (int j = 0; j < 8; ++j) qf[i * 8 + j] = a[j] * 0.125f; }
            float O[64];
#pragma unroll
            for (int d = 0; d < 64; ++d) O[d] = 0.f;
            float m = -1e30f, l = 0.f;
            const int t = r - 256, row = t >> 6, col = t & 63;
            const int rs = min(max(row - 4, 0), 248), cs = min(max(col - 8, 0), 48);
            const int nkeys = r < 256 ? 256 : 384;
            for (int kk = 0; kk < nkeys; ++kk) {
                int key; float bias = 0.f;
                if (kk < 256) key = kk;
                else { const int w = kk - 256, kr = rs + (w >> 4), kc = cs + (w & 15); key = 256 + kr * 64 + kc; bias = p.in[I_RPB][(h * 15 + (kr - row + 7)) * 31 + (kc - col + 15)]; }
                const bf16_t* krow = Kb + (size_t)key * 64; float s = bias;
#pragma unroll
                for (int i = 0; i < 8; ++i) { float a[8]; unpack8(*(const u32x4*)(krow + i * 8), a);
#pragma unroll
                    for (int j = 0; j < 8; ++j) s += a[j] * qf[i * 8 + j]; }
                const float mn = fmaxf(m, s), alpha = __expf(m - mn), pp = __expf(s - mn);
                l = l * alpha + pp; m = mn;
                const int vp = vpos(key);
#pragma unroll
                for (int d = 0; d < 64; ++d) O[d] = O[d] * alpha + pp * bf2f(VT[(size_t)d * R_ + vp]);
            }
            const float inv = 1.f / l;
            bf16_t* dst = B.mix + (size_t)r * 1024 + 512 + h * 64;
#pragma unroll
            for (int d = 0; d < 64; d += 2) *(u32*)(dst + d) = (u32)f2bf(O[d] * inv) | ((u32)f2bf(O[d + 1] * inv) << 16);
        }
    }
}

__device__ void phase_out(const Params& p, int l, int bid, int nblk) {
    Bufs B(p);
    const int tid = threadIdx.x, cc = tid & 127, rg = tid >> 7;
    const float* W = p.in[l == 0 ? I_EWOUT : I_OWOUT];
    const int rt0 = l == 0 ? 0 : 16, nrt = R_ / 16 - rt0;
    for (int item = bid; item < nrt * 8; item += nblk) {
        const int rt = rt0 + item / 8, ct = item % 8, row0 = rt * 16, col = ct * 128 + cc;
        const bf16_t* ap[4];
#pragma unroll
        for (int i = 0; i < 4; ++i) ap[i] = B.mix + (size_t)(row0 + rg * 4 + i) * 1024;
        float acc[4];
        tile_linear<4>(acc, 1024, ap, W, 1024, col);
#pragma unroll
        for (int i = 0; i < 4; ++i) {
            const int r = row0 + rg * 4 + i;
            if (r < 256) B.xc[(size_t)r * 1024 + col] = p.in[I_CTX][(size_t)r * 1024 + col] + modp(B, l, 1, 2)[col] * acc[i];
            else { const size_t o = (size_t)(r - 256) * 1024 + col; p.out[o] = (l == 0 ? p.in[I_X][o] : p.out[o]) + modp(B, l, 0, 2)[col] * acc[i]; }
        }
    }
}

__device__ void phase_up(const Params& p, int l, char* lds, int bid, int nblk) {
    Bufs B(p);
    float* tile = (float*)lds;
    const int tid = threadIdx.x, cc = tid & 127, rg = tid >> 7;
    const float* W = p.in[I_FUP] + (size_t)l * 1024 * F2_;
    const float* cw = p.in[I_FCW] + (size_t)l * 3 * F2_; const float* cb = p.in[I_FCB] + (size_t)l * F2_;
    const int rt0 = l == 0 ? 0 : 16, nrt = R_ / 16 - rt0;
    for (int item = bid; item < nrt * 44; item += nblk) {
        const int rt = rt0 + item / 44, ct = item % 44, row0 = rt * 16, c0 = ct * 64;
        const int lo = row0 < 256 ? 0 : 256, hi = row0 < 256 ? 256 : R_;
        const int wcol = cc < 64 ? c0 + cc : F_ + c0 + (cc - 64);
        const bf16_t* ap[5];
#pragma unroll
        for (int i = 0; i < 5; ++i) { const int rr = rg * 5 + i, r = row0 - 1 + rr; ap[i] = (rr < 18 && r >= lo && r < hi) ? B.h + (size_t)hrow(r) * 1024 : nullptr; }
        float acc[5];
        tile_linear<5>(acc, 1024, ap, W, F2_, wcol);
#pragma unroll
        for (int i = 0; i < 5; ++i) tile[(rg * 5 + i) * 128 + cc] = acc[i];
        __syncthreads();
        for (int e = tid; e < 16 * 64; e += NT) {
            const int rr = e >> 6, c = e & 63, ca = c0 + c, cg = F_ + c0 + c;
            const float a = cb[ca] + tile[rr * 128 + c] * cw[ca] + tile[(rr + 1) * 128 + c] * cw[F2_ + ca] + tile[(rr + 2) * 128 + c] * cw[2 * F2_ + ca];
            const float g = cb[cg] + tile[rr * 128 + 64 + c] * cw[cg] + tile[(rr + 1) * 128 + 64 + c] * cw[F2_ + cg] + tile[(rr + 2) * 128 + 64 + c] * cw[2 * F2_ + cg];
            B.act[(size_t)(row0 + rr) * F_ + ca] = f2bf(a * (g / (1.f + __expf(-g))));
        }
        __syncthreads();
    }
}

__device__ void phase_down(const Params& p, int l, int bid, int nblk) {
    Bufs B(p);
    const int tid = threadIdx.x, cc = tid & 127, rg = tid >> 7;
    const float* W = p.in[I_FDOWN] + (size_t)l * F_ * 1024;
    const int rt0 = l == 0 ? 0 : 16, nrt = R_ / 16 - rt0;
    for (int item = bid; item < nrt * 8; item += nblk) {
        const int rt = rt0 + item / 8, ct = item % 8, row0 = rt * 16, col = ct * 128 + cc;
        const bf16_t* ap[4];
#pragma unroll
        for (int i = 0; i < 4; ++i) ap[i] = B.act + (size_t)(row0 + rg * 4 + i) * F_;
        float acc[4];
        tile_linear<4>(acc, F_, ap, W, 1024, col);
#pragma unroll
        for (int i = 0; i < 4; ++i) {
            const int r = row0 + rg * 4 + i;
            if (r < 256) B.xc[(size_t)r * 1024 + col] += modp(B, l, 1, 5)[col] * acc[i];
            else p.out[(size_t)(r - 256) * 1024 + col] += modp(B, l, 0, 5)[col] * acc[i];
        }
    }
}

__device__ void phase_qkv1a(const Params& p, char* lds, int bid, int nblk) {
    Bufs B(p);
    float* tile = (float*)lds;
    const int tid = threadIdx.x, cc = tid & 127, rg = tid >> 7, wid = tid >> 6, lane = tid & 63;
    const float* W = p.in[I_OWIN];
    for (int item = bid; item < (R_ / 16) * 12; item += nblk) {
        const int rt = item / 12, ct = item % 12, row0 = rt * 16, v0 = ct * 128;
        const int v = v0 + cc;
        int wcol;
        if (v < 640) wcol = v; else if (v < 1152) wcol = 672 + (v - 640); else if (v < 1280) wcol = 1184 + (v - 1152); else if (v < 1408) wcol = 1312 + (v - 1280);
        else if (v < 1440) wcol = 640 + (v - 1408); else wcol = -1;
        const bf16_t* ap[4];
#pragma unroll
        for (int i = 0; i < 4; ++i) ap[i] = B.h + (size_t)hrow(row0 + rg * 4 + i) * 1024;
        float acc[4];
        tile_linear<4>(acc, 1024, ap, W, 1440, wcol);
#pragma unroll
        for (int i = 0; i < 4; ++i) tile[(rg * 4 + i) * 128 + cc] = acc[i];
        __syncthreads();
        if (ct < 5) {
            for (int e = tid; e < 16 * 128; e += NT) {
                const int rr = e >> 7, c = e & 127, r = row0 + rr;
                if (ct < 3) B.qkv[O_CQ + (size_t)r * 384 + v0 + c] = f2bf(tile[e]);
                else B.qkv[O_CKV + (size_t)r * 256 + (v0 - 384) + c] = f2bf(tile[e]);
            }
        } else if (ct < 10) {
            for (int q = wid * 4; q < wid * 4 + 4; ++q) {
                const int rr = q >> 1, hh = q & 1, r = row0 + rr;
                if (ct < 9) head64_norm_rope(tile + rr * 128 + hh * 64, p.in[I_DQN], r >= 256, B.rope, r - 256, B.qkv + O_GQ + ((size_t)((ct - 5) * 2 + hh) * R_ + r) * 64, lane);
                else head64_norm_rope(tile + rr * 128 + hh * 64, p.in[I_DKN], r >= 256, B.rope, r - 256, B.qkv + O_GK + ((size_t)hh * R_ + r) * 64, lane);
            }
        } else if (ct == 10) {
            for (int e = tid; e < 16 * 128; e += NT) {
                const int c = e >> 4, rr = e & 15, r = row0 + rr;
                B.qkv[O_GVT + ((size_t)(c >> 6) * 64 + (c & 63)) * R_ + vpos(r)] = f2bf(tile[rr * 128 + c]);
            }
        } else {
            for (int e = tid; e < 16 * 32; e += NT) { const int rr = e >> 5, c = e & 31; B.qkv[O_CKR + (size_t)(row0 + rr) * 32 + c] = f2bf(tile[rr * 128 + c]); }
        }
        __syncthreads();
    }
}

__device__ __forceinline__ void head96_norm_rope(const float* row, const float* g, bool rope, const float* tab, int t, bf16_t* dst, int lane) {
    const float v0 = row[lane], v1 = lane < 32 ? row[64 + lane] : 0.f;
    const float ss = wave_sum(v0 * v0 + v1 * v1);
    const float rr = rsqrtf(ss * (1.f / 96.f) + EPS_);
    dst[lane] = f2bf(v0 * rr * g[lane]);
    if (lane < 32) {
        float y = v1 * rr * g[64 + lane];
        if (rope) {
            const float yp = row[64 + (lane ^ 16)] * rr * g[64 + (lane ^ 16)];
            const float2 cs = rope32(tab, t, lane & 15);
            y = lane < 16 ? (y * cs.x - yp * cs.y) : (yp * cs.y + y * cs.x);
        }
        dst[64 + lane] = f2bf(y);
    }
}

__device__ void phase_qkv1b(const Params& p, char* lds, int bid, int nblk) {
    Bufs B(p);
    float* tile = (float*)lds;
    float* rsl = (float*)lds + 16 * 128;
    const int tid = threadIdx.x, cc = tid & 127, rg = tid >> 7, wid = tid >> 6, lane = tid & 63;
    for (int item = bid; item < (R_ / 16) * 16; item += nblk) {
        const int rt = item / 16, ht = item % 16, row0 = rt * 16;
        const bool isq = ht < 8; const int head = ht & 7;
        const int K = isq ? 384 : 256;
        const bf16_t* src = B.qkv + (isq ? O_CQ : O_CKV);
        for (int rr = wid * 2; rr < wid * 2 + 2; ++rr) {
            float ss = 0.f;
            for (int k = lane; k < K; k += 64) { const float v = bf2f(src[(size_t)(row0 + rr) * K + k]); ss += v * v; }
            ss = wave_sum(ss);
            if (lane == 0) rsl[rr] = rsqrtf(ss / (float)K + EPS_);
        }
        __syncthreads();
        const bf16_t* ap[4]; float rs[4];
#pragma unroll
        for (int i = 0; i < 4; ++i) { ap[i] = src + (size_t)(row0 + rg * 4 + i) * K; rs[i] = rsl[rg * 4 + i]; }
        float acc[4];
        if (isq) tile_linear_g<4>(acc, 384, ap, rs, p.in[I_CQAN], p.in[I_CWQB], 768, cc < 96 ? head * 96 + cc : -1);
        else tile_linear_g<4>(acc, 256, ap, rs, p.in[I_CKVAN], p.in[I_CWKVB], 1024, head * 128 + cc);
#pragma unroll
        for (int i = 0; i < 4; ++i) tile[(rg * 4 + i) * 128 + cc] = acc[i];
        __syncthreads();
        if (isq) {
            for (int rr = wid * 2; rr < wid * 2 + 2; ++rr) { const int r = row0 + rr;
                head96_norm_rope(tile + rr * 128, p.in[I_CQN], r >= 256, B.rope, r - 256, B.qkv + O_MQ + ((size_t)head * R_ + r) * 96, lane); }
        } else {
            for (int e = tid; e < 16 * 64; e += NT) { const int d = e >> 4, rr = e & 15; B.qkv[O_MVT + ((size_t)head * 64 + d) * R_ + vpos(row0 + rr)] = f2bf(tile[rr * 128 + 64 + d]); }
            __syncthreads();
            for (int e = tid; e < 16 * 32; e += NT) { const int rr = e >> 5, c = e & 31; tile[rr * 128 + 64 + c] = bf2f(B.qkv[O_CKR + (size_t)(row0 + rr) * 32 + c]); }
            __syncthreads();
            for (int rr = wid * 2; rr < wid * 2 + 2; ++rr) { const int r = row0 + rr;
                head96_norm_rope(tile + rr * 128, p.in[I_CKN], r >= 256, B.rope, r - 256, B.qkv + O_MK + ((size_t)head * R_ + r) * 96, lane); }
        }
        __syncthreads();
    }
}

__device__ void phase_attn1(const Params& p, int bid, int nblk) {
    Bufs B(p);
    const int tid = threadIdx.x;
    for (int item = bid + ((OPTA & 2) ? 512 : 0); item < ((OPTA & 8) ? 512 : 1024); item += nblk) {
        if (item < 512) {
            const int head = item / 64, half = tid >> 8, r = 256 + (item % 64) * 256 + (tid & 255);
            float O[32]; float l;
            naive_dense<96, 32>(B.qkv + O_MQ + ((size_t)head * R_ + r) * 96, B.qkv + O_MK + (size_t)head * R_ * 96, B.qkv + O_MVT + ((size_t)head * 64 + half * 32) * R_, R_, 0.10206207261596575f, O, l);
            const float inv = 1.f / l;
            bf16_t* dst = B.mix + (size_t)r * 1024 + head * 64 + half * 32;
#pragma unroll
            for (int d = 0; d < 32; d += 2) *(u32*)(dst + d) = (u32)f2bf(O[d] * inv) | ((u32)f2bf(O[d + 1] * inv) << 16);
        } else {
            const int idx = (item - 512) * NT + tid, half = idx / (8 * T_), hq = (idx / T_) & 7, t = idx % T_, r = 256 + t, kvh = hq >> 2;
            const bf16_t* q = B.qkv + O_GQ + ((size_t)hq * R_ + r) * 64;
            const bf16_t* Kb = B.qkv + O_GK + (size_t)kvh * R_ * 64;
            const bf16_t* VT = B.qkv + O_GVT + ((size_t)kvh * 64 + half * 32) * R_;
            u32x4 qp[8];
#pragma unroll
            for (int i = 0; i < 8; ++i) qp[i] = *(const u32x4*)(q + i * 8);
            float O[32];
#pragma unroll
            for (int d = 0; d < 32; ++d) O[d] = 0.f;
            float m = -1e30f, l = 0.f;
            const int j0 = max(t - 128, 0), j1 = min(t + 128, T_ - 1);
            const int nkeys = 256 + (j1 - j0 + 1);
            for (int kk = 0; kk < nkeys; ++kk) {
                const int key = kk < 256 ? kk : 256 + j0 + (kk - 256);
                const bf16_t* krow = Kb + (size_t)key * 64; float s = 0.f;
#pragma unroll
                for (int i = 0; i < 8; ++i) s += dot8p(*(const u32x4*)(krow + i * 8), qp[i].x, qp[i].y, qp[i].z, qp[i].w);
                s *= 0.125f;
                const float mn = fmaxf(m, s), alpha = __expf(m - mn), pp = __expf(s - mn);
                l = l * alpha + pp; m = mn;
                const int vp = vpos(key);
#pragma unroll
                for (int d = 0; d < 32; ++d) O[d] = O[d] * alpha + pp * bf2f(VT[(size_t)d * R_ + vp]);
            }
            { const float s = p.in[I_SINK][hq]; const float mn = fmaxf(m, s), alpha = __expf(m - mn); l = l * alpha + __expf(s - mn);
#pragma unroll
              for (int d = 0; d < 32; ++d) O[d] *= alpha; }
            const float inv = 1.f / l;
            bf16_t* dst = B.mix + (size_t)r * 1024 + 512 + hq * 64 + half * 32;
#pragma unroll
            for (int d = 0; d < 32; d += 2) *(u32*)(dst + d) = (u32)f2bf(O[d] * inv) | ((u32)f2bf(O[d + 1] * inv) << 16);
        }
    }
}

#define LAS __attribute__((address_space(3)))
typedef short bf16x8 __attribute__((ext_vector_type(8)));
typedef float f32x4 __attribute__((ext_vector_type(4)));
constexpr int LDS_STAGE = 131072, LDS_XCH = LDS_STAGE, LDS_BYTES = 147456;

__device__ __forceinline__ u32 pk2(float lo, float hi) { return (u32)f2bf(lo) | ((u32)f2bf(hi) << 16); }

namespace pg8 {
constexpr int BM = 256, BK = 64, HALF = 128, HTB = HALF * BK * 2, NXCD = 8, WGM = 8;
__host__ __device__ __forceinline__ int lds_byte(int r, int c) { const int st = (r >> 4) * 2 + (c >> 5), rr = r & 15, cc = c & 31, ob = rr * 64 + cc * 2; return st * 1024 + (ob ^ (((ob >> 9) & 1) << 5)); }
__host__ __device__ __forceinline__ void stage_rc(int b, int& R, int& C) { const int st = b / 1024, sb = b % 1024, swz = sb ^ (((sb >> 9) & 1) << 5); R = (st >> 1) * 16 + swz / 64; C = (st & 1) * 32 + (swz % 64) / 2; }
struct Unit { int pm, pn; };
struct Gemm { const bf16_t* A; const bf16_t* Bt; int K; };
struct Order {
    int nM, nN, nwg, G, c, pm0, amode;
    __device__ void init(int nM_, int nN_, int G_, int c_, int pm0_, int amode_) { nM = nM_; nN = nN_; nwg = nM * nN; G = G_; c = c_; pm0 = pm0_; amode = amode_; }
    __device__ bool next(int i, Unit& u) const {
        const long L = (long)i * G + c; if (L >= nwg) return false;
        int wgid = (int)L; { const int q = nwg / NXCD, r = nwg % NXCD, xcd = wgid % NXCD, off = wgid / NXCD; wgid = (xcd < r ? xcd * (q + 1) : r * (q + 1) + (xcd - r) * q) + off; }
        const int nig = WGM * nN, gid = wgid / nig, fm = gid * WGM, gsz = (nM - fm) < WGM ? (nM - fm) : WGM;
        u.pm = pm0 + fm + ((wgid % nig) % gsz); u.pn = (wgid % nig) / gsz; return true;
    }
    __device__ __forceinline__ int arow(int pm) const { return amode == 0 ? 256 * pm : amode == 1 ? (pm == 0 ? 1 : 2 + 256 * pm) : (pm < 2 ? 254 * pm : 257 + 254 * (pm - 2)); }
    __device__ __forceinline__ void a_ready(const Unit&) const {}
    __device__ __forceinline__ void done(const Unit&) const {}
};

template <class Epi, class Sched, bool ALIGN_EPI, bool SP2>
__device__ __forceinline__ void gemm_phase(LAS unsigned char* lds, const Gemm g, const Sched& S, const Epi& E) {
    const int tid = threadIdx.x, wid = __builtin_amdgcn_readfirstlane(tid >> 6), lane = tid & 63, wr = wid >> 2, wc = wid & 3, fr = lane & 15, fq = lane >> 4;
    int K_ = g.K; asm volatile("" : "+s"(K_));
    const int K = K_, nt = K / BK;
    unsigned voffA[2], voffB[2];
#pragma unroll
    for (int i = 0; i < 2; ++i) { int R, C; stage_rc(tid * 16 + i * 8192, R, C); voffA[i] = (unsigned)(R * K + C) * 2u; voffB[i] = (unsigned)(R * K + C) * 2u; }
    const size_t kstep = (size_t)(BK * 2);
    const size_t hstep = (size_t)HALF * K * 2;
    const size_t tstep = 2 * hstep;
    const size_t rstep = (size_t)K * 2;
    const unsigned ldsw = (unsigned)wid * 1024u;
    const int aoff = lds_byte(wr * 64 + fr, fq * 8), boff = lds_byte(wc * 32 + fr, fq * 8);
#define PG8_SA(b, h) (((b) * 2 + (h)) * HTB)
#define PG8_SB(b, h) ((4 + (b) * 2 + (h)) * HTB)
#define PG8_STAGE(bufoff, gbase, voff) do { _Pragma("unroll") for (int _i = 0; _i < 2; ++_i) \
        __builtin_amdgcn_global_load_lds((const unsigned*)((const char*)(gbase) + (voff)[_i]), (LAS unsigned*)(lds + (bufoff) + ldsw + _i * 8192), 16, 0, 0); } while (0)
#define PG8_LDA(dst, b, h) do { _Pragma("unroll") for (int m = 0; m < 4; ++m) _Pragma("unroll") for (int k = 0; k < 2; ++k) dst[m][k] = *(const LAS bf16x8*)(lds + PG8_SA(b, h) + aoff + m * 2048 + k * 1024); } while (0)
#define PG8_LDB(dst, b, h) do { _Pragma("unroll") for (int n = 0; n < 2; ++n) _Pragma("unroll") for (int k = 0; k < 2; ++k) dst[n][k] = *(const LAS bf16x8*)(lds + PG8_SB(b, h) + boff + n * 2048 + k * 1024); } while (0)
#define PG8_MMA(ai, bj, At, Bt) do { __builtin_amdgcn_s_setprio(1); _Pragma("unroll") for (int m = 0; m < 4; ++m) _Pragma("unroll") for (int n = 0; n < 2; ++n) _Pragma("unroll") for (int k = 0; k < 2; ++k) \
        acc[ai][bj][m][n] = __builtin_amdgcn_mfma_f32_16x16x32_bf16(Bt[n][k], At[m][k], acc[ai][bj][m][n], 0, 0, 0); __builtin_amdgcn_s_setprio(0); } while (0)
#define PG8_WAIT_V(n) asm volatile("s_waitcnt vmcnt(" #n ")" ::: "memory")
#define PG8_WAIT_L(n) asm volatile("s_waitcnt lgkmcnt(" #n ")" ::: "memory")
#define PG8_BAR __builtin_amdgcn_s_barrier()
#define PG8_SCHED __builtin_amdgcn_sched_barrier(0)
    Unit cur, nxt; int ui = 0;
    if (!S.next(0, cur)) return;
    f32x4 acc[2][2][4][2];
#pragma unroll
    for (int a = 0; a < 2; ++a)
#pragma unroll
        for (int b = 0; b < 2; ++b)
#pragma unroll
            for (int m = 0; m < 4; ++m)
#pragma unroll
                for (int n = 0; n < 2; ++n) acc[a][b][m][n] = (f32x4){0.f, 0.f, 0.f, 0.f};
    bf16x8 At[4][2], B0[2][2], B1[2][2];
    const char* cA = (const char*)g.A + (size_t)S.arow(cur.pm) * rstep; const char* cB = (const char*)g.Bt + (size_t)cur.pn * tstep;
    S.a_ready(cur);
    if constexpr (SP2) {
        PG8_STAGE(PG8_SB(0, 0), cB, voffB); PG8_STAGE(PG8_SB(0, 1), cB + hstep, voffB); PG8_STAGE(PG8_SA(0, 0), cA, voffA); PG8_STAGE(PG8_SA(0, 1), cA + hstep, voffA);
        if (wr == 1) PG8_BAR;
        PG8_WAIT_V(2); PG8_BAR;
        PG8_STAGE(PG8_SB(1, 0), cB + kstep, voffB); PG8_STAGE(PG8_SA(1, 0), cA + kstep, voffA); PG8_STAGE(PG8_SB(1, 1), cB + hstep + kstep, voffB);
        PG8_WAIT_V(6); PG8_BAR;
    } else {
        PG8_STAGE(PG8_SB(0, 0), cB, voffB); PG8_STAGE(PG8_SA(0, 0), cA, voffA); PG8_STAGE(PG8_SB(0, 1), cB + hstep, voffB); PG8_STAGE(PG8_SA(0, 1), cA + hstep, voffA);
        if (wr == 1) PG8_BAR;
        PG8_WAIT_V(4); PG8_BAR;
        PG8_STAGE(PG8_SB(1, 0), cB + kstep, voffB); PG8_STAGE(PG8_SA(1, 0), cA + kstep, voffA); PG8_STAGE(PG8_SB(1, 1), cB + hstep + kstep, voffB);
        PG8_WAIT_V(6); PG8_BAR;
    }
    for (;;) {
        const bool has_next = S.next(ui + 1, nxt);
        const char* nA = has_next ? (const char*)g.A + (size_t)S.arow(nxt.pm) * rstep : cA; const char* nB = has_next ? (const char*)g.Bt + (size_t)nxt.pn * tstep : cB;
        for (int t = 0; t < nt; t += 2) {
            const bool last = (t == nt - 2);
            const char* a1 = cA + (size_t)(t + 1) * kstep;
            const char* a2 = last ? nA : cA + (size_t)(t + 2) * kstep; const char* b2 = last ? nB : cB + (size_t)(t + 2) * kstep;
            const char* a3 = a2 + kstep; const char* b3 = b2 + kstep;
            if (last && has_next) S.a_ready(nxt);
            if constexpr (SP2) {
            PG8_LDB(B0, 0, 0); PG8_LDB(B1, 0, 1); PG8_SCHED; PG8_LDA(At, 0, 0); PG8_STAGE(PG8_SA(1, 1), a1 + hstep, voffA);
            PG8_WAIT_V(8); PG8_WAIT_L(0); PG8_BAR; PG8_MMA(0, 0, At, B0); PG8_MMA(0, 1, At, B1); PG8_BAR; PG8_SCHED;
            PG8_LDA(At, 0, 1); PG8_STAGE(PG8_SB(0, 0), b2, voffB); PG8_STAGE(PG8_SB(0, 1), b2 + hstep, voffB); PG8_STAGE(PG8_SA(0, 0), a2, voffA);
            PG8_WAIT_V(8); PG8_WAIT_L(0); PG8_BAR; PG8_MMA(1, 0, At, B0); PG8_MMA(1, 1, At, B1); PG8_BAR; PG8_SCHED;
            PG8_LDB(B0, 1, 0); PG8_LDB(B1, 1, 1); PG8_SCHED; PG8_LDA(At, 1, 0); PG8_STAGE(PG8_SA(0, 1), a2 + hstep, voffA);
            PG8_WAIT_V(8); PG8_WAIT_L(0); PG8_BAR; PG8_MMA(0, 0, At, B0); PG8_MMA(0, 1, At, B1); PG8_BAR; PG8_SCHED;
            PG8_LDA(At, 1, 1); PG8_STAGE(PG8_SB(1, 0), b3, voffB); PG8_STAGE(PG8_SB(1, 1), b3 + hstep, voffB); PG8_STAGE(PG8_SA(1, 0), a3, voffA);
            PG8_WAIT_V(8); PG8_WAIT_L(0); PG8_BAR; PG8_MMA(1, 0, At, B0); PG8_MMA(1, 1, At, B1); PG8_BAR; PG8_SCHED;
            } else {
            PG8_LDB(B0, 0, 0); PG8_SCHED; PG8_LDA(At, 0, 0); PG8_STAGE(PG8_SA(1, 1), a1 + hstep, voffA);
            PG8_WAIT_L(8); PG8_BAR; PG8_WAIT_L(0); PG8_MMA(0, 0, At, B0); PG8_BAR; PG8_SCHED;
            PG8_LDB(B1, 0, 1); PG8_STAGE(PG8_SB(0, 0), b2, voffB);
            PG8_BAR; PG8_WAIT_L(0); PG8_MMA(0, 1, At, B1); PG8_BAR;
            PG8_LDA(At, 0, 1); PG8_STAGE(PG8_SA(0, 0), a2, voffA);
            PG8_BAR; PG8_WAIT_L(0); PG8_MMA(1, 0, At, B0); PG8_BAR; PG8_SCHED;
            PG8_STAGE(PG8_SB(0, 1), b2 + hstep, voffB);
            PG8_WAIT_V(6); PG8_BAR; PG8_MMA(1, 1, At, B1); PG8_BAR;
            PG8_LDB(B0, 1, 0); PG8_SCHED; PG8_LDA(At, 1, 0); PG8_STAGE(PG8_SA(0, 1), a2 + hstep, voffA);
            PG8_WAIT_L(8); PG8_BAR; PG8_WAIT_L(0); PG8_MMA(0, 0, At, B0); PG8_BAR; PG8_SCHED;
            PG8_LDB(B1, 1, 1); PG8_STAGE(PG8_SB(1, 0), b3, voffB);
            PG8_BAR; PG8_WAIT_L(0); PG8_MMA(0, 1, At, B1); PG8_BAR;
            PG8_LDA(At, 1, 1); PG8_STAGE(PG8_SA(1, 0), a3, voffA);
            PG8_BAR; PG8_WAIT_L(0); PG8_MMA(1, 0, At, B0); PG8_BAR; PG8_SCHED;
            PG8_STAGE(PG8_SB(1, 1), b3 + hstep, voffB);
            PG8_WAIT_V(6); PG8_BAR; PG8_MMA(1, 1, At, B1); PG8_BAR;
            }
        }
        if constexpr (ALIGN_EPI) { if (wr == 0) PG8_BAR; }
        E(acc, cur, wr, wc, fr, fq); S.done(cur);
        if (!has_next) break;
#pragma unroll
        for (int a = 0; a < 2; ++a)
#pragma unroll
            for (int b = 0; b < 2; ++b)
#pragma unroll
                for (int m = 0; m < 4; ++m)
#pragma unroll
                    for (int n = 0; n < 2; ++n) acc[a][b][m][n] = (f32x4){0.f, 0.f, 0.f, 0.f};
        cur = nxt; cA = nA; cB = nB; ++ui;
        if constexpr (ALIGN_EPI) { if (wr == 1) PG8_BAR; }
    }
    PG8_WAIT_V(0);
    if constexpr (!ALIGN_EPI) { if (wr == 0) PG8_BAR; }
    PG8_BAR;
#undef PG8_SA
#undef PG8_SB
#undef PG8_STAGE
#undef PG8_LDA
#undef PG8_LDB
#undef PG8_MMA
#undef PG8_WAIT_V
#undef PG8_WAIT_L
#undef PG8_BAR
#undef PG8_SCHED
}
}

typedef f32x4 AccT[2][2][4][2];
__device__ __forceinline__ const float* launder(const float* p) { asm volatile("" : "+s"(p)); return p; }
#define EPI_IDS() int t_ = threadIdx.x; asm volatile("" : "+v"(t_)); const int fr = t_ & 15, fq = (t_ >> 4) & 3; const int wid_ = __builtin_amdgcn_readfirstlane(t_ >> 6), wr = wid_ >> 2, wc = wid_ & 3; (void)wr; (void)wc; (void)fr; (void)fq
#define ITER_FENCE() do { asm volatile("" ::: "memory"); __builtin_amdgcn_sched_barrier(0); } while (0)
#define EPI_BARRIER() do { asm volatile("s_waitcnt lgkmcnt(0)" ::: "memory"); __builtin_amdgcn_s_barrier(); asm volatile("" ::: "memory"); } while (0)

__device__ __forceinline__ int vcol_of_row(int J) { const int pn = J >> 8, j = J & 255, bj = j >> 7, wc = (j >> 5) & 3, n = (j >> 4) & 1, fq = (j >> 2) & 3, e = j & 3; return 256 * pn + 64 * wc + 32 * bj + 8 * fq + 4 * n + e; }
__device__ __forceinline__ int gmap(int map, int v) {
    if (map == 0) return v;
    if (map == 1) { const int pn = v >> 8, wc = (v >> 6) & 3, bj = (v >> 5) & 1, x = v & 31, h = 128 * pn + 32 * wc + x; return bj ? F_ + h : h; }
    if (map == 2) { if (v < 384) return v; if (v < 512) return 1184 + (v - 384); if (v < 768) return 384 + (v - 512); if (v < 1280) return 672 + (v - 768);
                    if (v < 1408) return 1312 + (v - 1280); if (v < 1440) return 640 + (v - 1408); return -1; }
    { const int hh = v >> 7, y = v & 127; if (y < 64) return hh * 96 + y; const int x = y - 64; if (x >= 32) return -1; const int fq = x >> 3, n = (x >> 2) & 1, e = x & 3; return hh * 96 + 64 + 16 * n + 4 * fq + e; }
}
__device__ __forceinline__ void prep_item(const float* __restrict__ W, int K, int ldw, bf16_t* Bt, int NV, int map, const float* kscale, float* scr, int item, int lane) {
    const int nb32 = NV / 32, kb = item / nb32, nb = item % nb32, k0 = 64 * kb, J0 = 32 * nb;
    const int col = gmap(map, vcol_of_row(J0 + (lane & 31)));
#pragma unroll 8
    for (int i = 0; i < 32; ++i) { const int kk = 2 * i + (lane >> 5); float v = col >= 0 ? W[(size_t)(k0 + kk) * ldw + col] : 0.f; if (kscale) v *= kscale[k0 + kk]; scr[kk * 33 + (lane & 31)] = v; }
    __builtin_amdgcn_wave_barrier();
    asm volatile("s_waitcnt lgkmcnt(0)" ::: "memory");
    const int c = lane & 7;
#pragma unroll
    for (int j = 0; j < 4; ++j) { const int n = (lane >> 3) + 8 * j; const float* s = scr + (8 * c) * 33 + n;
        u32x4 o; o.x = pk2(s[0 * 33], s[1 * 33]); o.y = pk2(s[2 * 33], s[3 * 33]); o.z = pk2(s[4 * 33], s[5 * 33]); o.w = pk2(s[6 * 33], s[7 * 33]);
        *(u32x4*)(Bt + (size_t)(J0 + n) * K + k0 + 8 * c) = o; }
    asm volatile("s_waitcnt lgkmcnt(0)" ::: "memory");
    __builtin_amdgcn_wave_barrier();
}
__device__ void phase_prep_weights(const Params& p, char* lds, int bid, int nblk) {
    Bufs B(p);
    const int wid = threadIdx.x >> 6, lane = threadIdx.x & 63;
    float* scr = (float*)lds + wid * (64 * 33 + 16);
    constexpr int I0 = 16 * 96, I1 = 16 * 32, I2 = 16 * 176, I3 = 44 * 32, I4 = 16 * 48, I5 = 16 * 32, I6 = 6 * 32, I7 = 4 * 32;
    constexpr int NIT = I0 + I1 + 2 * I2 + 2 * I3 + I4 + I5 + I6 + I7;
    for (int it = bid * 8 + wid; it < NIT; it += nblk * 8) {
        int r = it;
        if (r < I0) { prep_item(p.in[I_EWIN], 1024, 3072, B.wt + W_EIN, 3072, 0, nullptr, scr, r, lane); continue; } r -= I0;
        if (r < I1) { prep_item(p.in[I_EWOUT], 1024, 1024, B.wt + W_EOUT, 1024, 0, nullptr, scr, r, lane); continue; } r -= I1;
        if (r < 2 * I2) { const int l = r / I2; prep_item(p.in[I_FUP] + (size_t)l * 1024 * F2_, 1024, F2_, B.wt + W_UP + (size_t)l * F2_ * 1024, F2_, 1, nullptr, scr, r % I2, lane); continue; } r -= 2 * I2;
        if (r < 2 * I3) { const int l = r / I3; prep_item(p.in[I_FDOWN] + (size_t)l * F_ * 1024, F_, 1024, B.wt + W_DOWN + (size_t)l * 1024 * F_, 1024, 0, nullptr, scr, r % I3, lane); continue; } r -= 2 * I3;
        if (r < I4) { prep_item(p.in[I_OWIN], 1024, 1440, B.wt + W_OIN, 1536, 2, nullptr, scr, r, lane); continue; } r -= I4;
        if (r < I5) { prep_item(p.in[I_OWOUT], 1024, 1024, B.wt + W_OOUT, 1024, 0, nullptr, scr, r, lane); continue; } r -= I5;
        if (r < I6) { prep_item(p.in[I_CWQB], 384, 768, B.wt + W_QB, 1024, 3, p.in[I_CQAN], scr, r, lane); continue; } r -= I6;
        prep_item(p.in[I_CWKVB], 256, 1024, B.wt + W_KVB, 1024, 0, p.in[I_CKVAN], scr, r, lane);
    }
}

__device__ __forceinline__ void head64_epi(const AccT& acc, int ai, int m, const float (&gn)[2][2][4], bool rope, const float* tab, int t, int fq, bf16_t* dst) {
    float ss = 0.f;
#pragma unroll
    for (int bj = 0; bj < 2; ++bj)
#pragma unroll
        for (int n = 0; n < 2; ++n)
#pragma unroll
            for (int e = 0; e < 4; ++e) { const float v = acc[ai][bj][m][n][e]; ss += v * v; }
    ss += __shfl_xor(ss, 16); ss += __shfl_xor(ss, 32);
    const float rr = rsqrtf(ss * (1.f / 64.f) + EPS_);
    float y[2][2][4];
#pragma unroll
    for (int bj = 0; bj < 2; ++bj)
#pragma unroll
        for (int n = 0; n < 2; ++n)
#pragma unroll
            for (int e = 0; e < 4; ++e) y[bj][n][e] = acc[ai][bj][m][n][e] * rr * gn[bj][n][e];
    if (rope) {
        const int pos = fq < 2 ? (t >> 6) : (t & 63);
        const float4* cs = (const float4*)(tab + (pos * 16 + 8 * (fq & 1)) * 2);
#pragma unroll
        for (int n = 0; n < 2; ++n) {
            const float4 c0 = cs[2 * n], c1 = cs[2 * n + 1];
            const float cv[4] = {c0.x, c0.z, c1.x, c1.z}, sv[4] = {c0.y, c0.w, c1.y, c1.w};
#pragma unroll
            for (int e = 0; e < 4; ++e) { const float x1 = y[0][n][e], x2 = y[1][n][e]; y[0][n][e] = x1 * cv[e] - x2 * sv[e]; y[1][n][e] = x1 * sv[e] + x2 * cv[e]; }
        }
    }
#pragma unroll
    for (int bj = 0; bj < 2; ++bj) {
        u32x4 w; w.x = pk2(y[bj][0][0], y[bj][0][1]); w.y = pk2(y[bj][0][2], y[bj][0][3]); w.z = pk2(y[bj][1][0], y[bj][1][1]); w.w = pk2(y[bj][1][2], y[bj][1][3]);
        *(u32x4*)(dst + 32 * bj + 8 * fq) = w;
    }
}
__device__ __forceinline__ void load_gain64(float (&gn)[2][2][4], const float* g, int fq) {
#pragma unroll
    for (int bj = 0; bj < 2; ++bj)
#pragma unroll
        for (int n = 0; n < 2; ++n) { const float4 t = *(const float4*)(g + 32 * bj + 8 * fq + 4 * n); gn[bj][n][0] = t.x; gn[bj][n][1] = t.y; gn[bj][n][2] = t.z; gn[bj][n][3] = t.w; }
}
__device__ __forceinline__ void vt_store(const AccT& acc, int ai, int m, float scale, bf16_t* vt, int fq, int r) {
    const int pos = vpos(r);
#pragma unroll
    for (int bj = 0; bj < 2; ++bj)
#pragma unroll
        for (int n = 0; n < 2; ++n)
#pragma unroll
            for (int e = 0; e < 4; ++e) vt[(size_t)(32 * bj + 8 * fq + 4 * n + e) * R_ + pos] = f2bf(acc[ai][bj][m][n][e] * scale);
}
__device__ __forceinline__ float raw_store(const AccT& acc, int ai, int m, bf16_t* dst, int fq) {
    float ss = 0.f;
#pragma unroll
    for (int bj = 0; bj < 2; ++bj) {
        u32x4 w; const f32x4 a = acc[ai][bj][m][0], b = acc[ai][bj][m][1];
        w.x = pk2(a[0], a[1]); w.y = pk2(a[2], a[3]); w.z = pk2(b[0], b[1]); w.w = pk2(b[2], b[3]);
        *(u32x4*)(dst + 32 * bj + 8 * fq) = w;
        float t[8]; unpack8(w, t);
#pragma unroll
        for (int j = 0; j < 8; ++j) ss += t[j] * t[j];
    }
    return ss;
}

struct EpiQKV0 {
    bf16_t* qkv; const float* rope; const float* gt;
    __device__ __forceinline__ void operator()(const AccT& acc, const pg8::Unit& u, int, int, int, int) const {
        EPI_IDS();
        const int seg = u.pn >> 1, r0 = u.pm * 256 + wr * 64 + fr;
        if (seg == 2 || seg == 5) {
            const size_t vo = seg == 2 ? O_VAT + ((size_t)((u.pn & 1) * 2 + (wc >> 1)) * 128 + 64 * (wc & 1)) * R_ : O_VBT + (size_t)((u.pn & 1) * 4 + wc) * 64 * R_;
            bf16_t* vt = qkv + vo;
#pragma unroll
            for (int ai = 0; ai < 2; ++ai)
#pragma unroll
                for (int m = 0; m < 4; ++m) { vt_store(acc, ai, m, 1.f, vt, fq, r0 + 128 * ai + 16 * m); ITER_FENCE(); }
        } else {
            float gn[2][2][4]; load_gain64(gn, gt + 64 * (seg < 2 ? seg : seg - 1), fq);
            const int head = (u.pn & 1) * 4 + wc;
            const size_t bo = (seg == 0 ? O_QA : seg == 1 ? O_KA : seg == 3 ? O_QB : O_KB) + (size_t)head * R_ * 64;
            bf16_t* base = qkv + bo;
            const bool rp = seg < 2 && u.pm > 0;
#pragma unroll
            for (int ai = 0; ai < 2; ++ai)
#pragma unroll
                for (int m = 0; m < 4; ++m) { const int r = r0 + 128 * ai + 16 * m; head64_epi(acc, ai, m, gn, rp, rope, r - 256, fq, base + (size_t)r * 64); ITER_FENCE(); }
        }
    }
};

struct EpiResid {
    const float* resid_lat; float* dst_lat; const float* resid_ctx; float* dst_ctx; const float* gate_lat; const float* gate_ctx;
    __device__ __forceinline__ void rows(const AccT& acc, const float* __restrict__ resid, float* dst, const float* __restrict__ gate, int row0, int col0) const {
        f32x4 gt[2][2];
#pragma unroll
        for (int bj = 0; bj < 2; ++bj)
#pragma unroll
            for (int n = 0; n < 2; ++n) gt[bj][n] = *(const f32x4*)(gate + col0 + 32 * bj + 4 * n);
#pragma unroll
        for (int ai = 0; ai < 2; ++ai)
#pragma unroll
            for (int m = 0; m < 4; ++m) {
                const size_t ro = (size_t)(row0 + 128 * ai + 16 * m) * 1024 + col0;
#pragma unroll
                for (int bj = 0; bj < 2; ++bj)
#pragma unroll
                    for (int n = 0; n < 2; ++n) { const f32x4 x = *(const f32x4*)(resid + ro + 32 * bj + 4 * n); *(f32x4*)(dst + ro + 32 * bj + 4 * n) = x + gt[bj][n] * acc[ai][bj][m][n]; }
                ITER_FENCE();
            }
    }
    __device__ __forceinline__ void operator()(const AccT& acc, const pg8::Unit& u, int, int, int, int) const {
        EPI_IDS();
        const int col0 = u.pn * 256 + wc * 64 + 8 * fq, rl = 64 * wr + fr;
        if (u.pm == 0) rows(acc, resid_ctx, dst_ctx, gate_ctx, rl, col0);
        else rows(acc, resid_lat, dst_lat, gate_lat, (u.pm - 1) * 256 + rl, col0);
    }
};

#ifndef USE_DPP
#define USE_DPP 0
#endif
__device__ __forceinline__ float rot_prev(float x, int lane) {
#if USE_DPP
    return __builtin_bit_cast(float, __builtin_amdgcn_update_dpp(0, __builtin_bit_cast(int, x), 0x121, 0xf, 0xf, false));
#else
    return __shfl(x, (lane & 48) | ((lane - 1) & 15));
#endif
}
__device__ __forceinline__ float rot_next(float x, int lane) {
#if USE_DPP
    return __builtin_bit_cast(float, __builtin_amdgcn_update_dpp(0, __builtin_bit_cast(int, x), 0x12F, 0xf, 0xf, false));
#else
    return __shfl(x, (lane & 48) | ((lane + 1) & 15));
#endif
}
struct EpiUp {
    bf16_t* act; const float* cw; const float* cb; LAS float* xch;
    __device__ __forceinline__ int xidx(int c, int which, int wc, int fq, int bj, int n) const { return (((c * 2 + which) * 4 + wc) * 64) + fq * 16 + bj * 8 + n * 4; }
    __device__ __forceinline__ void operator()(const AccT& acc, const pg8::Unit& u, int, int, int, int) const {
        EPI_IDS();
        const int lane = fq * 16 + fr;
        if (fr == 0) {
#pragma unroll
            for (int ai = 0; ai < 2; ++ai)
#pragma unroll
                for (int bj = 0; bj < 2; ++bj)
#pragma unroll
                    for (int n = 0; n < 2; ++n) *(LAS f32x4*)(xch + xidx(2 * ai + wr, 0, wc, fq, bj, n)) = acc[ai][bj][0][n];
        }
        if (fr == 15) {
#pragma unroll
            for (int ai = 0; ai < 2; ++ai)
#pragma unroll
                for (int bj = 0; bj < 2; ++bj)
#pragma unroll
                    for (int n = 0; n < 2; ++n) *(LAS f32x4*)(xch + xidx(2 * ai + wr, 1, wc, fq, bj, n)) = acc[ai][bj][3][n];
        }
        EPI_BARRIER();
        const bool isctx = u.pm < 2;
        const int seq0 = isctx ? 254 * u.pm : 254 * (u.pm - 2), lim = isctx ? 256 : T_, rbase = isctx ? 0 : 256;
#pragma unroll
        for (int n = 0; n < 2; ++n) {
            const int h0 = 128 * u.pn + 32 * wc + 8 * fq + 4 * n;
            f32x4 w0[2], w1[2], w2[2], bb[2];
#pragma unroll
            for (int bj = 0; bj < 2; ++bj) { const int c = bj * F_ + h0; w0[bj] = *(const f32x4*)(cw + c); w1[bj] = *(const f32x4*)(cw + F2_ + c); w2[bj] = *(const f32x4*)(cw + 2 * F2_ + c); bb[bj] = *(const f32x4*)(cb + c); }
#pragma unroll
            for (int ai = 0; ai < 2; ++ai) {
                const int c = 2 * ai + wr;
                f32x4 eup[2], edn[2];
#pragma unroll
                for (int bj = 0; bj < 2; ++bj) {
                    eup[bj] = c > 0 ? *(const LAS f32x4*)(xch + xidx(c - 1, 1, wc, fq, bj, n)) : (f32x4){0.f, 0.f, 0.f, 0.f};
                    edn[bj] = c < 3 ? *(const LAS f32x4*)(xch + xidx(c + 1, 0, wc, fq, bj, n)) : (f32x4){0.f, 0.f, 0.f, 0.f};
                }
#pragma unroll
                for (int m = 0; m < 4; ++m) {
                    f32x4 cv[2];
#pragma unroll
                    for (int bj = 0; bj < 2; ++bj) {
                        const f32x4 x = acc[ai][bj][m][n];
                        f32x4 up, dn;
#pragma unroll
                        for (int e = 0; e < 4; ++e) {
                            const float ps = rot_prev(x[e], lane), ns = rot_next(x[e], lane);
                            float pe, ne;
                            if (m > 0) pe = rot_prev(acc[ai][bj][m > 0 ? m - 1 : 0][n][e], lane); else pe = eup[bj][e];
                            if (m < 3) ne = rot_next(acc[ai][bj][m < 3 ? m + 1 : 3][n][e], lane); else ne = edn[bj][e];
                            up[e] = fr == 0 ? pe : ps; dn[e] = fr == 15 ? ne : ns;
                        }
                        cv[bj] = bb[bj] + w0[bj] * up + w1[bj] * x + w2[bj] * dn;
                    }
                    const int j = 128 * ai + 64 * wr + 16 * m + fr, sr = seq0 + j - 1;
                    if (j >= 1 && j <= 254 && sr < lim) {
                        float o[4];
#pragma unroll
                        for (int e = 0; e < 4; ++e) { const float gg = cv[1][e]; o[e] = cv[0][e] * (gg / (1.f + __expf(-gg))); }
                        *(uint2*)(act + (size_t)(rbase + sr) * F_ + h0) = make_uint2(pk2(o[0], o[1]), pk2(o[2], o[3]));
                    }
                    ITER_FENCE();
                }
            }
        }
    }
};

struct EpiQKV1A {
    bf16_t* qkv; float* part; const float* rope; const float* gt;
    __device__ __forceinline__ void operator()(const AccT& acc, const pg8::Unit& u, int, int, int, int) const {
        EPI_IDS();
        const int r0 = u.pm * 256 + wr * 64 + fr, pn = u.pn;
        const bool rp = u.pm > 0;
        if (pn == 0 || (pn == 1 && wc < 2) || pn == 2) {
            const int chunk = pn == 0 ? wc : pn == 1 ? 4 + wc : wc;
            const size_t bo = pn == 2 ? O_CKV + 64 * wc : O_CQ + 64 * chunk;
            bf16_t* base = qkv + bo;
            const int ld = pn == 2 ? 256 : 384;
            float* pp = part + (pn == 2 ? 8 : 0) + chunk;
#pragma unroll
            for (int ai = 0; ai < 2; ++ai)
#pragma unroll
                for (int m = 0; m < 4; ++m) {
                    const int r = r0 + 128 * ai + 16 * m;
                    float ss = raw_store(acc, ai, m, base + (size_t)r * ld, fq);
                    ss += __shfl_xor(ss, 16); ss += __shfl_xor(ss, 32);
                    if (fq == 0) pp[(size_t)r * 12] = ss;
                    ITER_FENCE();
                }
        } else if (pn == 1 || pn == 3 || pn == 4) {
            const bool isk = pn == 1;
            float gn[2][2][4]; load_gain64(gn, gt + (isk ? 320 : 256), fq);
            const size_t bo = isk ? O_GK + (size_t)(wc - 2) * R_ * 64 : O_GQ + (size_t)(4 * (pn - 3) + wc) * R_ * 64;
            bf16_t* base = qkv + bo;
#pragma unroll
            for (int ai = 0; ai < 2; ++ai)
#pragma unroll
                for (int m = 0; m < 4; ++m) { const int r = r0 + 128 * ai + 16 * m; head64_epi(acc, ai, m, gn, rp, rope, r - 256, fq, base + (size_t)r * 64); ITER_FENCE(); }
        } else {
            if (wc < 2) {
                bf16_t* vt = qkv + O_GVT + (size_t)wc * 64 * R_;
#pragma unroll
                for (int ai = 0; ai < 2; ++ai)
#pragma unroll
                    for (int m = 0; m < 4; ++m) { vt_store(acc, ai, m, 1.f, vt, fq, r0 + 128 * ai + 16 * m); ITER_FENCE(); }
            } else if (wc == 2) {
#pragma unroll
                for (int ai = 0; ai < 2; ++ai)
#pragma unroll
                    for (int m = 0; m < 4; ++m) {
                        const int r = r0 + 128 * ai + 16 * m; const f32x4 a = acc[ai][0][m][0], b = acc[ai][0][m][1];
                        u32x4 w; w.x = pk2(a[0], a[1]); w.y = pk2(a[2], a[3]); w.z = pk2(b[0], b[1]); w.w = pk2(b[2], b[3]);
                        *(u32x4*)(qkv + O_CKR + (size_t)r * 32 + 8 * fq) = w;
                    }
            }
        }
    }
};

struct EpiQB {
    bf16_t* qkv; const float* part; const float* rope; const float* gq; LAS float* xch;
    __device__ __forceinline__ void operator()(const AccT& acc, const pg8::Unit& u, int, int, int, int) const {
        EPI_IDS();
        const int wid = wr * 4 + wc, head = 2 * u.pn + (wc >> 1), role = wc & 1, r0 = u.pm * 256 + wr * 64 + fr;
        const bool rp = u.pm > 0;
        float ssp[2][4];
#pragma unroll
        for (int ai = 0; ai < 2; ++ai)
#pragma unroll
            for (int m = 0; m < 4; ++m) {
                float ss = 0.f;
#pragma unroll
                for (int bj = 0; bj < 2; ++bj)
#pragma unroll
                    for (int n = 0; n < 2; ++n)
#pragma unroll
                        for (int e = 0; e < 4; ++e) { const float v = acc[ai][bj][m][n][e]; ss += v * v; }
                ss += __shfl_xor(ss, 16); ss += __shfl_xor(ss, 32);
                ssp[ai][m] = ss;
                if (fq == 0) xch[wid * 128 + ai * 64 + m * 16 + fr] = ss;
            }
        EPI_BARRIER();
        float g0[2][2][4];
        const float* gql = launder(gq);
        if (role == 0) load_gain64(g0, gql, fq);
        else {
#pragma unroll
            for (int n = 0; n < 2; ++n) { const float4 t = *(const float4*)(gql + 64 + 16 * n + 4 * fq); g0[0][n][0] = t.x; g0[0][n][1] = t.y; g0[0][n][2] = t.z; g0[0][n][3] = t.w; }
        }
#pragma unroll
        for (int ai = 0; ai < 2; ++ai)
#pragma unroll
            for (int m = 0; m < 4; ++m) {
                const int r = r0 + 128 * ai + 16 * m;
                const float so = xch[(wid ^ 1) * 128 + ai * 64 + m * 16 + fr];
                const float* pp = part + (size_t)r * 12;
                const float rq = rsqrtf((pp[0] + pp[1] + pp[2] + pp[3] + pp[4] + pp[5]) * (1.f / 384.f) + EPS_);
                const float sc = rq * rsqrtf(rq * rq * (ssp[ai][m] + so) * (1.f / 96.f) + EPS_);
                bf16_t* dst = qkv + O_MQ + ((size_t)head * R_ + r) * 96;
                if (role == 0) {
#pragma unroll
                    for (int bj = 0; bj < 2; ++bj) {
                        const f32x4 a = acc[ai][bj][m][0], b = acc[ai][bj][m][1];
                        u32x4 w; w.x = pk2(a[0] * sc * g0[bj][0][0], a[1] * sc * g0[bj][0][1]); w.y = pk2(a[2] * sc * g0[bj][0][2], a[3] * sc * g0[bj][0][3]);
                        w.z = pk2(b[0] * sc * g0[bj][1][0], b[1] * sc * g0[bj][1][1]); w.w = pk2(b[2] * sc * g0[bj][1][2], b[3] * sc * g0[bj][1][3]);
                        *(u32x4*)(dst + 32 * bj + 8 * fq) = w;
                    }
                } else {
                    float y1[4], y2[4];
#pragma unroll
                    for (int e = 0; e < 4; ++e) { y1[e] = acc[ai][0][m][0][e] * sc * g0[0][0][e]; y2[e] = acc[ai][0][m][1][e] * sc * g0[0][1][e]; }
                    if (rp) {
                        const int t = r - 256, pos = fq < 2 ? (t >> 6) : (t & 63);
                        const float* tb = rope + (pos * 16 + 8 * (fq & 1)) * 2;
#pragma unroll
                        for (int e = 0; e < 4; ++e) { const float2 cs = *(const float2*)(tb + 4 * e); const float a = y1[e], b = y2[e]; y1[e] = a * cs.x - b * cs.y; y2[e] = a * cs.y + b * cs.x; }
                    }
                    *(uint2*)(dst + 64 + 4 * fq) = make_uint2(pk2(y1[0], y1[1]), pk2(y1[2], y1[3]));
                    *(uint2*)(dst + 80 + 4 * fq) = make_uint2(pk2(y2[0], y2[1]), pk2(y2[2], y2[3]));
                }
                ITER_FENCE();
            }
        EPI_BARRIER();
    }
};

struct EpiKVB {
    bf16_t* qkv; const float* part; const float* rope; const float* gk;
    __device__ __forceinline__ void operator()(const AccT& acc, const pg8::Unit& u, int, int, int, int) const {
        EPI_IDS();
        const int head = 2 * u.pn + (wc >> 1), role = wc & 1, r0 = u.pm * 256 + wr * 64 + fr;
        const bool rp = u.pm > 0;
        if (role == 1) {
            bf16_t* vt = qkv + O_MVT + (size_t)head * 64 * R_;
#pragma unroll
            for (int ai = 0; ai < 2; ++ai)
#pragma unroll
                for (int m = 0; m < 4; ++m) {
                    const int r = r0 + 128 * ai + 16 * m; const float* pp = part + (size_t)r * 12 + 8;
                    const float rk = rsqrtf((pp[0] + pp[1] + pp[2] + pp[3]) * (1.f / 256.f) + EPS_);
                    vt_store(acc, ai, m, rk, vt, fq, r);
                    ITER_FENCE();
                }
        } else {
            const float* gkl = launder(gk);
            float gn[2][2][4]; load_gain64(gn, gkl, fq);
            float gr[2][4];
#pragma unroll
            for (int n = 0; n < 2; ++n) { const float4 t = *(const float4*)(gkl + 64 + 16 * n + 4 * fq); gr[n][0] = t.x; gr[n][1] = t.y; gr[n][2] = t.z; gr[n][3] = t.w; }
#pragma unroll
            for (int ai = 0; ai < 2; ++ai)
#pragma unroll
                for (int m = 0; m < 4; ++m) {
                    const int r = r0 + 128 * ai + 16 * m; const float* pp = part + (size_t)r * 12 + 8;
                    const float rk = rsqrtf((pp[0] + pp[1] + pp[2] + pp[3]) * (1.f / 256.f) + EPS_);
                    const uint2 c1 = *(const uint2*)(qkv + O_CKR + (size_t)r * 32 + 4 * fq), c2 = *(const uint2*)(qkv + O_CKR + (size_t)r * 32 + 16 + 4 * fq);
                    float y1[4] = {__uint_as_float(c1.x << 16), __uint_as_float(c1.x & 0xffff0000u), __uint_as_float(c1.y << 16), __uint_as_float(c1.y & 0xffff0000u)};
                    float y2[4] = {__uint_as_float(c2.x << 16), __uint_as_float(c2.x & 0xffff0000u), __uint_as_float(c2.y << 16), __uint_as_float(c2.y & 0xffff0000u)};
                    float ss = 0.f;
#pragma unroll
                    for (int bj = 0; bj < 2; ++bj)
#pragma unroll
                        for (int n = 0; n < 2; ++n)
#pragma unroll
                            for (int e = 0; e < 4; ++e) { const float v = acc[ai][bj][m][n][e] * rk; ss += v * v; }
#pragma unroll
                    for (int e = 0; e < 4; ++e) ss += y1[e] * y1[e] + y2[e] * y2[e];
                    ss += __shfl_xor(ss, 16); ss += __shfl_xor(ss, 32);
                    const float rr = rsqrtf(ss * (1.f / 96.f) + EPS_), sc = rk * rr;
                    bf16_t* dst = qkv + O_MK + ((size_t)head * R_ + r) * 96;
#pragma unroll
                    for (int bj = 0; bj < 2; ++bj) {
                        const f32x4 a = acc[ai][bj][m][0], b = acc[ai][bj][m][1];
                        u32x4 w; w.x = pk2(a[0] * sc * gn[bj][0][0], a[1] * sc * gn[bj][0][1]); w.y = pk2(a[2] * sc * gn[bj][0][2], a[3] * sc * gn[bj][0][3]);
                        w.z = pk2(b[0] * sc * gn[bj][1][0], b[1] * sc * gn[bj][1][1]); w.w = pk2(b[2] * sc * gn[bj][1][2], b[3] * sc * gn[bj][1][3]);
                        *(u32x4*)(dst + 32 * bj + 8 * fq) = w;
                    }
#pragma unroll
                    for (int e = 0; e < 4; ++e) { y1[e] *= rr * gr[0][e]; y2[e] *= rr * gr[1][e]; }
                    if (rp) {
                        const int t = r - 256, pos = fq < 2 ? (t >> 6) : (t & 63);
                        const float* tb = rope + (pos * 16 + 8 * (fq & 1)) * 2;
#pragma unroll
                        for (int e = 0; e < 4; ++e) { const float2 cs = *(const float2*)(tb + 4 * e); const float a = y1[e], b = y2[e]; y1[e] = a * cs.x - b * cs.y; y2[e] = a * cs.y + b * cs.x; }
                    }
                    *(uint2*)(dst + 64 + 4 * fq) = make_uint2(pk2(y1[0], y1[1]), pk2(y1[2], y1[3]));
                    *(uint2*)(dst + 80 + 4 * fq) = make_uint2(pk2(y2[0], y2[1]), pk2(y2[2], y2[3]));
                    ITER_FENCE();
                }
        }
    }
};

__device__ __forceinline__ void g_qkv0(const Params& p, LAS unsigned char* lds) {
    Bufs B(p);
    pg8::Gemm g{B.h, B.wt + W_EIN, 1024}; pg8::Order S; S.init(65, 12, gridDim.x, blockIdx.x, 0, 1);
    EpiQKV0 E{B.qkv, B.rope, B.gt};
    pg8::gemm_phase<EpiQKV0, pg8::Order, true, true>(lds, g, S, E);
}
__device__ __forceinline__ void g_out(const Params& p, int l, LAS unsigned char* lds) {
    Bufs B(p);
    pg8::Gemm g{B.mix, B.wt + (l == 0 ? W_EOUT : W_OOUT), 1024}; pg8::Order S; S.init(l == 0 ? 65 : 64, 4, gridDim.x, blockIdx.x, l == 0 ? 0 : 1, 0);
    EpiResid E{l == 0 ? p.in[I_X] : p.out, p.out, p.in[I_CTX], B.xc, modp(B, l, 0, 2), modp(B, l, 1, 2)};
    pg8::gemm_phase<EpiResid, pg8::Order, true, true>(lds, g, S, E);
}
__device__ __forceinline__ void g_up(const Params& p, int l, LAS unsigned char* lds) {
    Bufs B(p);
    pg8::Gemm g{B.h, B.wt + W_UP + (size_t)l * F2_ * 1024, 1024}; pg8::Order S; S.init(l == 0 ? 67 : 65, 22, gridDim.x, blockIdx.x, l == 0 ? 0 : 2, 2);
    EpiUp E{B.act, p.in[I_FCW] + (size_t)l * 3 * F2_, p.in[I_FCB] + (size_t)l * F2_, (LAS float*)(lds + LDS_XCH)};
    pg8::gemm_phase<EpiUp, pg8::Order, true, true>(lds, g, S, E);
}
__device__ __forceinline__ void g_down(const Params& p, int l, LAS unsigned char* lds) {
    Bufs B(p);
    pg8::Gemm g{B.act, B.wt + W_DOWN + (size_t)l * 1024 * F_, F_}; pg8::Order S; S.init(l == 0 ? 65 : 64, 4, gridDim.x, blockIdx.x, l == 0 ? 0 : 1, 0);
    EpiResid E{p.out, p.out, B.xc, B.xc, modp(B, l, 0, 5), modp(B, l, 1, 5)};
    pg8::gemm_phase<EpiResid, pg8::Order, true, true>(lds, g, S, E);
}
__device__ __forceinline__ void g_qkv1a(const Params& p, LAS unsigned char* lds) {
    Bufs B(p);
    pg8::Gemm g{B.h, B.wt + W_OIN, 1024}; pg8::Order S; S.init(65, 6, gridDim.x, blockIdx.x, 0, 1);
    EpiQKV1A E{B.qkv, B.part, B.rope, B.gt};
    pg8::gemm_phase<EpiQKV1A, pg8::Order, true, true>(lds, g, S, E);
}
__device__ __forceinline__ void g_qkv1b(const Params& p, LAS unsigned char* lds) {
    Bufs B(p);
    { pg8::Gemm g{B.qkv + O_CQ, B.wt + W_QB, 384}; pg8::Order S; S.init(64, 4, gridDim.x, blockIdx.x, 1, 0);
      EpiQB E{B.qkv, B.part, B.rope, p.in[I_CQN], (LAS float*)(lds + LDS_XCH)};
      pg8::gemm_phase<EpiQB, pg8::Order, true, true>(lds, g, S, E); }
    { pg8::Gemm g{B.qkv + O_CKV, B.wt + W_KVB, 256}; pg8::Order S; S.init(65, 4, gridDim.x, blockIdx.x, 0, 0);
      EpiKVB E{B.qkv, B.part, B.rope, p.in[I_CKN]};
      pg8::gemm_phase<EpiKVB, pg8::Order, true, true>(lds, g, S, E); }
}

typedef float f32x16 __attribute__((ext_vector_type(16)));
typedef __bf16 bf16x2_t __attribute__((ext_vector_type(2)));
typedef float f32x2_t __attribute__((ext_vector_type(2)));
__device__ __forceinline__ u32 cvtpk(float lo, float hi) { const f32x2_t v = {lo, hi}; const bf16x2_t b = __builtin_convertvector(v, bf16x2_t); return __builtin_bit_cast(u32, b); }

template <int DQK, int DV>
struct FlashGeom {
    static constexpr int KP = DQK * 2 + 16, VP = 144, KBYTES = 64 * KP, VBYTES = DV * VP, STAGE = KBYTES + VBYTES;
    static constexpr int KCH = DQK / 8, KN = (64 * KCH + NT - 1) / NT, VN = DV * 8 / NT;
};

template <int DQK, int DV>
__device__ __forceinline__ void flash_dense(LAS char* lds, const bf16_t* __restrict__ qptr, const bf16_t* __restrict__ Kb, const bf16_t* __restrict__ VT, int ntiles, float c1, float c2,
                                            f32x16 (&O)[DV / 32], float& lsum) {
    typedef FlashGeom<DQK, DV> G;
    const int tid = threadIdx.x, lane = tid & 63, r = lane & 31, h = lane >> 5;
    bf16x8 qf[DQK / 16];
#pragma unroll
    for (int ks = 0; ks < DQK / 16; ++ks) qf[ks] = *(const bf16x8*)(qptr + 16 * ks + 8 * h);
#pragma unroll
    for (int dt = 0; dt < DV / 32; ++dt)
#pragma unroll
        for (int i = 0; i < 16; ++i) O[dt][i] = 0.f;
    float l = 0.f;
    u32x4 kreg[G::KN], vreg[G::VN];
    auto load_tile = [&](int t) {
#pragma unroll
        for (int i = 0; i < G::KN; ++i) { const int q = tid + NT * i; if (q < 64 * G::KCH) kreg[i] = *(const u32x4*)(Kb + (size_t)t * 64 * DQK + q * 8); }
#pragma unroll
        for (int i = 0; i < G::VN; ++i) { const int q = tid + NT * i; vreg[i] = *(const u32x4*)(VT + (size_t)(q >> 3) * R_ + t * 64 + (q & 7) * 8); }
    };
    auto store_tile = [&](int buf) {
        LAS char* kb = lds + buf * G::STAGE; LAS char* vb = kb + G::KBYTES;
#pragma unroll
        for (int i = 0; i < G::KN; ++i) { const int q = tid + NT * i; if (q < 64 * G::KCH) *(LAS u32x4*)(kb + (q / G::KCH) * G::KP + (q % G::KCH) * 16) = kreg[i]; }
#pragma unroll
        for (int i = 0; i < G::VN; ++i) { const int q = tid + NT * i; *(LAS u32x4*)(vb + (q >> 3) * G::VP + (q & 7) * 16) = vreg[i]; }
    };
    load_tile(0); store_tile(0);
    if (ntiles > 1) load_tile(1);
    __syncthreads();
    for (int t = 0; t < ntiles; ++t) {
        if (t + 1 < ntiles) store_tile((t + 1) & 1);
        if (t + 2 < ntiles) load_tile(t + 2);
        const LAS char* kb = lds + (t & 1) * G::STAGE; const LAS char* vb = kb + G::KBYTES;
#pragma unroll
        for (int kt = 0; kt < 2; ++kt) {
            f32x16 S;
#pragma unroll
            for (int i = 0; i < 16; ++i) S[i] = 0.f;
#pragma unroll
            for (int ks = 0; ks < DQK / 16; ++ks) {
                const bf16x8 a = *(const LAS bf16x8*)(kb + (32 * kt + r) * G::KP + (16 * ks + 8 * h) * 2);
                S = __builtin_amdgcn_mfma_f32_32x32x16_bf16(a, qf[ks], S, 0, 0, 0);
            }
            float p[16];
#pragma unroll
            for (int i = 0; i < 16; ++i) { p[i] = __builtin_amdgcn_exp2f(S[i] * c1 - c2); l += p[i]; }
#pragma unroll
            for (int s = 0; s < 2; ++s) {
                u32x4 pw; pw.x = cvtpk(p[8 * s], p[8 * s + 1]); pw.y = cvtpk(p[8 * s + 2], p[8 * s + 3]); pw.z = cvtpk(p[8 * s + 4], p[8 * s + 5]); pw.w = cvtpk(p[8 * s + 6], p[8 * s + 7]);
                const bf16x8 pf = __builtin_bit_cast(bf16x8, pw);
#pragma unroll
                for (int dt = 0; dt < DV / 32; ++dt) {
                    const bf16x8 a = *(const LAS bf16x8*)(vb + (32 * dt + r) * G::VP + (16 * (2 * kt + s) + 8 * h) * 2);
                    O[dt] = __builtin_amdgcn_mfma_f32_32x32x16_bf16(a, pf, O[dt], 0, 0, 0);
                }
            }
        }
        __syncthreads();
    }
    lsum = l + __shfl_xor(l, 32);
}

__device__ __forceinline__ void diff_unit(const Params& p, const Bufs& B, LAS char* lds, int head, int qb) {
    const int tid = threadIdx.x, wid = tid >> 6, lane = tid & 63, c = lane & 31, h = lane >> 5;
    const int r = qb * 256 + wid * 32 + c, nt = qb == 0 ? 4 : R_ / 64;
    const float lam = B.scal[0], c1 = 0.125f * 1.4426950408889634f, c2 = B.scal[1];
    float* tmp = (float*)B.h + ((size_t)r * 4 + head) * 128 + 4 * h;
    f32x16 O[4]; float l;
    flash_dense<64, 128>(lds, B.qkv + O_QA + ((size_t)(2 * head) * R_ + r) * 64, B.qkv + O_KA + (size_t)(2 * head) * R_ * 64, B.qkv + O_VAT + (size_t)head * 128 * R_, nt, c1, c2, O, l);
    {
        const float inv = 1.f / l;
#pragma unroll
        for (int dt = 0; dt < 4; ++dt)
#pragma unroll
            for (int q = 0; q < 4; ++q) *(f32x4*)(tmp + 32 * dt + 8 * q) = (f32x4){O[dt][4 * q] * inv, O[dt][4 * q + 1] * inv, O[dt][4 * q + 2] * inv, O[dt][4 * q + 3] * inv};
    }
    flash_dense<64, 128>(lds, B.qkv + O_QA + ((size_t)(2 * head + 1) * R_ + r) * 64, B.qkv + O_KA + (size_t)(2 * head + 1) * R_ * 64, B.qkv + O_VAT + (size_t)head * 128 * R_, nt, c1, c2, O, l);
    {
        const float inv = lam / l; float ss = 0.f;
#pragma unroll
        for (int dt = 0; dt < 4; ++dt)
#pragma unroll
            for (int q = 0; q < 4; ++q) {
                const f32x4 o1 = *(const f32x4*)(tmp + 32 * dt + 8 * q);
#pragma unroll
                for (int e = 0; e < 4; ++e) { const float d = o1[e] - O[dt][4 * q + e] * inv; O[dt][4 * q + e] = d; ss += d * d; }
            }
        ss += __shfl_xor(ss, 32);
        const float rr = rsqrtf(ss * (1.f / 128.f) + EPS_) * 0.8f;
        bf16_t* dst = B.mix + (size_t)r * 1024 + head * 128 + 4 * h;
        const float* g = p.in[I_SUBLN] + 4 * h;
#pragma unroll
        for (int dt = 0; dt < 4; ++dt)
#pragma unroll
            for (int q = 0; q < 4; ++q) {
                const f32x4 gg = *(const f32x4*)(g + 32 * dt + 8 * q);
                *(uint2*)(dst + 32 * dt + 8 * q) = make_uint2(cvtpk(O[dt][4 * q] * rr * gg[0], O[dt][4 * q + 1] * rr * gg[1]), cvtpk(O[dt][4 * q + 2] * rr * gg[2], O[dt][4 * q + 3] * rr * gg[3]));
            }
    }
}
__device__ __forceinline__ void mla_unit(const Params& p, const Bufs& B, LAS char* lds, int head, int qb) {
    const int tid = threadIdx.x, wid = tid >> 6, lane = tid & 63, c = lane & 31, h = lane >> 5;
    const int r = qb * 256 + wid * 32 + c;
    const float c1 = 0.10206207261596575f * 1.4426950408889634f, c2 = B.scal[2];
    f32x16 O[2]; float l;
    flash_dense<96, 64>(lds, B.qkv + O_MQ + ((size_t)head * R_ + r) * 96, B.qkv + O_MK + (size_t)head * R_ * 96, B.qkv + O_MVT + (size_t)head * 64 * R_, R_ / 64, c1, c2, O, l);
    const float inv = 1.f / l;
    bf16_t* dst = B.mix + (size_t)r * 1024 + head * 64 + 4 * h;
#pragma unroll
    for (int dt = 0; dt < 2; ++dt)
#pragma unroll
        for (int q = 0; q < 4; ++q)
            *(uint2*)(dst + 32 * dt + 8 * q) = make_uint2(cvtpk(O[dt][4 * q] * inv, O[dt][4 * q + 1] * inv), cvtpk(O[dt][4 * q + 2] * inv, O[dt][4 * q + 3] * inv));
}
__device__ void phase_attn0_dense(const Params& p, LAS char* lds, int bid, int nblk) {
    Bufs B(p);
    for (int u = bid; u < 260; u += nblk) {
        int head, qb;
        if (u < 256) { const int x = u & 7; head = x >> 1; qb = 1 + (u >> 3) * 2 + (x & 1); } else { head = u - 256; qb = 0; }
        diff_unit(p, B, lds, head, qb);
    }
}
__device__ void phase_attn1_dense(const Params& p, LAS char* lds, int bid, int nblk) {
    Bufs B(p);
    for (int u = bid; u < 512; u += nblk) mla_unit(p, B, lds, u & 7, 1 + (u >> 3));
}

template <int MODE>
__device__ __forceinline__ void flash_win(LAS char* lds, const bf16_t* __restrict__ qptr, const bf16_t* __restrict__ Kb, const bf16_t* __restrict__ VT, int lat0, int nlat, float c1, float c2,
                                          int qi  , int qcol, const LAS float* bl, f32x16 (&O)[2], float& lsum) {
    typedef FlashGeom<64, 64> G;
    const int tid = threadIdx.x, lane = tid & 63, r = lane & 31, h = lane >> 5;
    const int ntiles = 4 + nlat;
    bf16x8 qf[4];
#pragma unroll
    for (int ks = 0; ks < 4; ++ks) qf[ks] = *(const bf16x8*)(qptr + 16 * ks + 8 * h);
#pragma unroll
    for (int dt = 0; dt < 2; ++dt)
#pragma unroll
        for (int i = 0; i < 16; ++i) O[dt][i] = 0.f;
    float l = 0.f;
    u32x4 kreg, vreg;
    auto load_tile = [&](int t) { const int at = t < 4 ? t : lat0 + (t - 4);
        kreg = *(const u32x4*)(Kb + (size_t)at * 64 * 64 + tid * 8); vreg = *(const u32x4*)(VT + (size_t)(tid >> 3) * R_ + at * 64 + (tid & 7) * 8); };
    auto store_tile = [&](int buf) { LAS char* kb = lds + buf * G::STAGE; LAS char* vb = kb + G::KBYTES;
        *(LAS u32x4*)(kb + (tid >> 3) * G::KP + (tid & 7) * 16) = kreg; *(LAS u32x4*)(vb + (tid >> 3) * G::VP + (tid & 7) * 16) = vreg; };
    const int rs = MODE == 1 ? min(max(qi - 4, 0), 248) : 0, cs = MODE == 1 ? min(max(qcol - 8, 0), 48) : 0;
    const int qlo = MODE == 2 ? __builtin_amdgcn_readfirstlane(qi - r) : 0;
    load_tile(0); store_tile(0);
    if (ntiles > 1) load_tile(1);
    __syncthreads();
    for (int t = 0; t < ntiles; ++t) {
        if (t + 1 < ntiles) store_tile((t + 1) & 1);
        if (t + 2 < ntiles) load_tile(t + 2);
        const LAS char* kb = lds + (t & 1) * G::STAGE; const LAS char* vb = kb + G::KBYTES;
        const int lt = lat0 + (t - 4) - 4;
        bool active = true;
        if (t >= 4) { if (MODE == 1) active = lt >= rs && lt < rs + 8; else active = (64 * lt + 63 >= qlo - 128) && (64 * lt <= qlo + 31 + 128); }
        if (active) {
#pragma unroll
            for (int kt = 0; kt < 2; ++kt) {
                f32x16 S;
#pragma unroll
                for (int i = 0; i < 16; ++i) S[i] = 0.f;
#pragma unroll
                for (int ks = 0; ks < 4; ++ks) {
                    const bf16x8 a = *(const LAS bf16x8*)(kb + (32 * kt + r) * G::KP + (16 * ks + 8 * h) * 2);
                    S = __builtin_amdgcn_mfma_f32_32x32x16_bf16(a, qf[ks], S, 0, 0, 0);
                }
                float p[16];
                if (t < 4) {
#pragma unroll
                    for (int i = 0; i < 16; ++i) p[i] = __builtin_amdgcn_exp2f(S[i] * c1 - c2);
                } else {
#pragma unroll
                    for (int i = 0; i < 16; ++i) {
                        const int kk = 32 * kt + (i & 3) + 8 * (i >> 2) + 4 * h;
                        if (MODE == 1) {
                            const bool valid = (unsigned)(kk - cs) < 16u;
                            const float b = bl[valid ? (lt - qi + 7) * 31 + (kk - qcol + 15) : 0];
                            p[i] = valid ? __builtin_amdgcn_exp2f(S[i] * c1 + b - c2) : 0.f;
                        } else {
                            const int d = 64 * lt + kk - qi;
                            p[i] = (d <= 128 && d >= -128) ? __builtin_amdgcn_exp2f(S[i] * c1 - c2) : 0.f;
                        }
                    }
                }
#pragma unroll
                for (int i = 0; i < 16; ++i) l += p[i];
#pragma unroll
                for (int s = 0; s < 2; ++s) {
                    u32x4 pw; pw.x = cvtpk(p[8 * s], p[8 * s + 1]); pw.y = cvtpk(p[8 * s + 2], p[8 * s + 3]); pw.z = cvtpk(p[8 * s + 4], p[8 * s + 5]); pw.w = cvtpk(p[8 * s + 6], p[8 * s + 7]);
                    const bf16x8 pf = __builtin_bit_cast(bf16x8, pw);
#pragma unroll
                    for (int dt = 0; dt < 2; ++dt) {
                        const bf16x8 a = *(const LAS bf16x8*)(vb + (32 * dt + r) * G::VP + (16 * (2 * kt + s) + 8 * h) * 2);
                        O[dt] = __builtin_amdgcn_mfma_f32_32x32x16_bf16(a, pf, O[dt], 0, 0, 0);
                    }
                }
            }
        }
        __syncthreads();
    }
    lsum = l + __shfl_xor(l, 32);
}
__device__ __forceinline__ void store_o64(bf16_t* dst  , const f32x16 (&O)[2], float inv) {
#pragma unroll
    for (int dt = 0; dt < 2; ++dt)
#pragma unroll
        for (int q = 0; q < 4; ++q)
            *(uint2*)(dst + 32 * dt + 8 * q) = make_uint2(cvtpk(O[dt][4 * q] * inv, O[dt][4 * q + 1] * inv), cvtpk(O[dt][4 * q + 2] * inv, O[dt][4 * q + 3] * inv));
}
constexpr int LDS_BIAS = 40960;
__device__ __forceinline__ void na_unit(const Params& p, const Bufs& B, LAS char* lds, int head, int qb) {
    const int tid = threadIdx.x, wid = tid >> 6, lane = tid & 63, c = lane & 31, h = lane >> 5;
    const int r = qb * 256 + wid * 32 + c;
    LAS float* bl = (LAS float*)(lds + LDS_BIAS);
    __syncthreads();
    for (int e = tid; e < 465; e += NT) bl[e] = p.in[I_RPB][head * 465 + e] * 1.4426950408889634f;
    int lat0 = 4, nlat = 0, grow = 0, gcol = 0;
    if (qb > 0) { const int r0 = 4 * (qb - 1), ra = min(max(r0 - 4, 0), 248), rb = min(max(r0 + 3 - 4, 0), 248) + 8; lat0 = 4 + ra; nlat = rb - ra; grow = r0 + (wid >> 1); gcol = 32 * (wid & 1) + c; }
    f32x16 O[2]; float l;
    flash_win<1>(lds, B.qkv + O_QB + ((size_t)head * R_ + r) * 64, B.qkv + O_KB + (size_t)head * R_ * 64, B.qkv + O_VBT + (size_t)head * 64 * R_, lat0, nlat,
                 0.125f * 1.4426950408889634f, B.scal[3], grow, gcol, bl, O, l);
    store_o64(B.mix + (size_t)r * 1024 + 512 + head * 64 + 4 * h, O, 1.f / l);
}
__device__ __forceinline__ void swa_unit(const Params& p, const Bufs& B, LAS char* lds, int hq, int qb) {
    const int tid = threadIdx.x, wid = tid >> 6, lane = tid & 63, c = lane & 31, h = lane >> 5;
    const int r = qb * 256 + wid * 32 + c, t0 = (qb - 1) * 256, kvh = hq >> 2;
    const int ta = max(t0 / 64 - 2, 0), tb = min(t0 / 64 + 5, 255);
    f32x16 O[2]; float l;
    const float c2 = B.scal[4];
    flash_win<2>(lds, B.qkv + O_GQ + ((size_t)hq * R_ + r) * 64, B.qkv + O_GK + (size_t)kvh * R_ * 64, B.qkv + O_GVT + (size_t)kvh * 64 * R_, 4 + ta, tb - ta + 1,
                 0.125f * 1.4426950408889634f, c2, r - 256, 0, nullptr, O, l);
    l += __builtin_amdgcn_exp2f(p.in[I_SINK][hq] * 1.4426950408889634f - c2);
    store_o64(B.mix + (size_t)r * 1024 + 512 + hq * 64 + 4 * h, O, 1.f / l);
}
__device__ void phase_attn0_win(const Params& p, LAS char* lds, int bid, int nblk) {
    Bufs B(p);
    for (int u = bid; u < 520; u += nblk) na_unit(p, B, lds, u & 7, u >> 3);
}
__device__ void phase_attn1_win(const Params& p, LAS char* lds, int bid, int nblk) {
    Bufs B(p);
    for (int u = bid; u < 512; u += nblk) swa_unit(p, B, lds, u & 7, 1 + (u >> 3));
}

#ifndef OPTG
#define OPTG 0x7f
#endif
constexpr int NPHASE = 16;
__device__ __forceinline__ void run_phase(int ph, const Params& p, char* lds, int bid, int nblk) {
    LAS unsigned char* l3 = (LAS unsigned char*)lds;
    switch (ph) {
        case 0: phase_prep(p, lds, bid, nblk); if (OPTG) phase_prep_weights(p, lds, bid, nblk); break;
        case 1: phase_norm(p, 0, 0, bid, nblk); break;
        case 2: if (OPTG & 1) g_qkv0(p, l3); else phase_qkv0(p, lds, bid, nblk); break;
        case 3: if (OPTA & 1) phase_attn0_dense(p, (LAS char*)lds, bid, nblk); if (OPTA & 4) phase_attn0_win(p, (LAS char*)lds, bid, nblk); if ((OPTA & 5) != 5) phase_attn0(p, lds, bid, nblk); break;
        case 4: if (OPTG & 2) g_out(p, 0, l3); else phase_out(p, 0, bid, nblk); break;
        case 5: phase_norm(p, 0, 1, bid, nblk); break;
        case 6: if (OPTG & 4) g_up(p, 0, l3); else phase_up(p, 0, lds, bid, nblk); break;
        case 7: if (OPTG & 8) g_down(p, 0, l3); else phase_down(p, 0, bid, nblk); break;
        case 8: phase_norm(p, 1, 0, bid, nblk); break;
        case 9: if (OPTG & 16) g_qkv1a(p, l3); else phase_qkv1a(p, lds, bid, nblk); break;
        case 10: if (OPTG & 32) g_qkv1b(p, l3); else phase_qkv1b(p, lds, bid, nblk); break;
        case 11: if (OPTA & 2) phase_attn1_dense(p, (LAS char*)lds, bid, nblk); if (OPTA & 8) phase_attn1_win(p, (LAS char*)lds, bid, nblk); if ((OPTA & 10) != 10) phase_attn1(p, bid, nblk); break;
        case 12: if (OPTG & 2) g_out(p, 1, l3); else phase_out(p, 1, bid, nblk); break;
        case 13: phase_norm(p, 1, 1, bid, nblk); break;
        case 14: if (OPTG & 4) g_up(p, 1, l3); else phase_up(p, 1, lds, bid, nblk); break;
        case 15: if (OPTG & 8) g_down(p, 1, l3); else phase_down(p, 1, bid, nblk); break;
    }
}

namespace cg = cooperative_groups;
__global__ void __launch_bounds__(NT, 2) k_mega(Params p) {
    extern __shared__ __attribute__((aligned(16))) char smem[];
    cg::grid_group grid = cg::this_grid();
    const int bid = blockIdx.x, nblk = gridDim.x;
#define PH(n) run_phase(n, p, smem, bid, nblk)
    PH(0); grid.sync(); PH(1); grid.sync(); PH(2); grid.sync(); PH(3); grid.sync(); PH(4); grid.sync(); PH(5); grid.sync(); PH(6); grid.sync(); PH(7); grid.sync();
    PH(8); grid.sync(); PH(9); grid.sync(); PH(10); grid.sync(); PH(11); grid.sync(); PH(12); grid.sync(); PH(13); grid.sync(); PH(14); grid.sync(); PH(15);
#undef PH
}

extern "C" void kernel_launch(void* const* d_in, const int* in_sizes, int n_in, void* d_out, int out_size, void* d_ws, size_t ws_size, hipStream_t stream) {
    Params p{};
    for (int i = 0; i < 35; ++i) p.in[i] = (const float*)d_in[i];
    p.out = (float*)d_out; p.ws = (char*)d_ws;
    if (ws_size < WS_END) { fprintf(stderr, "ws too small: %zu < %zu\n", ws_size, (size_t)WS_END); return; }
    static int grid_blocks = 0;
    if (!grid_blocks) {
        int dev = 0, cus = 0, per_cu = 0;
        hipGetDevice(&dev);
        hipDeviceGetAttribute(&cus, hipDeviceAttributeMultiprocessorCount, dev);
        if (hipFuncSetAttribute((const void*)k_mega, hipFuncAttributeMaxDynamicSharedMemorySize, LDS_BYTES) != hipSuccess) fprintf(stderr, "hipFuncSetAttribute failed\n");
        hipOccupancyMaxActiveBlocksPerMultiprocessor(&per_cu, (const void*)k_mega, NT, LDS_BYTES);
        if (per_cu < 1) { fprintf(stderr, "occupancy query returned %d\n", per_cu); per_cu = 1; }
        if (per_cu > 1) per_cu = 1;
        grid_blocks = cus * per_cu;
    }
    void* args[] = {&p};
    hipError_t e = hipLaunchCooperativeKernel((const void*)k_mega, dim3(grid_blocks), dim3(NT), args, LDS_BYTES, stream);
    if (e != hipSuccess) fprintf(stderr, "cooperative launch failed: %s (grid %d)\n", hipGetErrorString(e), grid_blocks);
}
```

```cpp
#include <hip/hip_runtime.h>
#include <hip/hip_cooperative_groups.h>
#include <cstdint>
#include <cstdio>
#include <cmath>

typedef unsigned short bf16_t;
__device__ __forceinline__ int ltid() { int t = threadIdx.x; asm volatile("" : "+v"(t)); return t; }
typedef unsigned int u32;
typedef u32 u32x4 __attribute__((ext_vector_type(4)));

#define NT 512
#ifndef REPEAT
#define REPEAT 0
#endif
#ifndef OPTA
#define OPTA 15
#endif
constexpr int T_ = 16384, L_ = 256, R_ = 16640, D_ = 1024, F_ = 2816, F2_ = 5632;
constexpr float EPS_ = 1e-6f;

constexpr size_t WS_CTL = 0;
constexpr size_t WS_MOD = 16384;
constexpr size_t WS_SCAL = WS_MOD + 2 * 2 * 6144 * 4;
constexpr size_t WS_GT = WS_SCAL + 256;
constexpr size_t WS_ROPE = WS_GT + 6 * 64 * 4;
constexpr size_t WS_XC = WS_ROPE + 256 * 16 * 2 * 4;
constexpr size_t WS_H = WS_XC + 256 * 1024 * 4;
constexpr int HROWS = R_ + 144;
constexpr size_t WS_MIX = WS_H + (size_t)HROWS * 1024 * 2;
constexpr size_t WS_QKV = WS_MIX + (size_t)R_ * 1024 * 2;
constexpr size_t E_SEG = (size_t)512 * R_;
constexpr size_t O_QA = 0, O_KA = E_SEG, O_VAT = 2 * E_SEG, O_QB = 3 * E_SEG, O_KB = 4 * E_SEG, O_VBT = 5 * E_SEG;
constexpr size_t O_CQ = 0, O_CKV = O_CQ + (size_t)R_ * 384, O_CKR = O_CKV + (size_t)R_ * 256, O_MQ = O_CKR + (size_t)R_ * 32,
                 O_MK = O_MQ + (size_t)R_ * 768, O_MVT = O_MK + (size_t)R_ * 768, O_GQ = O_MVT + (size_t)R_ * 512,
                 O_GK = O_GQ + (size_t)R_ * 512, O_GVT = O_GK + (size_t)R_ * 128, O_L1END = O_GVT + (size_t)R_ * 128;
constexpr size_t WS_QKV_BYTES = O_L1END * 2;
constexpr size_t WS_PART = WS_QKV + WS_QKV_BYTES;
constexpr size_t WS_WT = WS_PART + (size_t)R_ * 12 * 4;
constexpr size_t W_EIN = 0, W_EOUT = W_EIN + (size_t)3072 * 1024, W_UP = W_EOUT + (size_t)1024 * 1024, W_DOWN = W_UP + (size_t)2 * 5632 * 1024,
                 W_OIN = W_DOWN + (size_t)2 * 1024 * 2816, W_OOUT = W_OIN + (size_t)1536 * 1024, W_QB = W_OOUT + (size_t)1024 * 1024,
                 W_KVB = W_QB + (size_t)1024 * 384, W_END = W_KVB + (size_t)1024 * 256;
constexpr size_t WS_END = WS_WT + W_END * 2;
static_assert(WS_END < (size_t)255 * 1024 * 1024, "ws");
static_assert((size_t)(R_ + 8) * F_ * 2 <= WS_QKV_BYTES, "act alias");

struct Params { const float* in[35]; float* out; char* ws; };
enum { I_X = 0, I_C, I_CTX, I_CCTX, I_ADAW, I_ADAB, I_NMIX, I_NFFN, I_FUP, I_FCW, I_FCB, I_FDOWN, I_EWIN, I_EWOUT, I_AQN, I_AKN,
       I_LQ1, I_LK1, I_LQ2, I_LK2, I_SUBLN, I_BQN, I_BKN, I_RPB, I_OWIN, I_OWOUT, I_CQAN, I_CWQB, I_CKVAN, I_CWKVB, I_CQN, I_CKN,
       I_DQN, I_DKN, I_SINK };

__device__ __forceinline__ float bf2f(bf16_t v) { return __uint_as_float(((u32)v) << 16); }
__device__ __forceinline__ bf16_t f2bf(float f) { u32 u = __float_as_uint(f); return (bf16_t)((u + 0x7fffu + ((u >> 16) & 1u)) >> 16); }
__device__ __forceinline__ float wave_sum(float v) {
#pragma unroll
    for (int o = 32; o > 0; o >>= 1) v += __shfl_xor(v, o);
    return v;
}
__device__ __forceinline__ int swap23(int p) { return (p & 3) | ((p & 4) << 1) | ((p & 8) >> 1); }
__device__ __forceinline__ int hrow(int r) { return r < 256 ? r + 1 : r + 2; }
__device__ __forceinline__ int vpos(int key) { return (key & ~15) + swap23(key & 15); }
__device__ __forceinline__ void unpack8(u32x4 v, float (&a)[8]) {
    a[0] = __uint_as_float(v.x << 16); a[1] = __uint_as_float(v.x & 0xffff0000u);
    a[2] = __uint_as_float(v.y << 16); a[3] = __uint_as_float(v.y & 0xffff0000u);
    a[4] = __uint_as_float(v.z << 16); a[5] = __uint_as_float(v.z & 0xffff0000u);
    a[6] = __uint_as_float(v.w << 16); a[7] = __uint_as_float(v.w & 0xffff0000u);
}

struct Bufs {
    float* mod; float* scal; float* rope; float* xc; bf16_t* h; bf16_t* mix; bf16_t* qkv; bf16_t* act; float* part; bf16_t* wt; float* gt;
    __device__ Bufs(const Params& p) {
        mod = (float*)(p.ws + WS_MOD); scal = (float*)(p.ws + WS_SCAL); rope = (float*)(p.ws + WS_ROPE); xc = (float*)(p.ws + WS_XC);
        h = (bf16_t*)(p.ws + WS_H); mix = (bf16_t*)(p.ws + WS_MIX); qkv = (bf16_t*)(p.ws + WS_QKV); act = (bf16_t*)(p.ws + WS_QKV);
        part = (float*)(p.ws + WS_PART); wt = (bf16_t*)(p.ws + WS_WT); gt = (float*)(p.ws + WS_GT);
    }
};
__device__ __forceinline__ const float* modp(const Bufs& B, int l, int s, int chunk) { return B.mod + ((size_t)(l * 2 + s) * 6144) + chunk * 1024; }

__device__ void phase_prep(const Params& p, char* lds, int bid, int nblk) {
    Bufs B(p);
    float* red = (float*)lds;
    const int tid = ltid();
    for (int item = bid; item < 193; item += nblk) {
        if (item < 192) {
            const int l = item / 96, n0 = (item % 96) * 64, nn = tid & 63, kc = tid >> 6;
            const float* W = p.in[I_ADAW] + (size_t)l * 1024 * 6144 + n0 + nn;
            float a0 = 0.f, a1 = 0.f;
            for (int k = kc * 128; k < kc * 128 + 128; ++k) {
                const float w = W[(size_t)k * 6144];
                const float c0 = p.in[I_C][k], c1 = p.in[I_CCTX][k];
                a0 += (c0 / (1.f + __expf(-c0))) * w; a1 += (c1 / (1.f + __expf(-c1))) * w;
            }
            red[(kc * 64 + nn) * 2] = a0; red[(kc * 64 + nn) * 2 + 1] = a1;
            __syncthreads();
            if (tid < 128) {
                const int n = tid & 63, s = tid >> 6; float acc = 0.f;
                for (int k = 0; k < 8; ++k) acc += red[(k * 64 + n) * 2 + s];
                B.mod[(size_t)(l * 2 + s) * 6144 + n0 + n] = acc + p.in[I_ADAB][l * 6144 + n0 + n];
            }
            __syncthreads();
        } else {
            for (int e = tid; e < 256 * 16; e += NT) {
                const int pos = e >> 4, i = e & 15;
                const double f = pow(10000.0, -(double)i / 16.0), ang = (double)pos * f;
                B.rope[e * 2] = (float)cos(ang); B.rope[e * 2 + 1] = (float)sin(ang);
            }
            if (tid < 64) {
                B.gt[tid] = p.in[I_AQN][tid]; B.gt[64 + tid] = p.in[I_AKN][tid]; B.gt[128 + tid] = p.in[I_BQN][tid]; B.gt[192 + tid] = p.in[I_BKN][tid];
                B.gt[256 + tid] = p.in[I_DQN][tid]; B.gt[320 + tid] = p.in[I_DKN][tid];
                const float s1 = wave_sum(p.in[I_LQ1][tid] * p.in[I_LK1][tid]), s2 = wave_sum(p.in[I_LQ2][tid] * p.in[I_LK2][tid]);
                if (tid == 0) B.scal[0] = expf(s1) - expf(s2) + 0.2f;
                float ma = fabsf(p.in[I_AQN][tid]), mb = fabsf(p.in[I_AKN][tid]), mc = fmaxf(fabsf(p.in[I_CQN][tid]), tid < 32 ? fabsf(p.in[I_CQN][64 + tid]) : 0.f),
                      md = fmaxf(fabsf(p.in[I_CKN][tid]), tid < 32 ? fabsf(p.in[I_CKN][64 + tid]) : 0.f);
#pragma unroll
                for (int o = 32; o > 0; o >>= 1) { ma = fmaxf(ma, __shfl_xor(ma, o)); mb = fmaxf(mb, __shfl_xor(mb, o)); mc = fmaxf(mc, __shfl_xor(mc, o)); md = fmaxf(md, __shfl_xor(md, o)); }
                if (tid == 0) { B.scal[1] = 8.f * ma * mb * 1.4426950408889634f; B.scal[2] = 9.797958971132712f * mc * md * 1.4426950408889634f; }
                float na = fabsf(p.in[I_BQN][tid]), nb = fabsf(p.in[I_BKN][tid]), nc = fabsf(p.in[I_DQN][tid]), nd = fabsf(p.in[I_DKN][tid]), nr = 0.f, ns = tid < 8 ? p.in[I_SINK][tid] : -1e30f;
                for (int e = tid; e < 8 * 465; e += 64) nr = fmaxf(nr, fabsf(p.in[I_RPB][e]));
#pragma unroll
                for (int o = 32; o > 0; o >>= 1) { na = fmaxf(na, __shfl_xor(na, o)); nb = fmaxf(nb, __shfl_xor(nb, o)); nc = fmaxf(nc, __shfl_xor(nc, o)); nd = fmaxf(nd, __shfl_xor(nd, o));
                                                   nr = fmaxf(nr, __shfl_xor(nr, o)); ns = fmaxf(ns, __shfl_xor(ns, o)); }
                if (tid == 0) { B.scal[3] = (8.f * na * nb + nr) * 1.4426950408889634f; B.scal[4] = fmaxf(8.f * nc * nd, ns) * 1.4426950408889634f; }
            }
        }
    }
}

__device__ void phase_norm(const Params& p, int l, int which, int bid, int nblk) {
    Bufs B(p);
    const int wid = ltid() >> 6, lane = ltid() & 63;
    const float* gamma = p.in[which ? I_NFFN : I_NMIX] + l * 1024;
    for (int e = bid * NT + ltid(); e < (2 + HROWS - (R_ + 2)) * 128; e += nblk * NT) {
        const int rr = e >> 7, c = e & 127; const int rho = rr == 0 ? 0 : rr == 1 ? 257 : R_ + 2 + (rr - 2);
        *(u32x4*)(B.h + (size_t)rho * 1024 + c * 8) = (u32x4){0u, 0u, 0u, 0u};
    }
    for (int item = bid; item < R_ / 8; item += nblk) {
        const int r = item * 8 + wid;
        const bool first = (l == 0 && which == 0);
        const float* src = r < 256 ? ((first ? p.in[I_CTX] : B.xc) + (size_t)r * 1024) : ((first ? p.in[I_X] : p.out) + (size_t)(r - 256) * 1024);
        const int s = r < 256 ? 1 : 0;
        const float* sh = modp(B, l, s, which ? 3 : 0); const float* sc = modp(B, l, s, which ? 4 : 1);
        float v[16]; float ss = 0.f;
#pragma unroll
        for (int i = 0; i < 4; ++i) { const float4 t = *(const float4*)(src + i * 256 + lane * 4); v[4 * i] = t.x; v[4 * i + 1] = t.y; v[4 * i + 2] = t.z; v[4 * i + 3] = t.w; ss += t.x * t.x + t.y * t.y + t.z * t.z + t.w * t.w; }
        ss = wave_sum(ss);
        const float rr = rsqrtf(ss * (1.f / 1024.f) + EPS_);
#pragma unroll
        for (int i = 0; i < 4; ++i) {
            const int k = i * 256 + lane * 4; bf16_t o[4];
#pragma unroll
            for (int j = 0; j < 4; ++j) o[j] = f2bf(v[4 * i + j] * rr * gamma[k + j] * (1.f + sc[k + j]) + sh[k + j]);
            *(uint2*)(B.h + (size_t)hrow(r) * 1024 + k) = make_uint2((u32)o[0] | ((u32)o[1] << 16), (u32)o[2] | ((u32)o[3] << 16));
        }
    }
}

template <int RPG>
__device__ __forceinline__ void tile_linear(float (&acc)[RPG], int K, const bf16_t* const (&ap)[RPG], const float* __restrict__ W, int ldw, int wcol) {
#pragma unroll
    for (int i = 0; i < RPG; ++i) acc[i] = 0.f;
    if (wcol < 0) return;
    for (int k = 0; k < K; k += 8) {
        float w[8];
#pragma unroll
        for (int j = 0; j < 8; ++j) w[j] = W[(size_t)(k + j) * ldw + wcol];
#pragma unroll
        for (int i = 0; i < RPG; ++i) {
            if (ap[i]) { float a[8]; unpack8(*(const u32x4*)(ap[i] + k), a);
#pragma unroll
                for (int j = 0; j < 8; ++j) acc[i] += a[j] * w[j]; }
        }
    }
}
template <int RPG>
__device__ __forceinline__ void tile_linear_g(float (&acc)[RPG], int K, const bf16_t* const (&ap)[RPG], const float (&rs)[RPG], const float* __restrict__ g, const float* __restrict__ W, int ldw, int wcol) {
#pragma unroll
    for (int i = 0; i < RPG; ++i) acc[i] = 0.f;
    if (wcol < 0) return;
    for (int k = 0; k < K; k += 8) {
        float w[8];
#pragma unroll
        for (int j = 0; j < 8; ++j) w[j] = W[(size_t)(k + j) * ldw + wcol] * g[k + j];
#pragma unroll
        for (int i = 0; i < RPG; ++i) {
            if (ap[i]) { float a[8]; unpack8(*(const u32x4*)(ap[i] + k), a); float t = 0.f;
#pragma unroll
                for (int j = 0; j < 8; ++j) t += a[j] * w[j];
                acc[i] += t * rs[i]; }
        }
    }
}

__device__ __forceinline__ float2 rope64(const float* tab, int t, int i) { const int pos = i < 16 ? (t >> 6) : (t & 63); const int f = i & 15; return *(const float2*)(tab + (pos * 16 + f) * 2); }
__device__ __forceinline__ float2 rope32(const float* tab, int t, int i) { const int pos = i < 8 ? (t >> 6) : (t & 63); const int f = (i & 7) * 2; return *(const float2*)(tab + (pos * 16 + f) * 2); }

__device__ __forceinline__ void head64_norm_rope(const float* row, const float* g, bool rope, const float* tab, int t, bf16_t* dst, int lane) {
    const float v = row[lane];
    const float ss = wave_sum(v * v);
    const float rr = rsqrtf(ss * (1.f / 64.f) + EPS_);
    float y = v * rr * g[lane];
    if (rope) {
        const float yp = row[lane ^ 32] * rr * g[lane ^ 32];
        const float2 cs = rope64(tab, t, lane & 31);
        y = lane < 32 ? (y * cs.x - yp * cs.y) : (yp * cs.y + y * cs.x);
    }
    dst[lane] = f2bf(y);
}

__device__ void phase_qkv0(const Params& p, char* lds, int bid, int nblk) {
    Bufs B(p);
    float* tile = (float*)lds;
    const int tid = ltid(), cc = tid & 127, rg = tid >> 7, wid = tid >> 6, lane = tid & 63;
    const float* W = p.in[I_EWIN];
    for (int item = bid; item < (R_ / 16) * 24; item += nblk) {
        const int rt = item / 24, ct = item % 24, row0 = rt * 16, col0 = ct * 128;
        const bf16_t* ap[4];
#pragma unroll
        for (int i = 0; i < 4; ++i) ap[i] = B.h + (size_t)hrow(row0 + rg * 4 + i) * 1024;
        float acc[4];
        tile_linear<4>(acc, 1024, ap, W, 3072, col0 + cc);
#pragma unroll
        for (int i = 0; i < 4; ++i) tile[(rg * 4 + i) * 128 + cc] = acc[i];
        __syncthreads();
        const int seg = col0 / 512, cin = col0 % 512;
        if (seg == 2 || seg == 5) {
            for (int e = tid; e < 16 * 128; e += NT) {
                const int c = e >> 4, rr = e & 15, r = row0 + rr;
                bf16_t* dst;
                if (seg == 2) dst = B.qkv + O_VAT + ((size_t)(cin / 128) * 128 + c) * R_;
                else dst = B.qkv + O_VBT + ((size_t)((cin + c) / 64) * 64 + (c & 63)) * R_;
                dst[vpos(r)] = f2bf(tile[rr * 128 + c]);
            }
        } else {
            for (int q = wid * 4; q < wid * 4 + 4; ++q) {
                const int rr = q >> 1, hh = q & 1, r = row0 + rr, head = cin / 64 + hh;
                const float* g = p.in[seg == 0 ? I_AQN : seg == 1 ? I_AKN : seg == 3 ? I_BQN : I_BKN];
                bf16_t* dst = B.qkv + (seg == 0 ? O_QA : seg == 1 ? O_KA : seg == 3 ? O_QB : O_KB) + ((size_t)head * R_ + r) * 64;
                head64_norm_rope(tile + rr * 128 + hh * 64, g, (seg < 2) && r >= 256, B.rope, r - 256, dst, lane);
            }
        }
        __syncthreads();
    }
}

__device__ __forceinline__ float dot8p(u32x4 k, u32 q0, u32 q1, u32 q2, u32 q3) {
    float t = __uint_as_float(k.x << 16) * __uint_as_float(q0 << 16);
    t += __uint_as_float(k.x & 0xffff0000u) * __uint_as_float(q0 & 0xffff0000u);
    t += __uint_as_float(k.y << 16) * __uint_as_float(q1 << 16);
    t += __uint_as_float(k.y & 0xffff0000u) * __uint_as_float(q1 & 0xffff0000u);
    t += __uint_as_float(k.z << 16) * __uint_as_float(q2 << 16);
    t += __uint_as_float(k.z & 0xffff0000u) * __uint_as_float(q2 & 0xffff0000u);
    t += __uint_as_float(k.w << 16) * __uint_as_float(q3 << 16);
    t += __uint_as_float(k.w & 0xffff0000u) * __uint_as_float(q3 & 0xffff0000u);
    return t;
}
template <int DQK, int DVT>
__device__ __forceinline__ void naive_dense(const bf16_t* __restrict__ q, const bf16_t* __restrict__ Kb, const bf16_t* __restrict__ VT, int nk, float scale, float (&O)[DVT], float& lsum) {
    u32x4 qp[DQK / 8];
#pragma unroll
    for (int i = 0; i < DQK / 8; ++i) qp[i] = *(const u32x4*)(q + i * 8);
#pragma unroll
    for (int d = 0; d < DVT; ++d) O[d] = 0.f;
    float m = -1e30f, l = 0.f;
    for (int c = 0; c < nk; c += 8) {
        float s[8];
#pragma unroll
        for (int j = 0; j < 8; ++j) {
            const int key = (c & ~15) + swap23((c & 15) + j);
            const bf16_t* kr = Kb + (size_t)key * DQK; float t = 0.f;
#pragma unroll
            for (int i = 0; i < DQK / 8; ++i) t += dot8p(*(const u32x4*)(kr + i * 8), qp[i].x, qp[i].y, qp[i].z, qp[i].w);
            s[j] = t * scale;
        }
        float cm = s[0];
#pragma unroll
        for (int j = 1; j < 8; ++j) cm = fmaxf(cm, s[j]);
        const float mn = fmaxf(m, cm), alpha = __expf(m - mn);
        float ps = 0.f;
#pragma unroll
        for (int j = 0; j < 8; ++j) { s[j] = __expf(s[j] - mn); ps += s[j]; }
        l = l * alpha + ps; m = mn;
#pragma unroll
        for (int d = 0; d < DVT; ++d) {
            float a[8]; unpack8(*(const u32x4*)(VT + (size_t)d * R_ + c), a);
            float t = O[d] * alpha;
#pragma unroll
            for (int j = 0; j < 8; ++j) t += s[j] * a[j];
            O[d] = t;
            if ((d & 7) == 7) __builtin_amdgcn_sched_barrier(0);
        }
    }
    lsum = l;
}

__device__ void phase_attn0(const Params& p, char* lds, int bid, int nblk) {
    Bufs B(p);
    const int tid = ltid();
    float* xch = (float*)lds;
    const float lam = B.scal[0];
    for (int item = bid + ((OPTA & 1) ? 1040 : 0); item < ((OPTA & 4) ? 1040 : 1300); item += nblk) {
        if (item < 1040) {
            const int head = item / 260, chunk = item % 260, role = tid >> 6, m = role >> 2, qt = role & 3, qi = tid & 63, r = chunk * 64 + qi, sub = head * 2 + m;
            const int nk = chunk < 4 ? 256 : R_;
            float O[32]; float l;
            naive_dense<64, 32>(B.qkv + O_QA + ((size_t)sub * R_ + r) * 64, B.qkv + O_KA + (size_t)sub * R_ * 64, B.qkv + O_VAT + ((size_t)head * 128 + qt * 32) * R_, nk, 0.125f, O, l);
            const float inv = 1.f / l;
#pragma unroll
            for (int d = 0; d < 32; ++d) O[d] *= inv;
            float* xh = xch + (qt * 64 + qi) * 33;
            __syncthreads();
            if (m == 1) {
#pragma unroll
                for (int d = 0; d < 32; ++d) xh[d] = O[d];
            }
            __syncthreads();
            if (m == 0) {
#pragma unroll
                for (int d = 0; d < 32; ++d) O[d] -= lam * xh[d];
            }
            __syncthreads();
            float ss = 0.f;
#pragma unroll
            for (int d = 0; d < 32; ++d) ss += O[d] * O[d];
            if (m == 0) xh[0] = ss;
            __syncthreads();
            if (m == 0) {
                const float tot = xch[(0 * 64 + qi) * 33] + xch[(1 * 64 + qi) * 33] + xch[(2 * 64 + qi) * 33] + xch[(3 * 64 + qi) * 33];
                const float rr = rsqrtf(tot * (1.f / 128.f) + EPS_) * 0.8f;
                bf16_t* dst = B.mix + (size_t)r * 1024 + head * 128 + qt * 32;
                const float* g = p.in[I_SUBLN] + qt * 32;
#pragma unroll
                for (int d = 0; d < 32; d += 2) *(u32*)(dst + d) = (u32)f2bf(O[d] * rr * g[d]) | ((u32)f2bf(O[d + 1] * rr * g[d + 1]) << 16);
            }
            __syncthreads();
        } else {
            const int idx = (item - 1040) * NT + tid, h = idx / R_, r = idx % R_;
            const bf16_t* q = B.qkv + O_QB + ((size_t)h * R_ + r) * 64;
            const bf16_t* Kb = B.qkv + O_KB + (size_t)h * R_ * 64;
            const bf16_t* VT = B.qkv + O_VBT + (size_t)h * 64 * R_;
            float qf[64];
#pragma unroll
            for (int i = 0; i < 8; ++i) { float a[8]; unpack8(*(const u32x4*)(q + i * 8), a);
#pragma unroll
                for (int j = 0; j < 8; ++j) qf[i * 8 + j] = a[j] * 0.125f; }
            float O[64];
#pragma unroll
            for (int d = 0; d < 64; ++d) O[d] = 0.f;
            float m = -1e30f, l = 0.f;
            const int t = r - 256, row = t >> 6, col = t & 63;
            const int rs = min(max(row - 4, 0), 248), cs = min(max(col - 8, 0), 48);
            const int nkeys = r < 256 ? 256 : 384;
            for (int kk = 0; kk < nkeys; ++kk) {
                int key; float bias = 0.f;
                if (kk < 256) key = kk;
                else { const int w = kk - 256, kr = rs + (w >> 4), kc = cs + (w & 15); key = 256 + kr * 64 + kc; bias = p.in[I_RPB][(h * 15 + (kr - row + 7)) * 31 + (kc - col + 15)]; }
                const bf16_t* krow = Kb + (size_t)key * 64; float s = bias;
#pragma unroll
                for (int i = 0; i < 8; ++i) { float a[8]; unpack8(*(const u32x4*)(krow + i * 8), a);
#pragma unroll
                    for (int j = 0; j < 8; ++j) s += a[j] * qf[i * 8 + j]; }
                const float mn = fmaxf(m, s), alpha = __expf(m - mn), pp = __expf(s - mn);
                l = l * alpha + pp; m = mn;
                const int vp = vpos(key);
#pragma unroll
                for (int d = 0; d < 64; ++d) O[d] = O[d] * alpha + pp * bf2f(VT[(size_t)d * R_ + vp]);
            }
            const float inv = 1.f / l;
            bf16_t* dst = B.mix + (size_t)r * 1024 + 512 + h * 64;
#pragma unroll
            for (int d = 0; d < 64; d += 2) *(u32*)(dst + d) = (u32)f2bf(O[d] * inv) | ((u32)f2bf(O[d + 1] * inv) << 16);
        }
    }
}

__device__ void phase_out(const Params& p, int l, int bid, int nblk) {
    Bufs B(p);
    const int tid = ltid(), cc = tid & 127, rg = tid >> 7;
    const float* W = p.in[l == 0 ? I_EWOUT : I_OWOUT];
    const int rt0 = l == 0 ? 0 : 16, nrt = R_ / 16 - rt0;
    for (int item = bid; item < nrt * 8; item += nblk) {
        const int rt = rt0 + item / 8, ct = item % 8, row0 = rt * 16, col = ct * 128 + cc;
        const bf16_t* ap[4];
#pragma unroll
        for (int i = 0; i < 4; ++i) ap[i] = B.mix + (size_t)(row0 + rg * 4 + i) * 1024;
        float acc[4];
        tile_linear<4>(acc, 1024, ap, W, 1024, col);
#pragma unroll
        for (int i = 0; i < 4; ++i) {
            const int r = row0 + rg * 4 + i;
            if (r < 256) B.xc[(size_t)r * 1024 + col] = p.in[I_CTX][(size_t)r * 1024 + col] + modp(B, l, 1, 2)[col] * acc[i];
            else { const size_t o = (size_t)(r - 256) * 1024 + col; p.out[o] = (l == 0 ? p.in[I_X][o] : p.out[o]) + modp(B, l, 0, 2)[col] * acc[i]; }
        }
    }
}

__device__ void phase_up(const Params& p, int l, char* lds, int bid, int nblk) {
    Bufs B(p);
    float* tile = (float*)lds;
    const int tid = ltid(), cc = tid & 127, rg = tid >> 7;
    const float* W = p.in[I_FUP] + (size_t)l * 1024 * F2_;
    const float* cw = p.in[I_FCW] + (size_t)l * 3 * F2_; const float* cb = p.in[I_FCB] + (size_t)l * F2_;
    const int rt0 = l == 0 ? 0 : 16, nrt = R_ / 16 - rt0;
    for (int item = bid; item < nrt * 44; item += nblk) {
        const int rt = rt0 + item / 44, ct = item % 44, row0 = rt * 16, c0 = ct * 64;
        const int lo = row0 < 256 ? 0 : 256, hi = row0 < 256 ? 256 : R_;
        const int wcol = cc < 64 ? c0 + cc : F_ + c0 + (cc - 64);
        const bf16_t* ap[5];
#pragma unroll
        for (int i = 0; i < 5; ++i) { const int rr = rg * 5 + i, r = row0 - 1 + rr; ap[i] = (rr < 18 && r >= lo && r < hi) ? B.h + (size_t)hrow(r) * 1024 : nullptr; }
        float acc[5];
        tile_linear<5>(acc, 1024, ap, W, F2_, wcol);
#pragma unroll
        for (int i = 0; i < 5; ++i) tile[(rg * 5 + i) * 128 + cc] = acc[i];
        __syncthreads();
        for (int e = tid; e < 16 * 64; e += NT) {
            const int rr = e >> 6, c = e & 63, ca = c0 + c, cg = F_ + c0 + c;
            const float a = cb[ca] + tile[rr * 128 + c] * cw[ca] + tile[(rr + 1) * 128 + c] * cw[F2_ + ca] + tile[(rr + 2) * 128 + c] * cw[2 * F2_ + ca];
            const float g = cb[cg] + tile[rr * 128 + 64 + c] * cw[cg] + tile[(rr + 1) * 128 + 64 + c] * cw[F2_ + cg] + tile[(rr + 2) * 128 + 64 + c] * cw[2 * F2_ + cg];
            B.act[(size_t)(row0 + rr) * F_ + ca] = f2bf(a * (g / (1.f + __expf(-g))));
        }
        __syncthreads();
    }
}

__device__ void phase_down(const Params& p, int l, int bid, int nblk) {
    Bufs B(p);
    const int tid = ltid(), cc = tid & 127, rg = tid >> 7;
    const float* W = p.in[I_FDOWN] + (size_t)l * F_ * 1024;
    const int rt0 = l == 0 ? 0 : 16, nrt = R_ / 16 - rt0;
    for (int item = bid; item < nrt * 8; item += nblk) {
        const int rt = rt0 + item / 8, ct = item % 8, row0 = rt * 16, col = ct * 128 + cc;
        const bf16_t* ap[4];
#pragma unroll
        for (int i = 0; i < 4; ++i) ap[i] = B.act + (size_t)(row0 + rg * 4 + i) * F_;
        float acc[4];
        tile_linear<4>(acc, F_, ap, W, 1024, col);
#pragma unroll
        for (int i = 0; i < 4; ++i) {
            const int r = row0 + rg * 4 + i;
            if (r < 256) B.xc[(size_t)r * 1024 + col] += modp(B, l, 1, 5)[col] * acc[i];
            else p.out[(size_t)(r - 256) * 1024 + col] += modp(B, l, 0, 5)[col] * acc[i];
        }
    }
}

__device__ void phase_qkv1a(const Params& p, char* lds, int bid, int nblk) {
    Bufs B(p);
    float* tile = (float*)lds;
    const int tid = ltid(), cc = tid & 127, rg = tid >> 7, wid = tid >> 6, lane = tid & 63;
    const float* W = p.in[I_OWIN];
    for (int item = bid; item < (R_ / 16) * 12; item += nblk) {
        const int rt = item / 12, ct = item % 12, row0 = rt * 16, v0 = ct * 128;
        const int v = v0 + cc;
        int wcol;
        if (v < 640) wcol = v; else if (v < 1152) wcol = 672 + (v - 640); else if (v < 1280) wcol = 1184 + (v - 1152); else if (v < 1408) wcol = 1312 + (v - 1280);
        else if (v < 1440) wcol = 640 + (v - 1408); else wcol = -1;
        const bf16_t* ap[4];
#pragma unroll
        for (int i = 0; i < 4; ++i) ap[i] = B.h + (size_t)hrow(row0 + rg * 4 + i) * 1024;
        float acc[4];
        tile_linear<4>(acc, 1024, ap, W, 1440, wcol);
#pragma unroll
        for (int i = 0; i < 4; ++i) tile[(rg * 4 + i) * 128 + cc] = acc[i];
        __syncthreads();
        if (ct < 5) {
            for (int e = tid; e < 16 * 128; e += NT) {
                const int rr = e >> 7, c = e & 127, r = row0 + rr;
                if (ct < 3) B.qkv[O_CQ + (size_t)r * 384 + v0 + c] = f2bf(tile[e]);
                else B.qkv[O_CKV + (size_t)r * 256 + (v0 - 384) + c] = f2bf(tile[e]);
            }
        } else if (ct < 10) {
            for (int q = wid * 4; q < wid * 4 + 4; ++q) {
                const int rr = q >> 1, hh = q & 1, r = row0 + rr;
                if (ct < 9) head64_norm_rope(tile + rr * 128 + hh * 64, p.in[I_DQN], r >= 256, B.rope, r - 256, B.qkv + O_GQ + ((size_t)((ct - 5) * 2 + hh) * R_ + r) * 64, lane);
                else head64_norm_rope(tile + rr * 128 + hh * 64, p.in[I_DKN], r >= 256, B.rope, r - 256, B.qkv + O_GK + ((size_t)hh * R_ + r) * 64, lane);
            }
        } else if (ct == 10) {
            for (int e = tid; e < 16 * 128; e += NT) {
                const int c = e >> 4, rr = e & 15, r = row0 + rr;
                B.qkv[O_GVT + ((size_t)(c >> 6) * 64 + (c & 63)) * R_ + vpos(r)] = f2bf(tile[rr * 128 + c]);
            }
        } else {
            for (int e = tid; e < 16 * 32; e += NT) { const int rr = e >> 5, c = e & 31; B.qkv[O_CKR + (size_t)(row0 + rr) * 32 + c] = f2bf(tile[rr * 128 + c]); }
        }
        __syncthreads();
    }
}

__device__ __forceinline__ void head96_norm_rope(const float* row, const float* g, bool rope, const float* tab, int t, bf16_t* dst, int lane) {
    const float v0 = row[lane], v1 = lane < 32 ? row[64 + lane] : 0.f;
    const float ss = wave_sum(v0 * v0 + v1 * v1);
    const float rr = rsqrtf(ss * (1.f / 96.f) + EPS_);
    dst[lane] = f2bf(v0 * rr * g[lane]);
    if (lane < 32) {
        float y = v1 * rr * g[64 + lane];
        if (rope) {
            const float yp = row[64 + (lane ^ 16)] * rr * g[64 + (lane ^ 16)];
            const float2 cs = rope32(tab, t, lane & 15);
            y = lane < 16 ? (y * cs.x - yp * cs.y) : (yp * cs.y + y * cs.x);
        }
        dst[64 + lane] = f2bf(y);
    }
}

__device__ void phase_qkv1b(const Params& p, char* lds, int bid, int nblk) {
    Bufs B(p);
    float* tile = (float*)lds;
    float* rsl = (float*)lds + 16 * 128;
    const int tid = ltid(), cc = tid & 127, rg = tid >> 7, wid = tid >> 6, lane = tid & 63;
    for (int item = bid; item < (R_ / 16) * 16; item += nblk) {
        const int rt = item / 16, ht = item % 16, row0 = rt * 16;
        const bool isq = ht < 8; const int head = ht & 7;
        const int K = isq ? 384 : 256;
        const bf16_t* src = B.qkv + (isq ? O_CQ : O_CKV);
        for (int rr = wid * 2; rr < wid * 2 + 2; ++rr) {
            float ss = 0.f;
            for (int k = lane; k < K; k += 64) { const float v = bf2f(src[(size_t)(row0 + rr) * K + k]); ss += v * v; }
            ss = wave_sum(ss);
            if (lane == 0) rsl[rr] = rsqrtf(ss / (float)K + EPS_);
        }
        __syncthreads();
        const bf16_t* ap[4]; float rs[4];
#pragma unroll
        for (int i = 0; i < 4; ++i) { ap[i] = src + (size_t)(row0 + rg * 4 + i) * K; rs[i] = rsl[rg * 4 + i]; }
        float acc[4];
        if (isq) tile_linear_g<4>(acc, 384, ap, rs, p.in[I_CQAN], p.in[I_CWQB], 768, cc < 96 ? head * 96 + cc : -1);
        else tile_linear_g<4>(acc, 256, ap, rs, p.in[I_CKVAN], p.in[I_CWKVB], 1024, head * 128 + cc);
#pragma unroll
        for (int i = 0; i < 4; ++i) tile[(rg * 4 + i) * 128 + cc] = acc[i];
        __syncthreads();
        if (isq) {
            for (int rr = wid * 2; rr < wid * 2 + 2; ++rr) { const int r = row0 + rr;
                head96_norm_rope(tile + rr * 128, p.in[I_CQN], r >= 256, B.rope, r - 256, B.qkv + O_MQ + ((size_t)head * R_ + r) * 96, lane); }
        } else {
            for (int e = tid; e < 16 * 64; e += NT) { const int d = e >> 4, rr = e & 15; B.qkv[O_MVT + ((size_t)head * 64 + d) * R_ + vpos(row0 + rr)] = f2bf(tile[rr * 128 + 64 + d]); }
            __syncthreads();
            for (int e = tid; e < 16 * 32; e += NT) { const int rr = e >> 5, c = e & 31; tile[rr * 128 + 64 + c] = bf2f(B.qkv[O_CKR + (size_t)(row0 + rr) * 32 + c]); }
            __syncthreads();
            for (int rr = wid * 2; rr < wid * 2 + 2; ++rr) { const int r = row0 + rr;
                head96_norm_rope(tile + rr * 128, p.in[I_CKN], r >= 256, B.rope, r - 256, B.qkv + O_MK + ((size_t)head * R_ + r) * 96, lane); }
        }
        __syncthreads();
    }
}

__device__ void phase_attn1(const Params& p, int bid, int nblk) {
    Bufs B(p);
    const int tid = ltid();
    for (int item = bid + ((OPTA & 2) ? 512 : 0); item < ((OPTA & 8) ? 512 : 1024); item += nblk) {
        if (item < 512) {
            const int head = item / 64, half = tid >> 8, r = 256 + (item % 64) * 256 + (tid & 255);
            float O[32]; float l;
            naive_dense<96, 32>(B.qkv + O_MQ + ((size_t)head * R_ + r) * 96, B.qkv + O_MK + (size_t)head * R_ * 96, B.qkv + O_MVT + ((size_t)head * 64 + half * 32) * R_, R_, 0.10206207261596575f, O, l);
            const float inv = 1.f / l;
            bf16_t* dst = B.mix + (size_t)r * 1024 + head * 64 + half * 32;
#pragma unroll
            for (int d = 0; d < 32; d += 2) *(u32*)(dst + d) = (u32)f2bf(O[d] * inv) | ((u32)f2bf(O[d + 1] * inv) << 16);
        } else {
            const int idx = (item - 512) * NT + tid, half = idx / (8 * T_), hq = (idx / T_) & 7, t = idx % T_, r = 256 + t, kvh = hq >> 2;
            const bf16_t* q = B.qkv + O_GQ + ((size_t)hq * R_ + r) * 64;
            const bf16_t* Kb = B.qkv + O_GK + (size_t)kvh * R_ * 64;
            const bf16_t* VT = B.qkv + O_GVT + ((size_t)kvh * 64 + half * 32) * R_;
            u32x4 qp[8];
#pragma unroll
            for (int i = 0; i < 8; ++i) qp[i] = *(const u32x4*)(q + i * 8);
            float O[32];
#pragma unroll
            for (int d = 0; d < 32; ++d) O[d] = 0.f;
            float m = -1e30f, l = 0.f;
            const int j0 = max(t - 128, 0), j1 = min(t + 128, T_ - 1);
            const int nkeys = 256 + (j1 - j0 + 1);
            for (int kk = 0; kk < nkeys; ++kk) {
                const int key = kk < 256 ? kk : 256 + j0 + (kk - 256);
                const bf16_t* krow = Kb + (size_t)key * 64; float s = 0.f;
#pragma unroll
                for (int i = 0; i < 8; ++i) s += dot8p(*(const u32x4*)(krow + i * 8), qp[i].x, qp[i].y, qp[i].z, qp[i].w);
                s *= 0.125f;
                const float mn = fmaxf(m, s), alpha = __expf(m - mn), pp = __expf(s - mn);
                l = l * alpha + pp; m = mn;
                const int vp = vpos(key);
#pragma unroll
                for (int d = 0; d < 32; ++d) O[d] = O[d] * alpha + pp * bf2f(VT[(size_t)d * R_ + vp]);
            }
            { const float s = p.in[I_SINK][hq]; const float mn = fmaxf(m, s), alpha = __expf(m - mn); l = l * alpha + __expf(s - mn);
#pragma unroll
              for (int d = 0; d < 32; ++d) O[d] *= alpha; }
            const float inv = 1.f / l;
            bf16_t* dst = B.mix + (size_t)r * 1024 + 512 + hq * 64 + half * 32;
#pragma unroll
            for (int d = 0; d < 32; d += 2) *(u32*)(dst + d) = (u32)f2bf(O[d] * inv) | ((u32)f2bf(O[d + 1] * inv) << 16);
        }
    }
}

#define LAS __attribute__((address_space(3)))
typedef short bf16x8 __attribute__((ext_vector_type(8)));
typedef float f32x4 __attribute__((ext_vector_type(4)));
constexpr int LDS_STAGE = 131072, LDS_XCH = LDS_STAGE, LDS_BYTES = 147456;

__device__ __forceinline__ u32 pk2(float lo, float hi) { return (u32)f2bf(lo) | ((u32)f2bf(hi) << 16); }

namespace pg8 {
constexpr int BM = 256, BK = 64, HALF = 128, HTB = HALF * BK * 2, NXCD = 8, WGM = 8;
__host__ __device__ __forceinline__ int lds_byte(int r, int c) { const int st = (r >> 4) * 2 + (c >> 5), rr = r & 15, cc = c & 31, ob = rr * 64 + cc * 2; return st * 1024 + (ob ^ (((ob >> 9) & 1) << 5)); }
__host__ __device__ __forceinline__ void stage_rc(int b, int& R, int& C) { const int st = b / 1024, sb = b % 1024, swz = sb ^ (((sb >> 9) & 1) << 5); R = (st >> 1) * 16 + swz / 64; C = (st & 1) * 32 + (swz % 64) / 2; }
struct Unit { int pm, pn; };
struct Gemm { const bf16_t* A; const bf16_t* Bt; int K; };
struct Order {
    int nM, nN, nwg, G, c, pm0, amode;
    __device__ void init(int nM_, int nN_, int G_, int c_, int pm0_, int amode_) { nM = nM_; nN = nN_; nwg = nM * nN; G = G_; c = c_; pm0 = pm0_; amode = amode_; }
    __device__ bool next(int i, Unit& u) const {
        const long L = (long)i * G + c; if (L >= nwg) return false;
        int wgid = (int)L; { const int q = nwg / NXCD, r = nwg % NXCD, xcd = wgid % NXCD, off = wgid / NXCD; wgid = (xcd < r ? xcd * (q + 1) : r * (q + 1) + (xcd - r) * q) + off; }
        const int nig = WGM * nN, gid = wgid / nig, fm = gid * WGM, gsz = (nM - fm) < WGM ? (nM - fm) : WGM;
        u.pm = pm0 + fm + ((wgid % nig) % gsz); u.pn = (wgid % nig) / gsz; return true;
    }
    __device__ __forceinline__ int arow(int pm) const { return amode == 0 ? 256 * pm : amode == 1 ? (pm == 0 ? 1 : 2 + 256 * pm) : (pm < 2 ? 254 * pm : 257 + 254 * (pm - 2)); }
    __device__ __forceinline__ void a_ready(const Unit&) const {}
    __device__ __forceinline__ void done(const Unit&) const {}
};

template <class Epi, class Sched, bool ALIGN_EPI, bool SP2>
__device__ __forceinline__ void gemm_phase(LAS unsigned char* lds, const Gemm g, const Sched& S, const Epi& E) {
    const int tid = ltid(), wid = __builtin_amdgcn_readfirstlane(tid >> 6), lane = tid & 63, wr = wid >> 2, wc = wid & 3, fr = lane & 15, fq = lane >> 4;
    int K_ = g.K; asm volatile("" : "+s"(K_));
    const int K = K_, nt = K / BK;
    unsigned voffA[2], voffB[2];
#pragma unroll
    for (int i = 0; i < 2; ++i) { int R, C; stage_rc(tid * 16 + i * 8192, R, C); voffA[i] = (unsigned)(R * K + C) * 2u; voffB[i] = (unsigned)(R * K + C) * 2u; }
    const size_t kstep = (size_t)(BK * 2);
    const size_t hstep = (size_t)HALF * K * 2;
    const size_t tstep = 2 * hstep;
    const size_t rstep = (size_t)K * 2;
    const unsigned ldsw = (unsigned)wid * 1024u;
    const int aoff = lds_byte(wr * 64 + fr, fq * 8), boff = lds_byte(wc * 32 + fr, fq * 8);
#define PG8_SA(b, h) (((b) * 2 + (h)) * HTB)
#define PG8_SB(b, h) ((4 + (b) * 2 + (h)) * HTB)
#define PG8_STAGE(bufoff, gbase, voff) do { _Pragma("unroll") for (int _i = 0; _i < 2; ++_i) \
        __builtin_amdgcn_global_load_lds((const unsigned*)((const char*)(gbase) + (voff)[_i]), (LAS unsigned*)(lds + (bufoff) + ldsw + _i * 8192), 16, 0, 0); } while (0)
#define PG8_LDA(dst, b, h) do { _Pragma("unroll") for (int m = 0; m < 4; ++m) _Pragma("unroll") for (int k = 0; k < 2; ++k) dst[m][k] = *(const LAS bf16x8*)(lds + PG8_SA(b, h) + aoff + m * 2048 + k * 1024); } while (0)
#define PG8_LDB(dst, b, h) do { _Pragma("unroll") for (int n = 0; n < 2; ++n) _Pragma("unroll") for (int k = 0; k < 2; ++k) dst[n][k] = *(const LAS bf16x8*)(lds + PG8_SB(b, h) + boff + n * 2048 + k * 1024); } while (0)
#define PG8_MMA(ai, bj, At, Bt) do { __builtin_amdgcn_s_setprio(1); _Pragma("unroll") for (int m = 0; m < 4; ++m) _Pragma("unroll") for (int n = 0; n < 2; ++n) _Pragma("unroll") for (int k = 0; k < 2; ++k) \
        acc[ai][bj][m][n] = __builtin_amdgcn_mfma_f32_16x16x32_bf16(Bt[n][k], At[m][k], acc[ai][bj][m][n], 0, 0, 0); __builtin_amdgcn_s_setprio(0); } while (0)
#define PG8_WAIT_V(n) asm volatile("s_waitcnt vmcnt(" #n ")" ::: "memory")
#define PG8_WAIT_L(n) asm volatile("s_waitcnt lgkmcnt(" #n ")" ::: "memory")
#define PG8_BAR __builtin_amdgcn_s_barrier()
#define PG8_SCHED __builtin_amdgcn_sched_barrier(0)
    Unit cur, nxt; int ui = 0;
    if (!S.next(0, cur)) return;
    f32x4 acc[2][2][4][2];
#pragma unroll
    for (int a = 0; a < 2; ++a)
#pragma unroll
        for (int b = 0; b < 2; ++b)
#pragma unroll
            for (int m = 0; m < 4; ++m)
#pragma unroll
                for (int n = 0; n < 2; ++n) acc[a][b][m][n] = (f32x4){0.f, 0.f, 0.f, 0.f};
    bf16x8 At[4][2], B0[2][2], B1[2][2];
    const char* cA = (const char*)g.A + (size_t)S.arow(cur.pm) * rstep; const char* cB = (const char*)g.Bt + (size_t)cur.pn * tstep;
    S.a_ready(cur);
    if constexpr (SP2) {
        PG8_STAGE(PG8_SB(0, 0), cB, voffB); PG8_STAGE(PG8_SB(0, 1), cB + hstep, voffB); PG8_STAGE(PG8_SA(0, 0), cA, voffA); PG8_STAGE(PG8_SA(0, 1), cA + hstep, voffA);
        if (wr == 1) PG8_BAR;
        PG8_WAIT_V(2); PG8_BAR;
        PG8_STAGE(PG8_SB(1, 0), cB + kstep, voffB); PG8_STAGE(PG8_SA(1, 0), cA + kstep, voffA); PG8_STAGE(PG8_SB(1, 1), cB + hstep + kstep, voffB);
        PG8_WAIT_V(6); PG8_BAR;
    } else {
        PG8_STAGE(PG8_SB(0, 0), cB, voffB); PG8_STAGE(PG8_SA(0, 0), cA, voffA); PG8_STAGE(PG8_SB(0, 1), cB + hstep, voffB); PG8_STAGE(PG8_SA(0, 1), cA + hstep, voffA);
        if (wr == 1) PG8_BAR;
        PG8_WAIT_V(4); PG8_BAR;
        PG8_STAGE(PG8_SB(1, 0), cB + kstep, voffB); PG8_STAGE(PG8_SA(1, 0), cA + kstep, voffA); PG8_STAGE(PG8_SB(1, 1), cB + hstep + kstep, voffB);
        PG8_WAIT_V(6); PG8_BAR;
    }
    for (;;) {
        const bool has_next = S.next(ui + 1, nxt);
        const char* nA = has_next ? (const char*)g.A + (size_t)S.arow(nxt.pm) * rstep : cA; const char* nB = has_next ? (const char*)g.Bt + (size_t)nxt.pn * tstep : cB;
        for (int t = 0; t < nt; t += 2) {
            const bool last = (t == nt - 2);
            const char* a1 = cA + (size_t)(t + 1) * kstep;
            const char* a2 = last ? nA : cA + (size_t)(t + 2) * kstep; const char* b2 = last ? nB : cB + (size_t)(t + 2) * kstep;
            const char* a3 = a2 + kstep; const char* b3 = b2 + kstep;
            if (last && has_next) S.a_ready(nxt);
            if constexpr (SP2) {
            PG8_LDB(B0, 0, 0); PG8_LDB(B1, 0, 1); PG8_SCHED; PG8_LDA(At, 0, 0); PG8_STAGE(PG8_SA(1, 1), a1 + hstep, voffA);
            PG8_WAIT_V(8); PG8_WAIT_L(0); PG8_BAR; PG8_MMA(0, 0, At, B0); PG8_MMA(0, 1, At, B1); PG8_BAR; PG8_SCHED;
            PG8_LDA(At, 0, 1); PG8_STAGE(PG8_SB(0, 0), b2, voffB); PG8_STAGE(PG8_SB(0, 1), b2 + hstep, voffB); PG8_STAGE(PG8_SA(0, 0), a2, voffA);
            PG8_WAIT_V(8); PG8_WAIT_L(0); PG8_BAR; PG8_MMA(1, 0, At, B0); PG8_MMA(1, 1, At, B1); PG8_BAR; PG8_SCHED;
            PG8_LDB(B0, 1, 0); PG8_LDB(B1, 1, 1); PG8_SCHED; PG8_LDA(At, 1, 0); PG8_STAGE(PG8_SA(0, 1), a2 + hstep, voffA);
            PG8_WAIT_V(8); PG8_WAIT_L(0); PG8_BAR; PG8_MMA(0, 0, At, B0); PG8_MMA(0, 1, At, B1); PG8_BAR; PG8_SCHED;
            PG8_LDA(At, 1, 1); PG8_STAGE(PG8_SB(1, 0), b3, voffB); PG8_STAGE(PG8_SB(1, 1), b3 + hstep, voffB); PG8_STAGE(PG8_SA(1, 0), a3, voffA);
            PG8_WAIT_V(8); PG8_WAIT_L(0); PG8_BAR; PG8_MMA(1, 0, At, B0); PG8_MMA(1, 1, At, B1); PG8_BAR; PG8_SCHED;
            } else {
            PG8_LDB(B0, 0, 0); PG8_SCHED; PG8_LDA(At, 0, 0); PG8_STAGE(PG8_SA(1, 1), a1 + hstep, voffA);
            PG8_WAIT_L(8); PG8_BAR; PG8_WAIT_L(0); PG8_MMA(0, 0, At, B0); PG8_BAR; PG8_SCHED;
            PG8_LDB(B1, 0, 1); PG8_STAGE(PG8_SB(0, 0), b2, voffB);
            PG8_BAR; PG8_WAIT_L(0); PG8_MMA(0, 1, At, B1); PG8_BAR;
            PG8_LDA(At, 0, 1); PG8_STAGE(PG8_SA(0, 0), a2, voffA);
            PG8_BAR; PG8_WAIT_L(0); PG8_MMA(1, 0, At, B0); PG8_BAR; PG8_SCHED;
            PG8_STAGE(PG8_SB(0, 1), b2 + hstep, voffB);
            PG8_WAIT_V(6); PG8_BAR; PG8_MMA(1, 1, At, B1); PG8_BAR;
            PG8_LDB(B0, 1, 0); PG8_SCHED; PG8_LDA(At, 1, 0); PG8_STAGE(PG8_SA(0, 1), a2 + hstep, voffA);
            PG8_WAIT_L(8); PG8_BAR; PG8_WAIT_L(0); PG8_MMA(0, 0, At, B0); PG8_BAR; PG8_SCHED;
            PG8_LDB(B1, 1, 1); PG8_STAGE(PG8_SB(1, 0), b3, voffB);
            PG8_BAR; PG8_WAIT_L(0); PG8_MMA(0, 1, At, B1); PG8_BAR;
            PG8_LDA(At, 1, 1); PG8_STAGE(PG8_SA(1, 0), a3, voffA);
            PG8_BAR; PG8_WAIT_L(0); PG8_MMA(1, 0, At, B0); PG8_BAR; PG8_SCHED;
            PG8_STAGE(PG8_SB(1, 1), b3 + hstep, voffB);
            PG8_WAIT_V(6); PG8_BAR; PG8_MMA(1, 1, At, B1); PG8_BAR;
            }
        }
        if constexpr (ALIGN_EPI) { if (wr == 0) PG8_BAR; }
        E(acc, cur, wr, wc, fr, fq); S.done(cur);
        if (!has_next) break;
#pragma unroll
        for (int a = 0; a < 2; ++a)
#pragma unroll
            for (int b = 0; b < 2; ++b)
#pragma unroll
                for (int m = 0; m < 4; ++m)
#pragma unroll
                    for (int n = 0; n < 2; ++n) acc[a][b][m][n] = (f32x4){0.f, 0.f, 0.f, 0.f};
        cur = nxt; cA = nA; cB = nB; ++ui;
        if constexpr (ALIGN_EPI) { if (wr == 1) PG8_BAR; }
    }
    PG8_WAIT_V(0);
    if constexpr (!ALIGN_EPI) { if (wr == 0) PG8_BAR; }
    PG8_BAR;
#undef PG8_SA
#undef PG8_SB
#undef PG8_STAGE
#undef PG8_LDA
#undef PG8_LDB
#undef PG8_MMA
#undef PG8_WAIT_V
#undef PG8_WAIT_L
#undef PG8_BAR
#undef PG8_SCHED
}
}

typedef f32x4 AccT[2][2][4][2];
__device__ __forceinline__ const float* launder(const float* p) { asm volatile("" : "+s"(p)); return p; }
#define EPI_IDS() int t_ = ltid(); const int fr = t_ & 15, fq = (t_ >> 4) & 3; const int wid_ = __builtin_amdgcn_readfirstlane(t_ >> 6), wr = wid_ >> 2, wc = wid_ & 3; (void)wr; (void)wc; (void)fr; (void)fq
#define ITER_FENCE() do { asm volatile("" ::: "memory"); __builtin_amdgcn_sched_barrier(0); } while (0)
#define EPI_BARRIER() do { asm volatile("s_waitcnt lgkmcnt(0)" ::: "memory"); __builtin_amdgcn_s_barrier(); asm volatile("" ::: "memory"); } while (0)

__device__ __forceinline__ int vcol_of_row(int J) { const int pn = J >> 8, j = J & 255, bj = j >> 7, wc = (j >> 5) & 3, n = (j >> 4) & 1, fq = (j >> 2) & 3, e = j & 3; return 256 * pn + 64 * wc + 32 * bj + 8 * fq + 4 * n + e; }
__device__ __forceinline__ int gmap(int map, int v) {
    if (map == 0) return v;
    if (map == 1) { const int pn = v >> 8, wc = (v >> 6) & 3, bj = (v >> 5) & 1, x = v & 31, h = 128 * pn + 32 * wc + x; return bj ? F_ + h : h; }
    if (map == 2) { if (v < 384) return v; if (v < 512) return 1184 + (v - 384); if (v < 768) return 384 + (v - 512); if (v < 1280) return 672 + (v - 768);
                    if (v < 1408) return 1312 + (v - 1280); if (v < 1440) return 640 + (v - 1408); return -1; }
    { const int hh = v >> 7, y = v & 127; if (y < 64) return hh * 96 + y; const int x = y - 64; if (x >= 32) return -1; const int fq = x >> 3, n = (x >> 2) & 1, e = x & 3; return hh * 96 + 64 + 16 * n + 4 * fq + e; }
}
__device__ __forceinline__ void prep_item(const float* __restrict__ W, int K, int ldw, bf16_t* Bt, int NV, int map, const float* kscale, float* scr, int item, int lane) {
    const int nb32 = NV / 32, kb = item / nb32, nb = item % nb32, k0 = 64 * kb, J0 = 32 * nb;
    const int col = gmap(map, vcol_of_row(J0 + (lane & 31)));
#pragma unroll 8
    for (int i = 0; i < 32; ++i) { const int kk = 2 * i + (lane >> 5); float v = col >= 0 ? W[(size_t)(k0 + kk) * ldw + col] : 0.f; if (kscale) v *= kscale[k0 + kk]; scr[kk * 33 + (lane & 31)] = v; }
    __builtin_amdgcn_wave_barrier();
    asm volatile("s_waitcnt lgkmcnt(0)" ::: "memory");
    const int c = lane & 7;
#pragma unroll
    for (int j = 0; j < 4; ++j) { const int n = (lane >> 3) + 8 * j; const float* s = scr + (8 * c) * 33 + n;
        u32x4 o; o.x = pk2(s[0 * 33], s[1 * 33]); o.y = pk2(s[2 * 33], s[3 * 33]); o.z = pk2(s[4 * 33], s[5 * 33]); o.w = pk2(s[6 * 33], s[7 * 33]);
        *(u32x4*)(Bt + (size_t)(J0 + n) * K + k0 + 8 * c) = o; }
    asm volatile("s_waitcnt lgkmcnt(0)" ::: "memory");
    __builtin_amdgcn_wave_barrier();
}
__device__ void phase_prep_weights(const Params& p, char* lds, int bid, int nblk) {
    Bufs B(p);
    const int wid = ltid() >> 6, lane = ltid() & 63;
    float* scr = (float*)lds + wid * (64 * 33 + 16);
    constexpr int I0 = 16 * 96, I1 = 16 * 32, I2 = 16 * 176, I3 = 44 * 32, I4 = 16 * 48, I5 = 16 * 32, I6 = 6 * 32, I7 = 4 * 32;
    constexpr int NIT = I0 + I1 + 2 * I2 + 2 * I3 + I4 + I5 + I6 + I7;
    for (int it = bid * 8 + wid; it < NIT; it += nblk * 8) {
        int r = it;
        if (r < I0) { prep_item(p.in[I_EWIN], 1024, 3072, B.wt + W_EIN, 3072, 0, nullptr, scr, r, lane); continue; } r -= I0;
        if (r < I1) { prep_item(p.in[I_EWOUT], 1024, 1024, B.wt + W_EOUT, 1024, 0, nullptr, scr, r, lane); continue; } r -= I1;
        if (r < 2 * I2) { const int l = r / I2; prep_item(p.in[I_FUP] + (size_t)l * 1024 * F2_, 1024, F2_, B.wt + W_UP + (size_t)l * F2_ * 1024, F2_, 1, nullptr, scr, r % I2, lane); continue; } r -= 2 * I2;
        if (r < 2 * I3) { const int l = r / I3; prep_item(p.in[I_FDOWN] + (size_t)l * F_ * 1024, F_, 1024, B.wt + W_DOWN + (size_t)l * 1024 * F_, 1024, 0, nullptr, scr, r % I3, lane); continue; } r -= 2 * I3;
        if (r < I4) { prep_item(p.in[I_OWIN], 1024, 1440, B.wt + W_OIN, 1536, 2, nullptr, scr, r, lane); continue; } r -= I4;
        if (r < I5) { prep_item(p.in[I_OWOUT], 1024, 1024, B.wt + W_OOUT, 1024, 0, nullptr, scr, r, lane); continue; } r -= I5;
        if (r < I6) { prep_item(p.in[I_CWQB], 384, 768, B.wt + W_QB, 1024, 3, p.in[I_CQAN], scr, r, lane); continue; } r -= I6;
        prep_item(p.in[I_CWKVB], 256, 1024, B.wt + W_KVB, 1024, 0, p.in[I_CKVAN], scr, r, lane);
    }
}

__device__ __forceinline__ void head64_epi(const AccT& acc, int ai, int m, const float (&gn)[2][2][4], bool rope, const float* tab, int t, int fq, bf16_t* dst) {
    float ss = 0.f;
#pragma unroll
    for (int bj = 0; bj < 2; ++bj)
#pragma unroll
        for (int n = 0; n < 2; ++n)
#pragma unroll
            for (int e = 0; e < 4; ++e) { const float v = acc[ai][bj][m][n][e]; ss += v * v; }
    ss += __shfl_xor(ss, 16); ss += __shfl_xor(ss, 32);
    const float rr = rsqrtf(ss * (1.f / 64.f) + EPS_);
    float y[2][2][4];
#pragma unroll
    for (int bj = 0; bj < 2; ++bj)
#pragma unroll
        for (int n = 0; n < 2; ++n)
#pragma unroll
            for (int e = 0; e < 4; ++e) y[bj][n][e] = acc[ai][bj][m][n][e] * rr * gn[bj][n][e];
    if (rope) {
        const int pos = fq < 2 ? (t >> 6) : (t & 63);
        const float4* cs = (const float4*)(tab + (pos * 16 + 8 * (fq & 1)) * 2);
#pragma unroll
        for (int n = 0; n < 2; ++n) {
            const float4 c0 = cs[2 * n], c1 = cs[2 * n + 1];
            const float cv[4] = {c0.x, c0.z, c1.x, c1.z}, sv[4] = {c0.y, c0.w, c1.y, c1.w};
#pragma unroll
            for (int e = 0; e < 4; ++e) { const float x1 = y[0][n][e], x2 = y[1][n][e]; y[0][n][e] = x1 * cv[e] - x2 * sv[e]; y[1][n][e] = x1 * sv[e] + x2 * cv[e]; }
        }
    }
#pragma unroll
    for (int bj = 0; bj < 2; ++bj) {
        u32x4 w; w.x = pk2(y[bj][0][0], y[bj][0][1]); w.y = pk2(y[bj][0][2], y[bj][0][3]); w.z = pk2(y[bj][1][0], y[bj][1][1]); w.w = pk2(y[bj][1][2], y[bj][1][3]);
        *(u32x4*)(dst + 32 * bj + 8 * fq) = w;
    }
}
__device__ __forceinline__ void load_gain64(float (&gn)[2][2][4], const float* g, int fq) {
#pragma unroll
    for (int bj = 0; bj < 2; ++bj)
#pragma unroll
        for (int n = 0; n < 2; ++n) { const float4 t = *(const float4*)(g + 32 * bj + 8 * fq + 4 * n); gn[bj][n][0] = t.x; gn[bj][n][1] = t.y; gn[bj][n][2] = t.z; gn[bj][n][3] = t.w; }
}
__device__ __forceinline__ void vt_store(const AccT& acc, int ai, int m, float scale, bf16_t* vt, int fq, int r) {
    const int pos = vpos(r);
#pragma unroll
    for (int bj = 0; bj < 2; ++bj)
#pragma unroll
        for (int n = 0; n < 2; ++n)
#pragma unroll
            for (int e = 0; e < 4; ++e) vt[(size_t)(32 * bj + 8 * fq + 4 * n + e) * R_ + pos] = f2bf(acc[ai][bj][m][n][e] * scale);
}
__device__ __forceinline__ float raw_store(const AccT& acc, int ai, int m, bf16_t* dst, int fq) {
    float ss = 0.f;
#pragma unroll
    for (int bj = 0; bj < 2; ++bj) {
        u32x4 w; const f32x4 a = acc[ai][bj][m][0], b = acc[ai][bj][m][1];
        w.x = pk2(a[0], a[1]); w.y = pk2(a[2], a[3]); w.z = pk2(b[0], b[1]); w.w = pk2(b[2], b[3]);
        *(u32x4*)(dst + 32 * bj + 8 * fq) = w;
        float t[8]; unpack8(w, t);
#pragma unroll
        for (int j = 0; j < 8; ++j) ss += t[j] * t[j];
    }
    return ss;
}

struct EpiQKV0 {
    bf16_t* qkv; const float* rope; const float* gt;
    __device__ __forceinline__ void operator()(const AccT& acc, const pg8::Unit& u, int, int, int, int) const {
        EPI_IDS();
        const int seg = u.pn >> 1, r0 = u.pm * 256 + wr * 64 + fr;
        if (seg == 2 || seg == 5) {
            const size_t vo = seg == 2 ? O_VAT + ((size_t)((u.pn & 1) * 2 + (wc >> 1)) * 128 + 64 * (wc & 1)) * R_ : O_VBT + (size_t)((u.pn & 1) * 4 + wc) * 64 * R_;
            bf16_t* vt = qkv + vo;
#pragma unroll
            for (int ai = 0; ai < 2; ++ai)
#pragma unroll
                for (int m = 0; m < 4; ++m) { vt_store(acc, ai, m, 1.f, vt, fq, r0 + 128 * ai + 16 * m); ITER_FENCE(); }
        } else {
            float gn[2][2][4]; load_gain64(gn, gt + 64 * (seg < 2 ? seg : seg - 1), fq);
            const int head = (u.pn & 1) * 4 + wc;
            const size_t bo = (seg == 0 ? O_QA : seg == 1 ? O_KA : seg == 3 ? O_QB : O_KB) + (size_t)head * R_ * 64;
            bf16_t* base = qkv + bo;
            const bool rp = seg < 2 && u.pm > 0;
#pragma unroll
            for (int ai = 0; ai < 2; ++ai)
#pragma unroll
                for (int m = 0; m < 4; ++m) { const int r = r0 + 128 * ai + 16 * m; head64_epi(acc, ai, m, gn, rp, rope, r - 256, fq, base + (size_t)r * 64); ITER_FENCE(); }
        }
    }
};

struct EpiResid {
    const float* resid_lat; float* dst_lat; const float* resid_ctx; float* dst_ctx; const float* gate_lat; const float* gate_ctx;
    __device__ __forceinline__ void rows(const AccT& acc, const float* __restrict__ resid, float* dst, const float* __restrict__ gate, int row0, int col0) const {
        f32x4 gt[2][2];
#pragma unroll
        for (int bj = 0; bj < 2; ++bj)
#pragma unroll
            for (int n = 0; n < 2; ++n) gt[bj][n] = *(const f32x4*)(gate + col0 + 32 * bj + 4 * n);
#pragma unroll
        for (int ai = 0; ai < 2; ++ai)
#pragma unroll
            for (int m = 0; m < 4; ++m) {
                const size_t ro = (size_t)(row0 + 128 * ai + 16 * m) * 1024 + col0;
#pragma unroll
                for (int bj = 0; bj < 2; ++bj)
#pragma unroll
                    for (int n = 0; n < 2; ++n) { const f32x4 x = *(const f32x4*)(resid + ro + 32 * bj + 4 * n); *(f32x4*)(dst + ro + 32 * bj + 4 * n) = x + gt[bj][n] * acc[ai][bj][m][n]; }
                ITER_FENCE();
            }
    }
    __device__ __forceinline__ void operator()(const AccT& acc, const pg8::Unit& u, int, int, int, int) const {
        EPI_IDS();
        const int col0 = u.pn * 256 + wc * 64 + 8 * fq, rl = 64 * wr + fr;
        if (u.pm == 0) rows(acc, resid_ctx, dst_ctx, gate_ctx, rl, col0);
        else rows(acc, resid_lat, dst_lat, gate_lat, (u.pm - 1) * 256 + rl, col0);
    }
};

#ifndef USE_DPP
#define USE_DPP 0
#endif
__device__ __forceinline__ float rot_prev(float x, int lane) {
#if USE_DPP
    return __builtin_bit_cast(float, __builtin_amdgcn_update_dpp(0, __builtin_bit_cast(int, x), 0x121, 0xf, 0xf, false));
#else
    return __shfl(x, (lane & 48) | ((lane - 1) & 15));
#endif
}
__device__ __forceinline__ float rot_next(float x, int lane) {
#if USE_DPP
    return __builtin_bit_cast(float, __builtin_amdgcn_update_dpp(0, __builtin_bit_cast(int, x), 0x12F, 0xf, 0xf, false));
#else
    return __shfl(x, (lane & 48) | ((lane + 1) & 15));
#endif
}
struct EpiUp {
    bf16_t* act; const float* cw; const float* cb; LAS float* xch;
    __device__ __forceinline__ int xidx(int c, int which, int wc, int fq, int bj, int n) const { return (((c * 2 + which) * 4 + wc) * 64) + fq * 16 + bj * 8 + n * 4; }
    __device__ __forceinline__ void operator()(const AccT& acc, const pg8::Unit& u, int, int, int, int) const {
        EPI_IDS();
        const int lane = fq * 16 + fr;
        if (fr == 0) {
#pragma unroll
            for (int ai = 0; ai < 2; ++ai)
#pragma unroll
                for (int bj = 0; bj < 2; ++bj)
#pragma unroll
                    for (int n = 0; n < 2; ++n) *(LAS f32x4*)(xch + xidx(2 * ai + wr, 0, wc, fq, bj, n)) = acc[ai][bj][0][n];
        }
        if (fr == 15) {
#pragma unroll
            for (int ai = 0; ai < 2; ++ai)
#pragma unroll
                for (int bj = 0; bj < 2; ++bj)
#pragma unroll
                    for (int n = 0; n < 2; ++n) *(LAS f32x4*)(xch + xidx(2 * ai + wr, 1, wc, fq, bj, n)) = acc[ai][bj][3][n];
        }
        EPI_BARRIER();
        const bool isctx = u.pm < 2;
        const int seq0 = isctx ? 254 * u.pm : 254 * (u.pm - 2), lim = isctx ? 256 : T_, rbase = isctx ? 0 : 256;
#pragma unroll
        for (int n = 0; n < 2; ++n) {
            const int h0 = 128 * u.pn + 32 * wc + 8 * fq + 4 * n;
            f32x4 w0[2], w1[2], w2[2], bb[2];
#pragma unroll
            for (int bj = 0; bj < 2; ++bj) { const int c = bj * F_ + h0; w0[bj] = *(const f32x4*)(cw + c); w1[bj] = *(const f32x4*)(cw + F2_ + c); w2[bj] = *(const f32x4*)(cw + 2 * F2_ + c); bb[bj] = *(const f32x4*)(cb + c); }
#pragma unroll
            for (int ai = 0; ai < 2; ++ai) {
                const int c = 2 * ai + wr;
                f32x4 eup[2], edn[2];
#pragma unroll
                for (int bj = 0; bj < 2; ++bj) {
                    eup[bj] = c > 0 ? *(const LAS f32x4*)(xch + xidx(c - 1, 1, wc, fq, bj, n)) : (f32x4){0.f, 0.f, 0.f, 0.f};
                    edn[bj] = c < 3 ? *(const LAS f32x4*)(xch + xidx(c + 1, 0, wc, fq, bj, n)) : (f32x4){0.f, 0.f, 0.f, 0.f};
                }
#pragma unroll
                for (int m = 0; m < 4; ++m) {
                    f32x4 cv[2];
#pragma unroll
                    for (int bj = 0; bj < 2; ++bj) {
                        const f32x4 x = acc[ai][bj][m][n];
                        f32x4 up, dn;
#pragma unroll
                        for (int e = 0; e < 4; ++e) {
                            const float ps = rot_prev(x[e], lane), ns = rot_next(x[e], lane);
                            float pe, ne;
                            if (m > 0) pe = rot_prev(acc[ai][bj][m > 0 ? m - 1 : 0][n][e], lane); else pe = eup[bj][e];
                            if (m < 3) ne = rot_next(acc[ai][bj][m < 3 ? m + 1 : 3][n][e], lane); else ne = edn[bj][e];
                            up[e] = fr == 0 ? pe : ps; dn[e] = fr == 15 ? ne : ns;
                        }
                        cv[bj] = bb[bj] + w0[bj] * up + w1[bj] * x + w2[bj] * dn;
                    }
                    const int j = 128 * ai + 64 * wr + 16 * m + fr, sr = seq0 + j - 1;
                    if (j >= 1 && j <= 254 && sr < lim) {
                        float o[4];
#pragma unroll
                        for (int e = 0; e < 4; ++e) { const float gg = cv[1][e]; o[e] = cv[0][e] * (gg / (1.f + __expf(-gg))); }
                        *(uint2*)(act + (size_t)(rbase + sr) * F_ + h0) = make_uint2(pk2(o[0], o[1]), pk2(o[2], o[3]));
                    }
                    ITER_FENCE();
                }
            }
        }
    }
};

struct EpiQKV1A {
    bf16_t* qkv; float* part; const float* rope; const float* gt;
    __device__ __forceinline__ void operator()(const AccT& acc, const pg8::Unit& u, int, int, int, int) const {
        EPI_IDS();
        const int r0 = u.pm * 256 + wr * 64 + fr, pn = u.pn;
        const bool rp = u.pm > 0;
        if (pn == 0 || (pn == 1 && wc < 2) || pn == 2) {
            const int chunk = pn == 0 ? wc : pn == 1 ? 4 + wc : wc;
            const size_t bo = pn == 2 ? O_CKV + 64 * wc : O_CQ + 64 * chunk;
            bf16_t* base = qkv + bo;
            const int ld = pn == 2 ? 256 : 384;
            float* pp = part + (pn == 2 ? 8 : 0) + chunk;
#pragma unroll
            for (int ai = 0; ai < 2; ++ai)
#pragma unroll
                for (int m = 0; m < 4; ++m) {
                    const int r = r0 + 128 * ai + 16 * m;
                    float ss = raw_store(acc, ai, m, base + (size_t)r * ld, fq);
                    ss += __shfl_xor(ss, 16); ss += __shfl_xor(ss, 32);
                    if (fq == 0) pp[(size_t)r * 12] = ss;
                    ITER_FENCE();
                }
        } else if (pn == 1 || pn == 3 || pn == 4) {
            const bool isk = pn == 1;
            float gn[2][2][4]; load_gain64(gn, gt + (isk ? 320 : 256), fq);
            const size_t bo = isk ? O_GK + (size_t)(wc - 2) * R_ * 64 : O_GQ + (size_t)(4 * (pn - 3) + wc) * R_ * 64;
            bf16_t* base = qkv + bo;
#pragma unroll
            for (int ai = 0; ai < 2; ++ai)
#pragma unroll
                for (int m = 0; m < 4; ++m) { const int r = r0 + 128 * ai + 16 * m; head64_epi(acc, ai, m, gn, rp, rope, r - 256, fq, base + (size_t)r * 64); ITER_FENCE(); }
        } else {
            if (wc < 2) {
                bf16_t* vt = qkv + O_GVT + (size_t)wc * 64 * R_;
#pragma unroll
                for (int ai = 0; ai < 2; ++ai)
#pragma unroll
                    for (int m = 0; m < 4; ++m) { vt_store(acc, ai, m, 1.f, vt, fq, r0 + 128 * ai + 16 * m); ITER_FENCE(); }
            } else if (wc == 2) {
#pragma unroll
                for (int ai = 0; ai < 2; ++ai)
#pragma unroll
                    for (int m = 0; m < 4; ++m) {
                        const int r = r0 + 128 * ai + 16 * m; const f32x4 a = acc[ai][0][m][0], b = acc[ai][0][m][1];
                        u32x4 w; w.x = pk2(a[0], a[1]); w.y = pk2(a[2], a[3]); w.z = pk2(b[0], b[1]); w.w = pk2(b[2], b[3]);
                        *(u32x4*)(qkv + O_CKR + (size_t)r * 32 + 8 * fq) = w;
                    }
            }
        }
    }
};

struct EpiQB {
    bf16_t* qkv; const float* part; const float* rope; const float* gq; LAS float* xch;
    __device__ __forceinline__ void operator()(const AccT& acc, const pg8::Unit& u, int, int, int, int) const {
        EPI_IDS();
        const int wid = wr * 4 + wc, head = 2 * u.pn + (wc >> 1), role = wc & 1, r0 = u.pm * 256 + wr * 64 + fr;
        const bool rp = u.pm > 0;
        float ssp[2][4];
#pragma unroll
        for (int ai = 0; ai < 2; ++ai)
#pragma unroll
            for (int m = 0; m < 4; ++m) {
                float ss = 0.f;
#pragma unroll
                for (int bj = 0; bj < 2; ++bj)
#pragma unroll
                    for (int n = 0; n < 2; ++n)
#pragma unroll
                        for (int e = 0; e < 4; ++e) { const float v = acc[ai][bj][m][n][e]; ss += v * v; }
                ss += __shfl_xor(ss, 16); ss += __shfl_xor(ss, 32);
                ssp[ai][m] = ss;
                if (fq == 0) xch[wid * 128 + ai * 64 + m * 16 + fr] = ss;
            }
        EPI_BARRIER();
        float g0[2][2][4];
        const float* gql = launder(gq);
        if (role == 0) load_gain64(g0, gql, fq);
        else {
#pragma unroll
            for (int n = 0; n < 2; ++n) { const float4 t = *(const float4*)(gql + 64 + 16 * n + 4 * fq); g0[0][n][0] = t.x; g0[0][n][1] = t.y; g0[0][n][2] = t.z; g0[0][n][3] = t.w; }
        }
#pragma unroll
        for (int ai = 0; ai < 2; ++ai)
#pragma unroll
            for (int m = 0; m < 4; ++m) {
                const int r = r0 + 128 * ai + 16 * m;
                const float so = xch[(wid ^ 1) * 128 + ai * 64 + m * 16 + fr];
                const float* pp = part + (size_t)r * 12;
                const float rq = rsqrtf((pp[0] + pp[1] + pp[2] + pp[3] + pp[4] + pp[5]) * (1.f / 384.f) + EPS_);
                const float sc = rq * rsqrtf(rq * rq * (ssp[ai][m] + so) * (1.f / 96.f) + EPS_);
                bf16_t* dst = qkv + O_MQ + ((size_t)head * R_ + r) * 96;
                if (role == 0) {
#pragma unroll
                    for (int bj = 0; bj < 2; ++bj) {
                        const f32x4 a = acc[ai][bj][m][0], b = acc[ai][bj][m][1];
                        u32x4 w; w.x = pk2(a[0] * sc * g0[bj][0][0], a[1] * sc * g0[bj][0][1]); w.y = pk2(a[2] * sc * g0[bj][0][2], a[3] * sc * g0[bj][0][3]);
                        w.z = pk2(b[0] * sc * g0[bj][1][0], b[1] * sc * g0[bj][1][1]); w.w = pk2(b[2] * sc * g0[bj][1][2], b[3] * sc * g0[bj][1][3]);
                        *(u32x4*)(dst + 32 * bj + 8 * fq) = w;
                    }
                } else {
                    float y1[4], y2[4];
#pragma unroll
                    for (int e = 0; e < 4; ++e) { y1[e] = acc[ai][0][m][0][e] * sc * g0[0][0][e]; y2[e] = acc[ai][0][m][1][e] * sc * g0[0][1][e]; }
                    if (rp) {
                        const int t = r - 256, pos = fq < 2 ? (t >> 6) : (t & 63);
                        const float* tb = rope + (pos * 16 + 8 * (fq & 1)) * 2;
#pragma unroll
                        for (int e = 0; e < 4; ++e) { const float2 cs = *(const float2*)(tb + 4 * e); const float a = y1[e], b = y2[e]; y1[e] = a * cs.x - b * cs.y; y2[e] = a * cs.y + b * cs.x; }
                    }
                    *(uint2*)(dst + 64 + 4 * fq) = make_uint2(pk2(y1[0], y1[1]), pk2(y1[2], y1[3]));
                    *(uint2*)(dst + 80 + 4 * fq) = make_uint2(pk2(y2[0], y2[1]), pk2(y2[2], y2[3]));
                }
                ITER_FENCE();
            }
        EPI_BARRIER();
    }
};

struct EpiKVB {
    bf16_t* qkv; const float* part; const float* rope; const float* gk;
    __device__ __forceinline__ void operator()(const AccT& acc, const pg8::Unit& u, int, int, int, int) const {
        EPI_IDS();
        const int head = 2 * u.pn + (wc >> 1), role = wc & 1, r0 = u.pm * 256 + wr * 64 + fr;
        const bool rp = u.pm > 0;
        if (role == 1) {
            bf16_t* vt = qkv + O_MVT + (size_t)head * 64 * R_;
#pragma unroll
            for (int ai = 0; ai < 2; ++ai)
#pragma unroll
                for (int m = 0; m < 4; ++m) {
                    const int r = r0 + 128 * ai + 16 * m; const float* pp = part + (size_t)r * 12 + 8;
                    const float rk = rsqrtf((pp[0] + pp[1] + pp[2] + pp[3]) * (1.f / 256.f) + EPS_);
                    vt_store(acc, ai, m, rk, vt, fq, r);
                    ITER_FENCE();
                }
        } else {
            const float* gkl = launder(gk);
            float gn[2][2][4]; load_gain64(gn, gkl, fq);
            float gr[2][4];
#pragma unroll
            for (int n = 0; n < 2; ++n) { const float4 t = *(const float4*)(gkl + 64 + 16 * n + 4 * fq); gr[n][0] = t.x; gr[n][1] = t.y; gr[n][2] = t.z; gr[n][3] = t.w; }
#pragma unroll
            for (int ai = 0; ai < 2; ++ai)
#pragma unroll
                for (int m = 0; m < 4; ++m) {
                    const int r = r0 + 128 * ai + 16 * m; const float* pp = part + (size_t)r * 12 + 8;
                    const float rk = rsqrtf((pp[0] + pp[1] + pp[2] + pp[3]) * (1.f / 256.f) + EPS_);
                    const uint2 c1 = *(const uint2*)(qkv + O_CKR + (size_t)r * 32 + 4 * fq), c2 = *(const uint2*)(qkv + O_CKR + (size_t)r * 32 + 16 + 4 * fq);
                    float y1[4] = {__uint_as_float(c1.x << 16), __uint_as_float(c1.x & 0xffff0000u), __uint_as_float(c1.y << 16), __uint_as_float(c1.y & 0xffff0000u)};
                    float y2[4] = {__uint_as_float(c2.x << 16), __uint_as_float(c2.x & 0xffff0000u), __uint_as_float(c2.y << 16), __uint_as_float(c2.y & 0xffff0000u)};
                    float ss = 0.f;
#pragma unroll
                    for (int bj = 0; bj < 2; ++bj)
#pragma unroll
                        for (int n = 0; n < 2; ++n)
#pragma unroll
                            for (int e = 0; e < 4; ++e) { const float v = acc[ai][bj][m][n][e] * rk; ss += v * v; }
#pragma unroll
                    for (int e = 0; e < 4; ++e) ss += y1[e] * y1[e] + y2[e] * y2[e];
                    ss += __shfl_xor(ss, 16); ss += __shfl_xor(ss, 32);
                    const float rr = rsqrtf(ss * (1.f / 96.f) + EPS_), sc = rk * rr;
                    bf16_t* dst = qkv + O_MK + ((size_t)head * R_ + r) * 96;
#pragma unroll
                    for (int bj = 0; bj < 2; ++bj) {
                        const f32x4 a = acc[ai][bj][m][0], b = acc[ai][bj][m][1];
                        u32x4 w; w.x = pk2(a[0] * sc * gn[bj][0][0], a[1] * sc * gn[bj][0][1]); w.y = pk2(a[2] * sc * gn[bj][0][2], a[3] * sc * gn[bj][0][3]);
                        w.z = pk2(b[0] * sc * gn[bj][1][0], b[1] * sc * gn[bj][1][1]); w.w = pk2(b[2] * sc * gn[bj][1][2], b[3] * sc * gn[bj][1][3]);
                        *(u32x4*)(dst + 32 * bj + 8 * fq) = w;
                    }
#pragma unroll
                    for (int e = 0; e < 4; ++e) { y1[e] *= rr * gr[0][e]; y2[e] *= rr * gr[1][e]; }
                    if (rp) {
                        const int t = r - 256, pos = fq < 2 ? (t >> 6) : (t & 63);
                        const float* tb = rope + (pos * 16 + 8 * (fq & 1)) * 2;
#pragma unroll
                        for (int e = 0; e < 4; ++e) { const float2 cs = *(const float2*)(tb + 4 * e); const float a = y1[e], b = y2[e]; y1[e] = a * cs.x - b * cs.y; y2[e] = a * cs.y + b * cs.x; }
                    }
                    *(uint2*)(dst + 64 + 4 * fq) = make_uint2(pk2(y1[0], y1[1]), pk2(y1[2], y1[3]));
                    *(uint2*)(dst + 80 + 4 * fq) = make_uint2(pk2(y2[0], y2[1]), pk2(y2[2], y2[3]));
                    ITER_FENCE();
                }
        }
    }
};

__device__ __forceinline__ void g_qkv0(const Params& p, LAS unsigned char* lds) {
    Bufs B(p);
    pg8::Gemm g{B.h, B.wt + W_EIN, 1024}; pg8::Order S; S.init(65, 12, gridDim.x, blockIdx.x, 0, 1);
    EpiQKV0 E{B.qkv, B.rope, B.gt};
    pg8::gemm_phase<EpiQKV0, pg8::Order, true, true>(lds, g, S, E);
}
__device__ __forceinline__ void g_out(const Params& p, int l, LAS unsigned char* lds) {
    Bufs B(p);
    pg8::Gemm g{B.mix, B.wt + (l == 0 ? W_EOUT : W_OOUT), 1024}; pg8::Order S; S.init(l == 0 ? 65 : 64, 4, gridDim.x, blockIdx.x, l == 0 ? 0 : 1, 0);
    EpiResid E{l == 0 ? p.in[I_X] : p.out, p.out, p.in[I_CTX], B.xc, modp(B, l, 0, 2), modp(B, l, 1, 2)};
    pg8::gemm_phase<EpiResid, pg8::Order, true, true>(lds, g, S, E);
}
__device__ __forceinline__ void g_up(const Params& p, int l, LAS unsigned char* lds) {
    Bufs B(p);
    pg8::Gemm g{B.h, B.wt + W_UP + (size_t)l * F2_ * 1024, 1024}; pg8::Order S; S.init(l == 0 ? 67 : 65, 22, gridDim.x, blockIdx.x, l == 0 ? 0 : 2, 2);
    EpiUp E{B.act, p.in[I_FCW] + (size_t)l * 3 * F2_, p.in[I_FCB] + (size_t)l * F2_, (LAS float*)(lds + LDS_XCH)};
    pg8::gemm_phase<EpiUp, pg8::Order, true, true>(lds, g, S, E);
}
__device__ __forceinline__ void g_down(const Params& p, int l, LAS unsigned char* lds) {
    Bufs B(p);
    pg8::Gemm g{B.act, B.wt + W_DOWN + (size_t)l * 1024 * F_, F_}; pg8::Order S; S.init(l == 0 ? 65 : 64, 4, gridDim.x, blockIdx.x, l == 0 ? 0 : 1, 0);
    EpiResid E{p.out, p.out, B.xc, B.xc, modp(B, l, 0, 5), modp(B, l, 1, 5)};
    pg8::gemm_phase<EpiResid, pg8::Order, true, true>(lds, g, S, E);
}
__device__ __forceinline__ void g_qkv1a(const Params& p, LAS unsigned char* lds) {
    Bufs B(p);
    pg8::Gemm g{B.h, B.wt + W_OIN, 1024}; pg8::Order S; S.init(65, 6, gridDim.x, blockIdx.x, 0, 1);
    EpiQKV1A E{B.qkv, B.part, B.rope, B.gt};
    pg8::gemm_phase<EpiQKV1A, pg8::Order, true, true>(lds, g, S, E);
}
__device__ __forceinline__ void g_qkv1b(const Params& p, LAS unsigned char* lds) {
    Bufs B(p);
    { pg8::Gemm g{B.qkv + O_CQ, B.wt + W_QB, 384}; pg8::Order S; S.init(64, 4, gridDim.x, blockIdx.x, 1, 0);
      EpiQB E{B.qkv, B.part, B.rope, p.in[I_CQN], (LAS float*)(lds + LDS_XCH)};
      pg8::gemm_phase<EpiQB, pg8::Order, true, true>(lds, g, S, E); }
    { pg8::Gemm g{B.qkv + O_CKV, B.wt + W_KVB, 256}; pg8::Order S; S.init(65, 4, gridDim.x, blockIdx.x, 0, 0);
      EpiKVB E{B.qkv, B.part, B.rope, p.in[I_CKN]};
      pg8::gemm_phase<EpiKVB, pg8::Order, true, true>(lds, g, S, E); }
}

typedef float f32x16 __attribute__((ext_vector_type(16)));
typedef __bf16 bf16x2_t __attribute__((ext_vector_type(2)));
typedef float f32x2_t __attribute__((ext_vector_type(2)));
__device__ __forceinline__ u32 cvtpk(float lo, float hi) { const f32x2_t v = {lo, hi}; const bf16x2_t b = __builtin_convertvector(v, bf16x2_t); return __builtin_bit_cast(u32, b); }

template <int DQK, int DV>
struct FlashGeom {
    static constexpr int KP = DQK * 2 + 16, VP = 144, KBYTES = 64 * KP, VBYTES = DV * VP, STAGE = KBYTES + VBYTES;
    static constexpr int KCH = DQK / 8, KN = (64 * KCH + NT - 1) / NT, VN = DV * 8 / NT;
};

template <int DQK, int DV>
__device__ __forceinline__ void flash_dense(LAS char* lds, const bf16_t* __restrict__ qptr, const bf16_t* __restrict__ Kb, const bf16_t* __restrict__ VT, int ntiles, float c1, float c2,
                                            f32x16 (&O)[DV / 32], float& lsum) {
    typedef FlashGeom<DQK, DV> G;
    const int tid = ltid(), lane = tid & 63, r = lane & 31, h = lane >> 5;
    bf16x8 qf[DQK / 16];
#pragma unroll
    for (int ks = 0; ks < DQK / 16; ++ks) qf[ks] = *(const bf16x8*)(qptr + 16 * ks + 8 * h);
#pragma unroll
    for (int dt = 0; dt < DV / 32; ++dt)
#pragma unroll
        for (int i = 0; i < 16; ++i) O[dt][i] = 0.f;
    float l = 0.f;
    u32x4 kreg[G::KN], vreg[G::VN];
    auto load_tile = [&](int t) {
#pragma unroll
        for (int i = 0; i < G::KN; ++i) { const int q = tid + NT * i; if (q < 64 * G::KCH) kreg[i] = *(const u32x4*)(Kb + (size_t)t * 64 * DQK + q * 8); }
#pragma unroll
        for (int i = 0; i < G::VN; ++i) { const int q = tid + NT * i; vreg[i] = *(const u32x4*)(VT + (size_t)(q >> 3) * R_ + t * 64 + (q & 7) * 8); }
    };
    auto store_tile = [&](int buf) {
        LAS char* kb = lds + buf * G::STAGE; LAS char* vb = kb + G::KBYTES;
#pragma unroll
        for (int i = 0; i < G::KN; ++i) { const int q = tid + NT * i; if (q < 64 * G::KCH) *(LAS u32x4*)(kb + (q / G::KCH) * G::KP + (q % G::KCH) * 16) = kreg[i]; }
#pragma unroll
        for (int i = 0; i < G::VN; ++i) { const int q = tid + NT * i; *(LAS u32x4*)(vb + (q >> 3) * G::VP + (q & 7) * 16) = vreg[i]; }
    };
    load_tile(0); store_tile(0);
    if (ntiles > 1) load_tile(1);
    __syncthreads();
    for (int t = 0; t < ntiles; ++t) {
        if (t + 1 < ntiles) store_tile((t + 1) & 1);
        if (t + 2 < ntiles) load_tile(t + 2);
        const LAS char* kb = lds + (t & 1) * G::STAGE; const LAS char* vb = kb + G::KBYTES;
#pragma unroll
        for (int kt = 0; kt < 2; ++kt) {
            f32x16 S;
#pragma unroll
            for (int i = 0; i < 16; ++i) S[i] = 0.f;
#pragma unroll
            for (int ks = 0; ks < DQK / 16; ++ks) {
                const bf16x8 a = *(const LAS bf16x8*)(kb + (32 * kt + r) * G::KP + (16 * ks + 8 * h) * 2);
                S = __builtin_amdgcn_mfma_f32_32x32x16_bf16(a, qf[ks], S, 0, 0, 0);
            }
            float p[16];
#pragma unroll
            for (int i = 0; i < 16; ++i) { p[i] = __builtin_amdgcn_exp2f(S[i] * c1 - c2); l += p[i]; }
#pragma unroll
            for (int s = 0; s < 2; ++s) {
                u32x4 pw; pw.x = cvtpk(p[8 * s], p[8 * s + 1]); pw.y = cvtpk(p[8 * s + 2], p[8 * s + 3]); pw.z = cvtpk(p[8 * s + 4], p[8 * s + 5]); pw.w = cvtpk(p[8 * s + 6], p[8 * s + 7]);
                const bf16x8 pf = __builtin_bit_cast(bf16x8, pw);
#pragma unroll
                for (int dt = 0; dt < DV / 32; ++dt) {
                    const bf16x8 a = *(const LAS bf16x8*)(vb + (32 * dt + r) * G::VP + (16 * (2 * kt + s) + 8 * h) * 2);
                    O[dt] = __builtin_amdgcn_mfma_f32_32x32x16_bf16(a, pf, O[dt], 0, 0, 0);
                }
            }
        }
        __syncthreads();
    }
    lsum = l + __shfl_xor(l, 32);
}

__device__ __forceinline__ void diff_unit(const Params& p, const Bufs& B, LAS char* lds, int head, int qb) {
    const int tid = ltid(), wid = tid >> 6, lane = tid & 63, c = lane & 31, h = lane >> 5;
    const int r = qb * 256 + wid * 32 + c, nt = qb == 0 ? 4 : R_ / 64;
    const float lam = B.scal[0], c1 = 0.125f * 1.4426950408889634f, c2 = B.scal[1];
    float* tmp = (float*)B.h + ((size_t)r * 4 + head) * 128 + 4 * h;
    f32x16 O[4]; float l;
    flash_dense<64, 128>(lds, B.qkv + O_QA + ((size_t)(2 * head) * R_ + r) * 64, B.qkv + O_KA + (size_t)(2 * head) * R_ * 64, B.qkv + O_VAT + (size_t)head * 128 * R_, nt, c1, c2, O, l);
    {
        const float inv = 1.f / l;
#pragma unroll
        for (int dt = 0; dt < 4; ++dt)
#pragma unroll
            for (int q = 0; q < 4; ++q) *(f32x4*)(tmp + 32 * dt + 8 * q) = (f32x4){O[dt][4 * q] * inv, O[dt][4 * q + 1] * inv, O[dt][4 * q + 2] * inv, O[dt][4 * q + 3] * inv};
    }
    flash_dense<64, 128>(lds, B.qkv + O_QA + ((size_t)(2 * head + 1) * R_ + r) * 64, B.qkv + O_KA + (size_t)(2 * head + 1) * R_ * 64, B.qkv + O_VAT + (size_t)head * 128 * R_, nt, c1, c2, O, l);
    {
        const float inv = lam / l; float ss = 0.f;
#pragma unroll
        for (int dt = 0; dt < 4; ++dt)
#pragma unroll
            for (int q = 0; q < 4; ++q) {
                const f32x4 o1 = *(const f32x4*)(tmp + 32 * dt + 8 * q);
#pragma unroll
                for (int e = 0; e < 4; ++e) { const float d = o1[e] - O[dt][4 * q + e] * inv; O[dt][4 * q + e] = d; ss += d * d; }
            }
        ss += __shfl_xor(ss, 32);
        const float rr = rsqrtf(ss * (1.f / 128.f) + EPS_) * 0.8f;
        bf16_t* dst = B.mix + (size_t)r * 1024 + head * 128 + 4 * h;
        const float* g = p.in[I_SUBLN] + 4 * h;
#pragma unroll
        for (int dt = 0; dt < 4; ++dt)
#pragma unroll
            for (int q = 0; q < 4; ++q) {
                const f32x4 gg = *(const f32x4*)(g + 32 * dt + 8 * q);
                *(uint2*)(dst + 32 * dt + 8 * q) = make_uint2(cvtpk(O[dt][4 * q] * rr * gg[0], O[dt][4 * q + 1] * rr * gg[1]), cvtpk(O[dt][4 * q + 2] * rr * gg[2], O[dt][4 * q + 3] * rr * gg[3]));
            }
    }
}
__device__ __forceinline__ void mla_unit(const Params& p, const Bufs& B, LAS char* lds, int head, int qb) {
    const int tid = ltid(), wid = tid >> 6, lane = tid & 63, c = lane & 31, h = lane >> 5;
    const int r = qb * 256 + wid * 32 + c;
    const float c1 = 0.10206207261596575f * 1.4426950408889634f, c2 = B.scal[2];
    f32x16 O[2]; float l;
    flash_dense<96, 64>(lds, B.qkv + O_MQ + ((size_t)head * R_ + r) * 96, B.qkv + O_MK + (size_t)head * R_ * 96, B.qkv + O_MVT + (size_t)head * 64 * R_, R_ / 64, c1, c2, O, l);
    const float inv = 1.f / l;
    bf16_t* dst = B.mix + (size_t)r * 1024 + head * 64 + 4 * h;
#pragma unroll
    for (int dt = 0; dt < 2; ++dt)
#pragma unroll
        for (int q = 0; q < 4; ++q)
            *(uint2*)(dst + 32 * dt + 8 * q) = make_uint2(cvtpk(O[dt][4 * q] * inv, O[dt][4 * q + 1] * inv), cvtpk(O[dt][4 * q + 2] * inv, O[dt][4 * q + 3] * inv));
}
__device__ void phase_attn0_dense(const Params& p, LAS char* lds, int bid, int nblk) {
    Bufs B(p);
    for (int u = bid; u < 260; u += nblk) {
        int head, qb;
        if (u < 256) { const int x = u & 7; head = x >> 1; qb = 1 + (u >> 3) * 2 + (x & 1); } else { head = u - 256; qb = 0; }
        diff_unit(p, B, lds, head, qb);
    }
}
__device__ void phase_attn1_dense(const Params& p, LAS char* lds, int bid, int nblk) {
    Bufs B(p);
    for (int u = bid; u < 512; u += nblk) mla_unit(p, B, lds, u & 7, 1 + (u >> 3));
}

template <int MODE>
__device__ __forceinline__ void flash_win(LAS char* lds, const bf16_t* __restrict__ qptr, const bf16_t* __restrict__ Kb, const bf16_t* __restrict__ VT, int lat0, int nlat, float c1, float c2,
                                          int qi  , int qcol, const LAS float* bl, f32x16 (&O)[2], float& lsum) {
    typedef FlashGeom<64, 64> G;
    const int tid = ltid(), lane = tid & 63, r = lane & 31, h = lane >> 5;
    const int ntiles = 4 + nlat;
    bf16x8 qf[4];
#pragma unroll
    for (int ks = 0; ks < 4; ++ks) qf[ks] = *(const bf16x8*)(qptr + 16 * ks + 8 * h);
#pragma unroll
    for (int dt = 0; dt < 2; ++dt)
#pragma unroll
        for (int i = 0; i < 16; ++i) O[dt][i] = 0.f;
    float l = 0.f;
    u32x4 kreg, vreg;
    auto load_tile = [&](int t) { const int at = t < 4 ? t : lat0 + (t - 4);
        kreg = *(const u32x4*)(Kb + (size_t)at * 64 * 64 + tid * 8); vreg = *(const u32x4*)(VT + (size_t)(tid >> 3) * R_ + at * 64 + (tid & 7) * 8); };
    auto store_tile = [&](int buf) { LAS char* kb = lds + buf * G::STAGE; LAS char* vb = kb + G::KBYTES;
        *(LAS u32x4*)(kb + (tid >> 3) * G::KP + (tid & 7) * 16) = kreg; *(LAS u32x4*)(vb + (tid >> 3) * G::VP + (tid & 7) * 16) = vreg; };
    const int rs = MODE == 1 ? min(max(qi - 4, 0), 248) : 0, cs = MODE == 1 ? min(max(qcol - 8, 0), 48) : 0;
    const int qlo = MODE == 2 ? __builtin_amdgcn_readfirstlane(qi - r) : 0;
    load_tile(0); store_tile(0);
    if (ntiles > 1) load_tile(1);
    __syncthreads();
    for (int t = 0; t < ntiles; ++t) {
        if (t + 1 < ntiles) store_tile((t + 1) & 1);
        if (t + 2 < ntiles) load_tile(t + 2);
        const LAS char* kb = lds + (t & 1) * G::STAGE; const LAS char* vb = kb + G::KBYTES;
        const int lt = lat0 + (t - 4) - 4;
        bool active = true;
        if (t >= 4) { if (MODE == 1) active = lt >= rs && lt < rs + 8; else active = (64 * lt + 63 >= qlo - 128) && (64 * lt <= qlo + 31 + 128); }
        if (active) {
#pragma unroll
            for (int kt = 0; kt < 2; ++kt) {
                f32x16 S;
#pragma unroll
                for (int i = 0; i < 16; ++i) S[i] = 0.f;
#pragma unroll
                for (int ks = 0; ks < 4; ++ks) {
                    const bf16x8 a = *(const LAS bf16x8*)(kb + (32 * kt + r) * G::KP + (16 * ks + 8 * h) * 2);
                    S = __builtin_amdgcn_mfma_f32_32x32x16_bf16(a, qf[ks], S, 0, 0, 0);
                }
                float p[16];
                if (t < 4) {
#pragma unroll
                    for (int i = 0; i < 16; ++i) p[i] = __builtin_amdgcn_exp2f(S[i] * c1 - c2);
                } else {
#pragma unroll
                    for (int i = 0; i < 16; ++i) {
                        const int kk = 32 * kt + (i & 3) + 8 * (i >> 2) + 4 * h;
                        if (MODE == 1) {
                            const bool valid = (unsigned)(kk - cs) < 16u;
                            const float b = bl[valid ? (lt - qi + 7) * 31 + (kk - qcol + 15) : 0];
                            p[i] = valid ? __builtin_amdgcn_exp2f(S[i] * c1 + b - c2) : 0.f;
                        } else {
                            const int d = 64 * lt + kk - qi;
                            p[i] = (d <= 128 && d >= -128) ? __builtin_amdgcn_exp2f(S[i] * c1 - c2) : 0.f;
                        }
                    }
                }
#pragma unroll
                for (int i = 0; i < 16; ++i) l += p[i];
#pragma unroll
                for (int s = 0; s < 2; ++s) {
                    u32x4 pw; pw.x = cvtpk(p[8 * s], p[8 * s + 1]); pw.y = cvtpk(p[8 * s + 2], p[8 * s + 3]); pw.z = cvtpk(p[8 * s + 4], p[8 * s + 5]); pw.w = cvtpk(p[8 * s + 6], p[8 * s + 7]);
                    const bf16x8 pf = __builtin_bit_cast(bf16x8, pw);
#pragma unroll
                    for (int dt = 0; dt < 2; ++dt) {
                        const bf16x8 a = *(const LAS bf16x8*)(vb + (32 * dt + r) * G::VP + (16 * (2 * kt + s) + 8 * h) * 2);
                        O[dt] = __builtin_amdgcn_mfma_f32_32x32x16_bf16(a, pf, O[dt], 0, 0, 0);
                    }
                }
            }
        }
        __syncthreads();
    }
    lsum = l + __shfl_xor(l, 32);
}
__device__ __forceinline__ void store_o64(bf16_t* dst  , const f32x16 (&O)[2], float inv) {
#pragma unroll
    for (int dt = 0; dt < 2; ++dt)
#pragma unroll
        for (int q = 0; q < 4; ++q)
            *(uint2*)(dst + 32 * dt + 8 * q) = make_uint2(cvtpk(O[dt][4 * q] * inv, O[dt][4 * q + 1] * inv), cvtpk(O[dt][4 * q + 2] * inv, O[dt][4 * q + 3] * inv));
}
constexpr int LDS_BIAS = 40960;
__device__ __forceinline__ void na_unit(const Params& p, const Bufs& B, LAS char* lds, int head, int qb) {
    const int tid = ltid(), wid = tid >> 6, lane = tid & 63, c = lane & 31, h = lane >> 5;
    const int r = qb * 256 + wid * 32 + c;
    LAS float* bl = (LAS float*)(lds + LDS_BIAS);
    __syncthreads();
    for (int e = tid; e < 465; e += NT) bl[e] = p.in[I_RPB][head * 465 + e] * 1.4426950408889634f;
    int lat0 = 4, nlat = 0, grow = 0, gcol = 0;
    if (qb > 0) { const int r0 = 4 * (qb - 1), ra = min(max(r0 - 4, 0), 248), rb = min(max(r0 + 3 - 4, 0), 248) + 8; lat0 = 4 + ra; nlat = rb - ra; grow = r0 + (wid >> 1); gcol = 32 * (wid & 1) + c; }
    f32x16 O[2]; float l;
    flash_win<1>(lds, B.qkv + O_QB + ((size_t)head * R_ + r) * 64, B.qkv + O_KB + (size_t)head * R_ * 64, B.qkv + O_VBT + (size_t)head * 64 * R_, lat0, nlat,
                 0.125f * 1.4426950408889634f, B.scal[3], grow, gcol, bl, O, l);
    store_o64(B.mix + (size_t)r * 1024 + 512 + head * 64 + 4 * h, O, 1.f / l);
}
__device__ __forceinline__ void swa_unit(const Params& p, const Bufs& B, LAS char* lds, int hq, int qb) {
    const int tid = ltid(), wid = tid >> 6, lane = tid & 63, c = lane & 31, h = lane >> 5;
    const int r = qb * 256 + wid * 32 + c, t0 = (qb - 1) * 256, kvh = hq >> 2;
    const int ta = max(t0 / 64 - 2, 0), tb = min(t0 / 64 + 5, 255);
    f32x16 O[2]; float l;
    const float c2 = B.scal[4];
    flash_win<2>(lds, B.qkv + O_GQ + ((size_t)hq * R_ + r) * 64, B.qkv + O_GK + (size_t)kvh * R_ * 64, B.qkv + O_GVT + (size_t)kvh * 64 * R_, 4 + ta, tb - ta + 1,
                 0.125f * 1.4426950408889634f, c2, r - 256, 0, nullptr, O, l);
    l += __builtin_amdgcn_exp2f(p.in[I_SINK][hq] * 1.4426950408889634f - c2);
    store_o64(B.mix + (size_t)r * 1024 + 512 + hq * 64 + 4 * h, O, 1.f / l);
}
__device__ void phase_attn0_win(const Params& p, LAS char* lds, int bid, int nblk) {
    Bufs B(p);
    for (int u = bid; u < 520; u += nblk) na_unit(p, B, lds, u & 7, u >> 3);
}
__device__ void phase_attn1_win(const Params& p, LAS char* lds, int bid, int nblk) {
    Bufs B(p);
    for (int u = bid; u < 512; u += nblk) swa_unit(p, B, lds, u & 7, 1 + (u >> 3));
}

#define XB_TMO      128
#define XB_XCNT(j)  (256  + 64 * (j))
#define XB_XSUB(j)  (1280 + 64 * (j))
#define XB_XGEN(j)  (2304 + 64 * (j))
#define XB_TOP      3328
#define XB_TOPGEN   3392
#define XCD_BAR_WORDS 3456
#define XB_SPIN_CAP (1u << 20)
__device__ __forceinline__ unsigned xb_ld(unsigned* p)              { return __hip_atomic_load(p, __ATOMIC_RELAXED, __HIP_MEMORY_SCOPE_AGENT); }
__device__ __forceinline__ unsigned xb_add(unsigned* p, unsigned v) { return __hip_atomic_fetch_add(p, v, __ATOMIC_RELAXED, __HIP_MEMORY_SCOPE_AGENT); }
__device__ __forceinline__ unsigned xb_xcc_id() { return (unsigned)__builtin_amdgcn_s_getreg((3 << 11) | 20) & 0xFu; }
#define XB_SPIN(cond, bar) do { unsigned _sp = 0; while (cond) { __builtin_amdgcn_s_sleep(1); \
    if ((++_sp & 255u) == 0u) { if (xb_ld(&(bar)[XB_TMO])) break; if (_sp > XB_SPIN_CAP) { atomicAdd(&(bar)[XB_TMO], 1u); break; } } } } while (0)
struct XcdBarrier { unsigned* bar; unsigned x; volatile LAS unsigned* st; };
__device__ __forceinline__ XcdBarrier xcd_barrier_post(unsigned* bar, volatile LAS unsigned* st) {
    XcdBarrier b; b.bar = bar; b.x = xb_xcc_id(); b.st = st;
    if (threadIdx.x == 0) (void)xb_add(&bar[XB_XCNT(b.x)], 1u);
    return b;
}
__device__ __forceinline__ void xcd_barrier_complete(unsigned* bar, unsigned x, unsigned& nloc, unsigned& nx) {
    const unsigned G = gridDim.x * gridDim.y * gridDim.z;
    unsigned sum, cnt, mine, sp = 0u;
    for (;;) {
        sum = 0u; cnt = 0u; mine = 0u;
#pragma unroll
        for (unsigned j = 0; j < 16; ++j) { const unsigned c = xb_ld(&bar[XB_XCNT(j)]); sum += c; cnt += (c > 0u) ? 1u : 0u; mine = (j == x) ? c : mine; }
        if (sum == G) break;
        __builtin_amdgcn_s_sleep(1);
        if ((++sp & 255u) == 0u) { if (xb_ld(&bar[XB_TMO])) break; if (sp > XB_SPIN_CAP) { atomicAdd(&bar[XB_TMO], 1u); break; } }
    }
    nloc = mine > 0u ? mine : 1u; nx = cnt > 0u ? cnt : 1u;
}
__device__ __forceinline__ void xcd_barrier(const XcdBarrier& b) {
    asm volatile("s_waitcnt vmcnt(0)" ::: "memory");
    __syncthreads();
    if (threadIdx.x == 0) {
        unsigned* bar = b.bar;
        __builtin_amdgcn_s_waitcnt(0);
        unsigned nloc = b.st[0], nx = b.st[1];
        if (nloc == 0u) { xcd_barrier_complete(bar, b.x, nloc, nx); b.st[0] = nloc; b.st[1] = nx; }
        const unsigned old = xb_add(&bar[XB_XSUB(b.x)], 1u);
        const unsigned gen = old / nloc;
        if (old + 1u == (gen + 1u) * nloc) {
            __builtin_amdgcn_fence(__ATOMIC_RELEASE, "agent");
            asm volatile("s_waitcnt vmcnt(0)" ::: "memory");
            const unsigned og = xb_add(&bar[XB_TOP], 1u);
            const unsigned tg = og / nx;
            if (og + 1u == (tg + 1u) * nx) xb_add(&bar[XB_TOPGEN], 1u);
            else XB_SPIN(xb_ld(&bar[XB_TOPGEN]) == tg, bar);
            __builtin_amdgcn_fence(__ATOMIC_ACQUIRE, "agent");
            xb_add(&bar[XB_XGEN(b.x)], 1u);
            asm volatile("s_waitcnt vmcnt(0)" ::: "memory");
        } else {
            XB_SPIN(xb_ld(&bar[XB_XGEN(b.x)]) == gen, bar);
            __builtin_amdgcn_fence(__ATOMIC_ACQUIRE, "agent");
            asm volatile("s_waitcnt vmcnt(0)" ::: "memory");
        }
    }
    __syncthreads();
}

#ifndef OPTG
#define OPTG 0x7f
#endif
constexpr int NPHASE = 16;
__device__ __forceinline__ void run_phase(int ph, const Params& p, char* lds, int bid, int nblk) {
    LAS unsigned char* l3 = (LAS unsigned char*)lds;
    switch (ph) {
        case 0: phase_prep(p, lds, bid, nblk); if (OPTG) phase_prep_weights(p, lds, bid, nblk); break;
        case 1: phase_norm(p, 0, 0, bid, nblk); break;
        case 2: if (OPTG & 1) g_qkv0(p, l3); else phase_qkv0(p, lds, bid, nblk); break;
        case 3:
            _Pragma("nounroll") for (int rp = 0; rp <= ((REPEAT >> 16) & 1); ++rp) { if (OPTA & 1) phase_attn0_dense(p, (LAS char*)lds, bid, nblk); }
            _Pragma("nounroll") for (int rp = 0; rp <= ((REPEAT >> 17) & 1); ++rp) { if (OPTA & 4) phase_attn0_win(p, (LAS char*)lds, bid, nblk); }
            if ((OPTA & 5) != 5) phase_attn0(p, lds, bid, nblk); break;
        case 4: if (OPTG & 2) g_out(p, 0, l3); else phase_out(p, 0, bid, nblk); break;
        case 5: phase_norm(p, 0, 1, bid, nblk); break;
        case 6: if (OPTG & 4) g_up(p, 0, l3); else phase_up(p, 0, lds, bid, nblk); break;
        case 7: if (OPTG & 8) g_down(p, 0, l3); else phase_down(p, 0, bid, nblk); break;
        case 8: phase_norm(p, 1, 0, bid, nblk); break;
        case 9: if (OPTG & 16) g_qkv1a(p, l3); else phase_qkv1a(p, lds, bid, nblk); break;
        case 10: if (OPTG & 32) g_qkv1b(p, l3); else phase_qkv1b(p, lds, bid, nblk); break;
        case 11:
            _Pragma("nounroll") for (int rp = 0; rp <= ((REPEAT >> 18) & 1); ++rp) { if (OPTA & 2) phase_attn1_dense(p, (LAS char*)lds, bid, nblk); }
            _Pragma("nounroll") for (int rp = 0; rp <= ((REPEAT >> 19) & 1); ++rp) { if (OPTA & 8) phase_attn1_win(p, (LAS char*)lds, bid, nblk); }
            if ((OPTA & 10) != 10) phase_attn1(p, bid, nblk); break;
        case 12: if (OPTG & 2) g_out(p, 1, l3); else phase_out(p, 1, bid, nblk); break;
        case 13: phase_norm(p, 1, 1, bid, nblk); break;
        case 14: if (OPTG & 4) g_up(p, 1, l3); else phase_up(p, 1, lds, bid, nblk); break;
        case 15: if (OPTG & 8) g_down(p, 1, l3); else phase_down(p, 1, bid, nblk); break;
    }
}

namespace cg = cooperative_groups;
__global__ void __launch_bounds__(NT, 2) k_mega(Params p) {
    extern __shared__ __attribute__((aligned(16))) char smem[];
    cg::grid_group grid = cg::this_grid();
    const int bid = blockIdx.x, nblk = gridDim.x;
    volatile LAS unsigned* st = (volatile LAS unsigned*)((LAS char*)smem + LDS_BYTES - 16);
    if (threadIdx.x < 2) st[threadIdx.x] = 0u;
    __syncthreads();
    const XcdBarrier xb = xcd_barrier_post((unsigned*)(p.ws + WS_CTL), st);
#define SYNC() xcd_barrier(xb)
#define PH(n) do { _Pragma("nounroll") for (int rep_ = 0; rep_ <= ((REPEAT >> (n)) & 1); ++rep_) { if (rep_) SYNC(); run_phase(n, p, smem, bid, nblk); } } while (0)
    PH(0); grid.sync(); PH(1); SYNC(); PH(2); SYNC(); PH(3); SYNC(); PH(4); SYNC(); PH(5); SYNC(); PH(6); SYNC(); PH(7); SYNC();
    PH(8); SYNC(); PH(9); SYNC(); PH(10); SYNC(); PH(11); SYNC(); PH(12); SYNC(); PH(13); SYNC(); PH(14); SYNC(); PH(15);
    if (REPEAT & (1 << 20)) { for (int i = 0; i < 10; ++i) SYNC(); }
#undef PH
}

extern "C" void kernel_launch(void* const* d_in, const int* in_sizes, int n_in, void* d_out, int out_size, void* d_ws, size_t ws_size, hipStream_t stream) {
    Params p{};
    for (int i = 0; i < 35; ++i) p.in[i] = (const float*)d_in[i];
    p.out = (float*)d_out; p.ws = (char*)d_ws;
    if (ws_size < WS_END) { fprintf(stderr, "ws too small: %zu < %zu\n", ws_size, (size_t)WS_END); return; }
    static int grid_blocks = 0;
    if (!grid_blocks) {
        int dev = 0, cus = 0, per_cu = 0;
        hipGetDevice(&dev);
        hipDeviceGetAttribute(&cus, hipDeviceAttributeMultiprocessorCount, dev);
        if (hipFuncSetAttribute((const void*)k_mega, hipFuncAttributeMaxDynamicSharedMemorySize, LDS_BYTES) != hipSuccess) fprintf(stderr, "hipFuncSetAttribute failed\n");
        hipOccupancyMaxActiveBlocksPerMultiprocessor(&per_cu, (const void*)k_mega, NT, LDS_BYTES);
        if (per_cu < 1) { fprintf(stderr, "occupancy query returned %d\n", per_cu); per_cu = 1; }
        if (per_cu > 1) per_cu = 1;
        grid_blocks = cus * per_cu;
    }
    if (hipMemsetAsync((char*)d_ws + WS_CTL, 0, 16384, stream) != hipSuccess) fprintf(stderr, "memset failed\n");
    void* args[] = {&p};
    hipError_t e = hipLaunchCooperativeKernel((const void*)k_mega, dim3(grid_blocks), dim3(NT), args, LDS_BYTES, stream);
    if (e != hipSuccess) fprintf(stderr, "cooperative launch failed: %s (grid %d)\n", hipGetErrorString(e), grid_blocks);
}
```

```cpp
#include <hip/hip_runtime.h>
#include <hip/hip_cooperative_groups.h>
#include <cstdint>
#include <cstdio>
#include <cmath>

typedef unsigned short bf16_t;
__device__ __forceinline__ int ltid() { int t = threadIdx.x; asm volatile("" : "+v"(t)); return t; }
typedef unsigned int u32;
typedef u32 u32x4 __attribute__((ext_vector_type(4)));

#define NT 512
#ifndef REPEAT
#define REPEAT 0
#endif
#ifndef OPTA
#define OPTA 15
#endif
constexpr int T_ = 16384, L_ = 256, R_ = 16640, D_ = 1024, F_ = 2816, F2_ = 5632;
constexpr float EPS_ = 1e-6f;

constexpr size_t WS_CTL = 0;
constexpr size_t WS_MOD = 16384;
constexpr size_t WS_SCAL = WS_MOD + 2 * 2 * 6144 * 4;
constexpr size_t WS_GT = WS_SCAL + 256;
constexpr size_t WS_ROPE = WS_GT + 6 * 64 * 4;
constexpr size_t WS_XC = WS_ROPE + 256 * 16 * 2 * 4;
constexpr size_t WS_H = WS_XC + 256 * 1024 * 4;
constexpr int HROWS = R_ + 144;
constexpr size_t WS_MIX = WS_H + (size_t)HROWS * 1024 * 2;
constexpr size_t WS_QKV = WS_MIX + (size_t)R_ * 1024 * 2;
constexpr size_t E_SEG = (size_t)512 * R_;
constexpr size_t O_QA = 0, O_KA = E_SEG, O_VAT = 2 * E_SEG, O_QB = 3 * E_SEG, O_KB = 4 * E_SEG, O_VBT = 5 * E_SEG;
constexpr size_t O_CQ = 0, O_CKV = O_CQ + (size_t)R_ * 384, O_CKR = O_CKV + (size_t)R_ * 256, O_MQ = O_CKR + (size_t)R_ * 32,
                 O_MK = O_MQ + (size_t)R_ * 768, O_MVT = O_MK + (size_t)R_ * 768, O_GQ = O_MVT + (size_t)R_ * 512,
                 O_GK = O_GQ + (size_t)R_ * 512, O_GVT = O_GK + (size_t)R_ * 128, O_L1END = O_GVT + (size_t)R_ * 128;
constexpr size_t WS_QKV_BYTES = O_L1END * 2;
constexpr size_t WS_PART = WS_QKV + WS_QKV_BYTES;
constexpr size_t WS_WT = WS_PART + (size_t)R_ * 12 * 4;
constexpr size_t W_EIN = 0, W_EOUT = W_EIN + (size_t)3072 * 1024, W_UP = W_EOUT + (size_t)1024 * 1024, W_DOWN = W_UP + (size_t)2 * 5632 * 1024,
                 W_OIN = W_DOWN + (size_t)2 * 1024 * 2816, W_OOUT = W_OIN + (size_t)1536 * 1024, W_QB = W_OOUT + (size_t)1024 * 1024,
                 W_KVB = W_QB + (size_t)1024 * 384, W_END = W_KVB + (size_t)1024 * 256;
constexpr size_t WS_END = WS_WT + W_END * 2;
static_assert(WS_END < (size_t)255 * 1024 * 1024, "ws");
static_assert((size_t)(R_ + 8) * F_ * 2 <= WS_QKV_BYTES, "act alias");

struct Params { const float* in[35]; float* out; char* ws; };
enum { I_X = 0, I_C, I_CTX, I_CCTX, I_ADAW, I_ADAB, I_NMIX, I_NFFN, I_FUP, I_FCW, I_FCB, I_FDOWN, I_EWIN, I_EWOUT, I_AQN, I_AKN,
       I_LQ1, I_LK1, I_LQ2, I_LK2, I_SUBLN, I_BQN, I_BKN, I_RPB, I_OWIN, I_OWOUT, I_CQAN, I_CWQB, I_CKVAN, I_CWKVB, I_CQN, I_CKN,
       I_DQN, I_DKN, I_SINK };

__device__ __forceinline__ float bf2f(bf16_t v) { return __uint_as_float(((u32)v) << 16); }
__device__ __forceinline__ bf16_t f2bf(float f) { u32 u = __float_as_uint(f); return (bf16_t)((u + 0x7fffu + ((u >> 16) & 1u)) >> 16); }
__device__ __forceinline__ float wave_sum(float v) {
#pragma unroll
    for (int o = 32; o > 0; o >>= 1) v += __shfl_xor(v, o);
    return v;
}
__device__ __forceinline__ int swap23(int p) { return (p & 3) | ((p & 4) << 1) | ((p & 8) >> 1); }
__device__ __forceinline__ int hrow(int r) { return r < 256 ? r + 1 : r + 2; }
__device__ __forceinline__ int vpos(int key) { return (key & ~15) + swap23(key & 15); }
__device__ __forceinline__ void unpack8(u32x4 v, float (&a)[8]) {
    a[0] = __uint_as_float(v.x << 16); a[1] = __uint_as_float(v.x & 0xffff0000u);
    a[2] = __uint_as_float(v.y << 16); a[3] = __uint_as_float(v.y & 0xffff0000u);
    a[4] = __uint_as_float(v.z << 16); a[5] = __uint_as_float(v.z & 0xffff0000u);
    a[6] = __uint_as_float(v.w << 16); a[7] = __uint_as_float(v.w & 0xffff0000u);
}

struct Bufs {
    float* mod; float* scal; float* rope; float* xc; bf16_t* h; bf16_t* mix; bf16_t* qkv; bf16_t* act; float* part; bf16_t* wt; float* gt;
    __device__ Bufs(const Params& p) {
        mod = (float*)(p.ws + WS_MOD); scal = (float*)(p.ws + WS_SCAL); rope = (float*)(p.ws + WS_ROPE); xc = (float*)(p.ws + WS_XC);
        h = (bf16_t*)(p.ws + WS_H); mix = (bf16_t*)(p.ws + WS_MIX); qkv = (bf16_t*)(p.ws + WS_QKV); act = (bf16_t*)(p.ws + WS_QKV);
        part = (float*)(p.ws + WS_PART); wt = (bf16_t*)(p.ws + WS_WT); gt = (float*)(p.ws + WS_GT);
    }
};
__device__ __forceinline__ const float* modp(const Bufs& B, int l, int s, int chunk) { return B.mod + ((size_t)(l * 2 + s) * 6144) + chunk * 1024; }

__device__ void phase_prep(const Params& p, char* lds, int bid, int nblk) {
    Bufs B(p);
    float* red = (float*)lds;
    const int tid = ltid();
    for (int item = bid; item < 193; item += nblk) {
        if (item < 192) {
            const int l = item / 96, n0 = (item % 96) * 64, nn = tid & 63, kc = tid >> 6;
            const float* W = p.in[I_ADAW] + (size_t)l * 1024 * 6144 + n0 + nn;
            float a0 = 0.f, a1 = 0.f;
            for (int k = kc * 128; k < kc * 128 + 128; ++k) {
                const float w = W[(size_t)k * 6144];
                const float c0 = p.in[I_C][k], c1 = p.in[I_CCTX][k];
                a0 += (c0 / (1.f + __expf(-c0))) * w; a1 += (c1 / (1.f + __expf(-c1))) * w;
            }
            red[(kc * 64 + nn) * 2] = a0; red[(kc * 64 + nn) * 2 + 1] = a1;
            __syncthreads();
            if (tid < 128) {
                const int n = tid & 63, s = tid >> 6; float acc = 0.f;
                for (int k = 0; k < 8; ++k) acc += red[(k * 64 + n) * 2 + s];
                B.mod[(size_t)(l * 2 + s) * 6144 + n0 + n] = acc + p.in[I_ADAB][l * 6144 + n0 + n];
            }
            __syncthreads();
        } else {
            for (int e = tid; e < 256 * 16; e += NT) {
                const int pos = e >> 4, i = e & 15;
                const double f = pow(10000.0, -(double)i / 16.0), ang = (double)pos * f;
                B.rope[e * 2] = (float)cos(ang); B.rope[e * 2 + 1] = (float)sin(ang);
            }
            if (tid < 64) {
                B.gt[tid] = p.in[I_AQN][tid]; B.gt[64 + tid] = p.in[I_AKN][tid]; B.gt[128 + tid] = p.in[I_BQN][tid]; B.gt[192 + tid] = p.in[I_BKN][tid];
                B.gt[256 + tid] = p.in[I_DQN][tid]; B.gt[320 + tid] = p.in[I_DKN][tid];
                const float s1 = wave_sum(p.in[I_LQ1][tid] * p.in[I_LK1][tid]), s2 = wave_sum(p.in[I_LQ2][tid] * p.in[I_LK2][tid]);
                if (tid == 0) B.scal[0] = expf(s1) - expf(s2) + 0.2f;
                float ma = fabsf(p.in[I_AQN][tid]), mb = fabsf(p.in[I_AKN][tid]), mc = fmaxf(fabsf(p.in[I_CQN][tid]), tid < 32 ? fabsf(p.in[I_CQN][64 + tid]) : 0.f),
                      md = fmaxf(fabsf(p.in[I_CKN][tid]), tid < 32 ? fabsf(p.in[I_CKN][64 + tid]) : 0.f);
#pragma unroll
                for (int o = 32; o > 0; o >>= 1) { ma = fmaxf(ma, __shfl_xor(ma, o)); mb = fmaxf(mb, __shfl_xor(mb, o)); mc = fmaxf(mc, __shfl_xor(mc, o)); md = fmaxf(md, __shfl_xor(md, o)); }
                if (tid == 0) { B.scal[1] = 8.f * ma * mb * 1.4426950408889634f; B.scal[2] = 9.797958971132712f * mc * md * 1.4426950408889634f; }
                float na = fabsf(p.in[I_BQN][tid]), nb = fabsf(p.in[I_BKN][tid]), nc = fabsf(p.in[I_DQN][tid]), nd = fabsf(p.in[I_DKN][tid]), nr = 0.f, ns = tid < 8 ? p.in[I_SINK][tid] : -1e30f;
                for (int e = tid; e < 8 * 465; e += 64) nr = fmaxf(nr, fabsf(p.in[I_RPB][e]));
#pragma unroll
                for (int o = 32; o > 0; o >>= 1) { na = fmaxf(na, __shfl_xor(na, o)); nb = fmaxf(nb, __shfl_xor(nb, o)); nc = fmaxf(nc, __shfl_xor(nc, o)); nd = fmaxf(nd, __shfl_xor(nd, o));
                                                   nr = fmaxf(nr, __shfl_xor(nr, o)); ns = fmaxf(ns, __shfl_xor(ns, o)); }
                if (tid == 0) { B.scal[3] = (8.f * na * nb + nr) * 1.4426950408889634f; B.scal[4] = fmaxf(8.f * nc * nd, ns) * 1.4426950408889634f; }
            }
        }
    }
}

__device__ void phase_norm(const Params& p, int l, int which, int bid, int nblk) {
    Bufs B(p);
    const int wid = ltid() >> 6, lane = ltid() & 63;
    const float* gamma = p.in[which ? I_NFFN : I_NMIX] + l * 1024;
    for (int e = bid * NT + ltid(); e < (2 + HROWS - (R_ + 2)) * 128; e += nblk * NT) {
        const int rr = e >> 7, c = e & 127; const int rho = rr == 0 ? 0 : rr == 1 ? 257 : R_ + 2 + (rr - 2);
        *(u32x4*)(B.h + (size_t)rho * 1024 + c * 8) = (u32x4){0u, 0u, 0u, 0u};
    }
    for (int item = bid; item < R_ / 8; item += nblk) {
        const int r = item * 8 + wid;
        const bool first = (l == 0 && which == 0);
        const float* src = r < 256 ? ((first ? p.in[I_CTX] : B.xc) + (size_t)r * 1024) : ((first ? p.in[I_X] : p.out) + (size_t)(r - 256) * 1024);
        const int s = r < 256 ? 1 : 0;
        const float* sh = modp(B, l, s, which ? 3 : 0); const float* sc = modp(B, l, s, which ? 4 : 1);
        float v[16]; float ss = 0.f;
#pragma unroll
        for (int i = 0; i < 4; ++i) { const float4 t = *(const float4*)(src + i * 256 + lane * 4); v[4 * i] = t.x; v[4 * i + 1] = t.y; v[4 * i + 2] = t.z; v[4 * i + 3] = t.w; ss += t.x * t.x + t.y * t.y + t.z * t.z + t.w * t.w; }
        ss = wave_sum(ss);
        const float rr = rsqrtf(ss * (1.f / 1024.f) + EPS_);
#pragma unroll
        for (int i = 0; i < 4; ++i) {
            const int k = i * 256 + lane * 4; bf16_t o[4];
#pragma unroll
            for (int j = 0; j < 4; ++j) o[j] = f2bf(v[4 * i + j] * rr * gamma[k + j] * (1.f + sc[k + j]) + sh[k + j]);
            *(uint2*)(B.h + (size_t)hrow(r) * 1024 + k) = make_uint2((u32)o[0] | ((u32)o[1] << 16), (u32)o[2] | ((u32)o[3] << 16));
        }
    }
}

template <int RPG>
__device__ __forceinline__ void tile_linear(float (&acc)[RPG], int K, const bf16_t* const (&ap)[RPG], const float* __restrict__ W, int ldw, int wcol) {
#pragma unroll
    for (int i = 0; i < RPG; ++i) acc[i] = 0.f;
    if (wcol < 0) return;
    for (int k = 0; k < K; k += 8) {
        float w[8];
#pragma unroll
        for (int j = 0; j < 8; ++j) w[j] = W[(size_t)(k + j) * ldw + wcol];
#pragma unroll
        for (int i = 0; i < RPG; ++i) {
            if (ap[i]) { float a[8]; unpack8(*(const u32x4*)(ap[i] + k), a);
#pragma unroll
                for (int j = 0; j < 8; ++j) acc[i] += a[j] * w[j]; }
        }
    }
}
template <int RPG>
__device__ __forceinline__ void tile_linear_g(float (&acc)[RPG], int K, const bf16_t* const (&ap)[RPG], const float (&rs)[RPG], const float* __restrict__ g, const float* __restrict__ W, int ldw, int wcol) {
#pragma unroll
    for (int i = 0; i < RPG; ++i) acc[i] = 0.f;
    if (wcol < 0) return;
    for (int k = 0; k < K; k += 8) {
        float w[8];
#pragma unroll
        for (int j = 0; j < 8; ++j) w[j] = W[(size_t)(k + j) * ldw + wcol] * g[k + j];
#pragma unroll
        for (int i = 0; i < RPG; ++i) {
            if (ap[i]) { float a[8]; unpack8(*(const u32x4*)(ap[i] + k), a); float t = 0.f;
#pragma unroll
                for (int j = 0; j < 8; ++j) t += a[j] * w[j];
                acc[i] += t * rs[i]; }
        }
    }
}

__device__ __forceinline__ float2 rope64(const float* tab, int t, int i) { const int pos = i < 16 ? (t >> 6) : (t & 63); const int f = i & 15; return *(const float2*)(tab + (pos * 16 + f) * 2); }
__device__ __forceinline__ float2 rope32(const float* tab, int t, int i) { const int pos = i < 8 ? (t >> 6) : (t & 63); const int f = (i & 7) * 2; return *(const float2*)(tab + (pos * 16 + f) * 2); }

__device__ __forceinline__ void head64_norm_rope(const float* row, const float* g, bool rope, const float* tab, int t, bf16_t* dst, int lane) {
    const float v = row[lane];
    const float ss = wave_sum(v * v);
    const float rr = rsqrtf(ss * (1.f / 64.f) + EPS_);
    float y = v * rr * g[lane];
    if (rope) {
        const float yp = row[lane ^ 32] * rr * g[lane ^ 32];
        const float2 cs = rope64(tab, t, lane & 31);
        y = lane < 32 ? (y * cs.x - yp * cs.y) : (yp * cs.y + y * cs.x);
    }
    dst[lane] = f2bf(y);
}

__device__ void phase_qkv0(const Params& p, char* lds, int bid, int nblk) {
    Bufs B(p);
    float* tile = (float*)lds;
    const int tid = ltid(), cc = tid & 127, rg = tid >> 7, wid = tid >> 6, lane = tid & 63;
    const float* W = p.in[I_EWIN];
    for (int item = bid; item < (R_ / 16) * 24; item += nblk) {
        const int rt = item / 24, ct = item % 24, row0 = rt * 16, col0 = ct * 128;
        const bf16_t* ap[4];
#pragma unroll
        for (int i = 0; i < 4; ++i) ap[i] = B.h + (size_t)hrow(row0 + rg * 4 + i) * 1024;
        float acc[4];
        tile_linear<4>(acc, 1024, ap, W, 3072, col0 + cc);
#pragma unroll
        for (int i = 0; i < 4; ++i) tile[(rg * 4 + i) * 128 + cc] = acc[i];
        __syncthreads();
        const int seg = col0 / 512, cin = col0 % 512;
        if (seg == 2 || seg == 5) {
            for (int e = tid; e < 16 * 128; e += NT) {
                const int c = e >> 4, rr = e & 15, r = row0 + rr;
                bf16_t* dst;
                if (seg == 2) dst = B.qkv + O_VAT + ((size_t)(cin / 128) * 128 + c) * R_;
                else dst = B.qkv + O_VBT + ((size_t)((cin + c) / 64) * 64 + (c & 63)) * R_;
                dst[vpos(r)] = f2bf(tile[rr * 128 + c]);
            }
        } else {
            for (int q = wid * 4; q < wid * 4 + 4; ++q) {
                const int rr = q >> 1, hh = q & 1, r = row0 + rr, head = cin / 64 + hh;
                const float* g = p.in[seg == 0 ? I_AQN : seg == 1 ? I_AKN : seg == 3 ? I_BQN : I_BKN];
                bf16_t* dst = B.qkv + (seg == 0 ? O_QA : seg == 1 ? O_KA : seg == 3 ? O_QB : O_KB) + ((size_t)head * R_ + r) * 64;
                head64_norm_rope(tile + rr * 128 + hh * 64, g, (seg < 2) && r >= 256, B.rope, r - 256, dst, lane);
            }
        }
        __syncthreads();
    }
}

__device__ __forceinline__ float dot8p(u32x4 k, u32 q0, u32 q1, u32 q2, u32 q3) {
    float t = __uint_as_float(k.x << 16) * __uint_as_float(q0 << 16);
    t += __uint_as_float(k.x & 0xffff0000u) * __uint_as_float(q0 & 0xffff0000u);
    t += __uint_as_float(k.y << 16) * __uint_as_float(q1 << 16);
    t += __uint_as_float(k.y & 0xffff0000u) * __uint_as_float(q1 & 0xffff0000u);
    t += __uint_as_float(k.z << 16) * __uint_as_float(q2 << 16);
    t += __uint_as_float(k.z & 0xffff0000u) * __uint_as_float(q2 & 0xffff0000u);
    t += __uint_as_float(k.w << 16) * __uint_as_float(q3 << 16);
    t += __uint_as_float(k.w & 0xffff0000u) * __uint_as_float(q3 & 0xffff0000u);
    return t;
}
template <int DQK, int DVT>
__device__ __forceinline__ void naive_dense(const bf16_t* __restrict__ q, const bf16_t* __restrict__ Kb, const bf16_t* __restrict__ VT, int nk, float scale, float (&O)[DVT], float& lsum) {
    u32x4 qp[DQK / 8];
#pragma unroll
    for (int i = 0; i < DQK / 8; ++i) qp[i] = *(const u32x4*)(q + i * 8);
#pragma unroll
    for (int d = 0; d < DVT; ++d) O[d] = 0.f;
    float m = -1e30f, l = 0.f;
    for (int c = 0; c < nk; c += 8) {
        float s[8];
#pragma unroll
        for (int j = 0; j < 8; ++j) {
            const int key = (c & ~15) + swap23((c & 15) + j);
            const bf16_t* kr = Kb + (size_t)key * DQK; float t = 0.f;
#pragma unroll
            for (int i = 0; i < DQK / 8; ++i) t += dot8p(*(const u32x4*)(kr + i * 8), qp[i].x, qp[i].y, qp[i].z, qp[i].w);
            s[j] = t * scale;
        }
        float cm = s[0];
#pragma unroll
        for (int j = 1; j < 8; ++j) cm = fmaxf(cm, s[j]);
        const float mn = fmaxf(m, cm), alpha = __expf(m - mn);
        float ps = 0.f;
#pragma unroll
        for (int j = 0; j < 8; ++j) { s[j] = __expf(s[j] - mn); ps += s[j]; }
        l = l * alpha + ps; m = mn;
#pragma unroll
        for (int d = 0; d < DVT; ++d) {
            float a[8]; unpack8(*(const u32x4*)(VT + (size_t)d * R_ + c), a);
            float t = O[d] * alpha;
#pragma unroll
            for (int j = 0; j < 8; ++j) t += s[j] * a[j];
            O[d] = t;
            if ((d & 7) == 7) __builtin_amdgcn_sched_barrier(0);
        }
    }
    lsum = l;
}

__device__ void phase_attn0(const Params& p, char* lds, int bid, int nblk) {
    Bufs B(p);
    const int tid = ltid();
    float* xch = (float*)lds;
    const float lam = B.scal[0];
    for (int item = bid + ((OPTA & 1) ? 1040 : 0); item < ((OPTA & 4) ? 1040 : 1300); item += nblk) {
        if (item < 1040) {
            const int head = item / 260, chunk = item % 260, role = tid >> 6, m = role >> 2, qt = role & 3, qi = tid & 63, r = chunk * 64 + qi, sub = head * 2 + m;
            const int nk = chunk < 4 ? 256 : R_;
            float O[32]; float l;
            naive_dense<64, 32>(B.qkv + O_QA + ((size_t)sub * R_ + r) * 64, B.qkv + O_KA + (size_t)sub * R_ * 64, B.qkv + O_VAT + ((size_t)head * 128 + qt * 32) * R_, nk, 0.125f, O, l);
            const float inv = 1.f / l;
#pragma unroll
            for (int d = 0; d < 32; ++d) O[d] *= inv;
            float* xh = xch + (qt * 64 + qi) * 33;
            __syncthreads();
            if (m == 1) {
#pragma unroll
                for (int d = 0; d < 32; ++d) xh[d] = O[d];
            }
            __syncthreads();
            if (m == 0) {
#pragma unroll
                for (int d = 0; d < 32; ++d) O[d] -= lam * xh[d];
            }
            __syncthreads();
            float ss = 0.f;
#pragma unroll
            for (int d = 0; d < 32; ++d) ss += O[d] * O[d];
            if (m == 0) xh[0] = ss;
            __syncthreads();
            if (m == 0) {
                const float tot = xch[(0 * 64 + qi) * 33] + xch[(1 * 64 + qi) * 33] + xch[(2 * 64 + qi) * 33] + xch[(3 * 64 + qi) * 33];
                const float rr = rsqrtf(tot * (1.f / 128.f) + EPS_) * 0.8f;
                bf16_t* dst = B.mix + (size_t)r * 1024 + head * 128 + qt * 32;
                const float* g = p.in[I_SUBLN] + qt * 32;
#pragma unroll
                for (int d = 0; d < 32; d += 2) *(u32*)(dst + d) = (u32)f2bf(O[d] * rr * g[d]) | ((u32)f2bf(O[d + 1] * rr * g[d + 1]) << 16);
            }
            __syncthreads();
        } else {
            const int idx = (item - 1040) * NT + tid, h = idx / R_, r = idx % R_;
            const bf16_t* q = B.qkv + O_QB + ((size_t)h * R_ + r) * 64;
            const bf16_t* Kb = B.qkv + O_KB + (size_t)h * R_ * 64;
            const bf16_t* VT = B.qkv + O_VBT + (size_t)h * 64 * R_;
            float qf[64];
#pragma unroll
            for (int i = 0; i < 8; ++i) { float a[8]; unpack8(*(const u32x4*)(q + i * 8), a);
#pragma unroll
                for (int j = 0; j < 8; ++j) qf[i * 8 + j] = a[j] * 0.125f; }
            float O[64];
#pragma unroll
            for (int d = 0; d < 64; ++d) O[d] = 0.f;
            float m = -1e30f, l = 0.f;
            const int t = r - 256, row = t >> 6, col = t & 63;
            const int rs = min(max(row - 4, 0), 248), cs = min(max(col - 8, 0), 48);
            const int nkeys = r < 256 ? 256 : 384;
            for (int kk = 0; kk < nkeys; ++kk) {
                int key; float bias = 0.f;
                if (kk < 256) key = kk;
                else { const int w = kk - 256, kr = rs + (w >> 4), kc = cs + (w & 15); key = 256 + kr * 64 + kc; bias = p.in[I_RPB][(h * 15 + (kr - row + 7)) * 31 + (kc - col + 15)]; }
                const bf16_t* krow = Kb + (size_t)key * 64; float s = bias;
#pragma unroll
                for (int i = 0; i < 8; ++i) { float a[8]; unpack8(*(const u32x4*)(krow + i * 8), a);
#pragma unroll
                    for (int j = 0; j < 8; ++j) s += a[j] * qf[i * 8 + j]; }
                const float mn = fmaxf(m, s), alpha = __expf(m - mn), pp = __expf(s - mn);
                l = l * alpha + pp; m = mn;
                const int vp = vpos(key);
#pragma unroll
                for (int d = 0; d < 64; ++d) O[d] = O[d] * alpha + pp * bf2f(VT[(size_t)d * R_ + vp]);
            }
            const float inv = 1.f / l;
            bf16_t* dst = B.mix + (size_t)r * 1024 + 512 + h * 64;
#pragma unroll
            for (int d = 0; d < 64; d += 2) *(u32*)(dst + d) = (u32)f2bf(O[d] * inv) | ((u32)f2bf(O[d + 1] * inv) << 16);
        }
    }
}

__device__ void phase_out(const Params& p, int l, int bid, int nblk) {
    Bufs B(p);
    const int tid = ltid(), cc = tid & 127, rg = tid >> 7;
    const float* W = p.in[l == 0 ? I_EWOUT : I_OWOUT];
    const int rt0 = l == 0 ? 0 : 16, nrt = R_ / 16 - rt0;
    for (int item = bid; item < nrt * 8; item += nblk) {
        const int rt = rt0 + item / 8, ct = item % 8, row0 = rt * 16, col = ct * 128 + cc;
        const bf16_t* ap[4];
#pragma unroll
        for (int i = 0; i < 4; ++i) ap[i] = B.mix + (size_t)(row0 + rg * 4 + i) * 1024;
        float acc[4];
        tile_linear<4>(acc, 1024, ap, W, 1024, col);
#pragma unroll
        for (int i = 0; i < 4; ++i) {
            const int r = row0 + rg * 4 + i;
            if (r < 256) B.xc[(size_t)r * 1024 + col] = p.in[I_CTX][(size_t)r * 1024 + col] + modp(B, l, 1, 2)[col] * acc[i];
            else { const size_t o = (size_t)(r - 256) * 1024 + col; p.out[o] = (l == 0 ? p.in[I_X][o] : p.out[o]) + modp(B, l, 0, 2)[col] * acc[i]; }
        }
    }
}

__device__ void phase_up(const Params& p, int l, char* lds, int bid, int nblk) {
    Bufs B(p);
    float* tile = (float*)lds;
    const int tid = ltid(), cc = tid & 127, rg = tid >> 7;
    const float* W = p.in[I_FUP] + (size_t)l * 1024 * F2_;
    const float* cw = p.in[I_FCW] + (size_t)l * 3 * F2_; const float* cb = p.in[I_FCB] + (size_t)l * F2_;
    const int rt0 = l == 0 ? 0 : 16, nrt = R_ / 16 - rt0;
    for (int item = bid; item < nrt * 44; item += nblk) {
        const int rt = rt0 + item / 44, ct = item % 44, row0 = rt * 16, c0 = ct * 64;
        const int lo = row0 < 256 ? 0 : 256, hi = row0 < 256 ? 256 : R_;
        const int wcol = cc < 64 ? c0 + cc : F_ + c0 + (cc - 64);
        const bf16_t* ap[5];
#pragma unroll
        for (int i = 0; i < 5; ++i) { const int rr = rg * 5 + i, r = row0 - 1 + rr; ap[i] = (rr < 18 && r >= lo && r < hi) ? B.h + (size_t)hrow(r) * 1024 : nullptr; }
        float acc[5];
        tile_linear<5>(acc, 1024, ap, W, F2_, wcol);
#pragma unroll
        for (int i = 0; i < 5; ++i) tile[(rg * 5 + i) * 128 + cc] = acc[i];
        __syncthreads();
        for (int e = tid; e < 16 * 64; e += NT) {
            const int rr = e >> 6, c = e & 63, ca = c0 + c, cg = F_ + c0 + c;
            const float a = cb[ca] + tile[rr * 128 + c] * cw[ca] + tile[(rr + 1) * 128 + c] * cw[F2_ + ca] + tile[(rr + 2) * 128 + c] * cw[2 * F2_ + ca];
            const float g = cb[cg] + tile[rr * 128 + 64 + c] * cw[cg] + tile[(rr + 1) * 128 + 64 + c] * cw[F2_ + cg] + tile[(rr + 2) * 128 + 64 + c] * cw[2 * F2_ + cg];
            B.act[(size_t)(row0 + rr) * F_ + ca] = f2bf(a * (g / (1.f + __expf(-g))));
        }
        __syncthreads();
    }
}

__device__ void phase_down(const Params& p, int l, int bid, int nblk) {
    Bufs B(p);
    const int tid = ltid(), cc = tid & 127, rg = tid >> 7;
    const float* W = p.in[I_FDOWN] + (size_t)l * F_ * 1024;
    const int rt0 = l == 0 ? 0 : 16, nrt = R_ / 16 - rt0;
    for (int item = bid; item < nrt * 8; item += nblk) {
        const int rt = rt0 + item / 8, ct = item % 8, row0 = rt * 16, col = ct * 128 + cc;
        const bf16_t* ap[4];
#pragma unroll
        for (int i = 0; i < 4; ++i) ap[i] = B.act + (size_t)(row0 + rg * 4 + i) * F_;
        float acc[4];
        tile_linear<4>(acc, F_, ap, W, 1024, col);
#pragma unroll
        for (int i = 0; i < 4; ++i) {
            const int r = row0 + rg * 4 + i;
            if (r < 256) B.xc[(size_t)r * 1024 + col] += modp(B, l, 1, 5)[col] * acc[i];
            else p.out[(size_t)(r - 256) * 1024 + col] += modp(B, l, 0, 5)[col] * acc[i];
        }
    }
}

__device__ void phase_qkv1a(const Params& p, char* lds, int bid, int nblk) {
    Bufs B(p);
    float* tile = (float*)lds;
    const int tid = ltid(), cc = tid & 127, rg = tid >> 7, wid = tid >> 6, lane = tid & 63;
    const float* W = p.in[I_OWIN];
    for (int item = bid; item < (R_ / 16) * 12; item += nblk) {
        const int rt = item / 12, ct = item % 12, row0 = rt * 16, v0 = ct * 128;
        const int v = v0 + cc;
        int wcol;
        if (v < 640) wcol = v; else if (v < 1152) wcol = 672 + (v - 640); else if (v < 1280) wcol = 1184 + (v - 1152); else if (v < 1408) wcol = 1312 + (v - 1280);
        else if (v < 1440) wcol = 640 + (v - 1408); else wcol = -1;
        const bf16_t* ap[4];
#pragma unroll
        for (int i = 0; i < 4; ++i) ap[i] = B.h + (size_t)hrow(row0 + rg * 4 + i) * 1024;
        float acc[4];
        tile_linear<4>(acc, 1024, ap, W, 1440, wcol);
#pragma unroll
        for (int i = 0; i < 4; ++i) tile[(rg * 4 + i) * 128 + cc] = acc[i];
        __syncthreads();
        if (ct < 5) {
            for (int e = tid; e < 16 * 128; e += NT) {
                const int rr = e >> 7, c = e & 127, r = row0 + rr;
                if (ct < 3) B.qkv[O_CQ + (size_t)r * 384 + v0 + c] = f2bf(tile[e]);
                else B.qkv[O_CKV + (size_t)r * 256 + (v0 - 384) + c] = f2bf(tile[e]);
            }
        } else if (ct < 10) {
            for (int q = wid * 4; q < wid * 4 + 4; ++q) {
                const int rr = q >> 1, hh = q & 1, r = row0 + rr;
                if (ct < 9) head64_norm_rope(tile + rr * 128 + hh * 64, p.in[I_DQN], r >= 256, B.rope, r - 256, B.qkv + O_GQ + ((size_t)((ct - 5) * 2 + hh) * R_ + r) * 64, lane);
                else head64_norm_rope(tile + rr * 128 + hh * 64, p.in[I_DKN], r >= 256, B.rope, r - 256, B.qkv + O_GK + ((size_t)hh * R_ + r) * 64, lane);
            }
        } else if (ct == 10) {
            for (int e = tid; e < 16 * 128; e += NT) {
                const int c = e >> 4, rr = e & 15, r = row0 + rr;
                B.qkv[O_GVT + ((size_t)(c >> 6) * 64 + (c & 63)) * R_ + vpos(r)] = f2bf(tile[rr * 128 + c]);
            }
        } else {
            for (int e = tid; e < 16 * 32; e += NT) { const int rr = e >> 5, c = e & 31; B.qkv[O_CKR + (size_t)(row0 + rr) * 32 + c] = f2bf(tile[rr * 128 + c]); }
        }
        __syncthreads();
    }
}

__device__ __forceinline__ void head96_norm_rope(const float* row, const float* g, bool rope, const float* tab, int t, bf16_t* dst, int lane) {
    const float v0 = row[lane], v1 = lane < 32 ? row[64 + lane] : 0.f;
    const float ss = wave_sum(v0 * v0 + v1 * v1);
    const float rr = rsqrtf(ss * (1.f / 96.f) + EPS_);
    dst[lane] = f2bf(v0 * rr * g[lane]);
    if (lane < 32) {
        float y = v1 * rr * g[64 + lane];
        if (rope) {
            const float yp = row[64 + (lane ^ 16)] * rr * g[64 + (lane ^ 16)];
            const float2 cs = rope32(tab, t, lane & 15);
            y = lane < 16 ? (y * cs.x - yp * cs.y) : (yp * cs.y + y * cs.x);
        }
        dst[64 + lane] = f2bf(y);
    }
}

__device__ void phase_qkv1b(const Params& p, char* lds, int bid, int nblk) {
    Bufs B(p);
    float* tile = (float*)lds;
    float* rsl = (float*)lds + 16 * 128;
    const int tid = ltid(), cc = tid & 127, rg = tid >> 7, wid = tid >> 6, lane = tid & 63;
    for (int item = bid; item < (R_ / 16) * 16; item += nblk) {
        const int rt = item / 16, ht = item % 16, row0 = rt * 16;
        const bool isq = ht < 8; const int head = ht & 7;
        const int K = isq ? 384 : 256;
        const bf16_t* src = B.qkv + (isq ? O_CQ : O_CKV);
        for (int rr = wid * 2; rr < wid * 2 + 2; ++rr) {
            float ss = 0.f;
            for (int k = lane; k < K; k += 64) { const float v = bf2f(src[(size_t)(row0 + rr) * K + k]); ss += v * v; }
            ss = wave_sum(ss);
            if (lane == 0) rsl[rr] = rsqrtf(ss / (float)K + EPS_);
        }
        __syncthreads();
        const bf16_t* ap[4]; float rs[4];
#pragma unroll
        for (int i = 0; i < 4; ++i) { ap[i] = src + (size_t)(row0 + rg * 4 + i) * K; rs[i] = rsl[rg * 4 + i]; }
        float acc[4];
        if (isq) tile_linear_g<4>(acc, 384, ap, rs, p.in[I_CQAN], p.in[I_CWQB], 768, cc < 96 ? head * 96 + cc : -1);
        else tile_linear_g<4>(acc, 256, ap, rs, p.in[I_CKVAN], p.in[I_CWKVB], 1024, head * 128 + cc);
#pragma unroll
        for (int i = 0; i < 4; ++i) tile[(rg * 4 + i) * 128 + cc] = acc[i];
        __syncthreads();
        if (isq) {
            for (int rr = wid * 2; rr < wid * 2 + 2; ++rr) { const int r = row0 + rr;
                head96_norm_rope(tile + rr * 128, p.in[I_CQN], r >= 256, B.rope, r - 256, B.qkv + O_MQ + ((size_t)head * R_ + r) * 96, lane); }
        } else {
            for (int e = tid; e < 16 * 64; e += NT) { const int d = e >> 4, rr = e & 15; B.qkv[O_MVT + ((size_t)head * 64 + d) * R_ + vpos(row0 + rr)] = f2bf(tile[rr * 128 + 64 + d]); }
            __syncthreads();
            for (int e = tid; e < 16 * 32; e += NT) { const int rr = e >> 5, c = e & 31; tile[rr * 128 + 64 + c] = bf2f(B.qkv[O_CKR + (size_t)(row0 + rr) * 32 + c]); }
            __syncthreads();
            for (int rr = wid * 2; rr < wid * 2 + 2; ++rr) { const int r = row0 + rr;
                head96_norm_rope(tile + rr * 128, p.in[I_CKN], r >= 256, B.rope, r - 256, B.qkv + O_MK + ((size_t)head * R_ + r) * 96, lane); }
        }
        __syncthreads();
    }
}

__device__ void phase_attn1(const Params& p, int bid, int nblk) {
    Bufs B(p);
    const int tid = ltid();
    for (int item = bid + ((OPTA & 2) ? 512 : 0); item < ((OPTA & 8) ? 512 : 1024); item += nblk) {
        if (item < 512) {
            const int head = item / 64, half = tid >> 8, r = 256 + (item % 64) * 256 + (tid & 255);
            float O[32]; float l;
            naive_dense<96, 32>(B.qkv + O_MQ + ((size_t)head * R_ + r) * 96, B.qkv + O_MK + (size_t)head * R_ * 96, B.qkv + O_MVT + ((size_t)head * 64 + half * 32) * R_, R_, 0.10206207261596575f, O, l);
            const float inv = 1.f / l;
            bf16_t* dst = B.mix + (size_t)r * 1024 + head * 64 + half * 32;
#pragma unroll
            for (int d = 0; d < 32; d += 2) *(u32*)(dst + d) = (u32)f2bf(O[d] * inv) | ((u32)f2bf(O[d + 1] * inv) << 16);
        } else {
            const int idx = (item - 512) * NT + tid, half = idx / (8 * T_), hq = (idx / T_) & 7, t = idx % T_, r = 256 + t, kvh = hq >> 2;
            const bf16_t* q = B.qkv + O_GQ + ((size_t)hq * R_ + r) * 64;
            const bf16_t* Kb = B.qkv + O_GK + (size_t)kvh * R_ * 64;
            const bf16_t* VT = B.qkv + O_GVT + ((size_t)kvh * 64 + half * 32) * R_;
            u32x4 qp[8];
#pragma unroll
            for (int i = 0; i < 8; ++i) qp[i] = *(const u32x4*)(q + i * 8);
            float O[32];
#pragma unroll
            for (int d = 0; d < 32; ++d) O[d] = 0.f;
            float m = -1e30f, l = 0.f;
            const int j0 = max(t - 128, 0), j1 = min(t + 128, T_ - 1);
            const int nkeys = 256 + (j1 - j0 + 1);
            for (int kk = 0; kk < nkeys; ++kk) {
                const int key = kk < 256 ? kk : 256 + j0 + (kk - 256);
                const bf16_t* krow = Kb + (size_t)key * 64; float s = 0.f;
#pragma unroll
                for (int i = 0; i < 8; ++i) s += dot8p(*(const u32x4*)(krow + i * 8), qp[i].x, qp[i].y, qp[i].z, qp[i].w);
                s *= 0.125f;
                const float mn = fmaxf(m, s), alpha = __expf(m - mn), pp = __expf(s - mn);
                l = l * alpha + pp; m = mn;
                const int vp = vpos(key);
#pragma unroll
                for (int d = 0; d < 32; ++d) O[d] = O[d] * alpha + pp * bf2f(VT[(size_t)d * R_ + vp]);
            }
            { const float s = p.in[I_SINK][hq]; const float mn = fmaxf(m, s), alpha = __expf(m - mn); l = l * alpha + __expf(s - mn);
#pragma unroll
              for (int d = 0; d < 32; ++d) O[d] *= alpha; }
            const float inv = 1.f / l;
            bf16_t* dst = B.mix + (size_t)r * 1024 + 512 + hq * 64 + half * 32;
#pragma unroll
            for (int d = 0; d < 32; d += 2) *(u32*)(dst + d) = (u32)f2bf(O[d] * inv) | ((u32)f2bf(O[d + 1] * inv) << 16);
        }
    }
}

#define LAS __attribute__((address_space(3)))
typedef short bf16x8 __attribute__((ext_vector_type(8)));
typedef float f32x4 __attribute__((ext_vector_type(4)));
constexpr int LDS_STAGE = 131072, LDS_XCH = LDS_STAGE, LDS_BYTES = 147456;

__device__ __forceinline__ u32 pk2(float lo, float hi) { return (u32)f2bf(lo) | ((u32)f2bf(hi) << 16); }

namespace pg8 {
constexpr int BM = 256, BK = 64, HALF = 128, HTB = HALF * BK * 2, NXCD = 8, WGM = 8;
__host__ __device__ __forceinline__ int lds_byte(int r, int c) { const int st = (r >> 4) * 2 + (c >> 5), rr = r & 15, cc = c & 31, ob = rr * 64 + cc * 2; return st * 1024 + (ob ^ (((ob >> 9) & 1) << 5)); }
__host__ __device__ __forceinline__ void stage_rc(int b, int& R, int& C) { const int st = b / 1024, sb = b % 1024, swz = sb ^ (((sb >> 9) & 1) << 5); R = (st >> 1) * 16 + swz / 64; C = (st & 1) * 32 + (swz % 64) / 2; }
struct Unit { int pm, pn; };
struct Gemm { const bf16_t* A; const bf16_t* Bt; int K; };
struct Order {
    int nM, nN, nwg, G, c, pm0, amode;
    __device__ void init(int nM_, int nN_, int G_, int c_, int pm0_, int amode_) { nM = nM_; nN = nN_; nwg = nM * nN; G = G_; c = c_; pm0 = pm0_; amode = amode_; }
    __device__ bool next(int i, Unit& u) const {
        const long L = (long)i * G + c; if (L >= nwg) return false;
        int wgid = (int)L; { const int q = nwg / NXCD, r = nwg % NXCD, xcd = wgid % NXCD, off = wgid / NXCD; wgid = (xcd < r ? xcd * (q + 1) : r * (q + 1) + (xcd - r) * q) + off; }
        const int nig = WGM * nN, gid = wgid / nig, fm = gid * WGM, gsz = (nM - fm) < WGM ? (nM - fm) : WGM;
        u.pm = pm0 + fm + ((wgid % nig) % gsz); u.pn = (wgid % nig) / gsz; return true;
    }
    __device__ __forceinline__ int arow(int pm) const { return amode == 0 ? 256 * pm : amode == 1 ? (pm == 0 ? 1 : 2 + 256 * pm) : (pm < 2 ? 254 * pm : 257 + 254 * (pm - 2)); }
    __device__ __forceinline__ void a_ready(const Unit&) const {}
    __device__ __forceinline__ void done(const Unit&) const {}
};

template <class Epi, class Sched, bool ALIGN_EPI, bool SP2>
__device__ __forceinline__ void gemm_phase(LAS unsigned char* lds, const Gemm g, const Sched& S, const Epi& E) {
    const int tid = ltid(), wid = __builtin_amdgcn_readfirstlane(tid >> 6), lane = tid & 63, wr = wid >> 2, wc = wid & 3, fr = lane & 15, fq = lane >> 4;
    int K_ = g.K; asm volatile("" : "+s"(K_));
    const int K = K_, nt = K / BK;
    unsigned voffA[2], voffB[2];
#pragma unroll
    for (int i = 0; i < 2; ++i) { int R, C; stage_rc(tid * 16 + i * 8192, R, C); voffA[i] = (unsigned)(R * K + C) * 2u; voffB[i] = (unsigned)(R * K + C) * 2u; }
    const size_t kstep = (size_t)(BK * 2);
    const size_t hstep = (size_t)HALF * K * 2;
    const size_t tstep = 2 * hstep;
    const size_t rstep = (size_t)K * 2;
    const unsigned ldsw = (unsigned)wid * 1024u;
    const int aoff = lds_byte(wr * 64 + fr, fq * 8), boff = lds_byte(wc * 32 + fr, fq * 8);
#define PG8_SA(b, h) (((b) * 2 + (h)) * HTB)
#define PG8_SB(b, h) ((4 + (b) * 2 + (h)) * HTB)
#define PG8_STAGE(bufoff, gbase, voff) do { _Pragma("unroll") for (int _i = 0; _i < 2; ++_i) \
        __builtin_amdgcn_global_load_lds((const unsigned*)((const char*)(gbase) + (voff)[_i]), (LAS unsigned*)(lds + (bufoff) + ldsw + _i * 8192), 16, 0, 0); } while (0)
#define PG8_LDA(dst, b, h) do { _Pragma("unroll") for (int m = 0; m < 4; ++m) _Pragma("unroll") for (int k = 0; k < 2; ++k) dst[m][k] = *(const LAS bf16x8*)(lds + PG8_SA(b, h) + aoff + m * 2048 + k * 1024); } while (0)
#define PG8_LDB(dst, b, h) do { _Pragma("unroll") for (int n = 0; n < 2; ++n) _Pragma("unroll") for (int k = 0; k < 2; ++k) dst[n][k] = *(const LAS bf16x8*)(lds + PG8_SB(b, h) + boff + n * 2048 + k * 1024); } while (0)
#define PG8_MMA(ai, bj, At, Bt) do { __builtin_amdgcn_s_setprio(1); _Pragma("unroll") for (int m = 0; m < 4; ++m) _Pragma("unroll") for (int n = 0; n < 2; ++n) _Pragma("unroll") for (int k = 0; k < 2; ++k) \
        acc[ai][bj][m][n] = __builtin_amdgcn_mfma_f32_16x16x32_bf16(Bt[n][k], At[m][k], acc[ai][bj][m][n], 0, 0, 0); __builtin_amdgcn_s_setprio(0); } while (0)
#define PG8_WAIT_V(n) asm volatile("s_waitcnt vmcnt(" #n ")" ::: "memory")
#define PG8_WAIT_L(n) asm volatile("s_waitcnt lgkmcnt(" #n ")" ::: "memory")
#define PG8_BAR __builtin_amdgcn_s_barrier()
#define PG8_SCHED __builtin_amdgcn_sched_barrier(0)
    Unit cur, nxt; int ui = 0;
    if (!S.next(0, cur)) return;
    f32x4 acc[2][2][4][2];
#pragma unroll
    for (int a = 0; a < 2; ++a)
#pragma unroll
        for (int b = 0; b < 2; ++b)
#pragma unroll
            for (int m = 0; m < 4; ++m)
#pragma unroll
                for (int n = 0; n < 2; ++n) acc[a][b][m][n] = (f32x4){0.f, 0.f, 0.f, 0.f};
    bf16x8 At[4][2], B0[2][2], B1[2][2];
    const char* cA = (const char*)g.A + (size_t)S.arow(cur.pm) * rstep; const char* cB = (const char*)g.Bt + (size_t)cur.pn * tstep;
    S.a_ready(cur);
    if constexpr (SP2) {
        PG8_STAGE(PG8_SB(0, 0), cB, voffB); PG8_STAGE(PG8_SB(0, 1), cB + hstep, voffB); PG8_STAGE(PG8_SA(0, 0), cA, voffA); PG8_STAGE(PG8_SA(0, 1), cA + hstep, voffA);
        if (wr == 1) PG8_BAR;
        PG8_WAIT_V(2); PG8_BAR;
        PG8_STAGE(PG8_SB(1, 0), cB + kstep, voffB); PG8_STAGE(PG8_SA(1, 0), cA + kstep, voffA); PG8_STAGE(PG8_SB(1, 1), cB + hstep + kstep, voffB);
        PG8_WAIT_V(6); PG8_BAR;
    } else {
        PG8_STAGE(PG8_SB(0, 0), cB, voffB); PG8_STAGE(PG8_SA(0, 0), cA, voffA); PG8_STAGE(PG8_SB(0, 1), cB + hstep, voffB); PG8_STAGE(PG8_SA(0, 1), cA + hstep, voffA);
        if (wr == 1) PG8_BAR;
        PG8_WAIT_V(4); PG8_BAR;
        PG8_STAGE(PG8_SB(1, 0), cB + kstep, voffB); PG8_STAGE(PG8_SA(1, 0), cA + kstep, voffA); PG8_STAGE(PG8_SB(1, 1), cB + hstep + kstep, voffB);
        PG8_WAIT_V(6); PG8_BAR;
    }
    for (;;) {
        const bool has_next = S.next(ui + 1, nxt);
        const char* nA = has_next ? (const char*)g.A + (size_t)S.arow(nxt.pm) * rstep : cA; const char* nB = has_next ? (const char*)g.Bt + (size_t)nxt.pn * tstep : cB;
        for (int t = 0; t < nt; t += 2) {
            const bool last = (t == nt - 2);
            const char* a1 = cA + (size_t)(t + 1) * kstep;
            const char* a2 = last ? nA : cA + (size_t)(t + 2) * kstep; const char* b2 = last ? nB : cB + (size_t)(t + 2) * kstep;
            const char* a3 = a2 + kstep; const char* b3 = b2 + kstep;
            if (last && has_next) S.a_ready(nxt);
            if constexpr (SP2) {
            PG8_LDB(B0, 0, 0); PG8_LDB(B1, 0, 1); PG8_SCHED; PG8_LDA(At, 0, 0); PG8_STAGE(PG8_SA(1, 1), a1 + hstep, voffA);
            PG8_WAIT_V(8); PG8_WAIT_L(0); PG8_BAR; PG8_MMA(0, 0, At, B0); PG8_MMA(0, 1, At, B1); PG8_BAR; PG8_SCHED;
            PG8_LDA(At, 0, 1); PG8_STAGE(PG8_SB(0, 0), b2, voffB); PG8_STAGE(PG8_SB(0, 1), b2 + hstep, voffB); PG8_STAGE(PG8_SA(0, 0), a2, voffA);
            PG8_WAIT_V(8); PG8_WAIT_L(0); PG8_BAR; PG8_MMA(1, 0, At, B0); PG8_MMA(1, 1, At, B1); PG8_BAR; PG8_SCHED;
            PG8_LDB(B0, 1, 0); PG8_LDB(B1, 1, 1); PG8_SCHED; PG8_LDA(At, 1, 0); PG8_STAGE(PG8_SA(0, 1), a2 + hstep, voffA);
            PG8_WAIT_V(8); PG8_WAIT_L(0); PG8_BAR; PG8_MMA(0, 0, At, B0); PG8_MMA(0, 1, At, B1); PG8_BAR; PG8_SCHED;
            PG8_LDA(At, 1, 1); PG8_STAGE(PG8_SB(1, 0), b3, voffB); PG8_STAGE(PG8_SB(1, 1), b3 + hstep, voffB); PG8_STAGE(PG8_SA(1, 0), a3, voffA);
            PG8_WAIT_V(8); PG8_WAIT_L(0); PG8_BAR; PG8_MMA(1, 0, At, B0); PG8_MMA(1, 1, At, B1); PG8_BAR; PG8_SCHED;
            } else {
            PG8_LDB(B0, 0, 0); PG8_SCHED; PG8_LDA(At, 0, 0); PG8_STAGE(PG8_SA(1, 1), a1 + hstep, voffA);
            PG8_WAIT_L(8); PG8_BAR; PG8_WAIT_L(0); PG8_MMA(0, 0, At, B0); PG8_BAR; PG8_SCHED;
            PG8_LDB(B1, 0, 1); PG8_STAGE(PG8_SB(0, 0), b2, voffB);
            PG8_BAR; PG8_WAIT_L(0); PG8_MMA(0, 1, At, B1); PG8_BAR;
            PG8_LDA(At, 0, 1); PG8_STAGE(PG8_SA(0, 0), a2, voffA);
            PG8_BAR; PG8_WAIT_L(0); PG8_MMA(1, 0, At, B0); PG8_BAR; PG8_SCHED;
            PG8_STAGE(PG8_SB(0, 1), b2 + hstep, voffB);
            PG8_WAIT_V(6); PG8_BAR; PG8_MMA(1, 1, At, B1); PG8_BAR;
            PG8_LDB(B0, 1, 0); PG8_SCHED; PG8_LDA(At, 1, 0); PG8_STAGE(PG8_SA(0, 1), a2 + hstep, voffA);
            PG8_WAIT_L(8); PG8_BAR; PG8_WAIT_L(0); PG8_MMA(0, 0, At, B0); PG8_BAR; PG8_SCHED;
            PG8_LDB(B1, 1, 1); PG8_STAGE(PG8_SB(1, 0), b3, voffB);
            PG8_BAR; PG8_WAIT_L(0); PG8_MMA(0, 1, At, B1); PG8_BAR;
            PG8_LDA(At, 1, 1); PG8_STAGE(PG8_SA(1, 0), a3, voffA);
            PG8_BAR; PG8_WAIT_L(0); PG8_MMA(1, 0, At, B0); PG8_BAR; PG8_SCHED;
            PG8_STAGE(PG8_SB(1, 1), b3 + hstep, voffB);
            PG8_WAIT_V(6); PG8_BAR; PG8_MMA(1, 1, At, B1); PG8_BAR;
            }
        }
        if constexpr (ALIGN_EPI) { if (wr == 0) PG8_BAR; }
        E(acc, cur, wr, wc, fr, fq); S.done(cur);
        if (!has_next) break;
#pragma unroll
        for (int a = 0; a < 2; ++a)
#pragma unroll
            for (int b = 0; b < 2; ++b)
#pragma unroll
                for (int m = 0; m < 4; ++m)
#pragma unroll
                    for (int n = 0; n < 2; ++n) acc[a][b][m][n] = (f32x4){0.f, 0.f, 0.f, 0.f};
        cur = nxt; cA = nA; cB = nB; ++ui;
        if constexpr (ALIGN_EPI) { if (wr == 1) PG8_BAR; }
    }
    PG8_WAIT_V(0);
    if constexpr (!ALIGN_EPI) { if (wr == 0) PG8_BAR; }
    PG8_BAR;
#undef PG8_SA
#undef PG8_SB
#undef PG8_STAGE
#undef PG8_LDA
#undef PG8_LDB
#undef PG8_MMA
#undef PG8_WAIT_V
#undef PG8_WAIT_L
#undef PG8_BAR
#undef PG8_SCHED
}
}

constexpr float QS64 = 0.125f * 1.4426950408889634f, QS96 = 0.10206207261596575f * 1.4426950408889634f;
typedef f32x4 AccT[2][2][4][2];
__device__ __forceinline__ const float* launder(const float* p) { asm volatile("" : "+s"(p)); return p; }
#define EPI_IDS() int t_ = ltid(); const int fr = t_ & 15, fq = (t_ >> 4) & 3; const int wid_ = __builtin_amdgcn_readfirstlane(t_ >> 6), wr = wid_ >> 2, wc = wid_ & 3; (void)wr; (void)wc; (void)fr; (void)fq
#define ITER_FENCE() do { asm volatile("" ::: "memory"); __builtin_amdgcn_sched_barrier(0); } while (0)
#define EPI_BARRIER() do { asm volatile("s_waitcnt lgkmcnt(0)" ::: "memory"); __builtin_amdgcn_s_barrier(); asm volatile("" ::: "memory"); } while (0)

__device__ __forceinline__ int vcol_of_row(int J) { const int pn = J >> 8, j = J & 255, bj = j >> 7, wc = (j >> 5) & 3, n = (j >> 4) & 1, fq = (j >> 2) & 3, e = j & 3; return 256 * pn + 64 * wc + 32 * bj + 8 * fq + 4 * n + e; }
__device__ __forceinline__ int gmap(int map, int v) {
    if (map == 0) return v;
    if (map == 1) { const int pn = v >> 8, wc = (v >> 6) & 3, bj = (v >> 5) & 1, x = v & 31, h = 128 * pn + 32 * wc + x; return bj ? F_ + h : h; }
    if (map == 2) { if (v < 384) return v; if (v < 512) return 1184 + (v - 384); if (v < 768) return 384 + (v - 512); if (v < 1280) return 672 + (v - 768);
                    if (v < 1408) return 1312 + (v - 1280); if (v < 1440) return 640 + (v - 1408); return -1; }
    { const int hh = v >> 7, y = v & 127; if (y < 64) return hh * 96 + y; const int x = y - 64; if (x >= 32) return -1; const int fq = x >> 3, n = (x >> 2) & 1, e = x & 3; return hh * 96 + 64 + 16 * n + 4 * fq + e; }
}
__device__ __forceinline__ void prep_item(const float* __restrict__ W, int K, int ldw, bf16_t* Bt, int NV, int map, const float* kscale, float* scr, int item, int lane) {
    const int nb32 = NV / 32, kb = item / nb32, nb = item % nb32, k0 = 64 * kb, J0 = 32 * nb;
    const int col = gmap(map, vcol_of_row(J0 + (lane & 31)));
#pragma unroll 8
    for (int i = 0; i < 32; ++i) { const int kk = 2 * i + (lane >> 5); float v = col >= 0 ? W[(size_t)(k0 + kk) * ldw + col] : 0.f; if (kscale) v *= kscale[k0 + kk]; scr[kk * 33 + (lane & 31)] = v; }
    __builtin_amdgcn_wave_barrier();
    asm volatile("s_waitcnt lgkmcnt(0)" ::: "memory");
    const int c = lane & 7;
#pragma unroll
    for (int j = 0; j < 4; ++j) { const int n = (lane >> 3) + 8 * j; const float* s = scr + (8 * c) * 33 + n;
        u32x4 o; o.x = pk2(s[0 * 33], s[1 * 33]); o.y = pk2(s[2 * 33], s[3 * 33]); o.z = pk2(s[4 * 33], s[5 * 33]); o.w = pk2(s[6 * 33], s[7 * 33]);
        *(u32x4*)(Bt + (size_t)(J0 + n) * K + k0 + 8 * c) = o; }
    asm volatile("s_waitcnt lgkmcnt(0)" ::: "memory");
    __builtin_amdgcn_wave_barrier();
}
__device__ void phase_prep_weights(const Params& p, char* lds, int bid, int nblk) {
    Bufs B(p);
    const int wid = ltid() >> 6, lane = ltid() & 63;
    float* scr = (float*)lds + wid * (64 * 33 + 16);
    constexpr int I0 = 16 * 96, I1 = 16 * 32, I2 = 16 * 176, I3 = 44 * 32, I4 = 16 * 48, I5 = 16 * 32, I6 = 6 * 32, I7 = 4 * 32;
    constexpr int NIT = I0 + I1 + 2 * I2 + 2 * I3 + I4 + I5 + I6 + I7;
    for (int it = bid * 8 + wid; it < NIT; it += nblk * 8) {
        int r = it;
        if (r < I0) { prep_item(p.in[I_EWIN], 1024, 3072, B.wt + W_EIN, 3072, 0, nullptr, scr, r, lane); continue; } r -= I0;
        if (r < I1) { prep_item(p.in[I_EWOUT], 1024, 1024, B.wt + W_EOUT, 1024, 0, nullptr, scr, r, lane); continue; } r -= I1;
        if (r < 2 * I2) { const int l = r / I2; prep_item(p.in[I_FUP] + (size_t)l * 1024 * F2_, 1024, F2_, B.wt + W_UP + (size_t)l * F2_ * 1024, F2_, 1, nullptr, scr, r % I2, lane); continue; } r -= 2 * I2;
        if (r < 2 * I3) { const int l = r / I3; prep_item(p.in[I_FDOWN] + (size_t)l * F_ * 1024, F_, 1024, B.wt + W_DOWN + (size_t)l * 1024 * F_, 1024, 0, nullptr, scr, r % I3, lane); continue; } r -= 2 * I3;
        if (r < I4) { prep_item(p.in[I_OWIN], 1024, 1440, B.wt + W_OIN, 1536, 2, nullptr, scr, r, lane); continue; } r -= I4;
        if (r < I5) { prep_item(p.in[I_OWOUT], 1024, 1024, B.wt + W_OOUT, 1024, 0, nullptr, scr, r, lane); continue; } r -= I5;
        if (r < I6) { prep_item(p.in[I_CWQB], 384, 768, B.wt + W_QB, 1024, 3, p.in[I_CQAN], scr, r, lane); continue; } r -= I6;
        prep_item(p.in[I_CWKVB], 256, 1024, B.wt + W_KVB, 1024, 0, p.in[I_CKVAN], scr, r, lane);
    }
}

__device__ __forceinline__ void head64_epi(const AccT& acc, int ai, int m, const float (&gn)[2][2][4], bool rope, const float* tab, int t, int fq, bf16_t* dst, float qscale) {
    float ss = 0.f;
#pragma unroll
    for (int bj = 0; bj < 2; ++bj)
#pragma unroll
        for (int n = 0; n < 2; ++n)
#pragma unroll
            for (int e = 0; e < 4; ++e) { const float v = acc[ai][bj][m][n][e]; ss += v * v; }
    ss += __shfl_xor(ss, 16); ss += __shfl_xor(ss, 32);
    const float rr = rsqrtf(ss * (1.f / 64.f) + EPS_) * qscale;
    float y[2][2][4];
#pragma unroll
    for (int bj = 0; bj < 2; ++bj)
#pragma unroll
        for (int n = 0; n < 2; ++n)
#pragma unroll
            for (int e = 0; e < 4; ++e) y[bj][n][e] = acc[ai][bj][m][n][e] * rr * gn[bj][n][e];
    if (rope) {
        const int pos = fq < 2 ? (t >> 6) : (t & 63);
        const float4* cs = (const float4*)(tab + (pos * 16 + 8 * (fq & 1)) * 2);
#pragma unroll
        for (int n = 0; n < 2; ++n) {
            const float4 c0 = cs[2 * n], c1 = cs[2 * n + 1];
            const float cv[4] = {c0.x, c0.z, c1.x, c1.z}, sv[4] = {c0.y, c0.w, c1.y, c1.w};
#pragma unroll
            for (int e = 0; e < 4; ++e) { const float x1 = y[0][n][e], x2 = y[1][n][e]; y[0][n][e] = x1 * cv[e] - x2 * sv[e]; y[1][n][e] = x1 * sv[e] + x2 * cv[e]; }
        }
    }
#pragma unroll
    for (int bj = 0; bj < 2; ++bj) {
        u32x4 w; w.x = pk2(y[bj][0][0], y[bj][0][1]); w.y = pk2(y[bj][0][2], y[bj][0][3]); w.z = pk2(y[bj][1][0], y[bj][1][1]); w.w = pk2(y[bj][1][2], y[bj][1][3]);
        *(u32x4*)(dst + 32 * bj + 8 * fq) = w;
    }
}
__device__ __forceinline__ void load_gain64(float (&gn)[2][2][4], const float* g, int fq) {
#pragma unroll
    for (int bj = 0; bj < 2; ++bj)
#pragma unroll
        for (int n = 0; n < 2; ++n) { const float4 t = *(const float4*)(g + 32 * bj + 8 * fq + 4 * n); gn[bj][n][0] = t.x; gn[bj][n][1] = t.y; gn[bj][n][2] = t.z; gn[bj][n][3] = t.w; }
}
__device__ __forceinline__ void vt_store(const AccT& acc, int ai, int m, float scale, bf16_t* vt, int fq, int r) {
    const int pos = vpos(r);
#pragma unroll
    for (int bj = 0; bj < 2; ++bj)
#pragma unroll
        for (int n = 0; n < 2; ++n)
#pragma unroll
            for (int e = 0; e < 4; ++e) vt[(size_t)(32 * bj + 8 * fq + 4 * n + e) * R_ + pos] = f2bf(acc[ai][bj][m][n][e] * scale);
}
__device__ __forceinline__ float raw_store(const AccT& acc, int ai, int m, bf16_t* dst, int fq) {
    float ss = 0.f;
#pragma unroll
    for (int bj = 0; bj < 2; ++bj) {
        u32x4 w; const f32x4 a = acc[ai][bj][m][0], b = acc[ai][bj][m][1];
        w.x = pk2(a[0], a[1]); w.y = pk2(a[2], a[3]); w.z = pk2(b[0], b[1]); w.w = pk2(b[2], b[3]);
        *(u32x4*)(dst + 32 * bj + 8 * fq) = w;
        float t[8]; unpack8(w, t);
#pragma unroll
        for (int j = 0; j < 8; ++j) ss += t[j] * t[j];
    }
    return ss;
}

struct EpiQKV0 {
    bf16_t* qkv; const float* rope; const float* gt;
    __device__ __forceinline__ void operator()(const AccT& acc, const pg8::Unit& u, int, int, int, int) const {
        EPI_IDS();
        const int seg = u.pn >> 1, r0 = u.pm * 256 + wr * 64 + fr;
        if (seg == 2 || seg == 5) {
            const size_t vo = seg == 2 ? O_VAT + ((size_t)((u.pn & 1) * 2 + (wc >> 1)) * 128 + 64 * (wc & 1)) * R_ : O_VBT + (size_t)((u.pn & 1) * 4 + wc) * 64 * R_;
            bf16_t* vt = qkv + vo;
#pragma unroll
            for (int ai = 0; ai < 2; ++ai)
#pragma unroll
                for (int m = 0; m < 4; ++m) { vt_store(acc, ai, m, 1.f, vt, fq, r0 + 128 * ai + 16 * m); ITER_FENCE(); }
        } else {
            float gn[2][2][4]; load_gain64(gn, gt + 64 * (seg < 2 ? seg : seg - 1), fq);
            const int head = (u.pn & 1) * 4 + wc;
            const size_t bo = (seg == 0 ? O_QA : seg == 1 ? O_KA : seg == 3 ? O_QB : O_KB) + (size_t)head * R_ * 64;
            bf16_t* base = qkv + bo;
            const bool rp = seg < 2 && u.pm > 0;
#pragma unroll
            for (int ai = 0; ai < 2; ++ai)
#pragma unroll
                for (int m = 0; m < 4; ++m) { const int r = r0 + 128 * ai + 16 * m; head64_epi(acc, ai, m, gn, rp, rope, r - 256, fq, base + (size_t)r * 64, (seg == 0 || seg == 3) ? QS64 : 1.f); ITER_FENCE(); }
        }
    }
};

struct EpiResid {
    const float* resid_lat; float* dst_lat; const float* resid_ctx; float* dst_ctx; const float* gate_lat; const float* gate_ctx;
    __device__ __forceinline__ void rows(const AccT& acc, const float* __restrict__ resid, float* dst, const float* __restrict__ gate, int row0, int col0) const {
        f32x4 gt[2][2];
#pragma unroll
        for (int bj = 0; bj < 2; ++bj)
#pragma unroll
            for (int n = 0; n < 2; ++n) gt[bj][n] = *(const f32x4*)(gate + col0 + 32 * bj + 4 * n);
#pragma unroll
        for (int ai = 0; ai < 2; ++ai)
#pragma unroll
            for (int m = 0; m < 4; ++m) {
                const size_t ro = (size_t)(row0 + 128 * ai + 16 * m) * 1024 + col0;
#pragma unroll
                for (int bj = 0; bj < 2; ++bj)
#pragma unroll
                    for (int n = 0; n < 2; ++n) { const f32x4 x = *(const f32x4*)(resid + ro + 32 * bj + 4 * n); *(f32x4*)(dst + ro + 32 * bj + 4 * n) = x + gt[bj][n] * acc[ai][bj][m][n]; }
                ITER_FENCE();
            }
    }
    __device__ __forceinline__ void operator()(const AccT& acc, const pg8::Unit& u, int, int, int, int) const {
        EPI_IDS();
        const int col0 = u.pn * 256 + wc * 64 + 8 * fq, rl = 64 * wr + fr;
        if (u.pm == 0) rows(acc, resid_ctx, dst_ctx, gate_ctx, rl, col0);
        else rows(acc, resid_lat, dst_lat, gate_lat, (u.pm - 1) * 256 + rl, col0);
    }
};

#ifndef USE_DPP
#define USE_DPP 1
#endif
__device__ __forceinline__ float rot_prev(float x, int lane) {
#if USE_DPP
    return __builtin_bit_cast(float, __builtin_amdgcn_update_dpp(0, __builtin_bit_cast(int, x), 0x121, 0xf, 0xf, false));
#else
    return __shfl(x, (lane & 48) | ((lane - 1) & 15));
#endif
}
__device__ __forceinline__ float rot_next(float x, int lane) {
#if USE_DPP
    return __builtin_bit_cast(float, __builtin_amdgcn_update_dpp(0, __builtin_bit_cast(int, x), 0x12F, 0xf, 0xf, false));
#else
    return __shfl(x, (lane & 48) | ((lane + 1) & 15));
#endif
}
struct EpiUp {
    bf16_t* act; const float* cw; const float* cb; LAS float* xch;
    __device__ __forceinline__ int xidx(int c, int which, int wc, int fq, int bj, int n) const { return (((c * 2 + which) * 4 + wc) * 64) + fq * 16 + bj * 8 + n * 4; }
    __device__ __forceinline__ void operator()(const AccT& acc, const pg8::Unit& u, int, int, int, int) const {
        EPI_IDS();
        const int lane = fq * 16 + fr;
        if (fr == 0) {
#pragma unroll
            for (int ai = 0; ai < 2; ++ai)
#pragma unroll
                for (int bj = 0; bj < 2; ++bj)
#pragma unroll
                    for (int n = 0; n < 2; ++n) *(LAS f32x4*)(xch + xidx(2 * ai + wr, 0, wc, fq, bj, n)) = acc[ai][bj][0][n];
        }
        if (fr == 15) {
#pragma unroll
            for (int ai = 0; ai < 2; ++ai)
#pragma unroll
                for (int bj = 0; bj < 2; ++bj)
#pragma unroll
                    for (int n = 0; n < 2; ++n) *(LAS f32x4*)(xch + xidx(2 * ai + wr, 1, wc, fq, bj, n)) = acc[ai][bj][3][n];
        }
        EPI_BARRIER();
        const bool isctx = u.pm < 2;
        const int seq0 = isctx ? 254 * u.pm : 254 * (u.pm - 2), lim = isctx ? 256 : T_, rbase = isctx ? 0 : 256;
#pragma unroll
        for (int n = 0; n < 2; ++n) {
            const int h0 = 128 * u.pn + 32 * wc + 8 * fq + 4 * n;
            f32x4 w0[2], w1[2], w2[2], bb[2];
#pragma unroll
            for (int bj = 0; bj < 2; ++bj) { const int c = bj * F_ + h0; w0[bj] = *(const f32x4*)(cw + c); w1[bj] = *(const f32x4*)(cw + F2_ + c); w2[bj] = *(const f32x4*)(cw + 2 * F2_ + c); bb[bj] = *(const f32x4*)(cb + c); }
#pragma unroll
            for (int ai = 0; ai < 2; ++ai) {
                const int c = 2 * ai + wr;
                f32x4 eup[2], edn[2];
#pragma unroll
                for (int bj = 0; bj < 2; ++bj) {
                    eup[bj] = c > 0 ? *(const LAS f32x4*)(xch + xidx(c - 1, 1, wc, fq, bj, n)) : (f32x4){0.f, 0.f, 0.f, 0.f};
                    edn[bj] = c < 3 ? *(const LAS f32x4*)(xch + xidx(c + 1, 0, wc, fq, bj, n)) : (f32x4){0.f, 0.f, 0.f, 0.f};
                }
#pragma unroll
                for (int m = 0; m < 4; ++m) {
                    f32x4 cv[2];
#pragma unroll
                    for (int bj = 0; bj < 2; ++bj) {
                        const f32x4 x = acc[ai][bj][m][n];
                        f32x4 up, dn;
#pragma unroll
                        for (int e = 0; e < 4; ++e) {
                            const float ps = rot_prev(x[e], lane), ns = rot_next(x[e], lane);
                            float pe, ne;
                            if (m > 0) pe = rot_prev(acc[ai][bj][m > 0 ? m - 1 : 0][n][e], lane); else pe = eup[bj][e];
                            if (m < 3) ne = rot_next(acc[ai][bj][m < 3 ? m + 1 : 3][n][e], lane); else ne = edn[bj][e];
                            up[e] = fr == 0 ? pe : ps; dn[e] = fr == 15 ? ne : ns;
                        }
                        cv[bj] = bb[bj] + w0[bj] * up + w1[bj] * x + w2[bj] * dn;
                    }
                    const int j = 128 * ai + 64 * wr + 16 * m + fr, sr = seq0 + j - 1;
                    if (j >= 1 && j <= 254 && sr < lim) {
                        float o[4];
#pragma unroll
                        for (int e = 0; e < 4; ++e) { const float gg = cv[1][e]; o[e] = cv[0][e] * (gg / (1.f + __expf(-gg))); }
                        *(uint2*)(act + (size_t)(rbase + sr) * F_ + h0) = make_uint2(pk2(o[0], o[1]), pk2(o[2], o[3]));
                    }
                    ITER_FENCE();
                }
            }
        }
    }
};

struct EpiQKV1A {
    bf16_t* qkv; float* part; const float* rope; const float* gt;
    __device__ __forceinline__ void operator()(const AccT& acc, const pg8::Unit& u, int, int, int, int) const {
        EPI_IDS();
        const int r0 = u.pm * 256 + wr * 64 + fr, pn = u.pn;
        const bool rp = u.pm > 0;
        if (pn == 0 || (pn == 1 && wc < 2) || pn == 2) {
            const int chunk = pn == 0 ? wc : pn == 1 ? 4 + wc : wc;
            const size_t bo = pn == 2 ? O_CKV + 64 * wc : O_CQ + 64 * chunk;
            bf16_t* base = qkv + bo;
            const int ld = pn == 2 ? 256 : 384;
            float* pp = part + (pn == 2 ? 8 : 0) + chunk;
#pragma unroll
            for (int ai = 0; ai < 2; ++ai)
#pragma unroll
                for (int m = 0; m < 4; ++m) {
                    const int r = r0 + 128 * ai + 16 * m;
                    float ss = raw_store(acc, ai, m, base + (size_t)r * ld, fq);
                    ss += __shfl_xor(ss, 16); ss += __shfl_xor(ss, 32);
                    if (fq == 0) pp[(size_t)r * 12] = ss;
                    ITER_FENCE();
                }
        } else if (pn == 1 || pn == 3 || pn == 4) {
            const bool isk = pn == 1;
            float gn[2][2][4]; load_gain64(gn, gt + (isk ? 320 : 256), fq);
            const size_t bo = isk ? O_GK + (size_t)(wc - 2) * R_ * 64 : O_GQ + (size_t)(4 * (pn - 3) + wc) * R_ * 64;
            bf16_t* base = qkv + bo;
#pragma unroll
            for (int ai = 0; ai < 2; ++ai)
#pragma unroll
                for (int m = 0; m < 4; ++m) { const int r = r0 + 128 * ai + 16 * m; head64_epi(acc, ai, m, gn, rp, rope, r - 256, fq, base + (size_t)r * 64, isk ? 1.f : QS64); ITER_FENCE(); }
        } else {
            if (wc < 2) {
                bf16_t* vt = qkv + O_GVT + (size_t)wc * 64 * R_;
#pragma unroll
                for (int ai = 0; ai < 2; ++ai)
#pragma unroll
                    for (int m = 0; m < 4; ++m) { vt_store(acc, ai, m, 1.f, vt, fq, r0 + 128 * ai + 16 * m); ITER_FENCE(); }
            } else if (wc == 2) {
#pragma unroll
                for (int ai = 0; ai < 2; ++ai)
#pragma unroll
                    for (int m = 0; m < 4; ++m) {
                        const int r = r0 + 128 * ai + 16 * m; const f32x4 a = acc[ai][0][m][0], b = acc[ai][0][m][1];
                        u32x4 w; w.x = pk2(a[0], a[1]); w.y = pk2(a[2], a[3]); w.z = pk2(b[0], b[1]); w.w = pk2(b[2], b[3]);
                        *(u32x4*)(qkv + O_CKR + (size_t)r * 32 + 8 * fq) = w;
                    }
            }
        }
    }
};

struct EpiQB {
    bf16_t* qkv; const float* part; const float* rope; const float* gq; LAS float* xch;
    __device__ __forceinline__ void operator()(const AccT& acc, const pg8::Unit& u, int, int, int, int) const {
        EPI_IDS();
        const int wid = wr * 4 + wc, head = 2 * u.pn + (wc >> 1), role = wc & 1, r0 = u.pm * 256 + wr * 64 + fr;
        const bool rp = u.pm > 0;
        float ssp[2][4];
#pragma unroll
        for (int ai = 0; ai < 2; ++ai)
#pragma unroll
            for (int m = 0; m < 4; ++m) {
                float ss = 0.f;
#pragma unroll
                for (int bj = 0; bj < 2; ++bj)
#pragma unroll
                    for (int n = 0; n < 2; ++n)
#pragma unroll
                        for (int e = 0; e < 4; ++e) { const float v = acc[ai][bj][m][n][e]; ss += v * v; }
                ss += __shfl_xor(ss, 16); ss += __shfl_xor(ss, 32);
                ssp[ai][m] = ss;
                if (fq == 0) xch[wid * 128 + ai * 64 + m * 16 + fr] = ss;
            }
        EPI_BARRIER();
        float g0[2][2][4];
        const float* gql = launder(gq);
        if (role == 0) load_gain64(g0, gql, fq);
        else {
#pragma unroll
            for (int n = 0; n < 2; ++n) { const float4 t = *(const float4*)(gql + 64 + 16 * n + 4 * fq); g0[0][n][0] = t.x; g0[0][n][1] = t.y; g0[0][n][2] = t.z; g0[0][n][3] = t.w; }
        }
#pragma unroll
        for (int ai = 0; ai < 2; ++ai)
#pragma unroll
            for (int m = 0; m < 4; ++m) {
                const int r = r0 + 128 * ai + 16 * m;
                const float so = xch[(wid ^ 1) * 128 + ai * 64 + m * 16 + fr];
                const float* pp = part + (size_t)r * 12;
                const float rq = rsqrtf((pp[0] + pp[1] + pp[2] + pp[3] + pp[4] + pp[5]) * (1.f / 384.f) + EPS_);
                const float sc = rq * rsqrtf(rq * rq * (ssp[ai][m] + so) * (1.f / 96.f) + EPS_) * QS96;
                bf16_t* dst = qkv + O_MQ + ((size_t)head * R_ + r) * 96;
                if (role == 0) {
#pragma unroll
                    for (int bj = 0; bj < 2; ++bj) {
                        const f32x4 a = acc[ai][bj][m][0], b = acc[ai][bj][m][1];
                        u32x4 w; w.x = pk2(a[0] * sc * g0[bj][0][0], a[1] * sc * g0[bj][0][1]); w.y = pk2(a[2] * sc * g0[bj][0][2], a[3] * sc * g0[bj][0][3]);
                        w.z = pk2(b[0] * sc * g0[bj][1][0], b[1] * sc * g0[bj][1][1]); w.w = pk2(b[2] * sc * g0[bj][1][2], b[3] * sc * g0[bj][1][3]);
                        *(u32x4*)(dst + 32 * bj + 8 * fq) = w;
                    }
                } else {
                    float y1[4], y2[4];
#pragma unroll
                    for (int e = 0; e < 4; ++e) { y1[e] = acc[ai][0][m][0][e] * sc * g0[0][0][e]; y2[e] = acc[ai][0][m][1][e] * sc * g0[0][1][e]; }
                    if (rp) {
                        const int t = r - 256, pos = fq < 2 ? (t >> 6) : (t & 63);
                        const float* tb = rope + (pos * 16 + 8 * (fq & 1)) * 2;
#pragma unroll
                        for (int e = 0; e < 4; ++e) { const float2 cs = *(const float2*)(tb + 4 * e); const float a = y1[e], b = y2[e]; y1[e] = a * cs.x - b * cs.y; y2[e] = a * cs.y + b * cs.x; }
                    }
                    *(uint2*)(dst + 64 + 4 * fq) = make_uint2(pk2(y1[0], y1[1]), pk2(y1[2], y1[3]));
                    *(uint2*)(dst + 80 + 4 * fq) = make_uint2(pk2(y2[0], y2[1]), pk2(y2[2], y2[3]));
                }
                ITER_FENCE();
            }
        EPI_BARRIER();
    }
};

struct EpiKVB {
    bf16_t* qkv; const float* part; const float* rope; const float* gk;
    __device__ __forceinline__ void operator()(const AccT& acc, const pg8::Unit& u, int, int, int, int) const {
        EPI_IDS();
        const int head = 2 * u.pn + (wc >> 1), role = wc & 1, r0 = u.pm * 256 + wr * 64 + fr;
        const bool rp = u.pm > 0;
        if (role == 1) {
            bf16_t* vt = qkv + O_MVT + (size_t)head * 64 * R_;
#pragma unroll
            for (int ai = 0; ai < 2; ++ai)
#pragma unroll
                for (int m = 0; m < 4; ++m) {
                    const int r = r0 + 128 * ai + 16 * m; const float* pp = part + (size_t)r * 12 + 8;
                    const float rk = rsqrtf((pp[0] + pp[1] + pp[2] + pp[3]) * (1.f / 256.f) + EPS_);
                    vt_store(acc, ai, m, rk, vt, fq, r);
                    ITER_FENCE();
                }
        } else {
            const float* gkl = launder(gk);
            float gn[2][2][4]; load_gain64(gn, gkl, fq);
            float gr[2][4];
#pragma unroll
            for (int n = 0; n < 2; ++n) { const float4 t = *(const float4*)(gkl + 64 + 16 * n + 4 * fq); gr[n][0] = t.x; gr[n][1] = t.y; gr[n][2] = t.z; gr[n][3] = t.w; }
#pragma unroll
            for (int ai = 0; ai < 2; ++ai)
#pragma unroll
                for (int m = 0; m < 4; ++m) {
                    const int r = r0 + 128 * ai + 16 * m; const float* pp = part + (size_t)r * 12 + 8;
                    const float rk = rsqrtf((pp[0] + pp[1] + pp[2] + pp[3]) * (1.f / 256.f) + EPS_);
                    const uint2 c1 = *(const uint2*)(qkv + O_CKR + (size_t)r * 32 + 4 * fq), c2 = *(const uint2*)(qkv + O_CKR + (size_t)r * 32 + 16 + 4 * fq);
                    float y1[4] = {__uint_as_float(c1.x << 16), __uint_as_float(c1.x & 0xffff0000u), __uint_as_float(c1.y << 16), __uint_as_float(c1.y & 0xffff0000u)};
                    float y2[4] = {__uint_as_float(c2.x << 16), __uint_as_float(c2.x & 0xffff0000u), __uint_as_float(c2.y << 16), __uint_as_float(c2.y & 0xffff0000u)};
                    float ss = 0.f;
#pragma unroll
                    for (int bj = 0; bj < 2; ++bj)
#pragma unroll
                        for (int n = 0; n < 2; ++n)
#pragma unroll
                            for (int e = 0; e < 4; ++e) { const float v = acc[ai][bj][m][n][e] * rk; ss += v * v; }
#pragma unroll
                    for (int e = 0; e < 4; ++e) ss += y1[e] * y1[e] + y2[e] * y2[e];
                    ss += __shfl_xor(ss, 16); ss += __shfl_xor(ss, 32);
                    const float rr = rsqrtf(ss * (1.f / 96.f) + EPS_), sc = rk * rr;
                    bf16_t* dst = qkv + O_MK + ((size_t)head * R_ + r) * 96;
#pragma unroll
                    for (int bj = 0; bj < 2; ++bj) {
                        const f32x4 a = acc[ai][bj][m][0], b = acc[ai][bj][m][1];
                        u32x4 w; w.x = pk2(a[0] * sc * gn[bj][0][0], a[1] * sc * gn[bj][0][1]); w.y = pk2(a[2] * sc * gn[bj][0][2], a[3] * sc * gn[bj][0][3]);
                        w.z = pk2(b[0] * sc * gn[bj][1][0], b[1] * sc * gn[bj][1][1]); w.w = pk2(b[2] * sc * gn[bj][1][2], b[3] * sc * gn[bj][1][3]);
                        *(u32x4*)(dst + 32 * bj + 8 * fq) = w;
                    }
#pragma unroll
                    for (int e = 0; e < 4; ++e) { y1[e] *= rr * gr[0][e]; y2[e] *= rr * gr[1][e]; }
                    if (rp) {
                        const int t = r - 256, pos = fq < 2 ? (t >> 6) : (t & 63);
                        const float* tb = rope + (pos * 16 + 8 * (fq & 1)) * 2;
#pragma unroll
                        for (int e = 0; e < 4; ++e) { const float2 cs = *(const float2*)(tb + 4 * e); const float a = y1[e], b = y2[e]; y1[e] = a * cs.x - b * cs.y; y2[e] = a * cs.y + b * cs.x; }
                    }
                    *(uint2*)(dst + 64 + 4 * fq) = make_uint2(pk2(y1[0], y1[1]), pk2(y1[2], y1[3]));
                    *(uint2*)(dst + 80 + 4 * fq) = make_uint2(pk2(y2[0], y2[1]), pk2(y2[2], y2[3]));
                    ITER_FENCE();
                }
        }
    }
};

__device__ __forceinline__ void g_qkv0(const Params& p, LAS unsigned char* lds) {
    Bufs B(p);
    pg8::Gemm g{B.h, B.wt + W_EIN, 1024}; pg8::Order S; S.init(65, 12, gridDim.x, blockIdx.x, 0, 1);
    EpiQKV0 E{B.qkv, B.rope, B.gt};
    pg8::gemm_phase<EpiQKV0, pg8::Order, true, true>(lds, g, S, E);
}
__device__ __forceinline__ void g_out(const Params& p, int l, LAS unsigned char* lds) {
    Bufs B(p);
    pg8::Gemm g{B.mix, B.wt + (l == 0 ? W_EOUT : W_OOUT), 1024}; pg8::Order S; S.init(l == 0 ? 65 : 64, 4, gridDim.x, blockIdx.x, l == 0 ? 0 : 1, 0);
    EpiResid E{l == 0 ? p.in[I_X] : p.out, p.out, p.in[I_CTX], B.xc, modp(B, l, 0, 2), modp(B, l, 1, 2)};
    pg8::gemm_phase<EpiResid, pg8::Order, true, true>(lds, g, S, E);
}
__device__ __forceinline__ void g_up(const Params& p, int l, LAS unsigned char* lds) {
    Bufs B(p);
    pg8::Gemm g{B.h, B.wt + W_UP + (size_t)l * F2_ * 1024, 1024}; pg8::Order S; S.init(l == 0 ? 67 : 65, 22, gridDim.x, blockIdx.x, l == 0 ? 0 : 2, 2);
    EpiUp E{B.act, p.in[I_FCW] + (size_t)l * 3 * F2_, p.in[I_FCB] + (size_t)l * F2_, (LAS float*)(lds + LDS_XCH)};
    pg8::gemm_phase<EpiUp, pg8::Order, true, true>(lds, g, S, E);
}
__device__ __forceinline__ void g_down(const Params& p, int l, LAS unsigned char* lds) {
    Bufs B(p);
    pg8::Gemm g{B.act, B.wt + W_DOWN + (size_t)l * 1024 * F_, F_}; pg8::Order S; S.init(l == 0 ? 65 : 64, 4, gridDim.x, blockIdx.x, l == 0 ? 0 : 1, 0);
    EpiResid E{p.out, p.out, B.xc, B.xc, modp(B, l, 0, 5), modp(B, l, 1, 5)};
    pg8::gemm_phase<EpiResid, pg8::Order, true, true>(lds, g, S, E);
}
__device__ __forceinline__ void g_qkv1a(const Params& p, LAS unsigned char* lds) {
    Bufs B(p);
    pg8::Gemm g{B.h, B.wt + W_OIN, 1024}; pg8::Order S; S.init(65, 6, gridDim.x, blockIdx.x, 0, 1);
    EpiQKV1A E{B.qkv, B.part, B.rope, B.gt};
    pg8::gemm_phase<EpiQKV1A, pg8::Order, true, true>(lds, g, S, E);
}
__device__ __forceinline__ void g_qkv1b(const Params& p, LAS unsigned char* lds) {
    Bufs B(p);
    { pg8::Gemm g{B.qkv + O_CQ, B.wt + W_QB, 384}; pg8::Order S; S.init(64, 4, gridDim.x, blockIdx.x, 1, 0);
      EpiQB E{B.qkv, B.part, B.rope, p.in[I_CQN], (LAS float*)(lds + LDS_XCH)};
      pg8::gemm_phase<EpiQB, pg8::Order, true, true>(lds, g, S, E); }
    { pg8::Gemm g{B.qkv + O_CKV, B.wt + W_KVB, 256}; pg8::Order S; S.init(65, 4, gridDim.x, blockIdx.x, 0, 0);
      EpiKVB E{B.qkv, B.part, B.rope, p.in[I_CKN]};
      pg8::gemm_phase<EpiKVB, pg8::Order, true, true>(lds, g, S, E); }
}

typedef float f32x16 __attribute__((ext_vector_type(16)));
typedef __bf16 bf16x2_t __attribute__((ext_vector_type(2)));
typedef float f32x2_t __attribute__((ext_vector_type(2)));
__device__ __forceinline__ u32 cvtpk(float lo, float hi) { const f32x2_t v = {lo, hi}; const bf16x2_t b = __builtin_convertvector(v, bf16x2_t); return __builtin_bit_cast(u32, b); }

template <int DQK, int DV>
struct FlashGeom {
    static constexpr int KP = DQK * 2 + 16, VP = 144, KBYTES = 64 * KP, VBYTES = DV * VP, STAGE = KBYTES + VBYTES;
    static constexpr int KCH = DQK / 8, KN = (64 * KCH + NT - 1) / NT, VN = DV * 8 / NT;
};

#ifndef MLA_VAR
#define MLA_VAR 0
#endif
#ifndef FLASH_PD
#define FLASH_PD 3
#endif
__device__ __forceinline__ void asm_gload(u32x4& dst, const void* ptr) { asm volatile("global_load_dwordx4 %0, %1, off" : "=v"(dst) : "v"(ptr) : "memory"); }
template <int N> __device__ __forceinline__ void asm_vmwait() { asm volatile("s_waitcnt vmcnt(%0)" :: "n"(N) : "memory"); }
template <int DQK, int DV, int VAR = 0>
__device__ __forceinline__ void flash_dense(LAS char* lds, const bf16_t* __restrict__ qptr, const bf16_t* __restrict__ Kb, const bf16_t* __restrict__ VT, int ntiles, float c1, float c2,
                                            f32x16 (&O)[DV / 32], float& lsum) {
    typedef FlashGeom<DQK, DV> G;
    constexpr int PD = FLASH_PD, NL = G::KN + G::VN;
    const int tid = ltid(), lane = tid & 63, r = lane & 31, h = lane >> 5;
    bf16x8 qf[DQK / 16];
#pragma unroll
    for (int ks = 0; ks < DQK / 16; ++ks) qf[ks] = *(const bf16x8*)(qptr + 16 * ks + 8 * h);
#pragma unroll
    for (int dt = 0; dt < DV / 32; ++dt)
#pragma unroll
        for (int i = 0; i < 16; ++i) O[dt][i] = 0.f;
    float l = 0.f;
    f32x16 cneg;
#pragma unroll
    for (int i = 0; i < 16; ++i) cneg[i] = -c2;
    asm volatile("" : "+v"(cneg));
    u32x4 kreg[PD][G::KN], vreg[PD][G::VN];
    int kq[G::KN]; const char* kp[G::KN]; const char* vp[G::VN];
#pragma unroll
    for (int i = 0; i < G::KN; ++i) { kq[i] = tid + NT * i; const int qc = kq[i] < 64 * G::KCH ? kq[i] : 64 * G::KCH - 1; kp[i] = (const char*)Kb + (size_t)qc * 16; }
#pragma unroll
    for (int i = 0; i < G::VN; ++i) { const int q = tid + NT * i; vp[i] = (const char*)VT + ((size_t)(q >> 3) * R_ + (q & 7) * 8) * 2; }
    asm volatile("s_waitcnt vmcnt(0)" ::: "memory");
#define FD_LOAD(set, t) do { const int tt_ = (t) < ntiles ? (t) : ntiles - 1; \
        _Pragma("unroll") for (int i_ = 0; i_ < G::KN; ++i_) asm_gload(kreg[set][i_], kp[i_] + (size_t)tt_ * (64 * DQK * 2)); \
        _Pragma("unroll") for (int i_ = 0; i_ < G::VN; ++i_) asm_gload(vreg[set][i_], vp[i_] + (size_t)tt_ * 128); } while (0)
#define FD_FENCE(set) do { _Pragma("unroll") for (int i_ = 0; i_ < G::KN; ++i_) asm volatile("" : "+v"(kreg[set][i_])); _Pragma("unroll") for (int i_ = 0; i_ < G::VN; ++i_) asm volatile("" : "+v"(vreg[set][i_])); } while (0)
#define FD_STORE(set, buf) do { LAS char* kb_ = lds + (buf) * G::STAGE; LAS char* vb_ = kb_ + G::KBYTES; \
        _Pragma("unroll") for (int i_ = 0; i_ < G::KN; ++i_) { if (kq[i_] < 64 * G::KCH) *(LAS u32x4*)(kb_ + (kq[i_] / G::KCH) * G::KP + (kq[i_] % G::KCH) * 16) = kreg[set][i_]; } \
        _Pragma("unroll") for (int i_ = 0; i_ < G::VN; ++i_) { const int q_ = tid + NT * i_; *(LAS u32x4*)(vb_ + (q_ >> 3) * G::VP + (q_ & 7) * 16) = vreg[set][i_]; } } while (0)
    FD_LOAD(0, 0);
#pragma unroll
    for (int j = 1; j < PD; ++j) FD_LOAD(j, j);
    asm_vmwait<(PD - 1) * NL>(); FD_FENCE(0); FD_STORE(0, 0);
    FD_LOAD(0, PD);
    __syncthreads();
    for (int t0 = 0; t0 < ntiles; t0 += PD) {
#pragma unroll
        for (int j = 0; j < PD; ++j) {
            const int t = t0 + j;
            if (t >= ntiles) break;
            if (VAR != 3) { asm_vmwait<(PD - 1) * NL>(); FD_FENCE((j + 1) % PD);
            FD_STORE((j + 1) % PD, (t + 1) & 1);
            FD_LOAD((j + 1) % PD, t + 1 + PD); }
            const LAS char* kb = lds + (t & 1) * G::STAGE; const LAS char* vb = kb + G::KBYTES;
#pragma unroll
            for (int kt = 0; kt < 2; ++kt) {
                f32x16 S = cneg;
#pragma unroll
                for (int ks = 0; ks < DQK / 16; ++ks) {
                    const bf16x8 a = VAR == 2 ? qf[(ks + 1) % (DQK / 16)] : *(const LAS bf16x8*)(kb + (32 * kt + r) * G::KP + (16 * ks + 8 * h) * 2);
                    S = __builtin_amdgcn_mfma_f32_32x32x16_bf16(a, qf[ks], S, 0, 0, 0);
                }
                float p[16];
#pragma unroll
                for (int i = 0; i < 16; ++i) { if (VAR == 1) { p[i] = S[i] * S[i] + 1.f; if (i == 0) l += 1.f; } else { p[i] = __builtin_amdgcn_exp2f(S[i]); l += p[i]; } }
#pragma unroll
                for (int s = 0; s < 2; ++s) {
                    u32x4 pw; pw.x = cvtpk(p[8 * s], p[8 * s + 1]); pw.y = cvtpk(p[8 * s + 2], p[8 * s + 3]); pw.z = cvtpk(p[8 * s + 4], p[8 * s + 5]); pw.w = cvtpk(p[8 * s + 6], p[8 * s + 7]);
                    const bf16x8 pf = __builtin_bit_cast(bf16x8, pw);
#pragma unroll
                    for (int dt = 0; dt < DV / 32; ++dt) {
                        const bf16x8 a = VAR == 2 ? qf[dt % (DQK / 16)] : *(const LAS bf16x8*)(vb + (32 * dt + r) * G::VP + (16 * (2 * kt + s) + 8 * h) * 2);
                        O[dt] = __builtin_amdgcn_mfma_f32_32x32x16_bf16(a, pf, O[dt], 0, 0, 0);
                    }
                }
            }
            if (VAR != 4) __syncthreads();
        }
    }
    asm_vmwait<0>();
#pragma unroll
    for (int j = 0; j < PD; ++j) FD_FENCE(j);
#undef FD_LOAD
#undef FD_STORE
#undef FD_FENCE
    lsum = l + __shfl_xor(l, 32);
}

__device__ __forceinline__ void diff_unit(const Params& p, const Bufs& B, LAS char* lds, int head, int qb) {
    const int tid = ltid(), wid = tid >> 6, lane = tid & 63, c = lane & 31, h = lane >> 5;
    const int r = qb * 256 + wid * 32 + c, nt = qb == 0 ? 4 : R_ / 64;
    const float lam = B.scal[0], c1 = 0.125f * 1.4426950408889634f, c2 = B.scal[1];
    float* tmp = (float*)B.h + ((size_t)r * 4 + head) * 128 + 4 * h;
    f32x16 O[4]; float l;
    flash_dense<64, 128>(lds, B.qkv + O_QA + ((size_t)(2 * head) * R_ + r) * 64, B.qkv + O_KA + (size_t)(2 * head) * R_ * 64, B.qkv + O_VAT + (size_t)head * 128 * R_, nt, c1, c2, O, l);
    {
        const float inv = 1.f / l;
#pragma unroll
        for (int dt = 0; dt < 4; ++dt)
#pragma unroll
            for (int q = 0; q < 4; ++q) *(f32x4*)(tmp + 32 * dt + 8 * q) = (f32x4){O[dt][4 * q] * inv, O[dt][4 * q + 1] * inv, O[dt][4 * q + 2] * inv, O[dt][4 * q + 3] * inv};
    }
    flash_dense<64, 128>(lds, B.qkv + O_QA + ((size_t)(2 * head + 1) * R_ + r) * 64, B.qkv + O_KA + (size_t)(2 * head + 1) * R_ * 64, B.qkv + O_VAT + (size_t)head * 128 * R_, nt, c1, c2, O, l);
    {
        const float inv = lam / l; float ss = 0.f;
#pragma unroll
        for (int dt = 0; dt < 4; ++dt)
#pragma unroll
            for (int q = 0; q < 4; ++q) {
                const f32x4 o1 = *(const f32x4*)(tmp + 32 * dt + 8 * q);
#pragma unroll
                for (int e = 0; e < 4; ++e) { const float d = o1[e] - O[dt][4 * q + e] * inv; O[dt][4 * q + e] = d; ss += d * d; }
            }
        ss += __shfl_xor(ss, 32);
        const float rr = rsqrtf(ss * (1.f / 128.f) + EPS_) * 0.8f;
        bf16_t* dst = B.mix + (size_t)r * 1024 + head * 128 + 4 * h;
        const float* g = p.in[I_SUBLN] + 4 * h;
#pragma unroll
        for (int dt = 0; dt < 4; ++dt)
#pragma unroll
            for (int q = 0; q < 4; ++q) {
                const f32x4 gg = *(const f32x4*)(g + 32 * dt + 8 * q);
                *(uint2*)(dst + 32 * dt + 8 * q) = make_uint2(cvtpk(O[dt][4 * q] * rr * gg[0], O[dt][4 * q + 1] * rr * gg[1]), cvtpk(O[dt][4 * q + 2] * rr * gg[2], O[dt][4 * q + 3] * rr * gg[3]));
            }
    }
}
__device__ __forceinline__ void mla_unit(const Params& p, const Bufs& B, LAS char* lds, int head, int qb) {
    const int tid = ltid(), wid = tid >> 6, lane = tid & 63, c = lane & 31, h = lane >> 5;
    const int r = qb * 256 + wid * 32 + c;
    const float c1 = 0.10206207261596575f * 1.4426950408889634f, c2 = B.scal[2];
    f32x16 O[2]; float l;
    flash_dense<96, 64, MLA_VAR>(lds, B.qkv + O_MQ + ((size_t)head * R_ + r) * 96, B.qkv + O_MK + (size_t)head * R_ * 96, B.qkv + O_MVT + (size_t)head * 64 * R_, R_ / 64, c1, c2, O, l);
    const float inv = 1.f / l;
    bf16_t* dst = B.mix + (size_t)r * 1024 + head * 64 + 4 * h;
#pragma unroll
    for (int dt = 0; dt < 2; ++dt)
#pragma unroll
        for (int q = 0; q < 4; ++q)
            *(uint2*)(dst + 32 * dt + 8 * q) = make_uint2(cvtpk(O[dt][4 * q] * inv, O[dt][4 * q + 1] * inv), cvtpk(O[dt][4 * q + 2] * inv, O[dt][4 * q + 3] * inv));
}
__device__ void phase_attn0_dense(const Params& p, LAS char* lds, int bid, int nblk) {
    Bufs B(p);
    for (int u = bid; u < 260; u += nblk) {
        int head, qb;
        if (u < 256) { const int x = u & 7; head = x >> 1; qb = 1 + (u >> 3) * 2 + (x & 1); } else { head = u - 256; qb = 0; }
        diff_unit(p, B, lds, head, qb);
    }
}
__device__ void phase_attn1_dense(const Params& p, LAS char* lds, int bid, int nblk) {
    Bufs B(p);
    for (int u = bid; u < 512; u += nblk) mla_unit(p, B, lds, u & 7, 1 + (u >> 3));
}

template <int MODE>
__device__ __forceinline__ void flash_win(LAS char* lds, const bf16_t* __restrict__ qptr, const bf16_t* __restrict__ Kb, const bf16_t* __restrict__ VT, int lat0, int nlat, float c1, float c2,
                                          int qi  , int qcol, const LAS float* bl, f32x16 (&O)[2], float& lsum) {
    typedef FlashGeom<64, 64> G;
    const int tid = ltid(), lane = tid & 63, r = lane & 31, h = lane >> 5;
    const int ntiles = 4 + nlat;
    bf16x8 qf[4];
#pragma unroll
    for (int ks = 0; ks < 4; ++ks) qf[ks] = *(const bf16x8*)(qptr + 16 * ks + 8 * h);
#pragma unroll
    for (int dt = 0; dt < 2; ++dt)
#pragma unroll
        for (int i = 0; i < 16; ++i) O[dt][i] = 0.f;
    float l = 0.f;
    u32x4 kreg, vreg;
    auto load_tile = [&](int t) { const int at = t < 4 ? t : lat0 + (t - 4);
        kreg = *(const u32x4*)(Kb + (size_t)at * 64 * 64 + tid * 8); vreg = *(const u32x4*)(VT + (size_t)(tid >> 3) * R_ + at * 64 + (tid & 7) * 8); };
    auto store_tile = [&](int buf) { LAS char* kb = lds + buf * G::STAGE; LAS char* vb = kb + G::KBYTES;
        *(LAS u32x4*)(kb + (tid >> 3) * G::KP + (tid & 7) * 16) = kreg; *(LAS u32x4*)(vb + (tid >> 3) * G::VP + (tid & 7) * 16) = vreg; };
    const int rs = MODE == 1 ? min(max(qi - 4, 0), 248) : 0, cs = MODE == 1 ? min(max(qcol - 8, 0), 48) : 0;
    const int qlo = MODE == 2 ? __builtin_amdgcn_readfirstlane(qi - r) : 0;
    load_tile(0); store_tile(0);
    if (ntiles > 1) load_tile(1);
    __syncthreads();
    for (int t = 0; t < ntiles; ++t) {
        if (t + 1 < ntiles) store_tile((t + 1) & 1);
        if (t + 2 < ntiles) load_tile(t + 2);
        const LAS char* kb = lds + (t & 1) * G::STAGE; const LAS char* vb = kb + G::KBYTES;
        const int lt = lat0 + (t - 4) - 4;
        bool active = true;
        if (t >= 4) { if (MODE == 1) active = lt >= rs && lt < rs + 8; else active = (64 * lt + 63 >= qlo - 128) && (64 * lt <= qlo + 31 + 128); }
        if (active) {
#pragma unroll
            for (int kt = 0; kt < 2; ++kt) {
                f32x16 S;
#pragma unroll
                for (int i = 0; i < 16; ++i) S[i] = 0.f;
#pragma unroll
                for (int ks = 0; ks < 4; ++ks) {
                    const bf16x8 a = *(const LAS bf16x8*)(kb + (32 * kt + r) * G::KP + (16 * ks + 8 * h) * 2);
                    S = __builtin_amdgcn_mfma_f32_32x32x16_bf16(a, qf[ks], S, 0, 0, 0);
                }
                float p[16];
                if (t < 4) {
#pragma unroll
                    for (int i = 0; i < 16; ++i) p[i] = __builtin_amdgcn_exp2f(S[i] - c2);
                } else {
#pragma unroll
                    for (int i = 0; i < 16; ++i) {
                        const int kk = 32 * kt + (i & 3) + 8 * (i >> 2) + 4 * h;
                        if (MODE == 1) {
                            const bool valid = (unsigned)(kk - cs) < 16u;
                            const float b = bl[valid ? (lt - qi + 7) * 31 + (kk - qcol + 15) : 0];
                            p[i] = valid ? __builtin_amdgcn_exp2f(S[i] + b - c2) : 0.f;
                        } else {
                            const int d = 64 * lt + kk - qi;
                            p[i] = (d <= 128 && d >= -128) ? __builtin_amdgcn_exp2f(S[i] - c2) : 0.f;
                        }
                    }
                }
#pragma unroll
                for (int i = 0; i < 16; ++i) l += p[i];
#pragma unroll
                for (int s = 0; s < 2; ++s) {
                    u32x4 pw; pw.x = cvtpk(p[8 * s], p[8 * s + 1]); pw.y = cvtpk(p[8 * s + 2], p[8 * s + 3]); pw.z = cvtpk(p[8 * s + 4], p[8 * s + 5]); pw.w = cvtpk(p[8 * s + 6], p[8 * s + 7]);
                    const bf16x8 pf = __builtin_bit_cast(bf16x8, pw);
#pragma unroll
                    for (int dt = 0; dt < 2; ++dt) {
                        const bf16x8 a = *(const LAS bf16x8*)(vb + (32 * dt + r) * G::VP + (16 * (2 * kt + s) + 8 * h) * 2);
                        O[dt] = __builtin_amdgcn_mfma_f32_32x32x16_bf16(a, pf, O[dt], 0, 0, 0);
                    }
                }
            }
        }
        __syncthreads();
    }
    lsum = l + __shfl_xor(l, 32);
}
__device__ __forceinline__ void store_o64(bf16_t* dst  , const f32x16 (&O)[2], float inv) {
#pragma unroll
    for (int dt = 0; dt < 2; ++dt)
#pragma unroll
        for (int q = 0; q < 4; ++q)
            *(uint2*)(dst + 32 * dt + 8 * q) = make_uint2(cvtpk(O[dt][4 * q] * inv, O[dt][4 * q + 1] * inv), cvtpk(O[dt][4 * q + 2] * inv, O[dt][4 * q + 3] * inv));
}
constexpr int LDS_BIAS = 40960;
__device__ __forceinline__ void na_unit(const Params& p, const Bufs& B, LAS char* lds, int head, int qb) {
    const int tid = ltid(), wid = tid >> 6, lane = tid & 63, c = lane & 31, h = lane >> 5;
    const int r = qb * 256 + wid * 32 + c;
    LAS float* bl = (LAS float*)(lds + LDS_BIAS);
    __syncthreads();
    for (int e = tid; e < 465; e += NT) bl[e] = p.in[I_RPB][head * 465 + e] * 1.4426950408889634f;
    int lat0 = 4, nlat = 0, grow = 0, gcol = 0;
    if (qb > 0) { const int r0 = 4 * (qb - 1), ra = min(max(r0 - 4, 0), 248), rb = min(max(r0 + 3 - 4, 0), 248) + 8; lat0 = 4 + ra; nlat = rb - ra; grow = r0 + (wid >> 1); gcol = 32 * (wid & 1) + c; }
    f32x16 O[2]; float l;
    flash_win<1>(lds, B.qkv + O_QB + ((size_t)head * R_ + r) * 64, B.qkv + O_KB + (size_t)head * R_ * 64, B.qkv + O_VBT + (size_t)head * 64 * R_, lat0, nlat,
                 0.125f * 1.4426950408889634f, B.scal[3], grow, gcol, bl, O, l);
    store_o64(B.mix + (size_t)r * 1024 + 512 + head * 64 + 4 * h, O, 1.f / l);
}
__device__ __forceinline__ void swa_unit(const Params& p, const Bufs& B, LAS char* lds, int hq, int qb) {
    const int tid = ltid(), wid = tid >> 6, lane = tid & 63, c = lane & 31, h = lane >> 5;
    const int r = qb * 256 + wid * 32 + c, t0 = (qb - 1) * 256, kvh = hq >> 2;
    const int ta = max(t0 / 64 - 2, 0), tb = min(t0 / 64 + 5, 255);
    f32x16 O[2]; float l;
    const float c2 = B.scal[4];
    flash_win<2>(lds, B.qkv + O_GQ + ((size_t)hq * R_ + r) * 64, B.qkv + O_GK + (size_t)kvh * R_ * 64, B.qkv + O_GVT + (size_t)kvh * 64 * R_, 4 + ta, tb - ta + 1,
                 0.125f * 1.4426950408889634f, c2, r - 256, 0, nullptr, O, l);
    l += __builtin_amdgcn_exp2f(p.in[I_SINK][hq] * 1.4426950408889634f - c2);
    store_o64(B.mix + (size_t)r * 1024 + 512 + hq * 64 + 4 * h, O, 1.f / l);
}
__device__ void phase_attn0_win(const Params& p, LAS char* lds, int bid, int nblk) {
    Bufs B(p);
    for (int u = bid; u < 520; u += nblk) na_unit(p, B, lds, u & 7, u >> 3);
}
__device__ void phase_attn1_win(const Params& p, LAS char* lds, int bid, int nblk) {
    Bufs B(p);
    for (int u = bid; u < 512; u += nblk) swa_unit(p, B, lds, u & 7, 1 + (u >> 3));
}

#define XB_TMO      128
#define XB_XCNT(j)  (256  + 64 * (j))
#define XB_XSUB(j)  (1280 + 64 * (j))
#define XB_XGEN(j)  (2304 + 64 * (j))
#define XB_TOP      3328
#define XB_TOPGEN   3392
#define XCD_BAR_WORDS 3456
#define XB_SPIN_CAP (1u << 20)
__device__ __forceinline__ unsigned xb_ld(unsigned* p)              { return __hip_atomic_load(p, __ATOMIC_RELAXED, __HIP_MEMORY_SCOPE_AGENT); }
__device__ __forceinline__ unsigned xb_add(unsigned* p, unsigned v) { return __hip_atomic_fetch_add(p, v, __ATOMIC_RELAXED, __HIP_MEMORY_SCOPE_AGENT); }
__device__ __forceinline__ unsigned xb_xcc_id() { return (unsigned)__builtin_amdgcn_s_getreg((3 << 11) | 20) & 0xFu; }
#define XB_SPIN(cond, bar) do { unsigned _sp = 0; while (cond) { __builtin_amdgcn_s_sleep(1); \
    if ((++_sp & 255u) == 0u) { if (xb_ld(&(bar)[XB_TMO])) break; if (_sp > XB_SPIN_CAP) { atomicAdd(&(bar)[XB_TMO], 1u); break; } } } } while (0)
struct XcdBarrier { unsigned* bar; unsigned x; volatile LAS unsigned* st; };
__device__ __forceinline__ XcdBarrier xcd_barrier_post(unsigned* bar, volatile LAS unsigned* st) {
    XcdBarrier b; b.bar = bar; b.x = xb_xcc_id(); b.st = st;
    if (threadIdx.x == 0) (void)xb_add(&bar[XB_XCNT(b.x)], 1u);
    return b;
}
__device__ __forceinline__ void xcd_barrier_complete(unsigned* bar, unsigned x, unsigned& nloc, unsigned& nx) {
    const unsigned G = gridDim.x * gridDim.y * gridDim.z;
    unsigned sum, cnt, mine, sp = 0u;
    for (;;) {
        sum = 0u; cnt = 0u; mine = 0u;
#pragma unroll
        for (unsigned j = 0; j < 16; ++j) { const unsigned c = xb_ld(&bar[XB_XCNT(j)]); sum += c; cnt += (c > 0u) ? 1u : 0u; mine = (j == x) ? c : mine; }
        if (sum == G) break;
        __builtin_amdgcn_s_sleep(1);
        if ((++sp & 255u) == 0u) { if (xb_ld(&bar[XB_TMO])) break; if (sp > XB_SPIN_CAP) { atomicAdd(&bar[XB_TMO], 1u); break; } }
    }
    nloc = mine > 0u ? mine : 1u; nx = cnt > 0u ? cnt : 1u;
}
__device__ __forceinline__ void xcd_barrier(const XcdBarrier& b) {
    asm volatile("s_waitcnt vmcnt(0)" ::: "memory");
    __syncthreads();
    if (threadIdx.x == 0) {
        unsigned* bar = b.bar;
        __builtin_amdgcn_s_waitcnt(0);
        unsigned nloc = b.st[0], nx = b.st[1];
        if (nloc == 0u) { xcd_barrier_complete(bar, b.x, nloc, nx); b.st[0] = nloc; b.st[1] = nx; }
        const unsigned old = xb_add(&bar[XB_XSUB(b.x)], 1u);
        const unsigned gen = old / nloc;
        if (old + 1u == (gen + 1u) * nloc) {
            __builtin_amdgcn_fence(__ATOMIC_RELEASE, "agent");
            asm volatile("s_waitcnt vmcnt(0)" ::: "memory");
            const unsigned og = xb_add(&bar[XB_TOP], 1u);
            const unsigned tg = og / nx;
            if (og + 1u == (tg + 1u) * nx) xb_add(&bar[XB_TOPGEN], 1u);
            else XB_SPIN(xb_ld(&bar[XB_TOPGEN]) == tg, bar);
            __builtin_amdgcn_fence(__ATOMIC_ACQUIRE, "agent");
            xb_add(&bar[XB_XGEN(b.x)], 1u);
            asm volatile("s_waitcnt vmcnt(0)" ::: "memory");
        } else {
            XB_SPIN(xb_ld(&bar[XB_XGEN(b.x)]) == gen, bar);
            __builtin_amdgcn_fence(__ATOMIC_ACQUIRE, "agent");
            asm volatile("s_waitcnt vmcnt(0)" ::: "memory");
        }
    }
    __syncthreads();
}

#ifndef OPTG
#define OPTG 0x7f
#endif
constexpr int NPHASE = 16;
__device__ __forceinline__ void run_phase(int ph, const Params& p, char* lds, int bid, int nblk) {
    LAS unsigned char* l3 = (LAS unsigned char*)lds;
    switch (ph) {
        case 0: phase_prep(p, lds, bid, nblk); if (OPTG) phase_prep_weights(p, lds, bid, nblk); break;
        case 1: phase_norm(p, 0, 0, bid, nblk); break;
        case 2: if (OPTG & 1) g_qkv0(p, l3); else phase_qkv0(p, lds, bid, nblk); break;
        case 3:
            _Pragma("nounroll") for (int rp = 0; rp <= ((REPEAT >> 16) & 1); ++rp) { if (OPTA & 1) phase_attn0_dense(p, (LAS char*)lds, bid, nblk); }
            _Pragma("nounroll") for (int rp = 0; rp <= ((REPEAT >> 17) & 1); ++rp) { if (OPTA & 4) phase_attn0_win(p, (LAS char*)lds, bid, nblk); }
            if ((OPTA & 5) != 5) phase_attn0(p, lds, bid, nblk); break;
        case 4: if (OPTG & 2) g_out(p, 0, l3); else phase_out(p, 0, bid, nblk); break;
        case 5: phase_norm(p, 0, 1, bid, nblk); break;
        case 6: if (OPTG & 4) g_up(p, 0, l3); else phase_up(p, 0, lds, bid, nblk); break;
        case 7: if (OPTG & 8) g_down(p, 0, l3); else phase_down(p, 0, bid, nblk); break;
        case 8: phase_norm(p, 1, 0, bid, nblk); break;
        case 9: if (OPTG & 16) g_qkv1a(p, l3); else phase_qkv1a(p, lds, bid, nblk); break;
        case 10: if (OPTG & 32) g_qkv1b(p, l3); else phase_qkv1b(p, lds, bid, nblk); break;
        case 11:
            _Pragma("nounroll") for (int rp = 0; rp <= ((REPEAT >> 18) & 1); ++rp) { if (OPTA & 2) phase_attn1_dense(p, (LAS char*)lds, bid, nblk); }
            _Pragma("nounroll") for (int rp = 0; rp <= ((REPEAT >> 19) & 1); ++rp) { if (OPTA & 8) phase_attn1_win(p, (LAS char*)lds, bid, nblk); }
            if ((OPTA & 10) != 10) phase_attn1(p, bid, nblk); break;
        case 12: if (OPTG & 2) g_out(p, 1, l3); else phase_out(p, 1, bid, nblk); break;
        case 13: phase_norm(p, 1, 1, bid, nblk); break;
        case 14: if (OPTG & 4) g_up(p, 1, l3); else phase_up(p, 1, lds, bid, nblk); break;
        case 15: if (OPTG & 8) g_down(p, 1, l3); else phase_down(p, 1, bid, nblk); break;
    }
}

namespace cg = cooperative_groups;
__global__ void __launch_bounds__(NT, 2) k_mega(Params p) {
    extern __shared__ __attribute__((aligned(16))) char smem[];
    cg::grid_group grid = cg::this_grid();
    const int bid = blockIdx.x, nblk = gridDim.x;
    volatile LAS unsigned* st = (volatile LAS unsigned*)((LAS char*)smem + LDS_BYTES - 16);
    if (threadIdx.x < 2) st[threadIdx.x] = 0u;
    __syncthreads();
    const XcdBarrier xb = xcd_barrier_post((unsigned*)(p.ws + WS_CTL), st);
#define SYNC() xcd_barrier(xb)
#define PH(n) do { _Pragma("nounroll") for (int rep_ = 0; rep_ <= ((REPEAT >> (n)) & 1); ++rep_) { if (rep_) SYNC(); run_phase(n, p, smem, bid, nblk); } } while (0)
    PH(0); grid.sync(); PH(1); SYNC(); PH(2); SYNC(); PH(3); SYNC(); PH(4); SYNC(); PH(5); SYNC(); PH(6); SYNC(); PH(7); SYNC();
    PH(8); SYNC(); PH(9); SYNC(); PH(10); SYNC(); PH(11); SYNC(); PH(12); SYNC(); PH(13); SYNC(); PH(14); SYNC(); PH(15);
    if (REPEAT & (1 << 20)) { for (int i = 0; i < 10; ++i) SYNC(); }
#undef PH
}

extern "C" void kernel_launch(void* const* d_in, const int* in_sizes, int n_in, void* d_out, int out_size, void* d_ws, size_t ws_size, hipStream_t stream) {
    Params p{};
    for (int i = 0; i < 35; ++i) p.in[i] = (const float*)d_in[i];
    p.out = (float*)d_out; p.ws = (char*)d_ws;
    if (ws_size < WS_END) { fprintf(stderr, "ws too small: %zu < %zu\n", ws_size, (size_t)WS_END); return; }
    static int grid_blocks = 0;
    if (!grid_blocks) {
        int dev = 0, cus = 0, per_cu = 0;
        hipGetDevice(&dev);
        hipDeviceGetAttribute(&cus, hipDeviceAttributeMultiprocessorCount, dev);
        if (hipFuncSetAttribute((const void*)k_mega, hipFuncAttributeMaxDynamicSharedMemorySize, LDS_BYTES) != hipSuccess) fprintf(stderr, "hipFuncSetAttribute failed\n");
        hipOccupancyMaxActiveBlocksPerMultiprocessor(&per_cu, (const void*)k_mega, NT, LDS_BYTES);
        if (per_cu < 1) { fprintf(stderr, "occupancy query returned %d\n", per_cu); per_cu = 1; }
        if (per_cu > 1) per_cu = 1;
        grid_blocks = cus * per_cu;
    }
    if (hipMemsetAsync((char*)d_ws + WS_CTL, 0, 16384, stream) != hipSuccess) fprintf(stderr, "memset failed\n");
    void* args[] = {&p};
    hipError_t e = hipLaunchCooperativeKernel((const void*)k_mega, dim3(grid_blocks), dim3(NT), args, LDS_BYTES, stream);
    if (e != hipSuccess) fprintf(stderr, "cooperative launch failed: %s (grid %d)\n", hipGetErrorString(e), grid_blocks);
}
```

```cpp
#include <hip/hip_runtime.h>
#include <hip/hip_cooperative_groups.h>
#include <cstdint>
#include <cstdio>
#include <cmath>

typedef unsigned short bf16_t;
__device__ __forceinline__ int ltid() { int t = threadIdx.x; asm volatile("" : "+v"(t)); return t; }
typedef unsigned int u32;
typedef u32 u32x4 __attribute__((ext_vector_type(4)));

#define NT 512
constexpr int T_ = 16384, L_ = 256, R_ = 16640, D_ = 1024, F_ = 2816, F2_ = 5632;
constexpr float EPS_ = 1e-6f;

constexpr size_t WS_CTL = 0;
constexpr size_t WS_MOD = 16384;
constexpr size_t WS_SCAL = WS_MOD + 2 * 2 * 6144 * 4;
constexpr size_t WS_GT = WS_SCAL + 256;
constexpr size_t WS_ROPE = WS_GT + 6 * 64 * 4;
constexpr size_t WS_XC = WS_ROPE + 256 * 16 * 2 * 4;
constexpr size_t WS_H = WS_XC + 256 * 1024 * 4;
constexpr int HROWS = R_ + 144;
constexpr size_t WS_MIX = WS_H + (size_t)HROWS * 1024 * 2;
constexpr size_t WS_QKV = WS_MIX + (size_t)R_ * 1024 * 2;
constexpr size_t E_SEG = (size_t)512 * R_;
constexpr size_t O_QA = 0, O_KA = E_SEG, O_VAT = 2 * E_SEG, O_QB = 3 * E_SEG, O_KB = 4 * E_SEG, O_VBT = 5 * E_SEG;
constexpr size_t O_CQ = 0, O_CKV = O_CQ + (size_t)R_ * 384, O_CKR = O_CKV + (size_t)R_ * 256, O_MQ = O_CKR + (size_t)R_ * 32,
                 O_MK = O_MQ + (size_t)R_ * 768, O_MVT = O_MK + (size_t)R_ * 768, O_GQ = O_MVT + (size_t)R_ * 512,
                 O_GK = O_GQ + (size_t)R_ * 512, O_GVT = O_GK + (size_t)R_ * 128, O_L1END = O_GVT + (size_t)R_ * 128;
constexpr size_t WS_QKV_BYTES = O_L1END * 2;
constexpr size_t WS_PART = WS_QKV + WS_QKV_BYTES;
constexpr size_t WS_WT = WS_PART + (size_t)R_ * 12 * 4;
constexpr size_t W_EIN = 0, W_EOUT = W_EIN + (size_t)3072 * 1024, W_UP = W_EOUT + (size_t)1024 * 1024, W_DOWN = W_UP + (size_t)2 * 5632 * 1024,
                 W_OIN = W_DOWN + (size_t)2 * 1024 * 2816, W_OOUT = W_OIN + (size_t)1536 * 1024, W_QB = W_OOUT + (size_t)1024 * 1024,
                 W_KVB = W_QB + (size_t)1024 * 384, W_END = W_KVB + (size_t)1024 * 256;
constexpr size_t WS_PARK = ((WS_WT + W_END * 2 + 255) / 256) * 256;
constexpr size_t WS_END = WS_PARK + (size_t)3 * R_ * 128 * 4;
static_assert(WS_END <= (size_t)256 * 1024 * 1024, "ws");
constexpr size_t WS_PARTC = WS_QKV + (((size_t)(R_ + 8) * F_ * 2 + 255) / 256) * 256;
static_assert(WS_PARTC + (size_t)11 * 256 * 1024 * 4 <= WS_QKV + WS_QKV_BYTES, "act + partials alias");

struct Params { const float* in[35]; float* out; char* ws; };
enum { I_X = 0, I_C, I_CTX, I_CCTX, I_ADAW, I_ADAB, I_NMIX, I_NFFN, I_FUP, I_FCW, I_FCB, I_FDOWN, I_EWIN, I_EWOUT, I_AQN, I_AKN,
       I_LQ1, I_LK1, I_LQ2, I_LK2, I_SUBLN, I_BQN, I_BKN, I_RPB, I_OWIN, I_OWOUT, I_CQAN, I_CWQB, I_CKVAN, I_CWKVB, I_CQN, I_CKN,
       I_DQN, I_DKN, I_SINK };

__device__ __forceinline__ float bf2f(bf16_t v) { return __uint_as_float(((u32)v) << 16); }
__device__ __forceinline__ bf16_t f2bf(float f) { u32 u = __float_as_uint(f); return (bf16_t)((u + 0x7fffu + ((u >> 16) & 1u)) >> 16); }
__device__ __forceinline__ u32 pk2(float lo, float hi) { return (u32)f2bf(lo) | ((u32)f2bf(hi) << 16); }
__device__ __forceinline__ float wave_sum(float v) {
#pragma unroll
    for (int o = 32; o > 0; o >>= 1) v += __shfl_xor(v, o);
    return v;
}
__device__ __forceinline__ int swap23(int p) { return (p & 3) | ((p & 4) << 1) | ((p & 8) >> 1); }
__device__ __forceinline__ int hrow(int r) { return r < 256 ? r + 1 : r + 2; }
__device__ __forceinline__ int vpos(int key) { return (key & ~15) + swap23(key & 15); }
__device__ __forceinline__ void unpack8(u32x4 v, float (&a)[8]) {
    a[0] = __uint_as_float(v.x << 16); a[1] = __uint_as_float(v.x & 0xffff0000u);
    a[2] = __uint_as_float(v.y << 16); a[3] = __uint_as_float(v.y & 0xffff0000u);
    a[4] = __uint_as_float(v.z << 16); a[5] = __uint_as_float(v.z & 0xffff0000u);
    a[6] = __uint_as_float(v.w << 16); a[7] = __uint_as_float(v.w & 0xffff0000u);
}

struct Bufs {
    float* mod; float* scal; float* rope; float* xc; bf16_t* h; bf16_t* mix; bf16_t* qkv; bf16_t* act; float* part; bf16_t* wt; float* gt; float* partc;
    __device__ Bufs(const Params& p) {
        mod = (float*)(p.ws + WS_MOD); scal = (float*)(p.ws + WS_SCAL); rope = (float*)(p.ws + WS_ROPE); xc = (float*)(p.ws + WS_XC);
        h = (bf16_t*)(p.ws + WS_H); mix = (bf16_t*)(p.ws + WS_MIX); qkv = (bf16_t*)(p.ws + WS_QKV); act = (bf16_t*)(p.ws + WS_QKV);
        part = (float*)(p.ws + WS_PART); wt = (bf16_t*)(p.ws + WS_WT); gt = (float*)(p.ws + WS_GT); partc = (float*)(p.ws + WS_PARTC);
    }
};
__device__ __forceinline__ const float* modp(const Bufs& B, int l, int s, int chunk) { return B.mod + ((size_t)(l * 2 + s) * 6144) + chunk * 1024; }

__device__ void phase_prep(const Params& p, char* lds, int bid, int nblk) {
    Bufs B(p);
    float* sil = (float*)lds;
    float* red = (float*)lds + 2048;
    const int tid = ltid();
    for (int e = bid * NT + tid; e < 256 * 1024 / 4; e += nblk * NT) ((float4*)B.xc)[e] = ((const float4*)p.in[I_CTX])[e];
    for (int item = bid; item < 208; item += nblk) {
        if (item < 192) {
            __syncthreads();
            for (int k = tid; k < 2048; k += NT) { const float c = k < 1024 ? p.in[I_C][k] : p.in[I_CCTX][k - 1024]; sil[k] = c / (1.f + __expf(-c)); }
            __syncthreads();
            const int l = item / 96, n0 = (item % 96) * 64, q = tid & 15, kc = tid >> 4;
            const float* W = p.in[I_ADAW] + (size_t)l * 1024 * 6144 + n0 + 4 * q;
            float4 a0 = make_float4(0.f, 0.f, 0.f, 0.f), a1 = a0;
#pragma unroll 8
            for (int k = kc * 32; k < kc * 32 + 32; ++k) {
                const float4 w = *(const float4*)(W + (size_t)k * 6144);
                const float s0 = sil[k], s1 = sil[1024 + k];
                a0.x += s0 * w.x; a0.y += s0 * w.y; a0.z += s0 * w.z; a0.w += s0 * w.w;
                a1.x += s1 * w.x; a1.y += s1 * w.y; a1.z += s1 * w.z; a1.w += s1 * w.w;
            }
            float* rp = red + (kc * 16 + q) * 8;
            *(float4*)rp = a0; *(float4*)(rp + 4) = a1;
            __syncthreads();
            if (tid < 128) {
                const int n = tid & 63, sidx = tid >> 6; float acc = 0.f;
                for (int k = 0; k < 32; ++k) acc += red[(k * 16 + (n >> 2)) * 8 + sidx * 4 + (n & 3)];
                B.mod[(size_t)(l * 2 + sidx) * 6144 + n0 + n] = acc + p.in[I_ADAB][l * 6144 + n0 + n];
            }
        } else {
            if (tid < 256) { const int e = (item - 192) * 256 + tid;
                const int pos = e >> 4, i = e & 15;
                const double f = pow(10000.0, -(double)i / 16.0), ang = (double)pos * f;
                B.rope[e * 2] = (float)cos(ang); B.rope[e * 2 + 1] = (float)sin(ang);
            }
            if (item == 192 && tid < 64) {
                B.gt[tid] = p.in[I_AQN][tid]; B.gt[64 + tid] = p.in[I_AKN][tid]; B.gt[128 + tid] = p.in[I_BQN][tid]; B.gt[192 + tid] = p.in[I_BKN][tid];
                B.gt[256 + tid] = p.in[I_DQN][tid]; B.gt[320 + tid] = p.in[I_DKN][tid];
                const float s1 = wave_sum(p.in[I_LQ1][tid] * p.in[I_LK1][tid]), s2 = wave_sum(p.in[I_LQ2][tid] * p.in[I_LK2][tid]);
                if (tid == 0) B.scal[0] = expf(s1) - expf(s2) + 0.2f;
                float ma = fabsf(p.in[I_AQN][tid]), mb = fabsf(p.in[I_AKN][tid]), mc = fmaxf(fabsf(p.in[I_CQN][tid]), tid < 32 ? fabsf(p.in[I_CQN][64 + tid]) : 0.f),
                      md = fmaxf(fabsf(p.in[I_CKN][tid]), tid < 32 ? fabsf(p.in[I_CKN][64 + tid]) : 0.f);
#pragma unroll
                for (int o = 32; o > 0; o >>= 1) { ma = fmaxf(ma, __shfl_xor(ma, o)); mb = fmaxf(mb, __shfl_xor(mb, o)); mc = fmaxf(mc, __shfl_xor(mc, o)); md = fmaxf(md, __shfl_xor(md, o)); }
                if (tid == 0) { B.scal[1] = 8.f * ma * mb * 1.4426950408889634f; B.scal[2] = 9.797958971132712f * mc * md * 1.4426950408889634f; }
                float na = fabsf(p.in[I_BQN][tid]), nb = fabsf(p.in[I_BKN][tid]), nc = fabsf(p.in[I_DQN][tid]), nd = fabsf(p.in[I_DKN][tid]), nr = 0.f, ns = tid < 8 ? p.in[I_SINK][tid] : -1e30f;
                for (int e = tid; e < 8 * 465; e += 64) nr = fmaxf(nr, fabsf(p.in[I_RPB][e]));
#pragma unroll
                for (int o = 32; o > 0; o >>= 1) { na = fmaxf(na, __shfl_xor(na, o)); nb = fmaxf(nb, __shfl_xor(nb, o)); nc = fmaxf(nc, __shfl_xor(nc, o)); nd = fmaxf(nd, __shfl_xor(nd, o));
                                                   nr = fmaxf(nr, __shfl_xor(nr, o)); ns = fmaxf(ns, __shfl_xor(ns, o)); }
                if (tid == 0) { B.scal[3] = (8.f * na * nb + nr) * 1.4426950408889634f; B.scal[4] = fmaxf(8.f * nc * nd, ns) * 1.4426950408889634f; }
            }
        }
    }
}

__device__ void phase_norm(const Params& p, int l, int which, int bid, int nblk) {
    Bufs B(p);
    const int wid = ltid() >> 6, lane = ltid() & 63;
    const float* gamma = p.in[which ? I_NFFN : I_NMIX] + l * 1024;
    for (int e = bid * NT + ltid(); e < (2 + HROWS - (R_ + 2)) * 128; e += nblk * NT) {
        const int rr = e >> 7, c = e & 127; const int rho = rr == 0 ? 0 : rr == 1 ? 257 : R_ + 2 + (rr - 2);
        *(u32x4*)(B.h + (size_t)rho * 1024 + c * 8) = (u32x4){0u, 0u, 0u, 0u};
    }
    const bool first = (l == 0 && which == 0);
    for (int seg = 0; seg < 2; ++seg) {
        if (seg == 0 && l == 1 && which == 1) continue;
        const float* sh = modp(B, l, seg == 0 ? 1 : 0, which ? 3 : 0); const float* sc = modp(B, l, seg == 0 ? 1 : 0, which ? 4 : 1);
        float ca[16], cb[16];
#pragma unroll
        for (int i = 0; i < 4; ++i) {
            const int k = i * 256 + lane * 4;
            const float4 g4 = *(const float4*)(gamma + k), s4 = *(const float4*)(sc + k), h4 = *(const float4*)(sh + k);
            ca[4 * i] = g4.x * (1.f + s4.x); ca[4 * i + 1] = g4.y * (1.f + s4.y); ca[4 * i + 2] = g4.z * (1.f + s4.z); ca[4 * i + 3] = g4.w * (1.f + s4.w);
            cb[4 * i] = h4.x; cb[4 * i + 1] = h4.y; cb[4 * i + 2] = h4.z; cb[4 * i + 3] = h4.w;
        }
        const int r_lo = seg == 0 ? 0 : 256, r_hi = seg == 0 ? 256 : R_;
        const int nks = (seg == 0 && !first) ? (which == 1 ? 4 : 11) : 0;
        for (int r = r_lo + bid * 8 + wid; r < r_hi; r += nblk * 8) {
            const float* src = r < 256 ? ((first ? p.in[I_CTX] : B.xc) + (size_t)r * 1024) : ((first ? p.in[I_X] : p.out) + (size_t)(r - 256) * 1024);
            float v[16]; float ss = 0.f;
#pragma unroll
            for (int i = 0; i < 4; ++i) {
                float4 t = *(const float4*)(src + i * 256 + lane * 4);
                for (int kc = 0; kc < nks; ++kc) { const float4 q = *(const float4*)(B.partc + ((size_t)kc * 256 + r) * 1024 + i * 256 + lane * 4); t.x += q.x; t.y += q.y; t.z += q.z; t.w += q.w; }
                if (nks) *(float4*)(B.xc + (size_t)r * 1024 + i * 256 + lane * 4) = t;
                v[4 * i] = t.x; v[4 * i + 1] = t.y; v[4 * i + 2] = t.z; v[4 * i + 3] = t.w; ss += t.x * t.x + t.y * t.y + t.z * t.z + t.w * t.w; }
            ss = wave_sum(ss);
            const float rr = rsqrtf(ss * (1.f / 1024.f) + EPS_);
#pragma unroll
            for (int i = 0; i < 4; ++i) {
                const int k = i * 256 + lane * 4;
                *(uint2*)(B.h + (size_t)hrow(r) * 1024 + k) = make_uint2(pk2(v[4 * i] * rr * ca[4 * i] + cb[4 * i], v[4 * i + 1] * rr * ca[4 * i + 1] + cb[4 * i + 1]),
                                                                        pk2(v[4 * i + 2] * rr * ca[4 * i + 2] + cb[4 * i + 2], v[4 * i + 3] * rr * ca[4 * i + 3] + cb[4 * i + 3]));
            }
        }
    }
}

#define LAS __attribute__((address_space(3)))
typedef short bf16x8 __attribute__((ext_vector_type(8)));
typedef float f32x4 __attribute__((ext_vector_type(4)));
constexpr int LDS_STAGE = 131072, LDS_XCH = LDS_STAGE, LDS_BYTES = 147456;


namespace pg8 {
constexpr int BM = 256, BK = 64, HALF = 128, HTB = HALF * BK * 2, NXCD = 8, WGM = 8;
__host__ __device__ __forceinline__ int lds_byte(int r, int c) { const int st = (r >> 4) * 2 + (c >> 5), rr = r & 15, cc = c & 31, ob = rr * 64 + cc * 2; return st * 1024 + (ob ^ (((ob >> 9) & 1) << 5)); }
__host__ __device__ __forceinline__ void stage_rc(int b, int& R, int& C) { const int st = b / 1024, sb = b % 1024, swz = sb ^ (((sb >> 9) & 1) << 5); R = (st >> 1) * 16 + swz / 64; C = (st & 1) * 32 + (swz % 64) / 2; }
struct Unit { int pm, pn, koff; };
struct Gemm { const bf16_t* A; const bf16_t* Bt; int K; int ld; };
struct Order {
    int nM, nN, nwg, G, c, pm0, amode, nNr, kchunk;
    __device__ void init(int nM_, int nN_, int G_, int c_, int pm0_, int amode_, int ksplit = 1, int kchunk_ = 0) { nM = nM_; nNr = nN_; nN = nN_ * ksplit; nwg = nM * nN; G = G_; c = c_; pm0 = pm0_; amode = amode_; kchunk = kchunk_; }
    __device__ bool next(int i, Unit& u) const {
        const long L = (long)i * G + c; if (L >= nwg) return false;
        int wgid = (int)L; { const int q = nwg / NXCD, r = nwg % NXCD, xcd = wgid % NXCD, off = wgid / NXCD; wgid = (xcd < r ? xcd * (q + 1) : r * (q + 1) + (xcd - r) * q) + off; }
        const int nig = WGM * nN, gid = wgid / nig, fm = gid * WGM, gsz = (nM - fm) < WGM ? (nM - fm) : WGM;
        u.pm = pm0 + fm + ((wgid % nig) % gsz); const int slot = (wgid % nig) / gsz; u.pn = slot % nNr; u.koff = (slot / nNr) * kchunk; return true;
    }
    __device__ __forceinline__ int arow(int pm) const { return amode == 0 ? 256 * pm : amode == 1 ? (pm == 0 ? 1 : 2 + 256 * pm) : (pm < 2 ? 254 * pm : 257 + 254 * (pm - 2)); }
    __device__ __forceinline__ void a_ready(const Unit&) const {}
    __device__ __forceinline__ void done(const Unit&) const {}
};

template <class Epi, class Sched, bool ALIGN_EPI, bool SP2>
__device__ __forceinline__ void gemm_phase(LAS unsigned char* lds, const Gemm g, const Sched& S, const Epi& E) {
    const int tid = ltid(), wid = __builtin_amdgcn_readfirstlane(tid >> 6), lane = tid & 63, wr = wid >> 2, wc = wid & 3, fr = lane & 15, fq = lane >> 4;
    int K_ = g.K; asm volatile("" : "+s"(K_));
    const int K = K_, nt = K / BK, ld = g.ld;
    unsigned voffA[2], voffB[2];
#pragma unroll
    for (int i = 0; i < 2; ++i) { int R, C; stage_rc(tid * 16 + i * 8192, R, C); voffA[i] = (unsigned)(R * ld + C) * 2u; voffB[i] = (unsigned)(R * ld + C) * 2u; }
    const size_t kstep = (size_t)(BK * 2);
    const size_t hstep = (size_t)HALF * ld * 2;
    const size_t tstep = 2 * hstep;
    const size_t rstep = (size_t)ld * 2;
    const unsigned ldsw = (unsigned)wid * 1024u;
    const int aoff = lds_byte(wr * 64 + fr, fq * 8), boff = lds_byte(wc * 32 + fr, fq * 8);
#define PG8_SA(b, h) (((b) * 2 + (h)) * HTB)
#define PG8_SB(b, h) ((4 + (b) * 2 + (h)) * HTB)
#define PG8_STAGE(bufoff, gbase, voff) do { _Pragma("unroll") for (int _i = 0; _i < 2; ++_i) \
        __builtin_amdgcn_global_load_lds((const unsigned*)((const char*)(gbase) + (voff)[_i]), (LAS unsigned*)(lds + (bufoff) + ldsw + _i * 8192), 16, 0, 0); } while (0)
#define PG8_LDA(dst, b, h) do { _Pragma("unroll") for (int m = 0; m < 4; ++m) _Pragma("unroll") for (int k = 0; k < 2; ++k) dst[m][k] = *(const LAS bf16x8*)(lds + PG8_SA(b, h) + aoff + m * 2048 + k * 1024); } while (0)
#define PG8_LDB(dst, b, h) do { _Pragma("unroll") for (int n = 0; n < 2; ++n) _Pragma("unroll") for (int k = 0; k < 2; ++k) dst[n][k] = *(const LAS bf16x8*)(lds + PG8_SB(b, h) + boff + n * 2048 + k * 1024); } while (0)
#define PG8_MMA(ai, bj, At, Bt) do { __builtin_amdgcn_s_setprio(1); _Pragma("unroll") for (int m = 0; m < 4; ++m) _Pragma("unroll") for (int n = 0; n < 2; ++n) _Pragma("unroll") for (int k = 0; k < 2; ++k) \
        acc[ai][bj][m][n] = __builtin_amdgcn_mfma_f32_16x16x32_bf16(Bt[n][k], At[m][k], acc[ai][bj][m][n], 0, 0, 0); __builtin_amdgcn_s_setprio(0); } while (0)
#define PG8_WAIT_V(n) asm volatile("s_waitcnt vmcnt(" #n ")" ::: "memory")
#define PG8_WAIT_L(n) asm volatile("s_waitcnt lgkmcnt(" #n ")" ::: "memory")
#define PG8_BAR __builtin_amdgcn_s_barrier()
#define PG8_SCHED __builtin_amdgcn_sched_barrier(0)
    Unit cur, nxt; int ui = 0;
    if (!S.next(0, cur)) return;
    f32x4 acc[2][2][4][2];
#pragma unroll
    for (int a = 0; a < 2; ++a)
#pragma unroll
        for (int b = 0; b < 2; ++b)
#pragma unroll
            for (int m = 0; m < 4; ++m)
#pragma unroll
                for (int n = 0; n < 2; ++n) acc[a][b][m][n] = (f32x4){0.f, 0.f, 0.f, 0.f};
    bf16x8 At[4][2], B0[2][2], B1[2][2];
    const char* cA = (const char*)g.A + (size_t)S.arow(cur.pm) * rstep + (size_t)cur.koff * 2; const char* cB = (const char*)g.Bt + (size_t)cur.pn * tstep + (size_t)cur.koff * 2;
    S.a_ready(cur);
    if constexpr (SP2) {
        PG8_STAGE(PG8_SB(0, 0), cB, voffB); PG8_STAGE(PG8_SB(0, 1), cB + hstep, voffB); PG8_STAGE(PG8_SA(0, 0), cA, voffA); PG8_STAGE(PG8_SA(0, 1), cA + hstep, voffA);
        if (wr == 1) PG8_BAR;
        PG8_WAIT_V(2); PG8_BAR;
        PG8_STAGE(PG8_SB(1, 0), cB + kstep, voffB); PG8_STAGE(PG8_SA(1, 0), cA + kstep, voffA); PG8_STAGE(PG8_SB(1, 1), cB + hstep + kstep, voffB);
        PG8_WAIT_V(6); PG8_BAR;
    } else {
        PG8_STAGE(PG8_SB(0, 0), cB, voffB); PG8_STAGE(PG8_SA(0, 0), cA, voffA); PG8_STAGE(PG8_SB(0, 1), cB + hstep, voffB); PG8_STAGE(PG8_SA(0, 1), cA + hstep, voffA);
        if (wr == 1) PG8_BAR;
        PG8_WAIT_V(4); PG8_BAR;
        PG8_STAGE(PG8_SB(1, 0), cB + kstep, voffB); PG8_STAGE(PG8_SA(1, 0), cA + kstep, voffA); PG8_STAGE(PG8_SB(1, 1), cB + hstep + kstep, voffB);
        PG8_WAIT_V(6); PG8_BAR;
    }
    for (;;) {
        const bool has_next = S.next(ui + 1, nxt);
        const char* nA = has_next ? (const char*)g.A + (size_t)S.arow(nxt.pm) * rstep + (size_t)nxt.koff * 2 : cA; const char* nB = has_next ? (const char*)g.Bt + (size_t)nxt.pn * tstep + (size_t)nxt.koff * 2 : cB;
        for (int t = 0; t < nt; t += 2) {
            const bool last = (t == nt - 2);
            const char* a1 = cA + (size_t)(t + 1) * kstep;
            const char* a2 = last ? nA : cA + (size_t)(t + 2) * kstep; const char* b2 = last ? nB : cB + (size_t)(t + 2) * kstep;
            const char* a3 = a2 + kstep; const char* b3 = b2 + kstep;
            if (last && has_next) S.a_ready(nxt);
            if constexpr (SP2) {
            PG8_LDB(B0, 0, 0); PG8_LDB(B1, 0, 1); PG8_SCHED; PG8_LDA(At, 0, 0); PG8_STAGE(PG8_SA(1, 1), a1 + hstep, voffA);
            PG8_WAIT_V(8); PG8_WAIT_L(0); PG8_BAR; PG8_MMA(0, 0, At, B0); PG8_MMA(0, 1, At, B1); PG8_BAR; PG8_SCHED;
            PG8_LDA(At, 0, 1); PG8_STAGE(PG8_SB(0, 0), b2, voffB); PG8_STAGE(PG8_SB(0, 1), b2 + hstep, voffB); PG8_STAGE(PG8_SA(0, 0), a2, voffA);
            PG8_WAIT_V(8); PG8_WAIT_L(0); PG8_BAR; PG8_MMA(1, 0, At, B0); PG8_MMA(1, 1, At, B1); PG8_BAR; PG8_SCHED;
            PG8_LDB(B0, 1, 0); PG8_LDB(B1, 1, 1); PG8_SCHED; PG8_LDA(At, 1, 0); PG8_STAGE(PG8_SA(0, 1), a2 + hstep, voffA);
            PG8_WAIT_V(8); PG8_WAIT_L(0); PG8_BAR; PG8_MMA(0, 0, At, B0); PG8_MMA(0, 1, At, B1); PG8_BAR; PG8_SCHED;
            PG8_LDA(At, 1, 1); PG8_STAGE(PG8_SB(1, 0), b3, voffB); PG8_STAGE(PG8_SB(1, 1), b3 + hstep, voffB); PG8_STAGE(PG8_SA(1, 0), a3, voffA);
            PG8_WAIT_V(8); PG8_WAIT_L(0); PG8_BAR; PG8_MMA(1, 0, At, B0); PG8_MMA(1, 1, At, B1); PG8_BAR; PG8_SCHED;
            } else {
            PG8_LDB(B0, 0, 0); PG8_SCHED; PG8_LDA(At, 0, 0); PG8_STAGE(PG8_SA(1, 1), a1 + hstep, voffA);
            PG8_WAIT_L(8); PG8_BAR; PG8_WAIT_L(0); PG8_MMA(0, 0, At, B0); PG8_BAR; PG8_SCHED;
            PG8_LDB(B1, 0, 1); PG8_STAGE(PG8_SB(0, 0), b2, voffB);
            PG8_BAR; PG8_WAIT_L(0); PG8_MMA(0, 1, At, B1); PG8_BAR;
            PG8_LDA(At, 0, 1); PG8_STAGE(PG8_SA(0, 0), a2, voffA);
            PG8_BAR; PG8_WAIT_L(0); PG8_MMA(1, 0, At, B0); PG8_BAR; PG8_SCHED;
            PG8_STAGE(PG8_SB(0, 1), b2 + hstep, voffB);
            PG8_WAIT_V(6); PG8_BAR; PG8_MMA(1, 1, At, B1); PG8_BAR;
            PG8_LDB(B0, 1, 0); PG8_SCHED; PG8_LDA(At, 1, 0); PG8_STAGE(PG8_SA(0, 1), a2 + hstep, voffA);
            PG8_WAIT_L(8); PG8_BAR; PG8_WAIT_L(0); PG8_MMA(0, 0, At, B0); PG8_BAR; PG8_SCHED;
            PG8_LDB(B1, 1, 1); PG8_STAGE(PG8_SB(1, 0), b3, voffB);
            PG8_BAR; PG8_WAIT_L(0); PG8_MMA(0, 1, At, B1); PG8_BAR;
            PG8_LDA(At, 1, 1); PG8_STAGE(PG8_SA(1, 0), a3, voffA);
            PG8_BAR; PG8_WAIT_L(0); PG8_MMA(1, 0, At, B0); PG8_BAR; PG8_SCHED;
            PG8_STAGE(PG8_SB(1, 1), b3 + hstep, voffB);
            PG8_WAIT_V(6); PG8_BAR; PG8_MMA(1, 1, At, B1); PG8_BAR;
            }
        }
        if constexpr (ALIGN_EPI) { if (wr == 0) PG8_BAR; }
        E(acc, cur, wr, wc, fr, fq); S.done(cur);
        if (!has_next) break;
#pragma unroll
        for (int a = 0; a < 2; ++a)
#pragma unroll
            for (int b = 0; b < 2; ++b)
#pragma unroll
                for (int m = 0; m < 4; ++m)
#pragma unroll
                    for (int n = 0; n < 2; ++n) acc[a][b][m][n] = (f32x4){0.f, 0.f, 0.f, 0.f};
        cur = nxt; cA = nA; cB = nB; ++ui;
        if constexpr (ALIGN_EPI) { if (wr == 1) PG8_BAR; }
    }
    PG8_WAIT_V(0);
    if constexpr (!ALIGN_EPI) { if (wr == 0) PG8_BAR; }
    PG8_BAR;
#undef PG8_SA
#undef PG8_SB
#undef PG8_STAGE
#undef PG8_LDA
#undef PG8_LDB
#undef PG8_MMA
#undef PG8_WAIT_V
#undef PG8_WAIT_L
#undef PG8_BAR
#undef PG8_SCHED
}
}

constexpr float QS64 = 0.125f * 1.4426950408889634f, QS96 = 0.10206207261596575f * 1.4426950408889634f;
typedef f32x4 AccT[2][2][4][2];
__device__ __forceinline__ const float* launder(const float* p) { asm volatile("" : "+s"(p)); return p; }
#define EPI_IDS() int t_ = ltid(); const int fr = t_ & 15, fq = (t_ >> 4) & 3; const int wid_ = __builtin_amdgcn_readfirstlane(t_ >> 6), wr = wid_ >> 2, wc = wid_ & 3; (void)wr; (void)wc; (void)fr; (void)fq
#define ITER_FENCE() do { asm volatile("" ::: "memory"); __builtin_amdgcn_sched_barrier(0); } while (0)
#define EPI_BARRIER() do { asm volatile("s_waitcnt lgkmcnt(0)" ::: "memory"); __builtin_amdgcn_s_barrier(); asm volatile("" ::: "memory"); } while (0)

__device__ __forceinline__ int vcol_of_row(int J) { const int pn = J >> 8, j = J & 255, bj = j >> 7, wc = (j >> 5) & 3, n = (j >> 4) & 1, fq = (j >> 2) & 3, e = j & 3; return 256 * pn + 64 * wc + 32 * bj + 8 * fq + 4 * n + e; }
__device__ __forceinline__ int gmap(int map, int v) {
    if (map == 0) return v;
    if (map == 1) { const int pn = v >> 8, wc = (v >> 6) & 3, bj = (v >> 5) & 1, x = v & 31, h = 128 * pn + 32 * wc + x; return bj ? F_ + h : h; }
    if (map == 2) { if (v < 384) return v; if (v < 512) return 1184 + (v - 384); if (v < 768) return 384 + (v - 512); if (v < 1280) return 672 + (v - 768);
                    if (v < 1408) return 1312 + (v - 1280); if (v < 1440) return 640 + (v - 1408); return -1; }
    { const int hh = v >> 7, y = v & 127; if (y < 64) return hh * 96 + y; const int x = y - 64; if (x >= 32) return -1; const int fq = x >> 3, n = (x >> 2) & 1, e = x & 3; return hh * 96 + 64 + 16 * n + 4 * fq + e; }
}
__device__ __forceinline__ void prep_item(const float* __restrict__ W, int K, int ldw, bf16_t* Bt, int NV, int map, const float* kscale, float* scr, int item, int lane) {
    const int nb32 = NV / 32, kb = item / nb32, nb = item % nb32, k0 = 64 * kb, J0 = 32 * nb;
    const int kk8 = lane >> 3, jq = lane & 7;
    const int col = gmap(map, vcol_of_row(J0 + 4 * jq));
#pragma unroll
    for (int i = 0; i < 8; ++i) {
        const int kk = 8 * i + kk8;
        float4 v = col >= 0 ? *(const float4*)(W + (size_t)(k0 + kk) * ldw + col) : make_float4(0.f, 0.f, 0.f, 0.f);
        if (kscale) { const float sc = kscale[k0 + kk]; v.x *= sc; v.y *= sc; v.z *= sc; v.w *= sc; }
        float* d = scr + kk * 33 + 4 * jq; d[0] = v.x; d[1] = v.y; d[2] = v.z; d[3] = v.w;
    }
    __builtin_amdgcn_wave_barrier();
    asm volatile("s_waitcnt lgkmcnt(0)" ::: "memory");
    const int c = lane & 7;
#pragma unroll
    for (int j = 0; j < 4; ++j) { const int n = (lane >> 3) + 8 * j; const float* s = scr + (8 * c) * 33 + n;
        u32x4 o; o.x = pk2(s[0 * 33], s[1 * 33]); o.y = pk2(s[2 * 33], s[3 * 33]); o.z = pk2(s[4 * 33], s[5 * 33]); o.w = pk2(s[6 * 33], s[7 * 33]);
        *(u32x4*)(Bt + (size_t)(J0 + n) * K + k0 + 8 * c) = o; }
    asm volatile("s_waitcnt lgkmcnt(0)" ::: "memory");
    __builtin_amdgcn_wave_barrier();
}
constexpr int PW_I0 = 16 * 96, PW_I1 = 16 * 32, PW_I2 = 16 * 176, PW_I3 = 44 * 32, PW_I4 = 16 * 48, PW_I5 = 16 * 32, PW_I6 = 6 * 32, PW_I7 = 4 * 32;
constexpr int PW_NIT = PW_I0 + PW_I1 + 2 * PW_I2 + 2 * PW_I3 + PW_I4 + PW_I5 + PW_I6 + PW_I7;
__device__ __forceinline__ void prep_weight_item(const Params& p, const Bufs& B, float* scr, int it, int lane) {
    int r = it;
    if (r < PW_I0) { prep_item(p.in[I_EWIN], 1024, 3072, B.wt + W_EIN, 3072, 0, nullptr, scr, r, lane); return; } r -= PW_I0;
    if (r < PW_I1) { prep_item(p.in[I_EWOUT], 1024, 1024, B.wt + W_EOUT, 1024, 0, nullptr, scr, r, lane); return; } r -= PW_I1;
    if (r < 2 * PW_I2) { const int l = r / PW_I2; prep_item(p.in[I_FUP] + (size_t)l * 1024 * F2_, 1024, F2_, B.wt + W_UP + (size_t)l * F2_ * 1024, F2_, 1, nullptr, scr, r % PW_I2, lane); return; } r -= 2 * PW_I2;
    if (r < 2 * PW_I3) { const int l = r / PW_I3; prep_item(p.in[I_FDOWN] + (size_t)l * F_ * 1024, F_, 1024, B.wt + W_DOWN + (size_t)l * 1024 * F_, 1024, 0, nullptr, scr, r % PW_I3, lane); return; } r -= 2 * PW_I3;
    if (r < PW_I4) { prep_item(p.in[I_OWIN], 1024, 1440, B.wt + W_OIN, 1536, 2, nullptr, scr, r, lane); return; } r -= PW_I4;
    if (r < PW_I5) { prep_item(p.in[I_OWOUT], 1024, 1024, B.wt + W_OOUT, 1024, 0, nullptr, scr, r, lane); return; } r -= PW_I5;
    if (r < PW_I6) { prep_item(p.in[I_CWQB], 384, 768, B.wt + W_QB, 1024, 3, p.in[I_CQAN], scr, r, lane); return; } r -= PW_I6;
    prep_item(p.in[I_CWKVB], 256, 1024, B.wt + W_KVB, 1024, 0, p.in[I_CKVAN], scr, r, lane);
}
__device__ void phase_prep_weights(const Params& p, char* lds, int bid, int nblk) {
    Bufs B(p);
    const int wid = ltid() >> 6, lane = ltid() & 63;
    float* scr = (float*)lds + wid * (64 * 33 + 16);
    for (int it = bid * 8 + wid; it < PW_I0; it += nblk * 8) prep_weight_item(p, B, scr, it, lane);
}
__device__ void phase_prep_weights_rest(const Params& p, char* lds) {
    Bufs B(p);
    const int tid = ltid(), wid = tid >> 6, lane = tid & 63;
    float* scr = (float*)lds + wid * (64 * 33 + 16);
    volatile int* slot = (volatile int*)(lds + LDS_BYTES - 32);
    unsigned* ctr = (unsigned*)(p.ws + WS_CTL + 15360);
    for (;;) {
        __syncthreads();
        if (tid == 0) *slot = (int)__hip_atomic_fetch_add(ctr, 8u, __ATOMIC_RELAXED, __HIP_MEMORY_SCOPE_AGENT);
        __syncthreads();
        const int base = PW_I0 + *slot;
        if (base >= PW_NIT) break;
        if (base + wid < PW_NIT) prep_weight_item(p, B, scr, base + wid, lane);
    }
}

__device__ __forceinline__ void head64_epi(const AccT& acc, int ai, int m, const float (&gn)[2][2][4], bool rope, const float* tab, int t, int fq, bf16_t* dst, float qscale) {
    float ss = 0.f;
#pragma unroll
    for (int bj = 0; bj < 2; ++bj)
#pragma unroll
        for (int n = 0; n < 2; ++n)
#pragma unroll
            for (int e = 0; e < 4; ++e) { const float v = acc[ai][bj][m][n][e]; ss += v * v; }
    ss += __shfl_xor(ss, 16); ss += __shfl_xor(ss, 32);
    const float rr = rsqrtf(ss * (1.f / 64.f) + EPS_) * qscale;
    float y[2][2][4];
#pragma unroll
    for (int bj = 0; bj < 2; ++bj)
#pragma unroll
        for (int n = 0; n < 2; ++n)
#pragma unroll
            for (int e = 0; e < 4; ++e) y[bj][n][e] = acc[ai][bj][m][n][e] * rr * gn[bj][n][e];
    if (rope) {
        const int pos = fq < 2 ? (t >> 6) : (t & 63);
        const float4* cs = (const float4*)(tab + (pos * 16 + 8 * (fq & 1)) * 2);
#pragma unroll
        for (int n = 0; n < 2; ++n) {
            const float4 c0 = cs[2 * n], c1 = cs[2 * n + 1];
            const float cv[4] = {c0.x, c0.z, c1.x, c1.z}, sv[4] = {c0.y, c0.w, c1.y, c1.w};
#pragma unroll
            for (int e = 0; e < 4; ++e) { const float x1 = y[0][n][e], x2 = y[1][n][e]; y[0][n][e] = x1 * cv[e] - x2 * sv[e]; y[1][n][e] = x1 * sv[e] + x2 * cv[e]; }
        }
    }
#pragma unroll
    for (int bj = 0; bj < 2; ++bj) {
        u32x4 w; w.x = pk2(y[bj][0][0], y[bj][0][1]); w.y = pk2(y[bj][0][2], y[bj][0][3]); w.z = pk2(y[bj][1][0], y[bj][1][1]); w.w = pk2(y[bj][1][2], y[bj][1][3]);
        *(u32x4*)(dst + 32 * bj + 8 * fq) = w;
    }
}
__device__ __forceinline__ void load_gain64(float (&gn)[2][2][4], const float* g, int fq) {
#pragma unroll
    for (int bj = 0; bj < 2; ++bj)
#pragma unroll
        for (int n = 0; n < 2; ++n) { const float4 t = *(const float4*)(g + 32 * bj + 8 * fq + 4 * n); gn[bj][n][0] = t.x; gn[bj][n][1] = t.y; gn[bj][n][2] = t.z; gn[bj][n][3] = t.w; }
}
__device__ __forceinline__ void vt_store(const AccT& acc, int ai, int m, float scale, bf16_t* vt, int fq, int r) {
    const int pos = vpos(r);
#pragma unroll
    for (int bj = 0; bj < 2; ++bj)
#pragma unroll
        for (int n = 0; n < 2; ++n)
#pragma unroll
            for (int e = 0; e < 4; ++e) vt[(size_t)(32 * bj + 8 * fq + 4 * n + e) * R_ + pos] = f2bf(acc[ai][bj][m][n][e] * scale);
}
__device__ __forceinline__ float raw_store(const AccT& acc, int ai, int m, bf16_t* dst, int fq) {
    float ss = 0.f;
#pragma unroll
    for (int bj = 0; bj < 2; ++bj) {
        u32x4 w; const f32x4 a = acc[ai][bj][m][0], b = acc[ai][bj][m][1];
        w.x = pk2(a[0], a[1]); w.y = pk2(a[2], a[3]); w.z = pk2(b[0], b[1]); w.w = pk2(b[2], b[3]);
        *(u32x4*)(dst + 32 * bj + 8 * fq) = w;
        float t[8]; unpack8(w, t);
#pragma unroll
        for (int j = 0; j < 8; ++j) ss += t[j] * t[j];
    }
    return ss;
}

struct EpiQKV0 {
    bf16_t* qkv; const float* rope; const float* gt;
    __device__ __forceinline__ void operator()(const AccT& acc, const pg8::Unit& u, int, int, int, int) const {
        EPI_IDS();
        const int seg = u.pn >> 1, r0 = u.pm * 256 + wr * 64 + fr;
        if (seg == 2 || seg == 5) {
            const size_t vo = seg == 2 ? O_VAT + ((size_t)((u.pn & 1) * 2 + (wc >> 1)) * 128 + 64 * (wc & 1)) * R_ : O_VBT + (size_t)((u.pn & 1) * 4 + wc) * 64 * R_;
            bf16_t* vt = qkv + vo;
#pragma unroll
            for (int ai = 0; ai < 2; ++ai)
#pragma unroll
                for (int m = 0; m < 4; ++m) { vt_store(acc, ai, m, 1.f, vt, fq, r0 + 128 * ai + 16 * m); ITER_FENCE(); }
        } else {
            float gn[2][2][4]; load_gain64(gn, gt + 64 * (seg < 2 ? seg : seg - 1), fq);
            const int head = (u.pn & 1) * 4 + wc;
            const size_t bo = (seg == 0 ? O_QA : seg == 1 ? O_KA : seg == 3 ? O_QB : O_KB) + (size_t)head * R_ * 64;
            bf16_t* base = qkv + bo;
            const bool rp = seg < 2 && u.pm > 0;
#pragma unroll
            for (int ai = 0; ai < 2; ++ai)
#pragma unroll
                for (int m = 0; m < 4; ++m) { const int r = r0 + 128 * ai + 16 * m; head64_epi(acc, ai, m, gn, rp, rope, r - 256, fq, base + (size_t)r * 64, (seg == 0 || seg == 3) ? QS64 : 1.f); ITER_FENCE(); }
        }
    }
};

struct EpiResid {
    const float* resid_lat; float* dst_lat; const float* resid_ctx; float* dst_ctx; const float* gate_lat; const float* gate_ctx;
    __device__ __forceinline__ void rows(const AccT& acc, const float* __restrict__ resid, float* dst, const float* __restrict__ gate, int row0, int col0) const {
        f32x4 gt[2][2];
#pragma unroll
        for (int bj = 0; bj < 2; ++bj)
#pragma unroll
            for (int n = 0; n < 2; ++n) gt[bj][n] = *(const f32x4*)(gate + col0 + 32 * bj + 4 * n);
#pragma unroll
        for (int ai = 0; ai < 2; ++ai)
#pragma unroll
            for (int m = 0; m < 4; ++m) {
                const size_t ro = (size_t)(row0 + 128 * ai + 16 * m) * 1024 + col0;
#pragma unroll
                for (int bj = 0; bj < 2; ++bj)
#pragma unroll
                    for (int n = 0; n < 2; ++n) { const f32x4 x = *(const f32x4*)(resid + ro + 32 * bj + 4 * n); *(f32x4*)(dst + ro + 32 * bj + 4 * n) = x + gt[bj][n] * acc[ai][bj][m][n]; }
                ITER_FENCE();
            }
    }
    __device__ __forceinline__ void operator()(const AccT& acc, const pg8::Unit& u, int, int, int, int) const {
        EPI_IDS();
        const int col0 = u.pn * 256 + wc * 64 + 8 * fq, rl = 64 * wr + fr;
        if (u.pm == 0) rows(acc, resid_ctx, dst_ctx, gate_ctx, rl, col0);
        else rows(acc, resid_lat, dst_lat, gate_lat, (u.pm - 1) * 256 + rl, col0);
    }
};

struct EpiPartial {
    float* part; const float* gate;
    __device__ __forceinline__ void operator()(const AccT& acc, const pg8::Unit& u, int, int, int, int) const {
        EPI_IDS();
        const int col0 = u.pn * 256 + wc * 64 + 8 * fq, rl = 64 * wr + fr;
        float* base = part + (size_t)(u.koff >> 8) * 256 * 1024;
        f32x4 gt[2][2];
#pragma unroll
        for (int bj = 0; bj < 2; ++bj)
#pragma unroll
            for (int n = 0; n < 2; ++n) gt[bj][n] = *(const f32x4*)(gate + col0 + 32 * bj + 4 * n);
#pragma unroll
        for (int ai = 0; ai < 2; ++ai)
#pragma unroll
            for (int m = 0; m < 4; ++m) {
                float* d = base + (size_t)(rl + 128 * ai + 16 * m) * 1024 + col0;
#pragma unroll
                for (int bj = 0; bj < 2; ++bj)
#pragma unroll
                    for (int n = 0; n < 2; ++n) *(f32x4*)(d + 32 * bj + 4 * n) = gt[bj][n] * acc[ai][bj][m][n];
                ITER_FENCE();
            }
    }
};

#ifndef USE_DPP
#define USE_DPP 1
#endif
__device__ __forceinline__ float rot_prev(float x, int lane) {
#if USE_DPP
    return __builtin_bit_cast(float, __builtin_amdgcn_update_dpp(0, __builtin_bit_cast(int, x), 0x121, 0xf, 0xf, false));
#else
    return __shfl(x, (lane & 48) | ((lane - 1) & 15));
#endif
}
__device__ __forceinline__ float rot_next(float x, int lane) {
#if USE_DPP
    return __builtin_bit_cast(float, __builtin_amdgcn_update_dpp(0, __builtin_bit_cast(int, x), 0x12F, 0xf, 0xf, false));
#else
    return __shfl(x, (lane & 48) | ((lane + 1) & 15));
#endif
}
struct EpiUp {
    bf16_t* act; const float* cw; const float* cb; LAS float* xch;
    __device__ __forceinline__ int xidx(int c, int which, int wc, int fq, int bj, int n) const { return (((c * 2 + which) * 4 + wc) * 64) + fq * 16 + bj * 8 + n * 4; }
    __device__ __forceinline__ void operator()(const AccT& acc, const pg8::Unit& u, int, int, int, int) const {
        EPI_IDS();
        const int lane = fq * 16 + fr;
        if (fr == 0) {
#pragma unroll
            for (int ai = 0; ai < 2; ++ai)
#pragma unroll
                for (int bj = 0; bj < 2; ++bj)
#pragma unroll
                    for (int n = 0; n < 2; ++n) *(LAS f32x4*)(xch + xidx(2 * ai + wr, 0, wc, fq, bj, n)) = acc[ai][bj][0][n];
        }
        if (fr == 15) {
#pragma unroll
            for (int ai = 0; ai < 2; ++ai)
#pragma unroll
                for (int bj = 0; bj < 2; ++bj)
#pragma unroll
                    for (int n = 0; n < 2; ++n) *(LAS f32x4*)(xch + xidx(2 * ai + wr, 1, wc, fq, bj, n)) = acc[ai][bj][3][n];
        }
        EPI_BARRIER();
        const bool isctx = u.pm < 2;
        const int seq0 = isctx ? 254 * u.pm : 254 * (u.pm - 2), lim = isctx ? 256 : T_, rbase = isctx ? 0 : 256;
#pragma unroll
        for (int n = 0; n < 2; ++n) {
            const int h0 = 128 * u.pn + 32 * wc + 8 * fq + 4 * n;
            f32x4 w0[2], w1[2], w2[2], bb[2];
#pragma unroll
            for (int bj = 0; bj < 2; ++bj) { const int c = bj * F_ + h0; w0[bj] = *(const f32x4*)(cw + c); w1[bj] = *(const f32x4*)(cw + F2_ + c); w2[bj] = *(const f32x4*)(cw + 2 * F2_ + c); bb[bj] = *(const f32x4*)(cb + c); }
#pragma unroll
            for (int ai = 0; ai < 2; ++ai) {
                const int c = 2 * ai + wr;
                f32x4 eup[2], edn[2];
#pragma unroll
                for (int bj = 0; bj < 2; ++bj) {
                    eup[bj] = c > 0 ? *(const LAS f32x4*)(xch + xidx(c - 1, 1, wc, fq, bj, n)) : (f32x4){0.f, 0.f, 0.f, 0.f};
                    edn[bj] = c < 3 ? *(const LAS f32x4*)(xch + xidx(c + 1, 0, wc, fq, bj, n)) : (f32x4){0.f, 0.f, 0.f, 0.f};
                }
#pragma unroll
                for (int m = 0; m < 4; ++m) {
                    f32x4 cv[2];
#pragma unroll
                    for (int bj = 0; bj < 2; ++bj) {
                        const f32x4 x = acc[ai][bj][m][n];
                        f32x4 up, dn;
#pragma unroll
                        for (int e = 0; e < 4; ++e) {
                            const float ps = rot_prev(x[e], lane), ns = rot_next(x[e], lane);
                            float pe, ne;
                            if (m > 0) pe = rot_prev(acc[ai][bj][m > 0 ? m - 1 : 0][n][e], lane); else pe = eup[bj][e];
                            if (m < 3) ne = rot_next(acc[ai][bj][m < 3 ? m + 1 : 3][n][e], lane); else ne = edn[bj][e];
                            up[e] = fr == 0 ? pe : ps; dn[e] = fr == 15 ? ne : ns;
                        }
                        cv[bj] = bb[bj] + w0[bj] * up + w1[bj] * x + w2[bj] * dn;
                    }
                    const int j = 128 * ai + 64 * wr + 16 * m + fr, sr = seq0 + j - 1;
                    if (j >= 1 && j <= 254 && sr < lim) {
                        float o[4];
#pragma unroll
                        for (int e = 0; e < 4; ++e) { const float gg = cv[1][e]; o[e] = cv[0][e] * gg * __builtin_amdgcn_rcpf(1.f + __builtin_amdgcn_exp2f(-1.4426950408889634f * gg)); }
                        *(uint2*)(act + (size_t)(rbase + sr) * F_ + h0) = make_uint2(pk2(o[0], o[1]), pk2(o[2], o[3]));
                    }
                    ITER_FENCE();
                }
            }
        }
    }
};

struct EpiQKV1A {
    bf16_t* qkv; float* part; const float* rope; const float* gt;
    __device__ __forceinline__ void operator()(const AccT& acc, const pg8::Unit& u, int, int, int, int) const {
        EPI_IDS();
        const int r0 = u.pm * 256 + wr * 64 + fr, pn = u.pn;
        const bool rp = u.pm > 0;
        if (pn == 0 || (pn == 1 && wc < 2) || pn == 2) {
            const int chunk = pn == 0 ? wc : pn == 1 ? 4 + wc : wc;
            const size_t bo = pn == 2 ? O_CKV + 64 * wc : O_CQ + 64 * chunk;
            bf16_t* base = qkv + bo;
            const int ld = pn == 2 ? 256 : 384;
            float* pp = part + (pn == 2 ? 8 : 0) + chunk;
#pragma unroll
            for (int ai = 0; ai < 2; ++ai)
#pragma unroll
                for (int m = 0; m < 4; ++m) {
                    const int r = r0 + 128 * ai + 16 * m;
                    float ss = raw_store(acc, ai, m, base + (size_t)r * ld, fq);
                    ss += __shfl_xor(ss, 16); ss += __shfl_xor(ss, 32);
                    if (fq == 0) pp[(size_t)r * 12] = ss;
                    ITER_FENCE();
                }
        } else if (pn == 1 || pn == 3 || pn == 4) {
            const bool isk = pn == 1;
            float gn[2][2][4]; load_gain64(gn, gt + (isk ? 320 : 256), fq);
            const size_t bo = isk ? O_GK + (size_t)(wc - 2) * R_ * 64 : O_GQ + (size_t)(4 * (pn - 3) + wc) * R_ * 64;
            bf16_t* base = qkv + bo;
#pragma unroll
            for (int ai = 0; ai < 2; ++ai)
#pragma unroll
                for (int m = 0; m < 4; ++m) { const int r = r0 + 128 * ai + 16 * m; head64_epi(acc, ai, m, gn, rp, rope, r - 256, fq, base + (size_t)r * 64, isk ? 1.f : QS64); ITER_FENCE(); }
        } else {
            if (wc < 2) {
                bf16_t* vt = qkv + O_GVT + (size_t)wc * 64 * R_;
#pragma unroll
                for (int ai = 0; ai < 2; ++ai)
#pragma unroll
                    for (int m = 0; m < 4; ++m) { vt_store(acc, ai, m, 1.f, vt, fq, r0 + 128 * ai + 16 * m); ITER_FENCE(); }
            } else if (wc == 2) {
#pragma unroll
                for (int ai = 0; ai < 2; ++ai)
#pragma unroll
                    for (int m = 0; m < 4; ++m) {
                        const int r = r0 + 128 * ai + 16 * m; const f32x4 a = acc[ai][0][m][0], b = acc[ai][0][m][1];
                        u32x4 w; w.x = pk2(a[0], a[1]); w.y = pk2(a[2], a[3]); w.z = pk2(b[0], b[1]); w.w = pk2(b[2], b[3]);
                        *(u32x4*)(qkv + O_CKR + (size_t)r * 32 + 8 * fq) = w;
                    }
            }
        }
    }
};

struct EpiQB {
    bf16_t* qkv; const float* part; const float* rope; const float* gq; LAS float* xch;
    __device__ __forceinline__ void operator()(const AccT& acc, const pg8::Unit& u, int, int, int, int) const {
        EPI_IDS();
        const int wid = wr * 4 + wc, head = 2 * u.pn + (wc >> 1), role = wc & 1, r0 = u.pm * 256 + wr * 64 + fr;
        const bool rp = u.pm > 0;
        float ssp[2][4];
#pragma unroll
        for (int ai = 0; ai < 2; ++ai)
#pragma unroll
            for (int m = 0; m < 4; ++m) {
                float ss = 0.f;
#pragma unroll
                for (int bj = 0; bj < 2; ++bj)
#pragma unroll
                    for (int n = 0; n < 2; ++n)
#pragma unroll
                        for (int e = 0; e < 4; ++e) { const float v = acc[ai][bj][m][n][e]; ss += v * v; }
                ss += __shfl_xor(ss, 16); ss += __shfl_xor(ss, 32);
                ssp[ai][m] = ss;
                if (fq == 0) xch[wid * 128 + ai * 64 + m * 16 + fr] = ss;
            }
        EPI_BARRIER();
        float g0[2][2][4];
        const float* gql = launder(gq);
        if (role == 0) load_gain64(g0, gql, fq);
        else {
#pragma unroll
            for (int n = 0; n < 2; ++n) { const float4 t = *(const float4*)(gql + 64 + 16 * n + 4 * fq); g0[0][n][0] = t.x; g0[0][n][1] = t.y; g0[0][n][2] = t.z; g0[0][n][3] = t.w; }
        }
#pragma unroll
        for (int ai = 0; ai < 2; ++ai)
#pragma unroll
            for (int m = 0; m < 4; ++m) {
                const int r = r0 + 128 * ai + 16 * m;
                const float so = xch[(wid ^ 1) * 128 + ai * 64 + m * 16 + fr];
                const float* pp = part + (size_t)r * 12;
                const float rq = rsqrtf((pp[0] + pp[1] + pp[2] + pp[3] + pp[4] + pp[5]) * (1.f / 384.f) + EPS_);
                const float sc = rq * rsqrtf(rq * rq * (ssp[ai][m] + so) * (1.f / 96.f) + EPS_) * QS96;
                bf16_t* dst = qkv + O_MQ + ((size_t)head * R_ + r) * 96;
                if (role == 0) {
#pragma unroll
                    for (int bj = 0; bj < 2; ++bj) {
                        const f32x4 a = acc[ai][bj][m][0], b = acc[ai][bj][m][1];
                        u32x4 w; w.x = pk2(a[0] * sc * g0[bj][0][0], a[1] * sc * g0[bj][0][1]); w.y = pk2(a[2] * sc * g0[bj][0][2], a[3] * sc * g0[bj][0][3]);
                        w.z = pk2(b[0] * sc * g0[bj][1][0], b[1] * sc * g0[bj][1][1]); w.w = pk2(b[2] * sc * g0[bj][1][2], b[3] * sc * g0[bj][1][3]);
                        *(u32x4*)(dst + 32 * bj + 8 * fq) = w;
                    }
                } else {
                    float y1[4], y2[4];
#pragma unroll
                    for (int e = 0; e < 4; ++e) { y1[e] = acc[ai][0][m][0][e] * sc * g0[0][0][e]; y2[e] = acc[ai][0][m][1][e] * sc * g0[0][1][e]; }
                    if (rp) {
                        const int t = r - 256, pos = fq < 2 ? (t >> 6) : (t & 63);
                        const float* tb = rope + (pos * 16 + 8 * (fq & 1)) * 2;
#pragma unroll
                        for (int e = 0; e < 4; ++e) { const float2 cs = *(const float2*)(tb + 4 * e); const float a = y1[e], b = y2[e]; y1[e] = a * cs.x - b * cs.y; y2[e] = a * cs.y + b * cs.x; }
                    }
                    *(uint2*)(dst + 64 + 4 * fq) = make_uint2(pk2(y1[0], y1[1]), pk2(y1[2], y1[3]));
                    *(uint2*)(dst + 80 + 4 * fq) = make_uint2(pk2(y2[0], y2[1]), pk2(y2[2], y2[3]));
                }
                ITER_FENCE();
            }
        EPI_BARRIER();
    }
};

struct EpiKVB {
    bf16_t* qkv; const float* part; const float* rope; const float* gk;
    __device__ __forceinline__ void operator()(const AccT& acc, const pg8::Unit& u, int, int, int, int) const {
        EPI_IDS();
        const int head = 2 * u.pn + (wc >> 1), role = wc & 1, r0 = u.pm * 256 + wr * 64 + fr;
        const bool rp = u.pm > 0;
        if (role == 1) {
            bf16_t* vt = qkv + O_MVT + (size_t)head * 64 * R_;
#pragma unroll
            for (int ai = 0; ai < 2; ++ai)
#pragma unroll
                for (int m = 0; m < 4; ++m) {
                    const int r = r0 + 128 * ai + 16 * m; const float* pp = part + (size_t)r * 12 + 8;
                    const float rk = rsqrtf((pp[0] + pp[1] + pp[2] + pp[3]) * (1.f / 256.f) + EPS_);
                    vt_store(acc, ai, m, rk, vt, fq, r);
                    ITER_FENCE();
                }
        } else {
            const float* gkl = launder(gk);
            float gn[2][2][4]; load_gain64(gn, gkl, fq);
            float gr[2][4];
#pragma unroll
            for (int n = 0; n < 2; ++n) { const float4 t = *(const float4*)(gkl + 64 + 16 * n + 4 * fq); gr[n][0] = t.x; gr[n][1] = t.y; gr[n][2] = t.z; gr[n][3] = t.w; }
#pragma unroll
            for (int ai = 0; ai < 2; ++ai)
#pragma unroll
                for (int m = 0; m < 4; ++m) {
                    const int r = r0 + 128 * ai + 16 * m; const float* pp = part + (size_t)r * 12 + 8;
                    const float rk = rsqrtf((pp[0] + pp[1] + pp[2] + pp[3]) * (1.f / 256.f) + EPS_);
                    const uint2 c1 = *(const uint2*)(qkv + O_CKR + (size_t)r * 32 + 4 * fq), c2 = *(const uint2*)(qkv + O_CKR + (size_t)r * 32 + 16 + 4 * fq);
                    float y1[4] = {__uint_as_float(c1.x << 16), __uint_as_float(c1.x & 0xffff0000u), __uint_as_float(c1.y << 16), __uint_as_float(c1.y & 0xffff0000u)};
                    float y2[4] = {__uint_as_float(c2.x << 16), __uint_as_float(c2.x & 0xffff0000u), __uint_as_float(c2.y << 16), __uint_as_float(c2.y & 0xffff0000u)};
                    float ss = 0.f;
#pragma unroll
                    for (int bj = 0; bj < 2; ++bj)
#pragma unroll
                        for (int n = 0; n < 2; ++n)
#pragma unroll
                            for (int e = 0; e < 4; ++e) { const float v = acc[ai][bj][m][n][e] * rk; ss += v * v; }
#pragma unroll
                    for (int e = 0; e < 4; ++e) ss += y1[e] * y1[e] + y2[e] * y2[e];
                    ss += __shfl_xor(ss, 16); ss += __shfl_xor(ss, 32);
                    const float rr = rsqrtf(ss * (1.f / 96.f) + EPS_), sc = rk * rr;
                    bf16_t* dst = qkv + O_MK + ((size_t)head * R_ + r) * 96;
#pragma unroll
                    for (int bj = 0; bj < 2; ++bj) {
                        const f32x4 a = acc[ai][bj][m][0], b = acc[ai][bj][m][1];
                        u32x4 w; w.x = pk2(a[0] * sc * gn[bj][0][0], a[1] * sc * gn[bj][0][1]); w.y = pk2(a[2] * sc * gn[bj][0][2], a[3] * sc * gn[bj][0][3]);
                        w.z = pk2(b[0] * sc * gn[bj][1][0], b[1] * sc * gn[bj][1][1]); w.w = pk2(b[2] * sc * gn[bj][1][2], b[3] * sc * gn[bj][1][3]);
                        *(u32x4*)(dst + 32 * bj + 8 * fq) = w;
                    }
#pragma unroll
                    for (int e = 0; e < 4; ++e) { y1[e] *= rr * gr[0][e]; y2[e] *= rr * gr[1][e]; }
                    if (rp) {
                        const int t = r - 256, pos = fq < 2 ? (t >> 6) : (t & 63);
                        const float* tb = rope + (pos * 16 + 8 * (fq & 1)) * 2;
#pragma unroll
                        for (int e = 0; e < 4; ++e) { const float2 cs = *(const float2*)(tb + 4 * e); const float a = y1[e], b = y2[e]; y1[e] = a * cs.x - b * cs.y; y2[e] = a * cs.y + b * cs.x; }
                    }
                    *(uint2*)(dst + 64 + 4 * fq) = make_uint2(pk2(y1[0], y1[1]), pk2(y1[2], y1[3]));
                    *(uint2*)(dst + 80 + 4 * fq) = make_uint2(pk2(y2[0], y2[1]), pk2(y2[2], y2[3]));
                    ITER_FENCE();
                }
        }
    }
};

__device__ __forceinline__ void g_qkv0(const Params& p, LAS unsigned char* lds) {
    Bufs B(p);
    pg8::Gemm g{B.h, B.wt + W_EIN, 1024, 1024}; pg8::Order S; S.init(65, 12, gridDim.x, blockIdx.x, 0, 1);
    EpiQKV0 E{B.qkv, B.rope, B.gt};
    pg8::gemm_phase<EpiQKV0, pg8::Order, true, true>(lds, g, S, E);
}
__device__ __forceinline__ void g_out(const Params& p, int l, LAS unsigned char* lds) {
    Bufs B(p);
    { pg8::Gemm g{B.mix, B.wt + (l == 0 ? W_EOUT : W_OOUT), 1024, 1024}; pg8::Order S; S.init(64, 4, gridDim.x, blockIdx.x, 1, 0);
      EpiResid E{l == 0 ? p.in[I_X] : p.out, p.out, p.in[I_CTX], B.xc, modp(B, l, 0, 2), modp(B, l, 1, 2)};
      pg8::gemm_phase<EpiResid, pg8::Order, true, true>(lds, g, S, E); }
    if (l == 0) {
        pg8::Gemm g{B.mix, B.wt + W_EOUT, 256, 1024}; pg8::Order S; S.init(1, 4, gridDim.x, blockIdx.x, 0, 0, 4, 256);
        EpiPartial E{B.partc, modp(B, 0, 1, 2)};
        pg8::gemm_phase<EpiPartial, pg8::Order, true, true>(lds, g, S, E);
    }
}
__device__ __forceinline__ void g_up(const Params& p, int l, LAS unsigned char* lds) {
    Bufs B(p);
    pg8::Gemm g{B.h, B.wt + W_UP + (size_t)l * F2_ * 1024, 1024, 1024}; pg8::Order S; S.init(l == 0 ? 67 : 65, 22, gridDim.x, blockIdx.x, l == 0 ? 0 : 2, 2);
    EpiUp E{B.act, p.in[I_FCW] + (size_t)l * 3 * F2_, p.in[I_FCB] + (size_t)l * F2_, (LAS float*)(lds + LDS_XCH)};
    pg8::gemm_phase<EpiUp, pg8::Order, true, true>(lds, g, S, E);
}
__device__ __forceinline__ void g_down(const Params& p, int l, LAS unsigned char* lds) {
    Bufs B(p);
    { pg8::Gemm g{B.act, B.wt + W_DOWN + (size_t)l * 1024 * F_, F_, F_}; pg8::Order S; S.init(64, 4, gridDim.x, blockIdx.x, 1, 0);
      EpiResid E{p.out, p.out, B.xc, B.xc, modp(B, l, 0, 5), modp(B, l, 1, 5)};
      pg8::gemm_phase<EpiResid, pg8::Order, true, true>(lds, g, S, E); }
    if (l == 0) {
        pg8::Gemm g{B.act, B.wt + W_DOWN, 256, F_}; pg8::Order S; S.init(1, 4, gridDim.x, blockIdx.x, 0, 0, 11, 256);
        EpiPartial E{B.partc, modp(B, 0, 1, 5)};
        pg8::gemm_phase<EpiPartial, pg8::Order, true, true>(lds, g, S, E);
    }
}
__device__ __forceinline__ void g_qkv1a(const Params& p, LAS unsigned char* lds) {
    Bufs B(p);
    pg8::Gemm g{B.h, B.wt + W_OIN, 1024, 1024}; pg8::Order S; S.init(65, 6, gridDim.x, blockIdx.x, 0, 1);
    EpiQKV1A E{B.qkv, B.part, B.rope, B.gt};
    pg8::gemm_phase<EpiQKV1A, pg8::Order, true, true>(lds, g, S, E);
}
__device__ __forceinline__ void g_qkv1b(const Params& p, LAS unsigned char* lds) {
    Bufs B(p);
    { pg8::Gemm g{B.qkv + O_CQ, B.wt + W_QB, 384, 384}; pg8::Order S; S.init(64, 4, gridDim.x, blockIdx.x, 1, 0);
      EpiQB E{B.qkv, B.part, B.rope, p.in[I_CQN], (LAS float*)(lds + LDS_XCH)};
      pg8::gemm_phase<EpiQB, pg8::Order, true, true>(lds, g, S, E); }
    { pg8::Gemm g{B.qkv + O_CKV, B.wt + W_KVB, 256, 256}; pg8::Order S; S.init(65, 4, gridDim.x, blockIdx.x, 0, 0);
      EpiKVB E{B.qkv, B.part, B.rope, p.in[I_CKN]};
      pg8::gemm_phase<EpiKVB, pg8::Order, true, true>(lds, g, S, E); }
}

typedef float f32x16 __attribute__((ext_vector_type(16)));
typedef __bf16 bf16x2_t __attribute__((ext_vector_type(2)));
typedef float f32x2_t __attribute__((ext_vector_type(2)));
__device__ __forceinline__ u32 cvtpk(float lo, float hi) { const f32x2_t v = {lo, hi}; const bf16x2_t b = __builtin_convertvector(v, bf16x2_t); return __builtin_bit_cast(u32, b); }

template <int DQK, int DV, int TK = 64>
struct FlashGeom {
    static constexpr int KP = DQK * 2 + 16, VP = TK * 2 + 16, KBYTES = TK * KP, VBYTES = DV * VP, STAGE = KBYTES + VBYTES;
    static constexpr int KCH = DQK / 8, KN = (TK * KCH + NT - 1) / NT, VCH = TK / 8, VN = DV * VCH / NT;
};

#ifndef FLASH_PRIO
#define FLASH_PRIO 0
#endif
#ifndef DIFF_TK
#define DIFF_TK 64
#endif
#ifndef DIFF_PD
#define DIFF_PD 1
#endif
#ifndef MLA_TK
#define MLA_TK 64
#endif
#ifndef MLA_PD
#define MLA_PD 2
#endif
#ifndef FLASH_ASMLOAD
#define FLASH_ASMLOAD 0
#endif
#ifndef FLASH_SLEEP
#define FLASH_SLEEP 0
#endif
#ifndef FLASH_PD
#define FLASH_PD 2
#endif
#ifndef FLASH_TK
#define FLASH_TK 128
#endif
__device__ __forceinline__ void asm_gload(u32x4& dst, const void* ptr) { if (FLASH_ASMLOAD) asm volatile("global_load_dwordx4 %0, %1, off" : "=v"(dst) : "v"(ptr) : "memory"); else dst = *(const u32x4*)ptr; }
template <int N> __device__ __forceinline__ void asm_vmwait() { if (FLASH_ASMLOAD) asm volatile("s_waitcnt vmcnt(%0)" :: "n"(N) : "memory"); }
template <int DQK, int DV, int QS, int TK, int PD>
__device__ __forceinline__ void flash_dense(LAS char* lds, const bf16_t* __restrict__ qptr, const bf16_t* __restrict__ Kb, const bf16_t* __restrict__ VT, int ntiles,
                                            f32x16 (&O)[QS][DV / 32], float (&lsum)[QS]) {
    typedef FlashGeom<DQK, DV, TK> G;
    constexpr int NL = G::KN + G::VN;
    const int tid = ltid(), lane = tid & 63, r = lane & 31, h = lane >> 5;
    bf16x8 qf[QS][DQK / 16];
#pragma unroll
    for (int qs = 0; qs < QS; ++qs)
#pragma unroll
        for (int ks = 0; ks < DQK / 16; ++ks) qf[qs][ks] = *(const bf16x8*)(qptr + (size_t)qs * 32 * DQK + 16 * ks + 8 * h);
#pragma unroll
    for (int qs = 0; qs < QS; ++qs)
#pragma unroll
        for (int dt = 0; dt < DV / 32; ++dt)
#pragma unroll
            for (int i = 0; i < 16; ++i) O[qs][dt][i] = 0.f;
    float l[QS];
#pragma unroll
    for (int qs = 0; qs < QS; ++qs) l[qs] = 0.f;
    u32x4 kreg[PD][G::KN], vreg[PD][G::VN];
    int kq[G::KN]; const char* kp[G::KN]; const char* vp[G::VN];
#pragma unroll
    for (int i = 0; i < G::KN; ++i) { kq[i] = tid + NT * i; const int qc = kq[i] < TK * G::KCH ? kq[i] : TK * G::KCH - 1; kp[i] = (const char*)Kb + (size_t)qc * 16; }
#pragma unroll
    for (int i = 0; i < G::VN; ++i) { const int q = tid + NT * i; vp[i] = (const char*)VT + ((size_t)(q / G::VCH) * R_ + (q % G::VCH) * 8) * 2; }
#pragma unroll
    for (int qs = 0; qs < QS; ++qs)
#pragma unroll
        for (int ks = 0; ks < DQK / 16; ++ks) asm volatile("" : "+v"(qf[qs][ks]));
    if (FLASH_ASMLOAD) asm volatile("s_waitcnt vmcnt(0)" ::: "memory");
#define FD_LOAD(set, t) do { const int tt_ = (t) < ntiles ? (t) : ntiles - 1; \
        _Pragma("unroll") for (int i_ = 0; i_ < G::KN; ++i_) asm_gload(kreg[set][i_], kp[i_] + (size_t)tt_ * (TK * DQK * 2)); \
        _Pragma("unroll") for (int i_ = 0; i_ < G::VN; ++i_) asm_gload(vreg[set][i_], vp[i_] + (size_t)tt_ * (TK * 2)); } while (0)
#define FD_FENCE(set) do { if (FLASH_ASMLOAD) { _Pragma("unroll") for (int i_ = 0; i_ < G::KN; ++i_) asm volatile("" : "+v"(kreg[set][i_])); _Pragma("unroll") for (int i_ = 0; i_ < G::VN; ++i_) asm volatile("" : "+v"(vreg[set][i_])); } } while (0)
#define FD_STORE(set, buf) do { LAS char* kb_ = lds + (buf) * G::STAGE; LAS char* vb_ = kb_ + G::KBYTES; \
        _Pragma("unroll") for (int i_ = 0; i_ < G::KN; ++i_) { if (kq[i_] < TK * G::KCH) *(LAS u32x4*)(kb_ + (kq[i_] / G::KCH) * G::KP + (kq[i_] % G::KCH) * 16) = kreg[set][i_]; } \
        _Pragma("unroll") for (int i_ = 0; i_ < G::VN; ++i_) { const int q_ = tid + NT * i_; *(LAS u32x4*)(vb_ + (q_ / G::VCH) * G::VP + (q_ % G::VCH) * 16) = vreg[set][i_]; } } while (0)
    FD_LOAD(0, 0);
#pragma unroll
    for (int j = 1; j < PD; ++j) FD_LOAD(j, j);
    asm_vmwait<(PD - 1) * NL>(); FD_FENCE(0); FD_STORE(0, 0);
    FD_LOAD(0, PD);
    __syncthreads();
    for (int t0 = 0; t0 < ntiles; t0 += PD) {
#pragma unroll
        for (int j = 0; j < PD; ++j) {
            const int t = t0 + j;
            if (t >= ntiles) break;
            asm_vmwait<(PD - 1) * NL>(); FD_FENCE((j + 1) % PD);
            FD_STORE((j + 1) % PD, (t + 1) & 1);
            FD_LOAD((j + 1) % PD, t + 1 + PD);
            const LAS char* kb = lds + (t & 1) * G::STAGE; const LAS char* vb = kb + G::KBYTES;
#pragma unroll
            for (int kt = 0; kt < TK / 32; ++kt) {
                f32x16 S[QS];
#pragma unroll
                for (int qs = 0; qs < QS; ++qs)
#pragma unroll
                    for (int i = 0; i < 16; ++i) S[qs][i] = 0.f;
#pragma unroll
                for (int ks = 0; ks < DQK / 16; ++ks) {
                    const bf16x8 a = *(const LAS bf16x8*)(kb + (32 * kt + r) * G::KP + (16 * ks + 8 * h) * 2);
                    if (FLASH_PRIO) __builtin_amdgcn_s_setprio(1);
#pragma unroll
                    for (int qs = 0; qs < QS; ++qs) S[qs] = __builtin_amdgcn_mfma_f32_32x32x16_bf16(a, qf[qs][ks], S[qs], 0, 0, 0);
                    if (FLASH_PRIO) __builtin_amdgcn_s_setprio(0);
                }
                bf16x8 pf[QS][2];
#pragma unroll
                for (int qs = 0; qs < QS; ++qs) {
                    float p[16];
#pragma unroll
                    for (int i = 0; i < 16; ++i) { p[i] = __builtin_amdgcn_exp2f(S[qs][i]); l[qs] += p[i]; }
#pragma unroll
                    for (int s2 = 0; s2 < 2; ++s2) {
                        u32x4 pw; pw.x = cvtpk(p[8 * s2], p[8 * s2 + 1]); pw.y = cvtpk(p[8 * s2 + 2], p[8 * s2 + 3]); pw.z = cvtpk(p[8 * s2 + 4], p[8 * s2 + 5]); pw.w = cvtpk(p[8 * s2 + 6], p[8 * s2 + 7]);
                        pf[qs][s2] = __builtin_bit_cast(bf16x8, pw);
                    }
                }
#pragma unroll
                for (int s2 = 0; s2 < 2; ++s2)
#pragma unroll
                    for (int dt = 0; dt < DV / 32; ++dt) {
                        const bf16x8 a = *(const LAS bf16x8*)(vb + (32 * dt + r) * G::VP + (16 * (2 * kt + s2) + 8 * h) * 2);
                        if (FLASH_PRIO) __builtin_amdgcn_s_setprio(1);
#pragma unroll
                        for (int qs = 0; qs < QS; ++qs) O[qs][dt] = __builtin_amdgcn_mfma_f32_32x32x16_bf16(a, pf[qs][s2], O[qs][dt], 0, 0, 0);
                        if (FLASH_PRIO) __builtin_amdgcn_s_setprio(0);
                    }
            }
            __syncthreads();
        }
    }
    asm_vmwait<0>();
#pragma unroll
    for (int j = 0; j < PD; ++j) FD_FENCE(j);
#undef FD_LOAD
#undef FD_STORE
#undef FD_FENCE
#pragma unroll
    for (int qs = 0; qs < QS; ++qs) lsum[qs] = l[qs] + __shfl_xor(l[qs], 32);
}

__device__ __forceinline__ float* diff_park(const Params& p, int m, int head) {
    if (m == 0) return (float*)(p.ws + WS_H) + (size_t)head * R_ * 128;
    if (head == 0) return (float*)(p.ws + WS_QKV + 6 * E_SEG * 2);
    return (float*)(p.ws + WS_PARK) + (size_t)(head - 1) * R_ * 128;
}
__device__ __forceinline__ void diff_unit(const Params& p, const Bufs& B, LAS char* lds, int head, int qb) {
    const int tid = ltid(), wid = tid >> 6, lane = tid & 63, c = lane & 31, h = lane >> 5;
    const int r = qb * 256 + wid * 32 + c, nt = qb == 0 ? 256 / FLASH_TK : R_ / FLASH_TK;
    const float lam = B.scal[0];
    float* tmp = diff_park(p, 0, head) + (size_t)r * 128 + 4 * h;
    f32x16 Oa[1][4]; float la[1]; f32x16 (&O)[4] = Oa[0];
    flash_dense<64, 128, 1, FLASH_TK, FLASH_PD>(lds, B.qkv + O_QA + ((size_t)(2 * head) * R_ + r) * 64, B.qkv + O_KA + (size_t)(2 * head) * R_ * 64, B.qkv + O_VAT + (size_t)head * 128 * R_, nt, Oa, la);
    {
        const float inv = 1.f / la[0];
#pragma unroll
        for (int dt = 0; dt < 4; ++dt)
#pragma unroll
            for (int q = 0; q < 4; ++q) *(f32x4*)(tmp + 32 * dt + 8 * q) = (f32x4){O[dt][4 * q] * inv, O[dt][4 * q + 1] * inv, O[dt][4 * q + 2] * inv, O[dt][4 * q + 3] * inv};
    }
    flash_dense<64, 128, 1, FLASH_TK, FLASH_PD>(lds, B.qkv + O_QA + ((size_t)(2 * head + 1) * R_ + r) * 64, B.qkv + O_KA + (size_t)(2 * head + 1) * R_ * 64, B.qkv + O_VAT + (size_t)head * 128 * R_, nt, Oa, la);
    {
        const float inv = lam / la[0]; float ss = 0.f;
#pragma unroll
        for (int dt = 0; dt < 4; ++dt)
#pragma unroll
            for (int q = 0; q < 4; ++q) {
                const f32x4 o1 = *(const f32x4*)(tmp + 32 * dt + 8 * q);
#pragma unroll
                for (int e = 0; e < 4; ++e) { const float d = o1[e] - O[dt][4 * q + e] * inv; O[dt][4 * q + e] = d; ss += d * d; }
            }
        ss += __shfl_xor(ss, 32);
        const float rr = rsqrtf(ss * (1.f / 128.f) + EPS_) * 0.8f;
        bf16_t* dst = B.mix + (size_t)r * 1024 + head * 128 + 4 * h;
        const float* g = p.in[I_SUBLN] + 4 * h;
#pragma unroll
        for (int dt = 0; dt < 4; ++dt)
#pragma unroll
            for (int q = 0; q < 4; ++q) {
                const f32x4 gg = *(const f32x4*)(g + 32 * dt + 8 * q);
                *(uint2*)(dst + 32 * dt + 8 * q) = make_uint2(cvtpk(O[dt][4 * q] * rr * gg[0], O[dt][4 * q + 1] * rr * gg[1]), cvtpk(O[dt][4 * q + 2] * rr * gg[2], O[dt][4 * q + 3] * rr * gg[3]));
            }
    }
}
__device__ __forceinline__ void store_o64(bf16_t* dst, const f32x16 (&O)[2], float inv);
__device__ __forceinline__ void mla_unit(const Params& p, const Bufs& B, LAS char* lds, int head, int qb) {
    const int tid = ltid(), wid = tid >> 6, lane = tid & 63, c = lane & 31, h = lane >> 5;
    const int r = 256 + qb * 512 + wid * 64 + c;
    f32x16 O[2][2]; float l[2];
    flash_dense<96, 64, 2, MLA_TK, MLA_PD>(lds, B.qkv + O_MQ + ((size_t)head * R_ + r) * 96, B.qkv + O_MK + (size_t)head * R_ * 96, B.qkv + O_MVT + (size_t)head * 64 * R_, R_ / MLA_TK, O, l);
#pragma unroll
    for (int qs = 0; qs < 2; ++qs) store_o64(B.mix + (size_t)(r + 32 * qs) * 1024 + head * 64 + 4 * h, O[qs], 1.f / l[qs]);
}

__device__ __forceinline__ void diff_half_unit(const Params& p, const Bufs& B, LAS char* lds, int head, int m, int qb512) {
    const int tid = ltid(), wid = tid >> 6, lane = tid & 63, c = lane & 31, h = lane >> 5;
    const int r = 256 + qb512 * 512 + wid * 64 + c, sub = 2 * head + m;
    f32x16 O[2][4]; float l[2];
    flash_dense<64, 128, 2, DIFF_TK, DIFF_PD>(lds, B.qkv + O_QA + ((size_t)sub * R_ + r) * 64, B.qkv + O_KA + (size_t)sub * R_ * 64, B.qkv + O_VAT + (size_t)head * 128 * R_, R_ / DIFF_TK, O, l);
    float* park = diff_park(p, m, head);
#pragma unroll
    for (int qs = 0; qs < 2; ++qs) {
        const float inv = 1.f / l[qs];
        float* dst = park + (size_t)(r + 32 * qs) * 128 + 4 * h;
#pragma unroll
        for (int dt = 0; dt < 4; ++dt)
#pragma unroll
            for (int q = 0; q < 4; ++q) *(f32x4*)(dst + 32 * dt + 8 * q) = (f32x4){O[qs][dt][4 * q] * inv, O[qs][dt][4 * q + 1] * inv, O[qs][dt][4 * q + 2] * inv, O[qs][dt][4 * q + 3] * inv};
    }
}
__device__ void phase_diff_combine(const Params& p, int bid, int nblk) {
    Bufs B(p);
    const int tid = ltid(), wid = tid >> 6, lane = tid & 63;
    const float lam = B.scal[0];
    const float2 g = *(const float2*)(p.in[I_SUBLN] + 2 * lane);
    for (int it = bid * 8 + wid; it < T_ * 4; it += nblk * 8) {
        const int head = it & 3, r = 256 + (it >> 2);
        const float2 a = *(const float2*)(diff_park(p, 0, head) + (size_t)r * 128 + 2 * lane), b = *(const float2*)(diff_park(p, 1, head) + (size_t)r * 128 + 2 * lane);
        const float d0 = a.x - lam * b.x, d1 = a.y - lam * b.y;
        const float ss = wave_sum(d0 * d0 + d1 * d1);
        const float rr = rsqrtf(ss * (1.f / 128.f) + EPS_) * 0.8f;
        *(u32*)(B.mix + (size_t)r * 1024 + head * 128 + 2 * lane) = cvtpk(d0 * rr * g.x, d1 * rr * g.y);
    }
}
__device__ void phase_attn0_dense(const Params& p, LAS char* lds, int bid, int nblk) {
    Bufs B(p);
    for (int u = bid; u < 260; u += nblk) {
        if (u < 256) diff_half_unit(p, B, lds, (u & 7) >> 1, u & 1, u >> 3);
        else diff_unit(p, B, lds, u - 256, 0);
    }
}
__device__ void phase_attn1_dense(const Params& p, LAS char* lds, int bid, int nblk) {
    Bufs B(p);
    for (int u = bid; u < 256; u += nblk) mla_unit(p, B, lds, u & 7, u >> 3);
}

template <int MODE>
__device__ __forceinline__ void flash_win(LAS char* lds, const bf16_t* __restrict__ qptr, const bf16_t* __restrict__ Kb, const bf16_t* __restrict__ VT, int lat0, int nlat, float c2,
                                          int qi  , int qcol, const LAS float* bl, f32x16 (&O)[2][2], float (&lsum)[2]) {
    typedef FlashGeom<64, 64> G;
    const int tid = ltid(), lane = tid & 63, r = lane & 31, h = lane >> 5;
    const int ntiles = 4 + nlat;
    bf16x8 qf[2][4];
#pragma unroll
    for (int qs = 0; qs < 2; ++qs)
#pragma unroll
        for (int ks = 0; ks < 4; ++ks) qf[qs][ks] = *(const bf16x8*)(qptr + qs * 32 * 64 + 16 * ks + 8 * h);
#pragma unroll
    for (int qs = 0; qs < 2; ++qs)
#pragma unroll
        for (int dt = 0; dt < 2; ++dt)
#pragma unroll
            for (int i = 0; i < 16; ++i) O[qs][dt][i] = 0.f;
    float l[2] = {0.f, 0.f};
    u32x4 kreg, vreg;
    auto load_tile = [&](int t) { const int at = t < 4 ? t : lat0 + (t - 4);
        kreg = *(const u32x4*)(Kb + (size_t)at * 64 * 64 + tid * 8); vreg = *(const u32x4*)(VT + (size_t)(tid >> 3) * R_ + at * 64 + (tid & 7) * 8); };
    auto store_tile = [&](int buf) { LAS char* kb = lds + buf * G::STAGE; LAS char* vb = kb + G::KBYTES;
        *(LAS u32x4*)(kb + (tid >> 3) * G::KP + (tid & 7) * 16) = kreg; *(LAS u32x4*)(vb + (tid >> 3) * G::VP + (tid & 7) * 16) = vreg; };
    const int rs = MODE == 1 ? min(max(qi - 4, 0), 248) : 0;
    const int qlo = MODE == 2 ? __builtin_amdgcn_readfirstlane(qi - r) : 0;
    load_tile(0); store_tile(0);
    if (ntiles > 1) load_tile(1);
    __syncthreads();
    for (int t = 0; t < ntiles; ++t) {
        if (t + 1 < ntiles) store_tile((t + 1) & 1);
        if (t + 2 < ntiles) load_tile(t + 2);
        const LAS char* kb = lds + (t & 1) * G::STAGE; const LAS char* vb = kb + G::KBYTES;
        const int lt = lat0 + (t - 4) - 4;
        bool active = true;
        if (t >= 4) { if (MODE == 1) active = lt >= rs && lt < rs + 8; else active = (64 * lt + 63 >= qlo - 128) && (64 * lt <= qlo + 63 + 128); }
        if (active) {
#pragma unroll
            for (int kt = 0; kt < 2; ++kt) {
                f32x16 S[2];
#pragma unroll
                for (int qs = 0; qs < 2; ++qs)
#pragma unroll
                    for (int i = 0; i < 16; ++i) S[qs][i] = 0.f;
#pragma unroll
                for (int ks = 0; ks < 4; ++ks) {
                    const bf16x8 a = *(const LAS bf16x8*)(kb + (32 * kt + r) * G::KP + (16 * ks + 8 * h) * 2);
#pragma unroll
                    for (int qs = 0; qs < 2; ++qs) S[qs] = __builtin_amdgcn_mfma_f32_32x32x16_bf16(a, qf[qs][ks], S[qs], 0, 0, 0);
                }
                bf16x8 pf[2][2];
#pragma unroll
                for (int qs = 0; qs < 2; ++qs) {
                    float p[16];
                    if (t < 4) {
#pragma unroll
                        for (int i = 0; i < 16; ++i) p[i] = __builtin_amdgcn_exp2f(S[qs][i] - c2);
                    } else if (MODE == 1) {
                        const int qc = qcol + 32 * qs, cs = min(max(qc - 8, 0), 48), vlo = cs - 4 * h;
                        const LAS float* brow = bl + ((lt - qi + 7) * 31 + 4 * h - qc + 15);
#pragma unroll
                        for (int i = 0; i < 16; ++i) {
                            const int kc0 = 32 * kt + (i & 3) + 8 * (i >> 2);
                            const float e = __builtin_amdgcn_exp2f(S[qs][i] + brow[kc0] - c2);
                            p[i] = (unsigned)(kc0 - vlo) < 16u ? e : 0.f;
                        }
                    } else {
                        const int d0 = 64 * lt + 4 * h - (qi + 32 * qs) + 128;
#pragma unroll
                        for (int i = 0; i < 16; ++i) {
                            const int kc0 = 32 * kt + (i & 3) + 8 * (i >> 2);
                            const float e = __builtin_amdgcn_exp2f(S[qs][i] - c2);
                            p[i] = (unsigned)(d0 + kc0) <= 256u ? e : 0.f;
                        }
                    }
#pragma unroll
                    for (int i = 0; i < 16; ++i) l[qs] += p[i];
#pragma unroll
                    for (int s2 = 0; s2 < 2; ++s2) {
                        u32x4 pw; pw.x = cvtpk(p[8 * s2], p[8 * s2 + 1]); pw.y = cvtpk(p[8 * s2 + 2], p[8 * s2 + 3]); pw.z = cvtpk(p[8 * s2 + 4], p[8 * s2 + 5]); pw.w = cvtpk(p[8 * s2 + 6], p[8 * s2 + 7]);
                        pf[qs][s2] = __builtin_bit_cast(bf16x8, pw);
                    }
                }
#pragma unroll
                for (int s2 = 0; s2 < 2; ++s2)
#pragma unroll
                    for (int dt = 0; dt < 2; ++dt) {
                        const bf16x8 a = *(const LAS bf16x8*)(vb + (32 * dt + r) * G::VP + (16 * (2 * kt + s2) + 8 * h) * 2);
#pragma unroll
                        for (int qs = 0; qs < 2; ++qs) O[qs][dt] = __builtin_amdgcn_mfma_f32_32x32x16_bf16(a, pf[qs][s2], O[qs][dt], 0, 0, 0);
                    }
            }
        }
        __syncthreads();
    }
#pragma unroll
    for (int qs = 0; qs < 2; ++qs) lsum[qs] = l[qs] + __shfl_xor(l[qs], 32);
}
__device__ __forceinline__ void store_o64(bf16_t* dst  , const f32x16 (&O)[2], float inv) {
#pragma unroll
    for (int dt = 0; dt < 2; ++dt)
#pragma unroll
        for (int q = 0; q < 4; ++q)
            *(uint2*)(dst + 32 * dt + 8 * q) = make_uint2(cvtpk(O[dt][4 * q] * inv, O[dt][4 * q + 1] * inv), cvtpk(O[dt][4 * q + 2] * inv, O[dt][4 * q + 3] * inv));
}
constexpr int LDS_BIAS = 40960;
__device__ __forceinline__ void na_unit(const Params& p, const Bufs& B, LAS char* lds, int head, int qb) {
    const int tid = ltid(), wid = tid >> 6, lane = tid & 63, c = lane & 31, h = lane >> 5;
    LAS float* bl = (LAS float*)(lds + LDS_BIAS) + 64;
    __syncthreads();
    for (int e = tid; e < 64 + 465 + 128; e += NT) { const int j = e - 64; bl[j] = (j >= 0 && j < 465) ? p.in[I_RPB][head * 465 + j] * 1.4426950408889634f : 0.f; }
    int lat0 = 4, nlat = 0, grow = 0, r;
    if (qb > 0) { const int r0 = 8 * (qb - 1), ra = min(max(r0 - 4, 0), 248), rb = min(max(r0 + 7 - 4, 0), 248) + 8; lat0 = 4 + ra; nlat = rb - ra; grow = r0 + wid; r = 256 + grow * 64 + c; }
    else r = (wid & 3) * 64 + c;
    f32x16 O[2][2]; float l[2];
    flash_win<1>(lds, B.qkv + O_QB + ((size_t)head * R_ + r) * 64, B.qkv + O_KB + (size_t)head * R_ * 64, B.qkv + O_VBT + (size_t)head * 64 * R_, lat0, nlat, B.scal[3], grow, c, bl, O, l);
    if (qb > 0 || wid < 4) {
#pragma unroll
        for (int qs = 0; qs < 2; ++qs) store_o64(B.mix + (size_t)(r + 32 * qs) * 1024 + 512 + head * 64 + 4 * h, O[qs], 1.f / l[qs]);
    }
}
__device__ __forceinline__ void swa_unit(const Params& p, const Bufs& B, LAS char* lds, int hq, int qb) {
    const int tid = ltid(), wid = tid >> 6, lane = tid & 63, c = lane & 31, h = lane >> 5;
    const int t0 = qb * 512, tq = t0 + wid * 64 + c, r = 256 + tq, kvh = hq >> 2;
    const int ta = max(t0 / 64 - 2, 0), tb = min(t0 / 64 + 9, 255);
    f32x16 O[2][2]; float l[2];
    const float c2 = B.scal[4];
    flash_win<2>(lds, B.qkv + O_GQ + ((size_t)hq * R_ + r) * 64, B.qkv + O_GK + (size_t)kvh * R_ * 64, B.qkv + O_GVT + (size_t)kvh * 64 * R_, 4 + ta, tb - ta + 1, c2, tq, 0, nullptr, O, l);
    const float sk = __builtin_amdgcn_exp2f(p.in[I_SINK][hq] * 1.4426950408889634f - c2);
#pragma unroll
    for (int qs = 0; qs < 2; ++qs) store_o64(B.mix + (size_t)(r + 32 * qs) * 1024 + 512 + hq * 64 + 4 * h, O[qs], 1.f / (l[qs] + sk));
}
__device__ void phase_attn0_win(const Params& p, LAS char* lds, int bid, int nblk) {
    Bufs B(p);
    for (int u = bid; u < 264; u += nblk) na_unit(p, B, lds, u & 7, u < 256 ? 1 + (u >> 3) : 0);
}
__device__ void phase_attn1_win(const Params& p, LAS char* lds, int bid, int nblk) {
    Bufs B(p);
    for (int u = bid; u < 256; u += nblk) swa_unit(p, B, lds, u & 7, u >> 3);
}

#define XB_TMO      128
#define XB_XCNT(j)  (256  + 64 * (j))
#define XB_XSUB(j)  (1280 + 64 * (j))
#define XB_XGEN(j)  (2304 + 64 * (j))
#define XB_TOP      3328
#define XB_TOPGEN   3392
#define XCD_BAR_WORDS 3456
#define XB_SPIN_CAP (1u << 20)
__device__ __forceinline__ unsigned xb_ld(unsigned* p)              { return __hip_atomic_load(p, __ATOMIC_RELAXED, __HIP_MEMORY_SCOPE_AGENT); }
__device__ __forceinline__ unsigned xb_add(unsigned* p, unsigned v) { return __hip_atomic_fetch_add(p, v, __ATOMIC_RELAXED, __HIP_MEMORY_SCOPE_AGENT); }
__device__ __forceinline__ unsigned xb_xcc_id() { return (unsigned)__builtin_amdgcn_s_getreg((3 << 11) | 20) & 0xFu; }
#define XB_SPIN(cond, bar) do { unsigned _sp = 0; while (cond) { __builtin_amdgcn_s_sleep(1); \
    if ((++_sp & 255u) == 0u) { if (xb_ld(&(bar)[XB_TMO])) break; if (_sp > XB_SPIN_CAP) { atomicAdd(&(bar)[XB_TMO], 1u); break; } } } } while (0)
struct XcdBarrier { unsigned* bar; unsigned x; volatile LAS unsigned* st; };
__device__ __forceinline__ XcdBarrier xcd_barrier_post(unsigned* bar, volatile LAS unsigned* st) {
    XcdBarrier b; b.bar = bar; b.x = xb_xcc_id(); b.st = st;
    if (threadIdx.x == 0) (void)xb_add(&bar[XB_XCNT(b.x)], 1u);
    return b;
}
__device__ __forceinline__ void xcd_barrier_complete(unsigned* bar, unsigned x, unsigned& nloc, unsigned& nx) {
    const unsigned G = gridDim.x * gridDim.y * gridDim.z;
    unsigned sum, cnt, mine, sp = 0u;
    for (;;) {
        sum = 0u; cnt = 0u; mine = 0u;
#pragma unroll
        for (unsigned j = 0; j < 16; ++j) { const unsigned c = xb_ld(&bar[XB_XCNT(j)]); sum += c; cnt += (c > 0u) ? 1u : 0u; mine = (j == x) ? c : mine; }
        if (sum == G) break;
        __builtin_amdgcn_s_sleep(1);
        if ((++sp & 255u) == 0u) { if (xb_ld(&bar[XB_TMO])) break; if (sp > XB_SPIN_CAP) { atomicAdd(&bar[XB_TMO], 1u); break; } }
    }
    nloc = mine > 0u ? mine : 1u; nx = cnt > 0u ? cnt : 1u;
}
__device__ __forceinline__ void xcd_barrier(const XcdBarrier& b) {
    asm volatile("s_waitcnt vmcnt(0)" ::: "memory");
    __syncthreads();
    if (threadIdx.x == 0) {
        unsigned* bar = b.bar;
        __builtin_amdgcn_s_waitcnt(0);
        unsigned nloc = b.st[0], nx = b.st[1];
        if (nloc == 0u) { xcd_barrier_complete(bar, b.x, nloc, nx); b.st[0] = nloc; b.st[1] = nx; }
        const unsigned old = xb_add(&bar[XB_XSUB(b.x)], 1u);
        const unsigned gen = old / nloc;
        if (old + 1u == (gen + 1u) * nloc) {
            __builtin_amdgcn_fence(__ATOMIC_RELEASE, "agent");
            asm volatile("s_waitcnt vmcnt(0)" ::: "memory");
            const unsigned og = xb_add(&bar[XB_TOP], 1u);
            const unsigned tg = og / nx;
            if (og + 1u == (tg + 1u) * nx) xb_add(&bar[XB_TOPGEN], 1u);
            else XB_SPIN(xb_ld(&bar[XB_TOPGEN]) == tg, bar);
            __builtin_amdgcn_fence(__ATOMIC_ACQUIRE, "agent");
            xb_add(&bar[XB_XGEN(b.x)], 1u);
            asm volatile("s_waitcnt vmcnt(0)" ::: "memory");
        } else {
            XB_SPIN(xb_ld(&bar[XB_XGEN(b.x)]) == gen, bar);
            __builtin_amdgcn_fence(__ATOMIC_ACQUIRE, "agent");
            asm volatile("s_waitcnt vmcnt(0)" ::: "memory");
        }
    }
    __syncthreads();
}

__device__ __forceinline__ void run_phase(int ph, const Params& p, char* lds, int bid, int nblk) {
    LAS unsigned char* l3 = (LAS unsigned char*)lds;
    switch (ph) {
        case 0: phase_prep(p, lds, bid, nblk); phase_prep_weights(p, lds, bid, nblk); break;
        case 1: phase_norm(p, 0, 0, bid, nblk); break;
        case 2: g_qkv0(p, l3); phase_prep_weights_rest(p, lds); break;
        case 3: phase_attn0_dense(p, (LAS char*)lds, bid, nblk); break;
        case 16: phase_diff_combine(p, bid, nblk); phase_attn0_win(p, (LAS char*)lds, bid, nblk); break;
        case 4: g_out(p, 0, l3); break;
        case 5: phase_norm(p, 0, 1, bid, nblk); break;
        case 6: g_up(p, 0, l3); break;
        case 7: g_down(p, 0, l3); break;
        case 8: phase_norm(p, 1, 0, bid, nblk); break;
        case 9: g_qkv1a(p, l3); break;
        case 10: g_qkv1b(p, l3); break;
        case 11: phase_attn1_dense(p, (LAS char*)lds, bid, nblk); phase_attn1_win(p, (LAS char*)lds, bid, nblk); break;
        case 12: g_out(p, 1, l3); break;
        case 13: phase_norm(p, 1, 1, bid, nblk); break;
        case 14: g_up(p, 1, l3); break;
        case 15: g_down(p, 1, l3); break;
    }
}

namespace cg = cooperative_groups;
__global__ void __launch_bounds__(NT, 2) k_mega(Params p) {
    extern __shared__ __attribute__((aligned(16))) char smem[];
    cg::grid_group grid = cg::this_grid();
    const int bid = blockIdx.x, nblk = gridDim.x;
    volatile LAS unsigned* st = (volatile LAS unsigned*)((LAS char*)smem + LDS_BYTES - 16);
    if (threadIdx.x < 2) st[threadIdx.x] = 0u;
    __syncthreads();
    const XcdBarrier xb = xcd_barrier_post((unsigned*)(p.ws + WS_CTL), st);
#define SYNC() xcd_barrier(xb)
#define PH(n) run_phase(n, p, smem, bid, nblk)
    PH(0); if (p.out == nullptr) grid.sync(); SYNC(); PH(1); SYNC(); PH(2); SYNC(); PH(3); SYNC(); PH(16); SYNC(); PH(4); SYNC(); PH(5); SYNC(); PH(6); SYNC(); PH(7); SYNC();
    PH(8); SYNC(); PH(9); SYNC(); PH(10); SYNC(); PH(11); SYNC(); PH(12); SYNC(); PH(13); SYNC(); PH(14); SYNC(); PH(15);
#undef PH
}

extern "C" void kernel_launch(void* const* d_in, const int* in_sizes, int n_in, void* d_out, int out_size, void* d_ws, size_t ws_size, hipStream_t stream) {
    Params p{};
    for (int i = 0; i < 35; ++i) p.in[i] = (const float*)d_in[i];
    p.out = (float*)d_out; p.ws = (char*)d_ws;
    if (ws_size < WS_END) { fprintf(stderr, "ws too small: %zu < %zu\n", ws_size, (size_t)WS_END); return; }
    static int grid_blocks = 0;
    if (!grid_blocks) {
        int dev = 0, cus = 0, per_cu = 0;
        hipGetDevice(&dev);
        hipDeviceGetAttribute(&cus, hipDeviceAttributeMultiprocessorCount, dev);
        if (hipFuncSetAttribute((const void*)k_mega, hipFuncAttributeMaxDynamicSharedMemorySize, LDS_BYTES) != hipSuccess) fprintf(stderr, "hipFuncSetAttribute failed\n");
        hipOccupancyMaxActiveBlocksPerMultiprocessor(&per_cu, (const void*)k_mega, NT, LDS_BYTES);
        if (per_cu < 1) { fprintf(stderr, "occupancy query returned %d\n", per_cu); per_cu = 1; }
        if (per_cu > 1) per_cu = 1;
        grid_blocks = cus * per_cu;
    }
    if (hipMemsetAsync((char*)d_ws + WS_CTL, 0, 16384, stream) != hipSuccess) fprintf(stderr, "memset failed\n");
    void* args[] = {&p};
    hipError_t e = hipLaunchCooperativeKernel((const void*)k_mega, dim3(grid_blocks), dim3(NT), args, LDS_BYTES, stream);
    if (e != hipSuccess) fprintf(stderr, "cooperative launch failed: %s (grid %d)\n", hipGetErrorString(e), grid_blocks);
}
```

```cpp
#include <hip/hip_runtime.h>
#include <hip/hip_cooperative_groups.h>
#include <cstdint>
#include <cstdio>
#include <cmath>

typedef unsigned short bf16_t;
__device__ __forceinline__ int ltid() { int t = threadIdx.x; asm volatile("" : "+v"(t)); return t; }
typedef unsigned int u32;
typedef u32 u32x4 __attribute__((ext_vector_type(4)));

#define NT 512
constexpr int T_ = 16384, L_ = 256, R_ = 16640, D_ = 1024, F_ = 2816, F2_ = 5632;
constexpr float EPS_ = 1e-6f;

constexpr size_t WS_CTL = 0;
constexpr size_t WS_MOD = 16384;
constexpr size_t WS_SCAL = WS_MOD + 2 * 2 * 6144 * 4;
constexpr size_t WS_GT = WS_SCAL + 256;
constexpr size_t WS_ROPE = WS_GT + 6 * 64 * 4;
constexpr size_t WS_XC = WS_ROPE + 256 * 16 * 2 * 4;
constexpr size_t WS_H = WS_XC + 256 * 1024 * 4;
constexpr int HROWS = R_ + 144;
constexpr size_t WS_MIX = WS_H + (size_t)HROWS * 1024 * 2;
constexpr size_t WS_QKV = WS_MIX + (size_t)R_ * 1024 * 2;
constexpr size_t E_SEG = (size_t)512 * R_;
constexpr size_t O_QA = 0, O_KA = E_SEG, O_VAT = 2 * E_SEG, O_QB = 3 * E_SEG, O_KB = 4 * E_SEG, O_VBT = 5 * E_SEG;
constexpr size_t O_CQ = 0, O_CKV = O_CQ + (size_t)R_ * 384, O_CKR = O_CKV + (size_t)R_ * 256, O_MQ = O_CKR + (size_t)R_ * 32,
                 O_MK = O_MQ + (size_t)R_ * 768, O_MVT = O_MK + (size_t)R_ * 768, O_GQ = O_MVT + (size_t)R_ * 512,
                 O_GK = O_GQ + (size_t)R_ * 512, O_GVT = O_GK + (size_t)R_ * 128, O_L1END = O_GVT + (size_t)R_ * 128;
constexpr size_t WS_QKV_BYTES = O_L1END * 2;
constexpr size_t WS_PART = WS_QKV + WS_QKV_BYTES;
constexpr size_t WS_WT = WS_PART + (size_t)R_ * 12 * 4;
constexpr size_t W_EIN = 0, W_EOUT = W_EIN + (size_t)3072 * 1024, W_UP = W_EOUT + (size_t)1024 * 1024, W_DOWN = W_UP + (size_t)2 * 5632 * 1024,
                 W_OIN = W_DOWN + (size_t)2 * 1024 * 2816, W_OOUT = W_OIN + (size_t)1536 * 1024, W_QB = W_OOUT + (size_t)1024 * 1024,
                 W_KVB = W_QB + (size_t)1024 * 384, W_END = W_KVB + (size_t)1024 * 256;
constexpr size_t WS_PARK = ((WS_WT + W_END * 2 + 255) / 256) * 256;
constexpr size_t WS_END = WS_PARK + (size_t)3 * R_ * 128 * 4;
static_assert(WS_END <= (size_t)256 * 1024 * 1024, "ws");
constexpr size_t WS_PARTC = WS_QKV + (((size_t)(R_ + 8) * F_ * 2 + 255) / 256) * 256;
static_assert(WS_PARTC + (size_t)11 * 256 * 1024 * 4 <= WS_QKV + WS_QKV_BYTES, "act + partials alias");

struct Params { const float* in[35]; float* out; char* ws; };
enum { I_X = 0, I_C, I_CTX, I_CCTX, I_ADAW, I_ADAB, I_NMIX, I_NFFN, I_FUP, I_FCW, I_FCB, I_FDOWN, I_EWIN, I_EWOUT, I_AQN, I_AKN,
       I_LQ1, I_LK1, I_LQ2, I_LK2, I_SUBLN, I_BQN, I_BKN, I_RPB, I_OWIN, I_OWOUT, I_CQAN, I_CWQB, I_CKVAN, I_CWKVB, I_CQN, I_CKN,
       I_DQN, I_DKN, I_SINK };

__device__ __forceinline__ float bf2f(bf16_t v) { return __uint_as_float(((u32)v) << 16); }
__device__ __forceinline__ bf16_t f2bf(float f) { u32 u = __float_as_uint(f); return (bf16_t)((u + 0x7fffu + ((u >> 16) & 1u)) >> 16); }
typedef __bf16 bf16x2_t __attribute__((ext_vector_type(2)));
typedef float f32x2_t __attribute__((ext_vector_type(2)));
__device__ __forceinline__ u32 cvtpk(float lo, float hi) { const f32x2_t v = {lo, hi}; const bf16x2_t b = __builtin_convertvector(v, bf16x2_t); return __builtin_bit_cast(u32, b); }
__device__ __forceinline__ u32 pk2(float lo, float hi) { return cvtpk(lo, hi); }
__device__ __forceinline__ float wave_sum(float v) {
#pragma unroll
    for (int o = 32; o > 0; o >>= 1) v += __shfl_xor(v, o);
    return v;
}
__device__ __forceinline__ int swap23(int p) { return (p & 3) | ((p & 4) << 1) | ((p & 8) >> 1); }
__device__ __forceinline__ int hrow(int r) { return r < 256 ? r + 1 : r + 2; }
__device__ __forceinline__ int vpos(int key) { return (key & ~15) + swap23(key & 15); }
__device__ __forceinline__ void unpack8(u32x4 v, float (&a)[8]) {
    a[0] = __uint_as_float(v.x << 16); a[1] = __uint_as_float(v.x & 0xffff0000u);
    a[2] = __uint_as_float(v.y << 16); a[3] = __uint_as_float(v.y & 0xffff0000u);
    a[4] = __uint_as_float(v.z << 16); a[5] = __uint_as_float(v.z & 0xffff0000u);
    a[6] = __uint_as_float(v.w << 16); a[7] = __uint_as_float(v.w & 0xffff0000u);
}

struct Bufs {
    float* mod; float* scal; float* rope; float* xc; bf16_t* h; bf16_t* mix; bf16_t* qkv; bf16_t* act; float* part; bf16_t* wt; float* gt; float* partc;
    __device__ Bufs(const Params& p) {
        mod = (float*)(p.ws + WS_MOD); scal = (float*)(p.ws + WS_SCAL); rope = (float*)(p.ws + WS_ROPE); xc = (float*)(p.ws + WS_XC);
        h = (bf16_t*)(p.ws + WS_H); mix = (bf16_t*)(p.ws + WS_MIX); qkv = (bf16_t*)(p.ws + WS_QKV); act = (bf16_t*)(p.ws + WS_QKV);
        part = (float*)(p.ws + WS_PART); wt = (bf16_t*)(p.ws + WS_WT); gt = (float*)(p.ws + WS_GT); partc = (float*)(p.ws + WS_PARTC);
    }
};
__device__ __forceinline__ const float* modp(const Bufs& B, int l, int s, int chunk) { return B.mod + ((size_t)(l * 2 + s) * 6144) + chunk * 1024; }

__device__ __forceinline__ void phase_prep(const Params& p, char* lds, int bid, int nblk) {
    Bufs B(p);
    float* sil = (float*)lds;
    float* red = (float*)lds + 2048;
    const int tid = ltid();
    for (int e = bid * NT + tid; e < 256 * 1024 / 4; e += nblk * NT) ((float4*)B.xc)[e] = ((const float4*)p.in[I_CTX])[e];
    for (int item = bid; item < 208; item += nblk) {
        if (item < 192) {
            __syncthreads();
            for (int k = tid; k < 2048; k += NT) { const float c = k < 1024 ? p.in[I_C][k] : p.in[I_CCTX][k - 1024]; sil[k] = c / (1.f + __expf(-c)); }
            __syncthreads();
            const int l = item / 96, n0 = (item % 96) * 64, q = tid & 15, kc = tid >> 4;
            const float* W = p.in[I_ADAW] + (size_t)l * 1024 * 6144 + n0 + 4 * q;
            float4 a0 = make_float4(0.f, 0.f, 0.f, 0.f), a1 = a0;
#pragma unroll 8
            for (int k = kc * 32; k < kc * 32 + 32; ++k) {
                const float4 w = *(const float4*)(W + (size_t)k * 6144);
                const float s0 = sil[k], s1 = sil[1024 + k];
                a0.x += s0 * w.x; a0.y += s0 * w.y; a0.z += s0 * w.z; a0.w += s0 * w.w;
                a1.x += s1 * w.x; a1.y += s1 * w.y; a1.z += s1 * w.z; a1.w += s1 * w.w;
            }
            float* rp = red + (kc * 16 + q) * 8;
            *(float4*)rp = a0; *(float4*)(rp + 4) = a1;
            __syncthreads();
            if (tid < 128) {
                const int n = tid & 63, sidx = tid >> 6; float acc = 0.f;
                for (int k = 0; k < 32; ++k) acc += red[(k * 16 + (n >> 2)) * 8 + sidx * 4 + (n & 3)];
                B.mod[(size_t)(l * 2 + sidx) * 6144 + n0 + n] = acc + p.in[I_ADAB][l * 6144 + n0 + n];
            }
        } else {
            if (tid < 256) { const int e = (item - 192) * 256 + tid;
                const int pos = e >> 4, i = e & 15;
                const double f = pow(10000.0, -(double)i / 16.0), ang = (double)pos * f;
                B.rope[e * 2] = (float)cos(ang); B.rope[e * 2 + 1] = (float)sin(ang);
            }
            if (item == 192 && tid < 64) {
                B.gt[tid] = p.in[I_AQN][tid]; B.gt[64 + tid] = p.in[I_AKN][tid]; B.gt[128 + tid] = p.in[I_BQN][tid]; B.gt[192 + tid] = p.in[I_BKN][tid];
                B.gt[256 + tid] = p.in[I_DQN][tid]; B.gt[320 + tid] = p.in[I_DKN][tid];
                const float s1 = wave_sum(p.in[I_LQ1][tid] * p.in[I_LK1][tid]), s2 = wave_sum(p.in[I_LQ2][tid] * p.in[I_LK2][tid]);
                if (tid == 0) B.scal[0] = expf(s1) - expf(s2) + 0.2f;
                float ma = fabsf(p.in[I_AQN][tid]), mb = fabsf(p.in[I_AKN][tid]), mc = fmaxf(fabsf(p.in[I_CQN][tid]), tid < 32 ? fabsf(p.in[I_CQN][64 + tid]) : 0.f),
                      md = fmaxf(fabsf(p.in[I_CKN][tid]), tid < 32 ? fabsf(p.in[I_CKN][64 + tid]) : 0.f);
#pragma unroll
                for (int o = 32; o > 0; o >>= 1) { ma = fmaxf(ma, __shfl_xor(ma, o)); mb = fmaxf(mb, __shfl_xor(mb, o)); mc = fmaxf(mc, __shfl_xor(mc, o)); md = fmaxf(md, __shfl_xor(md, o)); }
                if (tid == 0) { B.scal[1] = 8.f * ma * mb * 1.4426950408889634f; B.scal[2] = 9.797958971132712f * mc * md * 1.4426950408889634f; }
                float na = fabsf(p.in[I_BQN][tid]), nb = fabsf(p.in[I_BKN][tid]), nc = fabsf(p.in[I_DQN][tid]), nd = fabsf(p.in[I_DKN][tid]), nr = 0.f, ns = tid < 8 ? p.in[I_SINK][tid] : -1e30f;
                for (int e = tid; e < 8 * 465; e += 64) nr = fmaxf(nr, fabsf(p.in[I_RPB][e]));
#pragma unroll
                for (int o = 32; o > 0; o >>= 1) { na = fmaxf(na, __shfl_xor(na, o)); nb = fmaxf(nb, __shfl_xor(nb, o)); nc = fmaxf(nc, __shfl_xor(nc, o)); nd = fmaxf(nd, __shfl_xor(nd, o));
                                                   nr = fmaxf(nr, __shfl_xor(nr, o)); ns = fmaxf(ns, __shfl_xor(ns, o)); }
                if (tid == 0) { B.scal[3] = (8.f * na * nb + nr) * 1.4426950408889634f; B.scal[4] = fmaxf(8.f * nc * nd, ns) * 1.4426950408889634f; }
            }
        }
    }
}

__device__ __forceinline__ void phase_norm(const Params& p, int l, int which, int bid, int nblk) {
    Bufs B(p);
    const int wid = ltid() >> 6, lane = ltid() & 63;
    const float* gamma = p.in[which ? I_NFFN : I_NMIX] + l * 1024;
    for (int e = bid * NT + ltid(); e < (2 + HROWS - (R_ + 2)) * 128; e += nblk * NT) {
        const int rr = e >> 7, c = e & 127; const int rho = rr == 0 ? 0 : rr == 1 ? 257 : R_ + 2 + (rr - 2);
        *(u32x4*)(B.h + (size_t)rho * 1024 + c * 8) = (u32x4){0u, 0u, 0u, 0u};
    }
    const bool first = (l == 0 && which == 0);
    for (int seg = 0; seg < 2; ++seg) {
        if (seg == 0 && l == 1 && which == 1) continue;
        const float* sh = modp(B, l, seg == 0 ? 1 : 0, which ? 3 : 0); const float* sc = modp(B, l, seg == 0 ? 1 : 0, which ? 4 : 1);
        float ca[16], cb[16];
#pragma unroll
        for (int i = 0; i < 4; ++i) {
            const int k = i * 256 + lane * 4;
            const float4 g4 = *(const float4*)(gamma + k), s4 = *(const float4*)(sc + k), h4 = *(const float4*)(sh + k);
            ca[4 * i] = g4.x * (1.f + s4.x); ca[4 * i + 1] = g4.y * (1.f + s4.y); ca[4 * i + 2] = g4.z * (1.f + s4.z); ca[4 * i + 3] = g4.w * (1.f + s4.w);
            cb[4 * i] = h4.x; cb[4 * i + 1] = h4.y; cb[4 * i + 2] = h4.z; cb[4 * i + 3] = h4.w;
        }
        const int r_lo = seg == 0 ? 0 : 256, r_hi = seg == 0 ? 256 : R_;
        const int nks = (seg == 0 && !first) ? (which == 1 ? 4 : 11) : 0;
        const int rstep = nblk * 8;
        int r = r_lo + bid * 8 + wid;
        float4 cur[4];
        if (r < r_hi) {
            const float* src = r < 256 ? ((first ? p.in[I_CTX] : B.xc) + (size_t)r * 1024) : ((first ? p.in[I_X] : p.out) + (size_t)(r - 256) * 1024);
#pragma unroll
            for (int i = 0; i < 4; ++i) cur[i] = *(const float4*)(src + i * 256 + lane * 4);
        }
        for (; r < r_hi; r += rstep) {
            const int rn = r + rstep;
            float4 nx[4];
            if (rn < r_hi) {
                const float* src = rn < 256 ? ((first ? p.in[I_CTX] : B.xc) + (size_t)rn * 1024) : ((first ? p.in[I_X] : p.out) + (size_t)(rn - 256) * 1024);
#pragma unroll
                for (int i = 0; i < 4; ++i) nx[i] = *(const float4*)(src + i * 256 + lane * 4);
            }
            float v[16]; float ss = 0.f;
#pragma unroll
            for (int i = 0; i < 4; ++i) {
                float4 t = cur[i];
                for (int kc = 0; kc < nks; ++kc) { const float4 q = *(const float4*)(B.partc + ((size_t)kc * 256 + r) * 1024 + i * 256 + lane * 4); t.x += q.x; t.y += q.y; t.z += q.z; t.w += q.w; }
                if (nks) *(float4*)(B.xc + (size_t)r * 1024 + i * 256 + lane * 4) = t;
                v[4 * i] = t.x; v[4 * i + 1] = t.y; v[4 * i + 2] = t.z; v[4 * i + 3] = t.w; ss += t.x * t.x + t.y * t.y + t.z * t.z + t.w * t.w; }
            ss = wave_sum(ss);
            const float rr = rsqrtf(ss * (1.f / 1024.f) + EPS_);
#pragma unroll
            for (int i = 0; i < 4; ++i) {
                const int k = i * 256 + lane * 4;
                *(uint2*)(B.h + (size_t)hrow(r) * 1024 + k) = make_uint2(pk2(v[4 * i] * rr * ca[4 * i] + cb[4 * i], v[4 * i + 1] * rr * ca[4 * i + 1] + cb[4 * i + 1]),
                                                                        pk2(v[4 * i + 2] * rr * ca[4 * i + 2] + cb[4 * i + 2], v[4 * i + 3] * rr * ca[4 * i + 3] + cb[4 * i + 3]));
            }
#pragma unroll
            for (int i = 0; i < 4; ++i) cur[i] = nx[i];
        }
    }
}

#define LAS __attribute__((address_space(3)))
typedef short bf16x8 __attribute__((ext_vector_type(8)));
typedef float f32x4 __attribute__((ext_vector_type(4)));
constexpr int LDS_STAGE = 131072, LDS_XCH = LDS_STAGE, LDS_BYTES = 147456;


namespace pg8 {
constexpr int BM = 256, BK = 64, HALF = 128, HTB = HALF * BK * 2, NXCD = 8, WGM = 8;
__host__ __device__ __forceinline__ int lds_byte(int r, int c) { const int st = (r >> 4) * 2 + (c >> 5), rr = r & 15, cc = c & 31, ob = rr * 64 + cc * 2; return st * 1024 + (ob ^ (((ob >> 9) & 1) << 5)); }
__host__ __device__ __forceinline__ void stage_rc(int b, int& R, int& C) { const int st = b / 1024, sb = b % 1024, swz = sb ^ (((sb >> 9) & 1) << 5); R = (st >> 1) * 16 + swz / 64; C = (st & 1) * 32 + (swz % 64) / 2; }
struct Unit { int pm, pn, koff; };
struct Gemm { const bf16_t* A; const bf16_t* Bt; int K; int ld; int rperm = 0; };
struct Order {
    int nM, nN, nwg, G, c, pm0, amode, nNr, kchunk;
    __device__ void init(int nM_, int nN_, int G_, int c_, int pm0_, int amode_, int ksplit = 1, int kchunk_ = 0) { nM = nM_; nNr = nN_; nN = nN_ * ksplit; nwg = nM * nN; G = G_; c = c_; pm0 = pm0_; amode = amode_; kchunk = kchunk_; }
    __device__ bool next(int i, Unit& u) const {
        const long L = (long)i * G + c; if (L >= nwg) return false;
        int wgid = (int)L; { const int q = nwg / NXCD, r = nwg % NXCD, xcd = wgid % NXCD, off = wgid / NXCD; wgid = (xcd < r ? xcd * (q + 1) : r * (q + 1) + (xcd - r) * q) + off; }
        const int nig = WGM * nN, gid = wgid / nig, fm = gid * WGM, gsz = (nM - fm) < WGM ? (nM - fm) : WGM;
        u.pm = pm0 + fm + ((wgid % nig) % gsz); const int slot = (wgid % nig) / gsz; u.pn = slot % nNr; u.koff = (slot / nNr) * kchunk; return true;
    }
    __device__ __forceinline__ int arow(int pm) const { return amode == 0 ? 256 * pm : amode == 1 ? (pm == 0 ? 1 : 2 + 256 * pm) : (pm < 2 ? 254 * pm : 257 + 254 * (pm - 2)); }
    __device__ __forceinline__ void a_ready(const Unit&) const {}
    __device__ __forceinline__ void done(const Unit&) const {}
};

template <class Epi, class Sched, bool ALIGN_EPI, bool SP2>
__device__ __forceinline__ void gemm_phase(LAS unsigned char* lds, const Gemm g, const Sched& S, const Epi& E) {
    const int tid = ltid(), wid = __builtin_amdgcn_readfirstlane(tid >> 6), lane = tid & 63, wr = wid >> 2, wc = wid & 3, fr = lane & 15, fq = lane >> 4;
    int K_ = g.K; asm volatile("" : "+s"(K_));
    const int K = K_, nt = K / BK, ld = g.ld;
    unsigned voffA[2], voffB[2];
#pragma unroll
    for (int i = 0; i < 2; ++i) { int R, C; stage_rc(tid * 16 + i * 8192, R, C); const int Ra = g.rperm ? ((R & 64) | (4 * (R & 15) + ((R >> 4) & 3))) : R; voffA[i] = (unsigned)(Ra * ld + C) * 2u; voffB[i] = (unsigned)(R * ld + C) * 2u; }
    const size_t kstep = (size_t)(BK * 2);
    const size_t hstep = (size_t)HALF * ld * 2;
    const size_t tstep = 2 * hstep;
    const size_t rstep = (size_t)ld * 2;
    const unsigned ldsw = (unsigned)wid * 1024u;
    const int aoff = lds_byte(wr * 64 + fr, fq * 8), boff = lds_byte(wc * 32 + fr, fq * 8);
#define PG8_SA(b, h) (((b) * 2 + (h)) * HTB)
#define PG8_SB(b, h) ((4 + (b) * 2 + (h)) * HTB)
#define PG8_STAGE(bufoff, gbase, voff) do { _Pragma("unroll") for (int _i = 0; _i < 2; ++_i) \
        __builtin_amdgcn_global_load_lds((const unsigned*)((const char*)(gbase) + (voff)[_i]), (LAS unsigned*)(lds + (bufoff) + ldsw + _i * 8192), 16, 0, 0); } while (0)
#define PG8_LDA(dst, b, h) do { _Pragma("unroll") for (int m = 0; m < 4; ++m) _Pragma("unroll") for (int k = 0; k < 2; ++k) dst[m][k] = *(const LAS bf16x8*)(lds + PG8_SA(b, h) + aoff + m * 2048 + k * 1024); } while (0)
#define PG8_LDB(dst, b, h) do { _Pragma("unroll") for (int n = 0; n < 2; ++n) _Pragma("unroll") for (int k = 0; k < 2; ++k) dst[n][k] = *(const LAS bf16x8*)(lds + PG8_SB(b, h) + boff + n * 2048 + k * 1024); } while (0)
#define PG8_MMA(ai, bj, At, Bt) do { __builtin_amdgcn_s_setprio(1); _Pragma("unroll") for (int m = 0; m < 4; ++m) _Pragma("unroll") for (int n = 0; n < 2; ++n) _Pragma("unroll") for (int k = 0; k < 2; ++k) \
        acc[ai][bj][m][n] = __builtin_amdgcn_mfma_f32_16x16x32_bf16(Bt[n][k], At[m][k], acc[ai][bj][m][n], 0, 0, 0); __builtin_amdgcn_s_setprio(0); } while (0)
#define PG8_WAIT_V(n) asm volatile("s_waitcnt vmcnt(" #n ")" ::: "memory")
#define PG8_WAIT_L(n) asm volatile("s_waitcnt lgkmcnt(" #n ")" ::: "memory")
#define PG8_BAR __builtin_amdgcn_s_barrier()
#define PG8_SCHED __builtin_amdgcn_sched_barrier(0)
    Unit cur, nxt; int ui = 0;
    if (!S.next(0, cur)) return;
    f32x4 acc[2][2][4][2];
#pragma unroll
    for (int a = 0; a < 2; ++a)
#pragma unroll
        for (int b = 0; b < 2; ++b)
#pragma unroll
            for (int m = 0; m < 4; ++m)
#pragma unroll
                for (int n = 0; n < 2; ++n) acc[a][b][m][n] = (f32x4){0.f, 0.f, 0.f, 0.f};
    bf16x8 At[4][2], B0[2][2], B1[2][2];
    const char* cA = (const char*)g.A + (size_t)S.arow(cur.pm) * rstep + (size_t)cur.koff * 2; const char* cB = (const char*)g.Bt + (size_t)cur.pn * tstep + (size_t)cur.koff * 2;
    S.a_ready(cur);
    if constexpr (SP2) {
        PG8_STAGE(PG8_SB(0, 0), cB, voffB); PG8_STAGE(PG8_SB(0, 1), cB + hstep, voffB); PG8_STAGE(PG8_SA(0, 0), cA, voffA); PG8_STAGE(PG8_SA(0, 1), cA + hstep, voffA);
        if (wr == 1) PG8_BAR;
        PG8_WAIT_V(2); PG8_BAR;
        PG8_STAGE(PG8_SB(1, 0), cB + kstep, voffB); PG8_STAGE(PG8_SA(1, 0), cA + kstep, voffA); PG8_STAGE(PG8_SB(1, 1), cB + hstep + kstep, voffB);
        PG8_WAIT_V(6); PG8_BAR;
    } else {
        PG8_STAGE(PG8_SB(0, 0), cB, voffB); PG8_STAGE(PG8_SA(0, 0), cA, voffA); PG8_STAGE(PG8_SB(0, 1), cB + hstep, voffB); PG8_STAGE(PG8_SA(0, 1), cA + hstep, voffA);
        if (wr == 1) PG8_BAR;
        PG8_WAIT_V(4); PG8_BAR;
        PG8_STAGE(PG8_SB(1, 0), cB + kstep, voffB); PG8_STAGE(PG8_SA(1, 0), cA + kstep, voffA); PG8_STAGE(PG8_SB(1, 1), cB + hstep + kstep, voffB);
        PG8_WAIT_V(6); PG8_BAR;
    }
    for (;;) {
        const bool has_next = S.next(ui + 1, nxt);
        const char* nA = has_next ? (const char*)g.A + (size_t)S.arow(nxt.pm) * rstep + (size_t)nxt.koff * 2 : cA; const char* nB = has_next ? (const char*)g.Bt + (size_t)nxt.pn * tstep + (size_t)nxt.koff * 2 : cB;
        for (int t = 0; t < nt; t += 2) {
            const bool last = (t == nt - 2);
            const char* a1 = cA + (size_t)(t + 1) * kstep;
            const char* a2 = last ? nA : cA + (size_t)(t + 2) * kstep; const char* b2 = last ? nB : cB + (size_t)(t + 2) * kstep;
            const char* a3 = a2 + kstep; const char* b3 = b2 + kstep;
            if (last && has_next) S.a_ready(nxt);
            if constexpr (SP2) {
            PG8_LDB(B0, 0, 0); PG8_LDB(B1, 0, 1); PG8_SCHED; PG8_LDA(At, 0, 0); PG8_STAGE(PG8_SA(1, 1), a1 + hstep, voffA);
            PG8_WAIT_V(8); PG8_WAIT_L(0); PG8_BAR; PG8_MMA(0, 0, At, B0); PG8_MMA(0, 1, At, B1); PG8_BAR; PG8_SCHED;
            PG8_LDA(At, 0, 1); PG8_STAGE(PG8_SB(0, 0), b2, voffB); PG8_STAGE(PG8_SB(0, 1), b2 + hstep, voffB); PG8_STAGE(PG8_SA(0, 0), a2, voffA);
            PG8_WAIT_V(8); PG8_WAIT_L(0); PG8_BAR; PG8_MMA(1, 0, At, B0); PG8_MMA(1, 1, At, B1); PG8_BAR; PG8_SCHED;
            PG8_LDB(B0, 1, 0); PG8_LDB(B1, 1, 1); PG8_SCHED; PG8_LDA(At, 1, 0); PG8_STAGE(PG8_SA(0, 1), a2 + hstep, voffA);
            PG8_WAIT_V(8); PG8_WAIT_L(0); PG8_BAR; PG8_MMA(0, 0, At, B0); PG8_MMA(0, 1, At, B1); PG8_BAR; PG8_SCHED;
            PG8_LDA(At, 1, 1); PG8_STAGE(PG8_SB(1, 0), b3, voffB); PG8_STAGE(PG8_SB(1, 1), b3 + hstep, voffB); PG8_STAGE(PG8_SA(1, 0), a3, voffA);
            PG8_WAIT_V(8); PG8_WAIT_L(0); PG8_BAR; PG8_MMA(1, 0, At, B0); PG8_MMA(1, 1, At, B1); PG8_BAR; PG8_SCHED;
            } else {
            PG8_LDB(B0, 0, 0); PG8_SCHED; PG8_LDA(At, 0, 0); PG8_STAGE(PG8_SA(1, 1), a1 + hstep, voffA);
            PG8_WAIT_L(8); PG8_BAR; PG8_WAIT_L(0); PG8_MMA(0, 0, At, B0); PG8_BAR; PG8_SCHED;
            PG8_LDB(B1, 0, 1); PG8_STAGE(PG8_SB(0, 0), b2, voffB);
            PG8_BAR; PG8_WAIT_L(0); PG8_MMA(0, 1, At, B1); PG8_BAR;
            PG8_LDA(At, 0, 1); PG8_STAGE(PG8_SA(0, 0), a2, voffA);
            PG8_BAR; PG8_WAIT_L(0); PG8_MMA(1, 0, At, B0); PG8_BAR; PG8_SCHED;
            PG8_STAGE(PG8_SB(0, 1), b2 + hstep, voffB);
            PG8_WAIT_V(6); PG8_BAR; PG8_MMA(1, 1, At, B1); PG8_BAR;
            PG8_LDB(B0, 1, 0); PG8_SCHED; PG8_LDA(At, 1, 0); PG8_STAGE(PG8_SA(0, 1), a2 + hstep, voffA);
            PG8_WAIT_L(8); PG8_BAR; PG8_WAIT_L(0); PG8_MMA(0, 0, At, B0); PG8_BAR; PG8_SCHED;
            PG8_LDB(B1, 1, 1); PG8_STAGE(PG8_SB(1, 0), b3, voffB);
            PG8_BAR; PG8_WAIT_L(0); PG8_MMA(0, 1, At, B1); PG8_BAR;
            PG8_LDA(At, 1, 1); PG8_STAGE(PG8_SA(1, 0), a3, voffA);
            PG8_BAR; PG8_WAIT_L(0); PG8_MMA(1, 0, At, B0); PG8_BAR; PG8_SCHED;
            PG8_STAGE(PG8_SB(1, 1), b3 + hstep, voffB);
            PG8_WAIT_V(6); PG8_BAR; PG8_MMA(1, 1, At, B1); PG8_BAR;
            }
        }
        if constexpr (ALIGN_EPI) { if (wr == 0) PG8_BAR; }
        E(acc, cur, wr, wc, fr, fq); S.done(cur);
        if (!has_next) break;
#pragma unroll
        for (int a = 0; a < 2; ++a)
#pragma unroll
            for (int b = 0; b < 2; ++b)
#pragma unroll
                for (int m = 0; m < 4; ++m)
#pragma unroll
                    for (int n = 0; n < 2; ++n) acc[a][b][m][n] = (f32x4){0.f, 0.f, 0.f, 0.f};
        cur = nxt; cA = nA; cB = nB; ++ui;
        if constexpr (ALIGN_EPI) { if (wr == 1) PG8_BAR; }
    }
    PG8_WAIT_V(0);
    if constexpr (!ALIGN_EPI) { if (wr == 0) PG8_BAR; }
    PG8_BAR;
#undef PG8_SA
#undef PG8_SB
#undef PG8_STAGE
#undef PG8_LDA
#undef PG8_LDB
#undef PG8_MMA
#undef PG8_WAIT_V
#undef PG8_WAIT_L
#undef PG8_BAR
#undef PG8_SCHED
}
}

constexpr float QS64 = 0.125f * 1.4426950408889634f, QS96 = 0.10206207261596575f * 1.4426950408889634f;
typedef f32x4 AccT[2][2][4][2];
__device__ __forceinline__ const float* launder(const float* p) { asm volatile("" : "+s"(p)); return p; }
#define EPI_IDS() int t_ = ltid(); const int fr = t_ & 15, fq = (t_ >> 4) & 3; const int wid_ = __builtin_amdgcn_readfirstlane(t_ >> 6), wr = wid_ >> 2, wc = wid_ & 3; (void)wr; (void)wc; (void)fr; (void)fq
#define ITER_FENCE() do { asm volatile("" ::: "memory"); __builtin_amdgcn_sched_barrier(0); } while (0)
#define EPI_BARRIER() do { asm volatile("s_waitcnt lgkmcnt(0)" ::: "memory"); __builtin_amdgcn_s_barrier(); asm volatile("" ::: "memory"); } while (0)

__device__ __forceinline__ int vcol_of_row(int J) { const int pn = J >> 8, j = J & 255, bj = j >> 7, wc = (j >> 5) & 3, n = (j >> 4) & 1, fq = (j >> 2) & 3, e = j & 3; return 256 * pn + 64 * wc + 32 * bj + 8 * fq + 4 * n + e; }
__device__ __forceinline__ int gmap(int map, int v) {
    if (map == 0) return v;
    if (map == 1) { const int pn = v >> 8, wc = (v >> 6) & 3, bj = (v >> 5) & 1, x = v & 31, h = 128 * pn + 32 * wc + x; return bj ? F_ + h : h; }
    if (map == 2) { if (v < 384) return v; if (v < 512) return 1184 + (v - 384); if (v < 768) return 384 + (v - 512); if (v < 1280) return 672 + (v - 768);
                    if (v < 1408) return 1312 + (v - 1280); if (v < 1440) return 640 + (v - 1408); return -1; }
    { const int hh = v >> 7, y = v & 127; if (y < 64) return hh * 96 + y; const int x = y - 64; if (x >= 32) return -1; const int fq = x >> 3, n = (x >> 2) & 1, e = x & 3; return hh * 96 + 64 + 16 * n + 4 * fq + e; }
}
__device__ __forceinline__ void prep_item(const float* __restrict__ W, int K, int ldw, bf16_t* Bt, int NV, int map, const float* kscale, float* scr, int item, int lane) {
    const int nb32 = NV / 32, kb = item / nb32, nb = item % nb32, k0 = 64 * kb, J0 = 32 * nb;
    const int kk8 = lane >> 3, jq = lane & 7;
    const int col = gmap(map, vcol_of_row(J0 + 4 * jq));
#pragma unroll
    for (int i = 0; i < 8; ++i) {
        const int kk = 8 * i + kk8;
        float4 v = col >= 0 ? *(const float4*)(W + (size_t)(k0 + kk) * ldw + col) : make_float4(0.f, 0.f, 0.f, 0.f);
        if (kscale) { const float sc = kscale[k0 + kk]; v.x *= sc; v.y *= sc; v.z *= sc; v.w *= sc; }
        float* d = scr + kk * 33 + 4 * jq; d[0] = v.x; d[1] = v.y; d[2] = v.z; d[3] = v.w;
    }
    __builtin_amdgcn_wave_barrier();
    asm volatile("s_waitcnt lgkmcnt(0)" ::: "memory");
    const int c = lane & 7;
#pragma unroll
    for (int j = 0; j < 4; ++j) { const int n = (lane >> 3) + 8 * j; const float* s = scr + (8 * c) * 33 + n;
        u32x4 o; o.x = pk2(s[0 * 33], s[1 * 33]); o.y = pk2(s[2 * 33], s[3 * 33]); o.z = pk2(s[4 * 33], s[5 * 33]); o.w = pk2(s[6 * 33], s[7 * 33]);
        *(u32x4*)(Bt + (size_t)(J0 + n) * K + k0 + 8 * c) = o; }
    asm volatile("s_waitcnt lgkmcnt(0)" ::: "memory");
    __builtin_amdgcn_wave_barrier();
}
constexpr int PW_I0 = 16 * 96, PW_I1 = 16 * 32, PW_I2 = 16 * 176, PW_I3 = 44 * 32, PW_I4 = 16 * 48, PW_I5 = 16 * 32, PW_I6 = 6 * 32, PW_I7 = 4 * 32;
constexpr int PW_NIT = PW_I0 + PW_I1 + 2 * PW_I2 + 2 * PW_I3 + PW_I4 + PW_I5 + PW_I6 + PW_I7;
__device__ __forceinline__ void prep_weight_item(const Params& p, const Bufs& B, float* scr, int it, int lane) {
    int r = it;
    if (r < PW_I0) { prep_item(p.in[I_EWIN], 1024, 3072, B.wt + W_EIN, 3072, 0, nullptr, scr, r, lane); return; } r -= PW_I0;
    if (r < PW_I1) { prep_item(p.in[I_EWOUT], 1024, 1024, B.wt + W_EOUT, 1024, 0, nullptr, scr, r, lane); return; } r -= PW_I1;
    if (r < 2 * PW_I2) { const int l = r / PW_I2; prep_item(p.in[I_FUP] + (size_t)l * 1024 * F2_, 1024, F2_, B.wt + W_UP + (size_t)l * F2_ * 1024, F2_, 1, nullptr, scr, r % PW_I2, lane); return; } r -= 2 * PW_I2;
    if (r < 2 * PW_I3) { const int l = r / PW_I3; prep_item(p.in[I_FDOWN] + (size_t)l * F_ * 1024, F_, 1024, B.wt + W_DOWN + (size_t)l * 1024 * F_, 1024, 0, nullptr, scr, r % PW_I3, lane); return; } r -= 2 * PW_I3;
    if (r < PW_I4) { prep_item(p.in[I_OWIN], 1024, 1440, B.wt + W_OIN, 1536, 2, nullptr, scr, r, lane); return; } r -= PW_I4;
    if (r < PW_I5) { prep_item(p.in[I_OWOUT], 1024, 1024, B.wt + W_OOUT, 1024, 0, nullptr, scr, r, lane); return; } r -= PW_I5;
    if (r < PW_I6) { prep_item(p.in[I_CWQB], 384, 768, B.wt + W_QB, 1024, 3, p.in[I_CQAN], scr, r, lane); return; } r -= PW_I6;
    prep_item(p.in[I_CWKVB], 256, 1024, B.wt + W_KVB, 1024, 0, p.in[I_CKVAN], scr, r, lane);
}
__device__ __forceinline__ void phase_prep_weights(const Params& p, char* lds, int bid, int nblk) {
    Bufs B(p);
    const int wid = ltid() >> 6, lane = ltid() & 63;
    float* scr = (float*)lds + wid * (64 * 33 + 16);
    for (int it = bid * 8 + wid; it < PW_I0; it += nblk * 8) prep_weight_item(p, B, scr, it, lane);
}
__device__ __forceinline__ void phase_prep_weights_rest(const Params& p, char* lds) {
    Bufs B(p);
    const int tid = ltid(), wid = tid >> 6, lane = tid & 63;
    float* scr = (float*)lds + wid * (64 * 33 + 16);
    volatile int* slot = (volatile int*)(lds + LDS_BYTES - 32);
    unsigned* ctr = (unsigned*)(p.ws + WS_CTL + 15360);
    for (;;) {
        __syncthreads();
        if (tid == 0) *slot = (int)__hip_atomic_fetch_add(ctr, 8u, __ATOMIC_RELAXED, __HIP_MEMORY_SCOPE_AGENT);
        __syncthreads();
        const int base = PW_I0 + *slot;
        if (base >= PW_NIT) break;
        if (base + wid < PW_NIT) prep_weight_item(p, B, scr, base + wid, lane);
    }
}

__device__ __forceinline__ void head64_epi(const AccT& acc, int ai, int m, const float (&gn)[2][2][4], bool rope, const float* tab, int t, int fq, bf16_t* dst, float qscale) {
    float ss = 0.f;
#pragma unroll
    for (int bj = 0; bj < 2; ++bj)
#pragma unroll
        for (int n = 0; n < 2; ++n)
#pragma unroll
            for (int e = 0; e < 4; ++e) { const float v = acc[ai][bj][m][n][e]; ss += v * v; }
    ss += __shfl_xor(ss, 16); ss += __shfl_xor(ss, 32);
    const float rr = rsqrtf(ss * (1.f / 64.f) + EPS_) * qscale;
    float y[2][2][4];
#pragma unroll
    for (int bj = 0; bj < 2; ++bj)
#pragma unroll
        for (int n = 0; n < 2; ++n)
#pragma unroll
            for (int e = 0; e < 4; ++e) y[bj][n][e] = acc[ai][bj][m][n][e] * rr * gn[bj][n][e];
    if (rope) {
        const int pos = fq < 2 ? (t >> 6) : (t & 63);
        const float4* cs = (const float4*)(tab + (pos * 16 + 8 * (fq & 1)) * 2);
#pragma unroll
        for (int n = 0; n < 2; ++n) {
            const float4 c0 = cs[2 * n], c1 = cs[2 * n + 1];
            const float cv[4] = {c0.x, c0.z, c1.x, c1.z}, sv[4] = {c0.y, c0.w, c1.y, c1.w};
#pragma unroll
            for (int e = 0; e < 4; ++e) { const float x1 = y[0][n][e], x2 = y[1][n][e]; y[0][n][e] = x1 * cv[e] - x2 * sv[e]; y[1][n][e] = x1 * sv[e] + x2 * cv[e]; }
        }
    }
#pragma unroll
    for (int bj = 0; bj < 2; ++bj) {
        u32x4 w; w.x = pk2(y[bj][0][0], y[bj][0][1]); w.y = pk2(y[bj][0][2], y[bj][0][3]); w.z = pk2(y[bj][1][0], y[bj][1][1]); w.w = pk2(y[bj][1][2], y[bj][1][3]);
        *(u32x4*)(dst + 32 * bj + 8 * fq) = w;
    }
}
__device__ __forceinline__ void load_gain64(float (&gn)[2][2][4], const float* g, int fq) {
#pragma unroll
    for (int bj = 0; bj < 2; ++bj)
#pragma unroll
        for (int n = 0; n < 2; ++n) { const float4 t = *(const float4*)(g + 32 * bj + 8 * fq + 4 * n); gn[bj][n][0] = t.x; gn[bj][n][1] = t.y; gn[bj][n][2] = t.z; gn[bj][n][3] = t.w; }
}
__device__ __forceinline__ void vt_store(const AccT& acc, int ai, int m, float scale, bf16_t* vt, int fq, int r) {
    const int pos = vpos(r);
#pragma unroll
    for (int bj = 0; bj < 2; ++bj)
#pragma unroll
        for (int n = 0; n < 2; ++n)
#pragma unroll
            for (int e = 0; e < 4; ++e) vt[(size_t)(32 * bj + 8 * fq + 4 * n + e) * R_ + pos] = f2bf(acc[ai][bj][m][n][e] * scale);
}
__device__ __forceinline__ float raw_store(const AccT& acc, int ai, int m, bf16_t* dst, int fq) {
    float ss = 0.f;
#pragma unroll
    for (int bj = 0; bj < 2; ++bj) {
        u32x4 w; const f32x4 a = acc[ai][bj][m][0], b = acc[ai][bj][m][1];
        w.x = pk2(a[0], a[1]); w.y = pk2(a[2], a[3]); w.z = pk2(b[0], b[1]); w.w = pk2(b[2], b[3]);
        *(u32x4*)(dst + 32 * bj + 8 * fq) = w;
        float t[8]; unpack8(w, t);
#pragma unroll
        for (int j = 0; j < 8; ++j) ss += t[j] * t[j];
    }
    return ss;
}

struct EpiQKV0 {
    bf16_t* qkv; const float* rope; const float* gt;
    __device__ __forceinline__ void operator()(const AccT& acc, const pg8::Unit& u, int, int, int, int) const {
        EPI_IDS();
        const int seg = u.pn >> 1, r0 = u.pm * 256 + wr * 64 + fr;
        if (seg == 2 || seg == 5) {
            const size_t vo = seg == 2 ? O_VAT + ((size_t)((u.pn & 1) * 2 + (wc >> 1)) * 128 + 64 * (wc & 1)) * R_ : O_VBT + (size_t)((u.pn & 1) * 4 + wc) * 64 * R_;
            bf16_t* vt = qkv + vo;
#pragma unroll
            for (int ai = 0; ai < 2; ++ai)
#pragma unroll
                for (int m = 0; m < 4; ++m) { vt_store(acc, ai, m, 1.f, vt, fq, r0 + 128 * ai + 16 * m); ITER_FENCE(); }
        } else {
            float gn[2][2][4]; load_gain64(gn, gt + 64 * (seg < 2 ? seg : seg - 1), fq);
            const int head = (u.pn & 1) * 4 + wc;
            const size_t bo = (seg == 0 ? O_QA : seg == 1 ? O_KA : seg == 3 ? O_QB : O_KB) + (size_t)head * R_ * 64;
            bf16_t* base = qkv + bo;
            const bool rp = seg < 2 && u.pm > 0;
#pragma unroll
            for (int ai = 0; ai < 2; ++ai)
#pragma unroll
                for (int m = 0; m < 4; ++m) { const int r = r0 + 128 * ai + 16 * m; head64_epi(acc, ai, m, gn, rp, rope, r - 256, fq, base + (size_t)r * 64, (seg == 0 || seg == 3) ? QS64 : 1.f); ITER_FENCE(); }
        }
    }
};

struct EpiResid {
    const float* resid_lat; float* dst_lat; const float* resid_ctx; float* dst_ctx; const float* gate_lat; const float* gate_ctx;
    __device__ __forceinline__ void rows(const AccT& acc, const float* __restrict__ resid, float* dst, const float* __restrict__ gate, int row0, int col0) const {
        f32x4 gt[2][2];
#pragma unroll
        for (int bj = 0; bj < 2; ++bj)
#pragma unroll
            for (int n = 0; n < 2; ++n) gt[bj][n] = *(const f32x4*)(gate + col0 + 32 * bj + 4 * n);
#pragma unroll
        for (int ai = 0; ai < 2; ++ai)
#pragma unroll
            for (int m = 0; m < 4; ++m) {
                const size_t ro = (size_t)(row0 + 128 * ai + 16 * m) * 1024 + col0;
#pragma unroll
                for (int bj = 0; bj < 2; ++bj)
#pragma unroll
                    for (int n = 0; n < 2; ++n) { const f32x4 x = *(const f32x4*)(resid + ro + 32 * bj + 4 * n); *(f32x4*)(dst + ro + 32 * bj + 4 * n) = x + gt[bj][n] * acc[ai][bj][m][n]; }
                if (m == 3) ITER_FENCE();
            }
    }
    __device__ __forceinline__ void operator()(const AccT& acc, const pg8::Unit& u, int, int, int, int) const {
        EPI_IDS();
        const int col0 = u.pn * 256 + wc * 64 + 8 * fq, rl = 64 * wr + fr;
        if (u.pm == 0) rows(acc, resid_ctx, dst_ctx, gate_ctx, rl, col0);
        else rows(acc, resid_lat, dst_lat, gate_lat, (u.pm - 1) * 256 + rl, col0);
    }
};

struct EpiPartial {
    float* part; const float* gate;
    __device__ __forceinline__ void operator()(const AccT& acc, const pg8::Unit& u, int, int, int, int) const {
        EPI_IDS();
        const int col0 = u.pn * 256 + wc * 64 + 8 * fq, rl = 64 * wr + fr;
        float* base = part + (size_t)(u.koff >> 8) * 256 * 1024;
        f32x4 gt[2][2];
#pragma unroll
        for (int bj = 0; bj < 2; ++bj)
#pragma unroll
            for (int n = 0; n < 2; ++n) gt[bj][n] = *(const f32x4*)(gate + col0 + 32 * bj + 4 * n);
#pragma unroll
        for (int ai = 0; ai < 2; ++ai)
#pragma unroll
            for (int m = 0; m < 4; ++m) {
                float* d = base + (size_t)(rl + 128 * ai + 16 * m) * 1024 + col0;
#pragma unroll
                for (int bj = 0; bj < 2; ++bj)
#pragma unroll
                    for (int n = 0; n < 2; ++n) *(f32x4*)(d + 32 * bj + 4 * n) = gt[bj][n] * acc[ai][bj][m][n];
                ITER_FENCE();
            }
    }
};

#ifndef USE_DPP
#define USE_DPP 1
#endif
__device__ __forceinline__ float rot_prev(float x, int lane) {
#if USE_DPP
    return __builtin_bit_cast(float, __builtin_amdgcn_update_dpp(0, __builtin_bit_cast(int, x), 0x121, 0xf, 0xf, false));
#else
    return __shfl(x, (lane & 48) | ((lane - 1) & 15));
#endif
}
__device__ __forceinline__ float rot_next(float x, int lane) {
#if USE_DPP
    return __builtin_bit_cast(float, __builtin_amdgcn_update_dpp(0, __builtin_bit_cast(int, x), 0x12F, 0xf, 0xf, false));
#else
    return __shfl(x, (lane & 48) | ((lane + 1) & 15));
#endif
}
__device__ __forceinline__ float dpp_shr1(float old, float x) { return __builtin_bit_cast(float, __builtin_amdgcn_update_dpp(__builtin_bit_cast(int, old), __builtin_bit_cast(int, x), 0x111, 0xf, 0xf, false)); }
__device__ __forceinline__ float dpp_shl1(float old, float x) { return __builtin_bit_cast(float, __builtin_amdgcn_update_dpp(__builtin_bit_cast(int, old), __builtin_bit_cast(int, x), 0x101, 0xf, 0xf, false)); }
struct EpiUp {
    bf16_t* act; const float* cw; const float* cb; LAS float* xch;
    __device__ __forceinline__ int xidx(int c, int which, int wc, int fq, int bj, int n) const { return (((c * 2 + which) * 4 + wc) * 64) + fq * 16 + bj * 8 + n * 4; }
    __device__ __forceinline__ void operator()(const AccT& acc, const pg8::Unit& u, int, int, int, int) const {
        EPI_IDS();
        const int lane = fq * 16 + fr;
        if (fr == 0) {
#pragma unroll
            for (int ai = 0; ai < 2; ++ai)
#pragma unroll
                for (int bj = 0; bj < 2; ++bj)
#pragma unroll
                    for (int n = 0; n < 2; ++n) *(LAS f32x4*)(xch + xidx(2 * ai + wr, 0, wc, fq, bj, n)) = acc[ai][bj][0][n];
        }
        if (fr == 15) {
#pragma unroll
            for (int ai = 0; ai < 2; ++ai)
#pragma unroll
                for (int bj = 0; bj < 2; ++bj)
#pragma unroll
                    for (int n = 0; n < 2; ++n) *(LAS f32x4*)(xch + xidx(2 * ai + wr, 1, wc, fq, bj, n)) = acc[ai][bj][3][n];
        }
        EPI_BARRIER();
        const bool isctx = u.pm < 2;
        const int seq0 = isctx ? 254 * u.pm : 254 * (u.pm - 2), lim = isctx ? 256 : T_, rbase = isctx ? 0 : 256;
#pragma unroll
        for (int n = 0; n < 2; ++n) {
            const int h0 = 128 * u.pn + 32 * wc + 8 * fq + 4 * n;
            f32x4 w0[2], w1[2], w2[2], bb[2];
#pragma unroll
            for (int bj = 0; bj < 2; ++bj) { const int c = bj * F_ + h0; w0[bj] = *(const f32x4*)(cw + c); w1[bj] = *(const f32x4*)(cw + F2_ + c); w2[bj] = *(const f32x4*)(cw + 2 * F2_ + c); bb[bj] = *(const f32x4*)(cb + c); }
#pragma unroll
            for (int ai = 0; ai < 2; ++ai) {
                const int c = 2 * ai + wr;
                f32x4 up0[2], dn3[2];
#pragma unroll
                for (int bj = 0; bj < 2; ++bj) {
                    const f32x4 eup = c > 0 ? *(const LAS f32x4*)(xch + xidx(c - 1, 1, wc, fq, bj, n)) : (f32x4){0.f, 0.f, 0.f, 0.f};
                    const f32x4 edn = c < 3 ? *(const LAS f32x4*)(xch + xidx(c + 1, 0, wc, fq, bj, n)) : (f32x4){0.f, 0.f, 0.f, 0.f};
#pragma unroll
                    for (int e = 0; e < 4; ++e) { up0[bj][e] = dpp_shr1(eup[e], acc[ai][bj][3][n][e]); dn3[bj][e] = dpp_shl1(edn[e], acc[ai][bj][0][n][e]); }
                }
#pragma unroll
                for (int m = 0; m < 4; ++m) {
                    f32x4 cv[2];
#pragma unroll
                    for (int bj = 0; bj < 2; ++bj) {
                        const f32x4 x = acc[ai][bj][m][n];
                        const f32x4 up = m > 0 ? acc[ai][bj][m > 0 ? m - 1 : 0][n] : up0[bj];
                        const f32x4 dn = m < 3 ? acc[ai][bj][m < 3 ? m + 1 : 3][n] : dn3[bj];
                        cv[bj] = bb[bj] + w0[bj] * up + w1[bj] * x + w2[bj] * dn;
                    }
                    const int j = 128 * ai + 64 * wr + 4 * fr + m, sr = seq0 + j - 1;
                    if (j >= 1 && j <= 254 && sr < lim) {
                        float o[4];
#pragma unroll
                        for (int e = 0; e < 4; ++e) { const float gg = cv[1][e]; o[e] = cv[0][e] * gg * __builtin_amdgcn_rcpf(1.f + __builtin_amdgcn_exp2f(-1.4426950408889634f * gg)); }
                        *(uint2*)(act + (size_t)(rbase + sr) * F_ + h0) = make_uint2(pk2(o[0], o[1]), pk2(o[2], o[3]));
                    }
                    ITER_FENCE();
                }
            }
        }
    }
};

struct EpiQKV1A {
    bf16_t* qkv; float* part; const float* rope; const float* gt;
    __device__ __forceinline__ void operator()(const AccT& acc, const pg8::Unit& u, int, int, int, int) const {
        EPI_IDS();
        const int r0 = u.pm * 256 + wr * 64 + fr, pn = u.pn;
        const bool rp = u.pm > 0;
        if (pn == 0 || (pn == 1 && wc < 2) || pn == 2) {
            const int chunk = pn == 0 ? wc : pn == 1 ? 4 + wc : wc;
            const size_t bo = pn == 2 ? O_CKV + 64 * wc : O_CQ + 64 * chunk;
            bf16_t* base = qkv + bo;
            const int ld = pn == 2 ? 256 : 384;
            float* pp = part + (pn == 2 ? 8 : 0) + chunk;
#pragma unroll
            for (int ai = 0; ai < 2; ++ai)
#pragma unroll
                for (int m = 0; m < 4; ++m) {
                    const int r = r0 + 128 * ai + 16 * m;
                    float ss = raw_store(acc, ai, m, base + (size_t)r * ld, fq);
                    ss += __shfl_xor(ss, 16); ss += __shfl_xor(ss, 32);
                    if (fq == 0) pp[(size_t)r * 12] = ss;
                    ITER_FENCE();
                }
        } else if (pn == 1 || pn == 3 || pn == 4) {
            const bool isk = pn == 1;
            float gn[2][2][4]; load_gain64(gn, gt + (isk ? 320 : 256), fq);
            const size_t bo = isk ? O_GK + (size_t)(wc - 2) * R_ * 64 : O_GQ + (size_t)(4 * (pn - 3) + wc) * R_ * 64;
            bf16_t* base = qkv + bo;
#pragma unroll
            for (int ai = 0; ai < 2; ++ai)
#pragma unroll
                for (int m = 0; m < 4; ++m) { const int r = r0 + 128 * ai + 16 * m; head64_epi(acc, ai, m, gn, rp, rope, r - 256, fq, base + (size_t)r * 64, isk ? 1.f : QS64); ITER_FENCE(); }
        } else {
            if (wc < 2) {
                bf16_t* vt = qkv + O_GVT + (size_t)wc * 64 * R_;
#pragma unroll
                for (int ai = 0; ai < 2; ++ai)
#pragma unroll
                    for (int m = 0; m < 4; ++m) { vt_store(acc, ai, m, 1.f, vt, fq, r0 + 128 * ai + 16 * m); ITER_FENCE(); }
            } else if (wc == 2) {
#pragma unroll
                for (int ai = 0; ai < 2; ++ai)
#pragma unroll
                    for (int m = 0; m < 4; ++m) {
                        const int r = r0 + 128 * ai + 16 * m; const f32x4 a = acc[ai][0][m][0], b = acc[ai][0][m][1];
                        u32x4 w; w.x = pk2(a[0], a[1]); w.y = pk2(a[2], a[3]); w.z = pk2(b[0], b[1]); w.w = pk2(b[2], b[3]);
                        *(u32x4*)(qkv + O_CKR + (size_t)r * 32 + 8 * fq) = w;
                    }
            }
        }
    }
};

struct EpiQB {
    bf16_t* qkv; const float* part; const float* rope; const float* gq; LAS float* xch;
    __device__ __forceinline__ void operator()(const AccT& acc, const pg8::Unit& u, int, int, int, int) const {
        EPI_IDS();
        const int wid = wr * 4 + wc, head = 2 * u.pn + (wc >> 1), role = wc & 1, r0 = u.pm * 256 + wr * 64 + fr;
        const bool rp = u.pm > 0;
        float ssp[2][4];
#pragma unroll
        for (int ai = 0; ai < 2; ++ai)
#pragma unroll
            for (int m = 0; m < 4; ++m) {
                float ss = 0.f;
#pragma unroll
                for (int bj = 0; bj < 2; ++bj)
#pragma unroll
                    for (int n = 0; n < 2; ++n)
#pragma unroll
                        for (int e = 0; e < 4; ++e) { const float v = acc[ai][bj][m][n][e]; ss += v * v; }
                ss += __shfl_xor(ss, 16); ss += __shfl_xor(ss, 32);
                ssp[ai][m] = ss;
                if (fq == 0) xch[wid * 128 + ai * 64 + m * 16 + fr] = ss;
            }
        EPI_BARRIER();
        float g0[2][2][4];
        const float* gql = launder(gq);
        if (role == 0) load_gain64(g0, gql, fq);
        else {
#pragma unroll
            for (int n = 0; n < 2; ++n) { const float4 t = *(const float4*)(gql + 64 + 16 * n + 4 * fq); g0[0][n][0] = t.x; g0[0][n][1] = t.y; g0[0][n][2] = t.z; g0[0][n][3] = t.w; }
        }
#pragma unroll
        for (int ai = 0; ai < 2; ++ai)
#pragma unroll
            for (int m = 0; m < 4; ++m) {
                const int r = r0 + 128 * ai + 16 * m;
                const float so = xch[(wid ^ 1) * 128 + ai * 64 + m * 16 + fr];
                const float* pp = part + (size_t)r * 12;
                const float rq = rsqrtf((pp[0] + pp[1] + pp[2] + pp[3] + pp[4] + pp[5]) * (1.f / 384.f) + EPS_);
                const float sc = rq * rsqrtf(rq * rq * (ssp[ai][m] + so) * (1.f / 96.f) + EPS_) * QS96;
                bf16_t* dst = qkv + O_MQ + ((size_t)head * R_ + r) * 96;
                if (role == 0) {
#pragma unroll
                    for (int bj = 0; bj < 2; ++bj) {
                        const f32x4 a = acc[ai][bj][m][0], b = acc[ai][bj][m][1];
                        u32x4 w; w.x = pk2(a[0] * sc * g0[bj][0][0], a[1] * sc * g0[bj][0][1]); w.y = pk2(a[2] * sc * g0[bj][0][2], a[3] * sc * g0[bj][0][3]);
                        w.z = pk2(b[0] * sc * g0[bj][1][0], b[1] * sc * g0[bj][1][1]); w.w = pk2(b[2] * sc * g0[bj][1][2], b[3] * sc * g0[bj][1][3]);
                        *(u32x4*)(dst + 32 * bj + 8 * fq) = w;
                    }
                } else {
                    float y1[4], y2[4];
#pragma unroll
                    for (int e = 0; e < 4; ++e) { y1[e] = acc[ai][0][m][0][e] * sc * g0[0][0][e]; y2[e] = acc[ai][0][m][1][e] * sc * g0[0][1][e]; }
                    if (rp) {
                        const int t = r - 256, pos = fq < 2 ? (t >> 6) : (t & 63);
                        const float* tb = rope + (pos * 16 + 8 * (fq & 1)) * 2;
#pragma unroll
                        for (int e = 0; e < 4; ++e) { const float2 cs = *(const float2*)(tb + 4 * e); const float a = y1[e], b = y2[e]; y1[e] = a * cs.x - b * cs.y; y2[e] = a * cs.y + b * cs.x; }
                    }
                    *(uint2*)(dst + 64 + 4 * fq) = make_uint2(pk2(y1[0], y1[1]), pk2(y1[2], y1[3]));
                    *(uint2*)(dst + 80 + 4 * fq) = make_uint2(pk2(y2[0], y2[1]), pk2(y2[2], y2[3]));
                }
                ITER_FENCE();
            }
        EPI_BARRIER();
    }
};

struct EpiKVB {
    bf16_t* qkv; const float* part; const float* rope; const float* gk;
    __device__ __forceinline__ void operator()(const AccT& acc, const pg8::Unit& u, int, int, int, int) const {
        EPI_IDS();
        const int head = 2 * u.pn + (wc >> 1), role = wc & 1, r0 = u.pm * 256 + wr * 64 + fr;
        const bool rp = u.pm > 0;
        if (role == 1) {
            bf16_t* vt = qkv + O_MVT + (size_t)head * 64 * R_;
#pragma unroll
            for (int ai = 0; ai < 2; ++ai)
#pragma unroll
                for (int m = 0; m < 4; ++m) {
                    const int r = r0 + 128 * ai + 16 * m; const float* pp = part + (size_t)r * 12 + 8;
                    const float rk = rsqrtf((pp[0] + pp[1] + pp[2] + pp[3]) * (1.f / 256.f) + EPS_);
                    vt_store(acc, ai, m, rk, vt, fq, r);
                    ITER_FENCE();
                }
        } else {
            const float* gkl = launder(gk);
            float gn[2][2][4]; load_gain64(gn, gkl, fq);
            float gr[2][4];
#pragma unroll
            for (int n = 0; n < 2; ++n) { const float4 t = *(const float4*)(gkl + 64 + 16 * n + 4 * fq); gr[n][0] = t.x; gr[n][1] = t.y; gr[n][2] = t.z; gr[n][3] = t.w; }
#pragma unroll
            for (int ai = 0; ai < 2; ++ai)
#pragma unroll
                for (int m = 0; m < 4; ++m) {
                    const int r = r0 + 128 * ai + 16 * m; const float* pp = part + (size_t)r * 12 + 8;
                    const float rk = rsqrtf((pp[0] + pp[1] + pp[2] + pp[3]) * (1.f / 256.f) + EPS_);
                    const uint2 c1 = *(const uint2*)(qkv + O_CKR + (size_t)r * 32 + 4 * fq), c2 = *(const uint2*)(qkv + O_CKR + (size_t)r * 32 + 16 + 4 * fq);
                    float y1[4] = {__uint_as_float(c1.x << 16), __uint_as_float(c1.x & 0xffff0000u), __uint_as_float(c1.y << 16), __uint_as_float(c1.y & 0xffff0000u)};
                    float y2[4] = {__uint_as_float(c2.x << 16), __uint_as_float(c2.x & 0xffff0000u), __uint_as_float(c2.y << 16), __uint_as_float(c2.y & 0xffff0000u)};
                    float ss = 0.f;
#pragma unroll
                    for (int bj = 0; bj < 2; ++bj)
#pragma unroll
                        for (int n = 0; n < 2; ++n)
#pragma unroll
                            for (int e = 0; e < 4; ++e) { const float v = acc[ai][bj][m][n][e] * rk; ss += v * v; }
#pragma unroll
                    for (int e = 0; e < 4; ++e) ss += y1[e] * y1[e] + y2[e] * y2[e];
                    ss += __shfl_xor(ss, 16); ss += __shfl_xor(ss, 32);
                    const float rr = rsqrtf(ss * (1.f / 96.f) + EPS_), sc = rk * rr;
                    bf16_t* dst = qkv + O_MK + ((size_t)head * R_ + r) * 96;
#pragma unroll
                    for (int bj = 0; bj < 2; ++bj) {
                        const f32x4 a = acc[ai][bj][m][0], b = acc[ai][bj][m][1];
                        u32x4 w; w.x = pk2(a[0] * sc * gn[bj][0][0], a[1] * sc * gn[bj][0][1]); w.y = pk2(a[2] * sc * gn[bj][0][2], a[3] * sc * gn[bj][0][3]);
                        w.z = pk2(b[0] * sc * gn[bj][1][0], b[1] * sc * gn[bj][1][1]); w.w = pk2(b[2] * sc * gn[bj][1][2], b[3] * sc * gn[bj][1][3]);
                        *(u32x4*)(dst + 32 * bj + 8 * fq) = w;
                    }
#pragma unroll
                    for (int e = 0; e < 4; ++e) { y1[e] *= rr * gr[0][e]; y2[e] *= rr * gr[1][e]; }
                    if (rp) {
                        const int t = r - 256, pos = fq < 2 ? (t >> 6) : (t & 63);
                        const float* tb = rope + (pos * 16 + 8 * (fq & 1)) * 2;
#pragma unroll
                        for (int e = 0; e < 4; ++e) { const float2 cs = *(const float2*)(tb + 4 * e); const float a = y1[e], b = y2[e]; y1[e] = a * cs.x - b * cs.y; y2[e] = a * cs.y + b * cs.x; }
                    }
                    *(uint2*)(dst + 64 + 4 * fq) = make_uint2(pk2(y1[0], y1[1]), pk2(y1[2], y1[3]));
                    *(uint2*)(dst + 80 + 4 * fq) = make_uint2(pk2(y2[0], y2[1]), pk2(y2[2], y2[3]));
                    ITER_FENCE();
                }
        }
    }
};

__device__ __forceinline__ void g_qkv0(const Params& p, LAS unsigned char* lds) {
    Bufs B(p);
    pg8::Gemm g{B.h, B.wt + W_EIN, 1024, 1024}; pg8::Order S; S.init(65, 12, gridDim.x, blockIdx.x, 0, 1);
    EpiQKV0 E{B.qkv, B.rope, B.gt};
    pg8::gemm_phase<EpiQKV0, pg8::Order, true, true>(lds, g, S, E);
}
__device__ __forceinline__ void g_out(const Params& p, int l, LAS unsigned char* lds) {
    Bufs B(p);
    { pg8::Gemm g{B.mix, B.wt + (l == 0 ? W_EOUT : W_OOUT), 1024, 1024}; pg8::Order S; S.init(64, 4, gridDim.x, blockIdx.x, 1, 0);
      EpiResid E{l == 0 ? p.in[I_X] : p.out, p.out, p.in[I_CTX], B.xc, modp(B, l, 0, 2), modp(B, l, 1, 2)};
      pg8::gemm_phase<EpiResid, pg8::Order, true, true>(lds, g, S, E); }
    if (l == 0) {
        pg8::Gemm g{B.mix, B.wt + W_EOUT, 256, 1024}; pg8::Order S; S.init(1, 4, gridDim.x, blockIdx.x, 0, 0, 4, 256);
        EpiPartial E{B.partc, modp(B, 0, 1, 2)};
        pg8::gemm_phase<EpiPartial, pg8::Order, true, true>(lds, g, S, E);
    }
}
__device__ __forceinline__ void g_up(const Params& p, int l, LAS unsigned char* lds) {
    Bufs B(p);
    pg8::Gemm g{B.h, B.wt + W_UP + (size_t)l * F2_ * 1024, 1024, 1024, 1}; pg8::Order S; S.init(l == 0 ? 67 : 65, 22, gridDim.x, blockIdx.x, l == 0 ? 0 : 2, 2);
    EpiUp E{B.act, p.in[I_FCW] + (size_t)l * 3 * F2_, p.in[I_FCB] + (size_t)l * F2_, (LAS float*)(lds + LDS_XCH)};
    pg8::gemm_phase<EpiUp, pg8::Order, true, true>(lds, g, S, E);
}
__device__ __forceinline__ void g_down(const Params& p, int l, LAS unsigned char* lds) {
    Bufs B(p);
    { pg8::Gemm g{B.act, B.wt + W_DOWN + (size_t)l * 1024 * F_, F_, F_}; pg8::Order S; S.init(64, 4, gridDim.x, blockIdx.x, 1, 0);
      EpiResid E{p.out, p.out, B.xc, B.xc, modp(B, l, 0, 5), modp(B, l, 1, 5)};
      pg8::gemm_phase<EpiResid, pg8::Order, true, true>(lds, g, S, E); }
    if (l == 0) {
        pg8::Gemm g{B.act, B.wt + W_DOWN, 256, F_}; pg8::Order S; S.init(1, 4, gridDim.x, blockIdx.x, 0, 0, 11, 256);
        EpiPartial E{B.partc, modp(B, 0, 1, 5)};
        pg8::gemm_phase<EpiPartial, pg8::Order, true, true>(lds, g, S, E);
    }
}
__device__ __forceinline__ void g_qkv1a(const Params& p, LAS unsigned char* lds) {
    Bufs B(p);
    pg8::Gemm g{B.h, B.wt + W_OIN, 1024, 1024}; pg8::Order S; S.init(65, 6, gridDim.x, blockIdx.x, 0, 1);
    EpiQKV1A E{B.qkv, B.part, B.rope, B.gt};
    pg8::gemm_phase<EpiQKV1A, pg8::Order, true, true>(lds, g, S, E);
}
__device__ __forceinline__ void g_qkv1b(const Params& p, LAS unsigned char* lds) {
    Bufs B(p);
    { pg8::Gemm g{B.qkv + O_CQ, B.wt + W_QB, 384, 384}; pg8::Order S; S.init(64, 4, gridDim.x, blockIdx.x, 1, 0);
      EpiQB E{B.qkv, B.part, B.rope, p.in[I_CQN], (LAS float*)(lds + LDS_XCH)};
      pg8::gemm_phase<EpiQB, pg8::Order, true, true>(lds, g, S, E); }
    { pg8::Gemm g{B.qkv + O_CKV, B.wt + W_KVB, 256, 256}; pg8::Order S; S.init(65, 4, gridDim.x, blockIdx.x, 0, 0);
      EpiKVB E{B.qkv, B.part, B.rope, p.in[I_CKN]};
      pg8::gemm_phase<EpiKVB, pg8::Order, true, true>(lds, g, S, E); }
}

typedef float f32x16 __attribute__((ext_vector_type(16)));

template <int DQK, int DV, int TK = 64>
struct FlashGeom {
    static constexpr int KP = DQK * 2 + 16, VP = TK * 2 + 16, KBYTES = TK * KP, VBYTES = DV * VP, STAGE = KBYTES + VBYTES;
    static constexpr int KCH = DQK / 8, KN = (TK * KCH + NT - 1) / NT, VCH = TK / 8, VN = DV * VCH / NT;
};

#ifndef FLASH_PRIO
#define FLASH_PRIO 0
#endif
#ifndef DIFF_TK
#define DIFF_TK 64
#endif
#ifndef DIFF_PD
#define DIFF_PD 1
#endif
#ifndef MLA_TK
#define MLA_TK 64
#endif
#ifndef MLA_PD
#define MLA_PD 2
#endif
#ifndef FLASH_ASMLOAD
#define FLASH_ASMLOAD 0
#endif
#ifndef FLASH_SLEEP
#define FLASH_SLEEP 0
#endif
#ifndef FLASH_PD
#define FLASH_PD 2
#endif
#ifndef FLASH_TK
#define FLASH_TK 128
#endif
__device__ __forceinline__ void asm_gload(u32x4& dst, const void* ptr) { if (FLASH_ASMLOAD) asm volatile("global_load_dwordx4 %0, %1, off" : "=v"(dst) : "v"(ptr) : "memory"); else dst = *(const u32x4*)ptr; }
template <int N> __device__ __forceinline__ void asm_vmwait() { if (FLASH_ASMLOAD) asm volatile("s_waitcnt vmcnt(%0)" :: "n"(N) : "memory"); }
template <int DQK, int DV, int QS, int TK, int PD>
__device__ __forceinline__ void flash_dense(LAS char* lds, const bf16_t* __restrict__ qptr, const bf16_t* __restrict__ Kb, const bf16_t* __restrict__ VT, int ntiles,
                                            f32x16 (&O)[QS][DV / 32], float (&lsum)[QS]) {
    typedef FlashGeom<DQK, DV, TK> G;
    constexpr int NL = G::KN + G::VN;
    const int tid = ltid(), lane = tid & 63, r = lane & 31, h = lane >> 5;
    bf16x8 qf[QS][DQK / 16];
#pragma unroll
    for (int qs = 0; qs < QS; ++qs)
#pragma unroll
        for (int ks = 0; ks < DQK / 16; ++ks) qf[qs][ks] = *(const bf16x8*)(qptr + (size_t)qs * 32 * DQK + 16 * ks + 8 * h);
#pragma unroll
    for (int qs = 0; qs < QS; ++qs)
#pragma unroll
        for (int dt = 0; dt < DV / 32; ++dt)
#pragma unroll
            for (int i = 0; i < 16; ++i) O[qs][dt][i] = 0.f;
    float l[QS];
#pragma unroll
    for (int qs = 0; qs < QS; ++qs) l[qs] = 0.f;
    u32x4 kreg[PD][G::KN], vreg[PD][G::VN];
    int kq[G::KN]; const char* kp[G::KN]; const char* vp[G::VN];
#pragma unroll
    for (int i = 0; i < G::KN; ++i) { kq[i] = tid + NT * i; const int qc = kq[i] < TK * G::KCH ? kq[i] : TK * G::KCH - 1; kp[i] = (const char*)Kb + (size_t)qc * 16; }
#pragma unroll
    for (int i = 0; i < G::VN; ++i) { const int q = tid + NT * i; vp[i] = (const char*)VT + ((size_t)(q / G::VCH) * R_ + (q % G::VCH) * 8) * 2; }
#pragma unroll
    for (int qs = 0; qs < QS; ++qs)
#pragma unroll
        for (int ks = 0; ks < DQK / 16; ++ks) asm volatile("" : "+v"(qf[qs][ks]));
    if (FLASH_ASMLOAD) asm volatile("s_waitcnt vmcnt(0)" ::: "memory");
#define FD_LOAD(set, t) do { const int tt_ = (t) < ntiles ? (t) : ntiles - 1; \
        _Pragma("unroll") for (int i_ = 0; i_ < G::KN; ++i_) asm_gload(kreg[set][i_], kp[i_] + (size_t)tt_ * (TK * DQK * 2)); \
        _Pragma("unroll") for (int i_ = 0; i_ < G::VN; ++i_) asm_gload(vreg[set][i_], vp[i_] + (size_t)tt_ * (TK * 2)); } while (0)
#define FD_FENCE(set) do { if (FLASH_ASMLOAD) { _Pragma("unroll") for (int i_ = 0; i_ < G::KN; ++i_) asm volatile("" : "+v"(kreg[set][i_])); _Pragma("unroll") for (int i_ = 0; i_ < G::VN; ++i_) asm volatile("" : "+v"(vreg[set][i_])); } } while (0)
#define FD_STORE(set, buf) do { LAS char* kb_ = lds + (buf) * G::STAGE; LAS char* vb_ = kb_ + G::KBYTES; \
        _Pragma("unroll") for (int i_ = 0; i_ < G::KN; ++i_) { if (kq[i_] < TK * G::KCH) *(LAS u32x4*)(kb_ + (kq[i_] / G::KCH) * G::KP + (kq[i_] % G::KCH) * 16) = kreg[set][i_]; } \
        _Pragma("unroll") for (int i_ = 0; i_ < G::VN; ++i_) { const int q_ = tid + NT * i_; *(LAS u32x4*)(vb_ + (q_ / G::VCH) * G::VP + (q_ % G::VCH) * 16) = vreg[set][i_]; } } while (0)
    FD_LOAD(0, 0);
#pragma unroll
    for (int j = 1; j < PD; ++j) FD_LOAD(j, j);
    asm_vmwait<(PD - 1) * NL>(); FD_FENCE(0); FD_STORE(0, 0);
    FD_LOAD(0, PD);
    __syncthreads();
    for (int t0 = 0; t0 < ntiles; t0 += PD) {
#pragma unroll
        for (int j = 0; j < PD; ++j) {
            const int t = t0 + j;
            if (t >= ntiles) break;
            asm_vmwait<(PD - 1) * NL>(); FD_FENCE((j + 1) % PD);
            FD_STORE((j + 1) % PD, (t + 1) & 1);
            FD_LOAD((j + 1) % PD, t + 1 + PD);
            const LAS char* kb = lds + (t & 1) * G::STAGE; const LAS char* vb = kb + G::KBYTES;
#pragma unroll
            for (int kt = 0; kt < TK / 32; ++kt) {
                f32x16 S[QS];
#pragma unroll
                for (int qs = 0; qs < QS; ++qs)
#pragma unroll
                    for (int i = 0; i < 16; ++i) S[qs][i] = 0.f;
#pragma unroll
                for (int ks = 0; ks < DQK / 16; ++ks) {
                    const bf16x8 a = *(const LAS bf16x8*)(kb + (32 * kt + r) * G::KP + (16 * ks + 8 * h) * 2);
                    if (FLASH_PRIO) __builtin_amdgcn_s_setprio(1);
#pragma unroll
                    for (int qs = 0; qs < QS; ++qs) S[qs] = __builtin_amdgcn_mfma_f32_32x32x16_bf16(a, qf[qs][ks], S[qs], 0, 0, 0);
                    if (FLASH_PRIO) __builtin_amdgcn_s_setprio(0);
                }
                bf16x8 pf[QS][2];
#pragma unroll
                for (int qs = 0; qs < QS; ++qs) {
                    float p[16];
#pragma unroll
                    for (int i = 0; i < 16; ++i) { p[i] = __builtin_amdgcn_exp2f(S[qs][i]); l[qs] += p[i]; }
#pragma unroll
                    for (int s2 = 0; s2 < 2; ++s2) {
                        u32x4 pw; pw.x = cvtpk(p[8 * s2], p[8 * s2 + 1]); pw.y = cvtpk(p[8 * s2 + 2], p[8 * s2 + 3]); pw.z = cvtpk(p[8 * s2 + 4], p[8 * s2 + 5]); pw.w = cvtpk(p[8 * s2 + 6], p[8 * s2 + 7]);
                        pf[qs][s2] = __builtin_bit_cast(bf16x8, pw);
                    }
                }
#pragma unroll
                for (int s2 = 0; s2 < 2; ++s2)
#pragma unroll
                    for (int dt = 0; dt < DV / 32; ++dt) {
                        const bf16x8 a = *(const LAS bf16x8*)(vb + (32 * dt + r) * G::VP + (16 * (2 * kt + s2) + 8 * h) * 2);
                        if (FLASH_PRIO) __builtin_amdgcn_s_setprio(1);
#pragma unroll
                        for (int qs = 0; qs < QS; ++qs) O[qs][dt] = __builtin_amdgcn_mfma_f32_32x32x16_bf16(a, pf[qs][s2], O[qs][dt], 0, 0, 0);
                        if (FLASH_PRIO) __builtin_amdgcn_s_setprio(0);
                    }
            }
            __syncthreads();
        }
    }
    asm_vmwait<0>();
#pragma unroll
    for (int j = 0; j < PD; ++j) FD_FENCE(j);
#undef FD_LOAD
#undef FD_STORE
#undef FD_FENCE
#pragma unroll
    for (int qs = 0; qs < QS; ++qs) lsum[qs] = l[qs] + __shfl_xor(l[qs], 32);
}

__device__ __forceinline__ float* diff_park(const Params& p, int m, int head) {
    if (m == 0) return (float*)(p.ws + WS_H) + (size_t)head * R_ * 128;
    if (head == 0) return (float*)(p.ws + WS_QKV + 6 * E_SEG * 2);
    return (float*)(p.ws + WS_PARK) + (size_t)(head - 1) * R_ * 128;
}
__device__ __forceinline__ void diff_unit(const Params& p, const Bufs& B, LAS char* lds, int head, int qb) {
    const int tid = ltid(), wid = tid >> 6, lane = tid & 63, c = lane & 31, h = lane >> 5;
    const int r = qb * 256 + wid * 32 + c, nt = qb == 0 ? 256 / FLASH_TK : R_ / FLASH_TK;
    const float lam = B.scal[0];
    float* tmp = diff_park(p, 0, head) + (size_t)r * 128 + 4 * h;
    f32x16 Oa[1][4]; float la[1]; f32x16 (&O)[4] = Oa[0];
    flash_dense<64, 128, 1, FLASH_TK, FLASH_PD>(lds, B.qkv + O_QA + ((size_t)(2 * head) * R_ + r) * 64, B.qkv + O_KA + (size_t)(2 * head) * R_ * 64, B.qkv + O_VAT + (size_t)head * 128 * R_, nt, Oa, la);
    {
        const float inv = 1.f / la[0];
#pragma unroll
        for (int dt = 0; dt < 4; ++dt)
#pragma unroll
            for (int q = 0; q < 4; ++q) *(f32x4*)(tmp + 32 * dt + 8 * q) = (f32x4){O[dt][4 * q] * inv, O[dt][4 * q + 1] * inv, O[dt][4 * q + 2] * inv, O[dt][4 * q + 3] * inv};
    }
    flash_dense<64, 128, 1, FLASH_TK, FLASH_PD>(lds, B.qkv + O_QA + ((size_t)(2 * head + 1) * R_ + r) * 64, B.qkv + O_KA + (size_t)(2 * head + 1) * R_ * 64, B.qkv + O_VAT + (size_t)head * 128 * R_, nt, Oa, la);
    {
        const float inv = lam / la[0]; float ss = 0.f;
#pragma unroll
        for (int dt = 0; dt < 4; ++dt)
#pragma unroll
            for (int q = 0; q < 4; ++q) {
                const f32x4 o1 = *(const f32x4*)(tmp + 32 * dt + 8 * q);
#pragma unroll
                for (int e = 0; e < 4; ++e) { const float d = o1[e] - O[dt][4 * q + e] * inv; O[dt][4 * q + e] = d; ss += d * d; }
            }
        ss += __shfl_xor(ss, 32);
        const float rr = rsqrtf(ss * (1.f / 128.f) + EPS_) * 0.8f;
        bf16_t* dst = B.mix + (size_t)r * 1024 + head * 128 + 4 * h;
        const float* g = p.in[I_SUBLN] + 4 * h;
#pragma unroll
        for (int dt = 0; dt < 4; ++dt)
#pragma unroll
            for (int q = 0; q < 4; ++q) {
                const f32x4 gg = *(const f32x4*)(g + 32 * dt + 8 * q);
                *(uint2*)(dst + 32 * dt + 8 * q) = make_uint2(cvtpk(O[dt][4 * q] * rr * gg[0], O[dt][4 * q + 1] * rr * gg[1]), cvtpk(O[dt][4 * q + 2] * rr * gg[2], O[dt][4 * q + 3] * rr * gg[3]));
            }
    }
}
__device__ __forceinline__ void store_o64(bf16_t* dst, const f32x16 (&O)[2], float inv);
__device__ __forceinline__ void mla_unit(const Params& p, const Bufs& B, LAS char* lds, int head, int qb) {
    const int tid = ltid(), wid = tid >> 6, lane = tid & 63, c = lane & 31, h = lane >> 5;
    const int r = 256 + qb * 512 + wid * 64 + c;
    f32x16 O[2][2]; float l[2];
    flash_dense<96, 64, 2, MLA_TK, MLA_PD>(lds, B.qkv + O_MQ + ((size_t)head * R_ + r) * 96, B.qkv + O_MK + (size_t)head * R_ * 96, B.qkv + O_MVT + (size_t)head * 64 * R_, R_ / MLA_TK, O, l);
#pragma unroll
    for (int qs = 0; qs < 2; ++qs) store_o64(B.mix + (size_t)(r + 32 * qs) * 1024 + head * 64 + 4 * h, O[qs], 1.f / l[qs]);
}

__device__ __forceinline__ void diff_half_unit(const Params& p, const Bufs& B, LAS char* lds, int head, int m, int qb512) {
    const int tid = ltid(), wid = tid >> 6, lane = tid & 63, c = lane & 31, h = lane >> 5;
    const int r = 256 + qb512 * 512 + wid * 64 + c, sub = 2 * head + m;
    f32x16 O[2][4]; float l[2];
    flash_dense<64, 128, 2, DIFF_TK, DIFF_PD>(lds, B.qkv + O_QA + ((size_t)sub * R_ + r) * 64, B.qkv + O_KA + (size_t)sub * R_ * 64, B.qkv + O_VAT + (size_t)head * 128 * R_, R_ / DIFF_TK, O, l);
    float* park = diff_park(p, m, head);
#pragma unroll
    for (int qs = 0; qs < 2; ++qs) {
        const float inv = 1.f / l[qs];
        float* dst = park + (size_t)(r + 32 * qs) * 128 + 4 * h;
#pragma unroll
        for (int dt = 0; dt < 4; ++dt)
#pragma unroll
            for (int q = 0; q < 4; ++q) *(f32x4*)(dst + 32 * dt + 8 * q) = (f32x4){O[qs][dt][4 * q] * inv, O[qs][dt][4 * q + 1] * inv, O[qs][dt][4 * q + 2] * inv, O[qs][dt][4 * q + 3] * inv};
    }
}
__device__ __forceinline__ void phase_diff_combine(const Params& p, int bid, int nblk) {
    Bufs B(p);
    const int tid = ltid(), wid = tid >> 6, lane = tid & 63;
    const float lam = B.scal[0];
    const float2 g = *(const float2*)(p.in[I_SUBLN] + 2 * lane);
    for (int rp = bid * 8 + wid; rp < T_ / 2; rp += nblk * 8) {
        float2 a[8], b[8];
#pragma unroll
        for (int j = 0; j < 8; ++j) {
            const size_t o = (size_t)(256 + 2 * rp + (j >> 2)) * 128 + 2 * lane;
            a[j] = *(const float2*)(diff_park(p, 0, j & 3) + o); b[j] = *(const float2*)(diff_park(p, 1, j & 3) + o);
        }
#pragma unroll
        for (int j = 0; j < 8; ++j) {
            const float d0 = a[j].x - lam * b[j].x, d1 = a[j].y - lam * b[j].y;
            const float ss = wave_sum(d0 * d0 + d1 * d1);
            const float rr = rsqrtf(ss * (1.f / 128.f) + EPS_) * 0.8f;
            *(u32*)(B.mix + (size_t)(256 + 2 * rp + (j >> 2)) * 1024 + (j & 3) * 128 + 2 * lane) = cvtpk(d0 * rr * g.x, d1 * rr * g.y);
        }
    }
}
__device__ __forceinline__ void phase_attn0_dense(const Params& p, LAS char* lds, int bid, int nblk) {
    Bufs B(p);
    for (int u = bid; u < 256; u += nblk) diff_half_unit(p, B, lds, (u & 7) >> 1, u & 1, u >> 3);
}
__device__ __forceinline__ void phase_attn1_dense(const Params& p, LAS char* lds, int bid, int nblk) {
    Bufs B(p);
    for (int u = bid; u < 256; u += nblk) mla_unit(p, B, lds, u & 7, u >> 3);
}

template <int MODE>
__device__ __forceinline__ void flash_win(LAS char* lds, const bf16_t* __restrict__ qptr, const bf16_t* __restrict__ Kb, const bf16_t* __restrict__ VT, int lat0, int nlat, float c2,
                                          int qi  , int qcol, const LAS float* bl, f32x16 (&O)[2][2], float (&lsum)[2]) {
    typedef FlashGeom<64, 64> G;
    const int tid = ltid(), lane = tid & 63, r = lane & 31, h = lane >> 5;
    const int ntiles = 4 + nlat;
    bf16x8 qf[2][4];
#pragma unroll
    for (int qs = 0; qs < 2; ++qs)
#pragma unroll
        for (int ks = 0; ks < 4; ++ks) qf[qs][ks] = *(const bf16x8*)(qptr + qs * 32 * 64 + 16 * ks + 8 * h);
#pragma unroll
    for (int qs = 0; qs < 2; ++qs)
#pragma unroll
        for (int dt = 0; dt < 2; ++dt)
#pragma unroll
            for (int i = 0; i < 16; ++i) O[qs][dt][i] = 0.f;
    float l[2] = {0.f, 0.f};
    constexpr int PD = 3;
    u32x4 kreg[PD], vreg[PD];
    auto load_tile = [&](u32x4& kr, u32x4& vr, int t) { const int tt = t < ntiles ? t : ntiles - 1; const int at = tt < 4 ? tt : lat0 + (tt - 4);
        kr = *(const u32x4*)(Kb + (size_t)at * 64 * 64 + tid * 8); vr = *(const u32x4*)(VT + (size_t)(tid >> 3) * R_ + at * 64 + (tid & 7) * 8); };
    auto store_tile = [&](const u32x4& kr, const u32x4& vr, int buf) { LAS char* kb = lds + buf * G::STAGE; LAS char* vb = kb + G::KBYTES;
        *(LAS u32x4*)(kb + (tid >> 3) * G::KP + (tid & 7) * 16) = kr; *(LAS u32x4*)(vb + (tid >> 3) * G::VP + (tid & 7) * 16) = vr; };
    const int rs = MODE == 1 ? min(max(qi - 4, 0), 248) : 0;
    const int qlo = MODE == 2 ? __builtin_amdgcn_readfirstlane(qi - r) : 0;
#pragma unroll
    for (int qs = 0; qs < 2; ++qs)
#pragma unroll
        for (int ks = 0; ks < 4; ++ks) asm volatile("" : "+v"(qf[qs][ks]));
#pragma unroll
    for (int j = 0; j < PD; ++j) load_tile(kreg[j], vreg[j], j);
    store_tile(kreg[0], vreg[0], 0);
    load_tile(kreg[0], vreg[0], PD);
    __syncthreads();
    for (int t0 = 0; t0 < ntiles; t0 += PD) {
#pragma unroll
      for (int j = 0; j < PD; ++j) {
        const int t = t0 + j;
        if (t >= ntiles) break;
        if (t + 1 < ntiles) store_tile(kreg[(j + 1) % PD], vreg[(j + 1) % PD], (t + 1) & 1);
        load_tile(kreg[(j + 1) % PD], vreg[(j + 1) % PD], t + 1 + PD);
        const LAS char* kb = lds + (t & 1) * G::STAGE; const LAS char* vb = kb + G::KBYTES;
        const int lt = lat0 + (t - 4) - 4;
        bool active = true;
        if (t >= 4) { if (MODE == 1) active = lt >= rs && lt < rs + 8; else active = (64 * lt + 63 >= qlo - 128) && (64 * lt <= qlo + 63 + 128); }
        if (active) {
#pragma unroll
            for (int kt = 0; kt < 2; ++kt) {
                f32x16 S[2];
#pragma unroll
                for (int qs = 0; qs < 2; ++qs)
#pragma unroll
                    for (int i = 0; i < 16; ++i) S[qs][i] = 0.f;
#pragma unroll
                for (int ks = 0; ks < 4; ++ks) {
                    const bf16x8 a = *(const LAS bf16x8*)(kb + (32 * kt + r) * G::KP + (16 * ks + 8 * h) * 2);
#pragma unroll
                    for (int qs = 0; qs < 2; ++qs) S[qs] = __builtin_amdgcn_mfma_f32_32x32x16_bf16(a, qf[qs][ks], S[qs], 0, 0, 0);
                }
                bf16x8 pf[2][2];
#pragma unroll
                for (int qs = 0; qs < 2; ++qs) {
                    float p[16];
                    if (t < 4) {
#pragma unroll
                        for (int i = 0; i < 16; ++i) p[i] = __builtin_amdgcn_exp2f(S[qs][i] - c2);
                    } else if (MODE == 1) {
                        const int qc = qcol + 32 * qs, cs = min(max(qc - 8, 0), 48), vlo = cs - 4 * h;
                        const LAS float* brow = bl + ((lt - qi + 7) * 31 + 4 * h - qc + 15);
#pragma unroll
                        for (int i = 0; i < 16; ++i) {
                            const int kc0 = 32 * kt + (i & 3) + 8 * (i >> 2);
                            const float e = __builtin_amdgcn_exp2f(S[qs][i] + brow[kc0] - c2);
                            p[i] = (unsigned)(kc0 - vlo) < 16u ? e : 0.f;
                        }
                    } else {
                        const int d0 = 64 * lt + 4 * h - (qi + 32 * qs) + 128;
#pragma unroll
                        for (int i = 0; i < 16; ++i) {
                            const int kc0 = 32 * kt + (i & 3) + 8 * (i >> 2);
                            const float e = __builtin_amdgcn_exp2f(S[qs][i] - c2);
                            p[i] = (unsigned)(d0 + kc0) <= 256u ? e : 0.f;
                        }
                    }
#pragma unroll
                    for (int i = 0; i < 16; ++i) l[qs] += p[i];
#pragma unroll
                    for (int s2 = 0; s2 < 2; ++s2) {
                        u32x4 pw; pw.x = cvtpk(p[8 * s2], p[8 * s2 + 1]); pw.y = cvtpk(p[8 * s2 + 2], p[8 * s2 + 3]); pw.z = cvtpk(p[8 * s2 + 4], p[8 * s2 + 5]); pw.w = cvtpk(p[8 * s2 + 6], p[8 * s2 + 7]);
                        pf[qs][s2] = __builtin_bit_cast(bf16x8, pw);
                    }
                }
#pragma unroll
                for (int s2 = 0; s2 < 2; ++s2)
#pragma unroll
                    for (int dt = 0; dt < 2; ++dt) {
                        const bf16x8 a = *(const LAS bf16x8*)(vb + (32 * dt + r) * G::VP + (16 * (2 * kt + s2) + 8 * h) * 2);
#pragma unroll
                        for (int qs = 0; qs < 2; ++qs) O[qs][dt] = __builtin_amdgcn_mfma_f32_32x32x16_bf16(a, pf[qs][s2], O[qs][dt], 0, 0, 0);
                    }
            }
        }
        __syncthreads();
      }
    }
#pragma unroll
    for (int qs = 0; qs < 2; ++qs) lsum[qs] = l[qs] + __shfl_xor(l[qs], 32);
}
__device__ __forceinline__ void store_o64(bf16_t* dst  , const f32x16 (&O)[2], float inv) {
#pragma unroll
    for (int dt = 0; dt < 2; ++dt)
#pragma unroll
        for (int q = 0; q < 4; ++q)
            *(uint2*)(dst + 32 * dt + 8 * q) = make_uint2(cvtpk(O[dt][4 * q] * inv, O[dt][4 * q + 1] * inv), cvtpk(O[dt][4 * q + 2] * inv, O[dt][4 * q + 3] * inv));
}
constexpr int LDS_BIAS = 40960;
__device__ __forceinline__ void na_unit(const Params& p, const Bufs& B, LAS char* lds, int head, int qb) {
    const int tid = ltid(), wid = tid >> 6, lane = tid & 63, c = lane & 31, h = lane >> 5;
    LAS float* bl = (LAS float*)(lds + LDS_BIAS) + 64;
    __syncthreads();
    for (int e = tid; e < 64 + 465 + 128; e += NT) { const int j = e - 64; bl[j] = (j >= 0 && j < 465) ? p.in[I_RPB][head * 465 + j] * 1.4426950408889634f : 0.f; }
    int lat0 = 4, nlat = 0, grow = 0, r;
    if (qb > 0) { const int r0 = 8 * (qb - 1), ra = min(max(r0 - 4, 0), 248), rb = min(max(r0 + 7 - 4, 0), 248) + 8; lat0 = 4 + ra; nlat = rb - ra; grow = r0 + wid; r = 256 + grow * 64 + c; }
    else r = (wid & 3) * 64 + c;
    f32x16 O[2][2]; float l[2];
    flash_win<1>(lds, B.qkv + O_QB + ((size_t)head * R_ + r) * 64, B.qkv + O_KB + (size_t)head * R_ * 64, B.qkv + O_VBT + (size_t)head * 64 * R_, lat0, nlat, B.scal[3], grow, c, bl, O, l);
    if (qb > 0 || wid < 4) {
#pragma unroll
        for (int qs = 0; qs < 2; ++qs) store_o64(B.mix + (size_t)(r + 32 * qs) * 1024 + 512 + head * 64 + 4 * h, O[qs], 1.f / l[qs]);
    }
}
__device__ __forceinline__ void swa_unit(const Params& p, const Bufs& B, LAS char* lds, int hq, int qb) {
    const int tid = ltid(), wid = tid >> 6, lane = tid & 63, c = lane & 31, h = lane >> 5;
    const int t0 = qb * 512, tq = t0 + wid * 64 + c, r = 256 + tq, kvh = hq >> 2;
    const int ta = max(t0 / 64 - 2, 0), tb = min(t0 / 64 + 9, 255);
    f32x16 O[2][2]; float l[2];
    const float c2 = B.scal[4];
    flash_win<2>(lds, B.qkv + O_GQ + ((size_t)hq * R_ + r) * 64, B.qkv + O_GK + (size_t)kvh * R_ * 64, B.qkv + O_GVT + (size_t)kvh * 64 * R_, 4 + ta, tb - ta + 1, c2, tq, 0, nullptr, O, l);
    const float sk = __builtin_amdgcn_exp2f(p.in[I_SINK][hq] * 1.4426950408889634f - c2);
#pragma unroll
    for (int qs = 0; qs < 2; ++qs) store_o64(B.mix + (size_t)(r + 32 * qs) * 1024 + 512 + hq * 64 + 4 * h, O[qs], 1.f / (l[qs] + sk));
}
__device__ __forceinline__ void phase_attn0_win(const Params& p, LAS char* lds, int bid, int nblk) {
    Bufs B(p);
    for (int u = bid; u < 256; u += nblk) na_unit(p, B, lds, u & 7, 1 + (u >> 3));
}
__device__ __forceinline__ void phase_attn1_win(const Params& p, LAS char* lds, int bid, int nblk) {
    Bufs B(p);
    for (int u = bid; u < 256; u += nblk) swa_unit(p, B, lds, u & 7, u >> 3);
}

#define XB_TMO      128
#define XB_XCNT(j)  (256  + 64 * (j))
#define XB_XSUB(j)  (1280 + 64 * (j))
#define XB_XGEN(j)  (2304 + 64 * (j))
#define XB_TOP      3328
#define XB_TOPGEN   3392
#define XCD_BAR_WORDS 3456
#define XB_SPIN_CAP (1u << 20)
__device__ __forceinline__ unsigned xb_ld(unsigned* p)              { return __hip_atomic_load(p, __ATOMIC_RELAXED, __HIP_MEMORY_SCOPE_AGENT); }
__device__ __forceinline__ unsigned xb_add(unsigned* p, unsigned v) { return __hip_atomic_fetch_add(p, v, __ATOMIC_RELAXED, __HIP_MEMORY_SCOPE_AGENT); }
__device__ __forceinline__ unsigned xb_xcc_id() { return (unsigned)__builtin_amdgcn_s_getreg((3 << 11) | 20) & 0xFu; }
#define XB_SPIN(cond, bar) do { unsigned _sp = 0; while (cond) { __builtin_amdgcn_s_sleep(1); \
    if ((++_sp & 255u) == 0u) { if (xb_ld(&(bar)[XB_TMO])) break; if (_sp > XB_SPIN_CAP) { atomicAdd(&(bar)[XB_TMO], 1u); break; } } } } while (0)
struct XcdBarrier { unsigned* bar; unsigned x; volatile LAS unsigned* st; };
__device__ __forceinline__ XcdBarrier xcd_barrier_post(unsigned* bar, volatile LAS unsigned* st) {
    XcdBarrier b; b.bar = bar; b.x = xb_xcc_id(); b.st = st;
    if (threadIdx.x == 0) (void)xb_add(&bar[XB_XCNT(b.x)], 1u);
    return b;
}
__device__ __forceinline__ void xcd_barrier_complete(unsigned* bar, unsigned x, unsigned& nloc, unsigned& nx) {
    const unsigned G = gridDim.x * gridDim.y * gridDim.z;
    unsigned sum, cnt, mine, sp = 0u;
    for (;;) {
        sum = 0u; cnt = 0u; mine = 0u;
#pragma unroll
        for (unsigned j = 0; j < 16; ++j) { const unsigned c = xb_ld(&bar[XB_XCNT(j)]); sum += c; cnt += (c > 0u) ? 1u : 0u; mine = (j == x) ? c : mine; }
        if (sum == G) break;
        __builtin_amdgcn_s_sleep(1);
        if ((++sp & 255u) == 0u) { if (xb_ld(&bar[XB_TMO])) break; if (sp > XB_SPIN_CAP) { atomicAdd(&bar[XB_TMO], 1u); break; } }
    }
    nloc = mine > 0u ? mine : 1u; nx = cnt > 0u ? cnt : 1u;
}
__device__ __forceinline__ void xcd_barrier(const XcdBarrier& b) {
    asm volatile("s_waitcnt vmcnt(0)" ::: "memory");
    __syncthreads();
    if (threadIdx.x == 0) {
        unsigned* bar = b.bar;
        __builtin_amdgcn_s_waitcnt(0);
        unsigned nloc = b.st[0], nx = b.st[1];
        if (nloc == 0u) { xcd_barrier_complete(bar, b.x, nloc, nx); b.st[0] = nloc; b.st[1] = nx; }
        const unsigned old = xb_add(&bar[XB_XSUB(b.x)], 1u);
        const unsigned gen = old / nloc;
        if (old + 1u == (gen + 1u) * nloc) {
            __builtin_amdgcn_fence(__ATOMIC_RELEASE, "agent");
            asm volatile("s_waitcnt vmcnt(0)" ::: "memory");
            const unsigned og = xb_add(&bar[XB_TOP], 1u);
            const unsigned tg = og / nx;
            if (og + 1u == (tg + 1u) * nx) xb_add(&bar[XB_TOPGEN], 1u);
            else XB_SPIN(xb_ld(&bar[XB_TOPGEN]) == tg, bar);
            xb_add(&bar[XB_XGEN(b.x)], 1u);
            __builtin_amdgcn_fence(__ATOMIC_ACQUIRE, "agent");
            asm volatile("s_waitcnt vmcnt(0)" ::: "memory");
        } else {
            XB_SPIN(xb_ld(&bar[XB_XGEN(b.x)]) == gen, bar);
            __builtin_amdgcn_fence(__ATOMIC_ACQUIRE, "agent");
            asm volatile("s_waitcnt vmcnt(0)" ::: "memory");
        }
    }
    __syncthreads();
}

__device__ __forceinline__ void run_phase(int ph, const Params& p, char* lds, int bid, int nblk) {
    LAS unsigned char* l3 = (LAS unsigned char*)lds;
    switch (ph) {
        case 0: phase_prep(p, lds, bid, nblk); __syncthreads();   phase_prep_weights(p, lds, bid, nblk); break;
        case 1: phase_norm(p, 0, 0, bid, nblk); break;
        case 2: g_qkv0(p, l3); phase_prep_weights_rest(p, lds); break;
        case 3: phase_attn0_dense(p, (LAS char*)lds, bid, nblk); break;
        case 16: {
            Bufs B(p);
            if (bid < 4) diff_unit(p, B, (LAS char*)lds, bid, 0);
            else if (bid < 12) na_unit(p, B, (LAS char*)lds, bid - 4, 0);
            else phase_diff_combine(p, bid - 12, nblk - 12);
            phase_attn0_win(p, (LAS char*)lds, bid, nblk); } break;
        case 4: g_out(p, 0, l3); break;
        case 5: phase_norm(p, 0, 1, bid, nblk); break;
        case 6: g_up(p, 0, l3); break;
        case 7: g_down(p, 0, l3); break;
        case 8: phase_norm(p, 1, 0, bid, nblk); break;
        case 9: g_qkv1a(p, l3); break;
        case 10: g_qkv1b(p, l3); break;
        case 11: phase_attn1_dense(p, (LAS char*)lds, bid, nblk); phase_attn1_win(p, (LAS char*)lds, bid, nblk); break;
        case 12: g_out(p, 1, l3); break;
        case 13: phase_norm(p, 1, 1, bid, nblk); break;
        case 14: g_up(p, 1, l3); break;
        case 15: g_down(p, 1, l3); break;
    }
}

namespace cg = cooperative_groups;
__global__ void __launch_bounds__(NT, 2) k_mega(Params p) {
    extern __shared__ __attribute__((aligned(16))) char smem[];
    cg::grid_group grid = cg::this_grid();
    const int bid = blockIdx.x, nblk = gridDim.x;
    volatile LAS unsigned* st = (volatile LAS unsigned*)((LAS char*)smem + LDS_BYTES - 16);
    if (threadIdx.x < 2) st[threadIdx.x] = 0u;
    __syncthreads();
    const XcdBarrier xb = xcd_barrier_post((unsigned*)(p.ws + WS_CTL), st);
#define SYNC() xcd_barrier(xb)
#define PH(n) run_phase(n, p, smem, bid, nblk)
    PH(0); if (p.out == nullptr) grid.sync(); SYNC(); PH(1); SYNC(); PH(2); SYNC(); PH(3); SYNC(); PH(16); SYNC(); PH(4); SYNC(); PH(5); SYNC(); PH(6); SYNC(); PH(7); SYNC();
    PH(8); SYNC(); PH(9); SYNC(); PH(10); SYNC(); PH(11); SYNC(); PH(12); SYNC(); PH(13); SYNC(); PH(14); SYNC(); PH(15);
#undef PH
}

extern "C" void kernel_launch(void* const* d_in, const int* in_sizes, int n_in, void* d_out, int out_size, void* d_ws, size_t ws_size, hipStream_t stream) {
    Params p{};
    for (int i = 0; i < 35; ++i) p.in[i] = (const float*)d_in[i];
    p.out = (float*)d_out; p.ws = (char*)d_ws;
    if (ws_size < WS_END) { fprintf(stderr, "ws too small: %zu < %zu\n", ws_size, (size_t)WS_END); return; }
    static int grid_blocks = 0;
    if (!grid_blocks) {
        int dev = 0, cus = 0, per_cu = 0;
        hipGetDevice(&dev);
        hipDeviceGetAttribute(&cus, hipDeviceAttributeMultiprocessorCount, dev);
        if (hipFuncSetAttribute((const void*)k_mega, hipFuncAttributeMaxDynamicSharedMemorySize, LDS_BYTES) != hipSuccess) fprintf(stderr, "hipFuncSetAttribute failed\n");
        hipOccupancyMaxActiveBlocksPerMultiprocessor(&per_cu, (const void*)k_mega, NT, LDS_BYTES);
        if (per_cu < 1) { fprintf(stderr, "occupancy query returned %d\n", per_cu); per_cu = 1; }
        if (per_cu > 1) per_cu = 1;
        grid_blocks = cus * per_cu;
    }
    if (hipMemsetAsync((char*)d_ws + WS_CTL, 0, 16384, stream) != hipSuccess) fprintf(stderr, "memset failed\n");
    void* args[] = {&p};
    hipError_t e = hipLaunchCooperativeKernel((const void*)k_mega, dim3(grid_blocks), dim3(NT), args, LDS_BYTES, stream);
    if (e != hipSuccess) fprintf(stderr, "cooperative launch failed: %s (grid %d)\n", hipGetErrorString(e), grid_blocks);
}
```

```cpp
#include <hip/hip_runtime.h>
#include <hip/hip_cooperative_groups.h>
#include <cstdint>
#include <cstdio>
#include <cmath>

typedef unsigned short bf16_t;
__device__ __forceinline__ int ltid() { int t = threadIdx.x; asm volatile("" : "+v"(t)); return t; }
typedef unsigned int u32;
typedef u32 u32x4 __attribute__((ext_vector_type(4)));

#define NT 512
constexpr int T_ = 16384, L_ = 256, R_ = 16640, D_ = 1024, F_ = 2816, F2_ = 5632;
constexpr float EPS_ = 1e-6f;

constexpr size_t WS_CTL = 0;
constexpr size_t WS_MOD = 16384;
constexpr size_t WS_SCAL = WS_MOD + 2 * 2 * 6144 * 4;
constexpr size_t WS_GT = WS_SCAL + 256;
constexpr size_t WS_ROPE = WS_GT + 6 * 64 * 4;
constexpr size_t WS_XC = WS_ROPE + 256 * 16 * 2 * 4;
constexpr size_t WS_H = WS_XC + 256 * 1024 * 4;
constexpr int HROWS = R_ + 144;
constexpr size_t WS_MIX = WS_H + (size_t)HROWS * 1024 * 2;
constexpr size_t WS_QKV = WS_MIX + (size_t)R_ * 1024 * 2;
constexpr size_t E_SEG = (size_t)512 * R_;
constexpr size_t O_QA = 0, O_KA = E_SEG, O_VAT = 2 * E_SEG, O_QB = 3 * E_SEG, O_KB = 4 * E_SEG, O_VBT = 5 * E_SEG;
constexpr size_t O_CQ = 0, O_CKV = O_CQ + (size_t)R_ * 384, O_CKR = O_CKV + (size_t)R_ * 256, O_MQ = O_CKR + (size_t)R_ * 32,
                 O_MK = O_MQ + (size_t)R_ * 768, O_MVT = O_MK + (size_t)R_ * 768, O_GQ = O_MVT + (size_t)R_ * 512,
                 O_GK = O_GQ + (size_t)R_ * 512, O_GVT = O_GK + (size_t)R_ * 128, O_L1END = O_GVT + (size_t)R_ * 128;
constexpr size_t WS_QKV_BYTES = O_L1END * 2;
constexpr size_t WS_PART = WS_QKV + WS_QKV_BYTES;
constexpr size_t WS_WT = WS_PART + (size_t)R_ * 12 * 4;
constexpr size_t W_EIN = 0, W_EOUT = W_EIN + (size_t)3072 * 1024, W_UP = W_EOUT + (size_t)1024 * 1024, W_DOWN = W_UP + (size_t)2 * 5632 * 1024,
                 W_OIN = W_DOWN + (size_t)2 * 1024 * 2816, W_OOUT = W_OIN + (size_t)1536 * 1024, W_QB = W_OOUT + (size_t)1024 * 1024,
                 W_KVB = W_QB + (size_t)1024 * 384, W_END = W_KVB + (size_t)1024 * 256;
constexpr size_t WS_PARK = ((WS_WT + W_END * 2 + 255) / 256) * 256;
constexpr size_t WS_END = WS_PARK + (size_t)3 * R_ * 128 * 4;
static_assert(WS_END <= (size_t)256 * 1024 * 1024, "ws");
constexpr size_t WS_PARTC = WS_QKV + (((size_t)(R_ + 8) * F_ * 2 + 255) / 256) * 256;
static_assert(WS_PARTC + (size_t)11 * 256 * 1024 * 4 <= WS_QKV + WS_QKV_BYTES, "act + partials alias");

struct Params { const float* in[35]; float* out; char* ws; };
enum { I_X = 0, I_C, I_CTX, I_CCTX, I_ADAW, I_ADAB, I_NMIX, I_NFFN, I_FUP, I_FCW, I_FCB, I_FDOWN, I_EWIN, I_EWOUT, I_AQN, I_AKN,
       I_LQ1, I_LK1, I_LQ2, I_LK2, I_SUBLN, I_BQN, I_BKN, I_RPB, I_OWIN, I_OWOUT, I_CQAN, I_CWQB, I_CKVAN, I_CWKVB, I_CQN, I_CKN,
       I_DQN, I_DKN, I_SINK };

__device__ __forceinline__ float bf2f(bf16_t v) { return __uint_as_float(((u32)v) << 16); }
__device__ __forceinline__ bf16_t f2bf(float f) { u32 u = __float_as_uint(f); return (bf16_t)((u + 0x7fffu + ((u >> 16) & 1u)) >> 16); }
typedef __bf16 bf16x2_t __attribute__((ext_vector_type(2)));
typedef float f32x2_t __attribute__((ext_vector_type(2)));
__device__ __forceinline__ u32 cvtpk(float lo, float hi) { const f32x2_t v = {lo, hi}; const bf16x2_t b = __builtin_convertvector(v, bf16x2_t); return __builtin_bit_cast(u32, b); }
__device__ __forceinline__ u32 pk2(float lo, float hi) { return cvtpk(lo, hi); }
__device__ __forceinline__ float wave_sum(float v) {
#pragma unroll
    for (int o = 32; o > 0; o >>= 1) v += __shfl_xor(v, o);
    return v;
}
__device__ __forceinline__ int swap23(int p) { return (p & 3) | ((p & 4) << 1) | ((p & 8) >> 1); }
__device__ __forceinline__ int hrow(int r) { return r < 256 ? r + 1 : r + 2; }
__device__ __forceinline__ int vpos(int key) { return (key & ~15) + swap23(key & 15); }
__device__ __forceinline__ void unpack8(u32x4 v, float (&a)[8]) {
    a[0] = __uint_as_float(v.x << 16); a[1] = __uint_as_float(v.x & 0xffff0000u);
    a[2] = __uint_as_float(v.y << 16); a[3] = __uint_as_float(v.y & 0xffff0000u);
    a[4] = __uint_as_float(v.z << 16); a[5] = __uint_as_float(v.z & 0xffff0000u);
    a[6] = __uint_as_float(v.w << 16); a[7] = __uint_as_float(v.w & 0xffff0000u);
}

struct Bufs {
    float* mod; float* scal; float* rope; float* xc; bf16_t* h; bf16_t* mix; bf16_t* qkv; bf16_t* act; float* part; bf16_t* wt; float* gt; float* partc;
    __device__ Bufs(const Params& p) {
        mod = (float*)(p.ws + WS_MOD); scal = (float*)(p.ws + WS_SCAL); rope = (float*)(p.ws + WS_ROPE); xc = (float*)(p.ws + WS_XC);
        h = (bf16_t*)(p.ws + WS_H); mix = (bf16_t*)(p.ws + WS_MIX); qkv = (bf16_t*)(p.ws + WS_QKV); act = (bf16_t*)(p.ws + WS_QKV);
        part = (float*)(p.ws + WS_PART); wt = (bf16_t*)(p.ws + WS_WT); gt = (float*)(p.ws + WS_GT); partc = (float*)(p.ws + WS_PARTC);
    }
};
__device__ __forceinline__ const float* modp(const Bufs& B, int l, int s, int chunk) { return B.mod + ((size_t)(l * 2 + s) * 6144) + chunk * 1024; }

__device__ __forceinline__ void phase_prep(const Params& p, char* lds, int bid, int nblk) {
    Bufs B(p);
    float* sil = (float*)lds;
    float* red = (float*)lds + 2048;
    const int tid = ltid();
    for (int e = bid * NT + tid; e < 256 * 1024 / 4; e += nblk * NT) ((float4*)B.xc)[e] = ((const float4*)p.in[I_CTX])[e];
    for (int item = bid; item < 208; item += nblk) {
        if (item < 192) {
            __syncthreads();
            for (int k = tid; k < 2048; k += NT) { const float c = k < 1024 ? p.in[I_C][k] : p.in[I_CCTX][k - 1024]; sil[k] = c / (1.f + __expf(-c)); }
            __syncthreads();
            const int l = item / 96, n0 = (item % 96) * 64, q = tid & 15, kc = tid >> 4;
            const float* W = p.in[I_ADAW] + (size_t)l * 1024 * 6144 + n0 + 4 * q;
            float4 a0 = make_float4(0.f, 0.f, 0.f, 0.f), a1 = a0;
#pragma unroll 8
            for (int k = kc * 32; k < kc * 32 + 32; ++k) {
                const float4 w = *(const float4*)(W + (size_t)k * 6144);
                const float s0 = sil[k], s1 = sil[1024 + k];
                a0.x += s0 * w.x; a0.y += s0 * w.y; a0.z += s0 * w.z; a0.w += s0 * w.w;
                a1.x += s1 * w.x; a1.y += s1 * w.y; a1.z += s1 * w.z; a1.w += s1 * w.w;
            }
            float* rp = red + (kc * 16 + q) * 8;
            *(float4*)rp = a0; *(float4*)(rp + 4) = a1;
            __syncthreads();
            if (tid < 128) {
                const int n = tid & 63, sidx = tid >> 6; float acc = 0.f;
                for (int k = 0; k < 32; ++k) acc += red[(k * 16 + (n >> 2)) * 8 + sidx * 4 + (n & 3)];
                B.mod[(size_t)(l * 2 + sidx) * 6144 + n0 + n] = acc + p.in[I_ADAB][l * 6144 + n0 + n];
            }
        } else {
            if (tid < 256) { const int e = (item - 192) * 256 + tid;
                const int pos = e >> 4, i = e & 15;
                const double f = pow(10000.0, -(double)i / 16.0), ang = (double)pos * f;
                B.rope[e * 2] = (float)cos(ang); B.rope[e * 2 + 1] = (float)sin(ang);
            }
            if (item == 192 && tid < 64) {
                B.gt[tid] = p.in[I_AQN][tid]; B.gt[64 + tid] = p.in[I_AKN][tid]; B.gt[128 + tid] = p.in[I_BQN][tid]; B.gt[192 + tid] = p.in[I_BKN][tid];
                B.gt[256 + tid] = p.in[I_DQN][tid]; B.gt[320 + tid] = p.in[I_DKN][tid];
                const float s1 = wave_sum(p.in[I_LQ1][tid] * p.in[I_LK1][tid]), s2 = wave_sum(p.in[I_LQ2][tid] * p.in[I_LK2][tid]);
                if (tid == 0) B.scal[0] = expf(s1) - expf(s2) + 0.2f;
                float ma = fabsf(p.in[I_AQN][tid]), mb = fabsf(p.in[I_AKN][tid]), mc = fmaxf(fabsf(p.in[I_CQN][tid]), tid < 32 ? fabsf(p.in[I_CQN][64 + tid]) : 0.f),
                      md = fmaxf(fabsf(p.in[I_CKN][tid]), tid < 32 ? fabsf(p.in[I_CKN][64 + tid]) : 0.f);
#pragma unroll
                for (int o = 32; o > 0; o >>= 1) { ma = fmaxf(ma, __shfl_xor(ma, o)); mb = fmaxf(mb, __shfl_xor(mb, o)); mc = fmaxf(mc, __shfl_xor(mc, o)); md = fmaxf(md, __shfl_xor(md, o)); }
                if (tid == 0) { B.scal[1] = 8.f * ma * mb * 1.4426950408889634f; B.scal[2] = 9.797958971132712f * mc * md * 1.4426950408889634f; }
                float na = fabsf(p.in[I_BQN][tid]), nb = fabsf(p.in[I_BKN][tid]), nc = fabsf(p.in[I_DQN][tid]), nd = fabsf(p.in[I_DKN][tid]), nr = 0.f, ns = tid < 8 ? p.in[I_SINK][tid] : -1e30f;
                for (int e = tid; e < 8 * 465; e += 64) nr = fmaxf(nr, fabsf(p.in[I_RPB][e]));
#pragma unroll
                for (int o = 32; o > 0; o >>= 1) { na = fmaxf(na, __shfl_xor(na, o)); nb = fmaxf(nb, __shfl_xor(nb, o)); nc = fmaxf(nc, __shfl_xor(nc, o)); nd = fmaxf(nd, __shfl_xor(nd, o));
                                                   nr = fmaxf(nr, __shfl_xor(nr, o)); ns = fmaxf(ns, __shfl_xor(ns, o)); }
                if (tid == 0) { B.scal[3] = (8.f * na * nb + nr) * 1.4426950408889634f; B.scal[4] = fmaxf(8.f * nc * nd, ns) * 1.4426950408889634f; }
            }
        }
    }
}

__device__ __forceinline__ void phase_norm(const Params& p, int l, int which, int bid, int nblk) {
    Bufs B(p);
    const int wid = ltid() >> 6, lane = ltid() & 63;
    const float* gamma = p.in[which ? I_NFFN : I_NMIX] + l * 1024;
    for (int e = bid * NT + ltid(); e < (2 + HROWS - (R_ + 2)) * 128; e += nblk * NT) {
        const int rr = e >> 7, c = e & 127; const int rho = rr == 0 ? 0 : rr == 1 ? 257 : R_ + 2 + (rr - 2);
        *(u32x4*)(B.h + (size_t)rho * 1024 + c * 8) = (u32x4){0u, 0u, 0u, 0u};
    }
    const bool first = (l == 0 && which == 0);
    for (int seg = 0; seg < 2; ++seg) {
        if (seg == 0 && l == 1 && which == 1) continue;
        const float* sh = modp(B, l, seg == 0 ? 1 : 0, which ? 3 : 0); const float* sc = modp(B, l, seg == 0 ? 1 : 0, which ? 4 : 1);
        float ca[16], cb[16];
#pragma unroll
        for (int i = 0; i < 4; ++i) {
            const int k = i * 256 + lane * 4;
            const float4 g4 = *(const float4*)(gamma + k), s4 = *(const float4*)(sc + k), h4 = *(const float4*)(sh + k);
            ca[4 * i] = g4.x * (1.f + s4.x); ca[4 * i + 1] = g4.y * (1.f + s4.y); ca[4 * i + 2] = g4.z * (1.f + s4.z); ca[4 * i + 3] = g4.w * (1.f + s4.w);
            cb[4 * i] = h4.x; cb[4 * i + 1] = h4.y; cb[4 * i + 2] = h4.z; cb[4 * i + 3] = h4.w;
        }
        const int r_lo = seg == 0 ? 0 : 256, r_hi = seg == 0 ? 256 : R_;
        const int nks = 0;
        const int rstep = nblk * 8;
        int r = r_lo + bid * 8 + wid;
        float4 cur[4];
        if (r < r_hi) {
            const float* src = r < 256 ? ((first ? p.in[I_CTX] : B.xc) + (size_t)r * 1024) : ((first ? p.in[I_X] : p.out) + (size_t)(r - 256) * 1024);
#pragma unroll
            for (int i = 0; i < 4; ++i) cur[i] = *(const float4*)(src + i * 256 + lane * 4);
        }
        for (; r < r_hi; r += rstep) {
            const int rn = r + rstep;
            float4 nx[4];
            if (rn < r_hi) {
                const float* src = rn < 256 ? ((first ? p.in[I_CTX] : B.xc) + (size_t)rn * 1024) : ((first ? p.in[I_X] : p.out) + (size_t)(rn - 256) * 1024);
#pragma unroll
                for (int i = 0; i < 4; ++i) nx[i] = *(const float4*)(src + i * 256 + lane * 4);
            }
            float v[16]; float ss = 0.f;
#pragma unroll
            for (int i = 0; i < 4; ++i) {
                float4 t = cur[i];
                for (int kc = 0; kc < nks; ++kc) { const float4 q = *(const float4*)(B.partc + ((size_t)kc * 256 + r) * 1024 + i * 256 + lane * 4); t.x += q.x; t.y += q.y; t.z += q.z; t.w += q.w; }
                if (nks) *(float4*)(B.xc + (size_t)r * 1024 + i * 256 + lane * 4) = t;
                v[4 * i] = t.x; v[4 * i + 1] = t.y; v[4 * i + 2] = t.z; v[4 * i + 3] = t.w; ss += t.x * t.x + t.y * t.y + t.z * t.z + t.w * t.w; }
            ss = wave_sum(ss);
            const float rr = rsqrtf(ss * (1.f / 1024.f) + EPS_);
#pragma unroll
            for (int i = 0; i < 4; ++i) {
                const int k = i * 256 + lane * 4;
                *(uint2*)(B.h + (size_t)hrow(r) * 1024 + k) = make_uint2(pk2(v[4 * i] * rr * ca[4 * i] + cb[4 * i], v[4 * i + 1] * rr * ca[4 * i + 1] + cb[4 * i + 1]),
                                                                        pk2(v[4 * i + 2] * rr * ca[4 * i + 2] + cb[4 * i + 2], v[4 * i + 3] * rr * ca[4 * i + 3] + cb[4 * i + 3]));
            }
#pragma unroll
            for (int i = 0; i < 4; ++i) cur[i] = nx[i];
        }
    }
}

#define LAS __attribute__((address_space(3)))
typedef short bf16x8 __attribute__((ext_vector_type(8)));
typedef float f32x4 __attribute__((ext_vector_type(4)));
constexpr int LDS_STAGE = 131072, LDS_XCH = LDS_STAGE, LDS_BYTES = 147456;


namespace pg8 {
constexpr int BM = 256, BK = 64, HALF = 128, HTB = HALF * BK * 2, NXCD = 8, WGM = 8;
__host__ __device__ __forceinline__ int lds_byte(int r, int c) { const int st = (r >> 4) * 2 + (c >> 5), rr = r & 15, cc = c & 31, ob = rr * 64 + cc * 2; return st * 1024 + (ob ^ (((ob >> 9) & 1) << 5)); }
__host__ __device__ __forceinline__ void stage_rc(int b, int& R, int& C) { const int st = b / 1024, sb = b % 1024, swz = sb ^ (((sb >> 9) & 1) << 5); R = (st >> 1) * 16 + swz / 64; C = (st & 1) * 32 + (swz % 64) / 2; }
struct Unit { int pm, pn, koff; };
struct Gemm { const bf16_t* A; const bf16_t* Bt; int K; int ld; int rperm = 0; };
struct Order {
    int nM, nN, nwg, G, c, pm0, amode, nNr, kchunk;
    __device__ void init(int nM_, int nN_, int G_, int c_, int pm0_, int amode_, int ksplit = 1, int kchunk_ = 0) { nM = nM_; nNr = nN_; nN = nN_ * ksplit; nwg = nM * nN; G = G_; c = c_; pm0 = pm0_; amode = amode_; kchunk = kchunk_; }
    __device__ bool next(int i, Unit& u) const {
        const long L = (long)i * G + c; if (L >= nwg) return false;
        int wgid = (int)L; { const int q = nwg / NXCD, r = nwg % NXCD, xcd = wgid % NXCD, off = wgid / NXCD; wgid = (xcd < r ? xcd * (q + 1) : r * (q + 1) + (xcd - r) * q) + off; }
        const int nig = WGM * nN, gid = wgid / nig, fm = gid * WGM, gsz = (nM - fm) < WGM ? (nM - fm) : WGM;
        u.pm = pm0 + fm + ((wgid % nig) % gsz); const int slot = (wgid % nig) / gsz; u.pn = slot % nNr; u.koff = (slot / nNr) * kchunk; return true;
    }
    __device__ __forceinline__ int arow(int pm) const { return amode == 0 ? 256 * pm : amode == 1 ? (pm == 0 ? 1 : 2 + 256 * pm) : (pm < 2 ? 254 * pm : 257 + 254 * (pm - 2)); }
    __device__ __forceinline__ void a_ready(const Unit&) const {}
    __device__ __forceinline__ void done(const Unit&) const {}
};

template <class Epi, class Sched, bool ALIGN_EPI, bool SP2>
__device__ __forceinline__ void gemm_phase(LAS unsigned char* lds, const Gemm g, const Sched& S, const Epi& E) {
    const int tid = ltid(), wid = __builtin_amdgcn_readfirstlane(tid >> 6), lane = tid & 63, wr = wid >> 2, wc = wid & 3, fr = lane & 15, fq = lane >> 4;
    int K_ = g.K; asm volatile("" : "+s"(K_));
    const int K = K_, nt = K / BK, ld = g.ld;
    unsigned voffA[2], voffB[2];
#pragma unroll
    for (int i = 0; i < 2; ++i) { int R, C; stage_rc(tid * 16 + i * 8192, R, C); const int Ra = g.rperm ? ((R & 64) | (4 * (R & 15) + ((R >> 4) & 3))) : R; voffA[i] = (unsigned)(Ra * ld + C) * 2u; voffB[i] = (unsigned)(R * ld + C) * 2u; }
    const size_t kstep = (size_t)(BK * 2);
    const size_t hstep = (size_t)HALF * ld * 2;
    const size_t tstep = 2 * hstep;
    const size_t rstep = (size_t)ld * 2;
    const unsigned ldsw = (unsigned)wid * 1024u;
    const int aoff = lds_byte(wr * 64 + fr, fq * 8), boff = lds_byte(wc * 32 + fr, fq * 8);
#define PG8_SA(b, h) (((b) * 2 + (h)) * HTB)
#define PG8_SB(b, h) ((4 + (b) * 2 + (h)) * HTB)
#define PG8_STAGE(bufoff, gbase, voff) do { _Pragma("unroll") for (int _i = 0; _i < 2; ++_i) \
        __builtin_amdgcn_global_load_lds((const unsigned*)((const char*)(gbase) + (voff)[_i]), (LAS unsigned*)(lds + (bufoff) + ldsw + _i * 8192), 16, 0, 0); } while (0)
#define PG8_LDA(dst, b, h) do { _Pragma("unroll") for (int m = 0; m < 4; ++m) _Pragma("unroll") for (int k = 0; k < 2; ++k) dst[m][k] = *(const LAS bf16x8*)(lds + PG8_SA(b, h) + aoff + m * 2048 + k * 1024); } while (0)
#define PG8_LDB(dst, b, h) do { _Pragma("unroll") for (int n = 0; n < 2; ++n) _Pragma("unroll") for (int k = 0; k < 2; ++k) dst[n][k] = *(const LAS bf16x8*)(lds + PG8_SB(b, h) + boff + n * 2048 + k * 1024); } while (0)
#define PG8_MMA(ai, bj, At, Bt) do { __builtin_amdgcn_s_setprio(1); _Pragma("unroll") for (int m = 0; m < 4; ++m) _Pragma("unroll") for (int n = 0; n < 2; ++n) _Pragma("unroll") for (int k = 0; k < 2; ++k) \
        acc[ai][bj][m][n] = __builtin_amdgcn_mfma_f32_16x16x32_bf16(Bt[n][k], At[m][k], acc[ai][bj][m][n], 0, 0, 0); __builtin_amdgcn_s_setprio(0); } while (0)
#define PG8_WAIT_V(n) asm volatile("s_waitcnt vmcnt(" #n ")" ::: "memory")
#define PG8_WAIT_L(n) asm volatile("s_waitcnt lgkmcnt(" #n ")" ::: "memory")
#define PG8_BAR __builtin_amdgcn_s_barrier()
#define PG8_SCHED __builtin_amdgcn_sched_barrier(0)
    Unit cur, nxt; int ui = 0;
    if (!S.next(0, cur)) return;
    f32x4 acc[2][2][4][2];
#pragma unroll
    for (int a = 0; a < 2; ++a)
#pragma unroll
        for (int b = 0; b < 2; ++b)
#pragma unroll
            for (int m = 0; m < 4; ++m)
#pragma unroll
                for (int n = 0; n < 2; ++n) acc[a][b][m][n] = (f32x4){0.f, 0.f, 0.f, 0.f};
    bf16x8 At[4][2], B0[2][2], B1[2][2];
    const char* cA = (const char*)g.A + (size_t)S.arow(cur.pm) * rstep + (size_t)cur.koff * 2; const char* cB = (const char*)g.Bt + (size_t)cur.pn * tstep + (size_t)cur.koff * 2;
    S.a_ready(cur);
    if constexpr (SP2) {
        PG8_STAGE(PG8_SB(0, 0), cB, voffB); PG8_STAGE(PG8_SB(0, 1), cB + hstep, voffB); PG8_STAGE(PG8_SA(0, 0), cA, voffA); PG8_STAGE(PG8_SA(0, 1), cA + hstep, voffA);
        if (wr == 1) PG8_BAR;
        PG8_WAIT_V(2); PG8_BAR;
        PG8_STAGE(PG8_SB(1, 0), cB + kstep, voffB); PG8_STAGE(PG8_SA(1, 0), cA + kstep, voffA); PG8_STAGE(PG8_SB(1, 1), cB + hstep + kstep, voffB);
        PG8_WAIT_V(6); PG8_BAR;
    } else {
        PG8_STAGE(PG8_SB(0, 0), cB, voffB); PG8_STAGE(PG8_SA(0, 0), cA, voffA); PG8_STAGE(PG8_SB(0, 1), cB + hstep, voffB); PG8_STAGE(PG8_SA(0, 1), cA + hstep, voffA);
        if (wr == 1) PG8_BAR;
        PG8_WAIT_V(4); PG8_BAR;
        PG8_STAGE(PG8_SB(1, 0), cB + kstep, voffB); PG8_STAGE(PG8_SA(1, 0), cA + kstep, voffA); PG8_STAGE(PG8_SB(1, 1), cB + hstep + kstep, voffB);
        PG8_WAIT_V(6); PG8_BAR;
    }
    for (;;) {
        const bool has_next = S.next(ui + 1, nxt);
        const char* nA = has_next ? (const char*)g.A + (size_t)S.arow(nxt.pm) * rstep + (size_t)nxt.koff * 2 : cA; const char* nB = has_next ? (const char*)g.Bt + (size_t)nxt.pn * tstep + (size_t)nxt.koff * 2 : cB;
        for (int t = 0; t < nt; t += 2) {
            const bool last = (t == nt - 2);
            const char* a1 = cA + (size_t)(t + 1) * kstep;
            const char* a2 = last ? nA : cA + (size_t)(t + 2) * kstep; const char* b2 = last ? nB : cB + (size_t)(t + 2) * kstep;
            const char* a3 = a2 + kstep; const char* b3 = b2 + kstep;
            if (last && has_next) S.a_ready(nxt);
            if constexpr (SP2) {
            PG8_LDB(B0, 0, 0); PG8_LDB(B1, 0, 1); PG8_SCHED; PG8_LDA(At, 0, 0); PG8_STAGE(PG8_SA(1, 1), a1 + hstep, voffA);
            PG8_WAIT_V(8); PG8_WAIT_L(0); PG8_BAR; PG8_MMA(0, 0, At, B0); PG8_MMA(0, 1, At, B1); PG8_BAR; PG8_SCHED;
            PG8_LDA(At, 0, 1); PG8_STAGE(PG8_SB(0, 0), b2, voffB); PG8_STAGE(PG8_SB(0, 1), b2 + hstep, voffB); PG8_STAGE(PG8_SA(0, 0), a2, voffA);
            PG8_WAIT_V(8); PG8_WAIT_L(0); PG8_BAR; PG8_MMA(1, 0, At, B0); PG8_MMA(1, 1, At, B1); PG8_BAR; PG8_SCHED;
            PG8_LDB(B0, 1, 0); PG8_LDB(B1, 1, 1); PG8_SCHED; PG8_LDA(At, 1, 0); PG8_STAGE(PG8_SA(0, 1), a2 + hstep, voffA);
            PG8_WAIT_V(8); PG8_WAIT_L(0); PG8_BAR; PG8_MMA(0, 0, At, B0); PG8_MMA(0, 1, At, B1); PG8_BAR; PG8_SCHED;
            PG8_LDA(At, 1, 1); PG8_STAGE(PG8_SB(1, 0), b3, voffB); PG8_STAGE(PG8_SB(1, 1), b3 + hstep, voffB); PG8_STAGE(PG8_SA(1, 0), a3, voffA);
            PG8_WAIT_V(8); PG8_WAIT_L(0); PG8_BAR; PG8_MMA(1, 0, At, B0); PG8_MMA(1, 1, At, B1); PG8_BAR; PG8_SCHED;
            } else {
            PG8_LDB(B0, 0, 0); PG8_SCHED; PG8_LDA(At, 0, 0); PG8_STAGE(PG8_SA(1, 1), a1 + hstep, voffA);
            PG8_WAIT_L(8); PG8_BAR; PG8_WAIT_L(0); PG8_MMA(0, 0, At, B0); PG8_BAR; PG8_SCHED;
            PG8_LDB(B1, 0, 1); PG8_STAGE(PG8_SB(0, 0), b2, voffB);
            PG8_BAR; PG8_WAIT_L(0); PG8_MMA(0, 1, At, B1); PG8_BAR;
            PG8_LDA(At, 0, 1); PG8_STAGE(PG8_SA(0, 0), a2, voffA);
            PG8_BAR; PG8_WAIT_L(0); PG8_MMA(1, 0, At, B0); PG8_BAR; PG8_SCHED;
            PG8_STAGE(PG8_SB(0, 1), b2 + hstep, voffB);
            PG8_WAIT_V(6); PG8_BAR; PG8_MMA(1, 1, At, B1); PG8_BAR;
            PG8_LDB(B0, 1, 0); PG8_SCHED; PG8_LDA(At, 1, 0); PG8_STAGE(PG8_SA(0, 1), a2 + hstep, voffA);
            PG8_WAIT_L(8); PG8_BAR; PG8_WAIT_L(0); PG8_MMA(0, 0, At, B0); PG8_BAR; PG8_SCHED;
            PG8_LDB(B1, 1, 1); PG8_STAGE(PG8_SB(1, 0), b3, voffB);
            PG8_BAR; PG8_WAIT_L(0); PG8_MMA(0, 1, At, B1); PG8_BAR;
            PG8_LDA(At, 1, 1); PG8_STAGE(PG8_SA(1, 0), a3, voffA);
            PG8_BAR; PG8_WAIT_L(0); PG8_MMA(1, 0, At, B0); PG8_BAR; PG8_SCHED;
            PG8_STAGE(PG8_SB(1, 1), b3 + hstep, voffB);
            PG8_WAIT_V(6); PG8_BAR; PG8_MMA(1, 1, At, B1); PG8_BAR;
            }
        }
        if constexpr (ALIGN_EPI) { if (wr == 0) PG8_BAR; }
        E(acc, cur, wr, wc, fr, fq); S.done(cur);
        if (!has_next) break;
#pragma unroll
        for (int a = 0; a < 2; ++a)
#pragma unroll
            for (int b = 0; b < 2; ++b)
#pragma unroll
                for (int m = 0; m < 4; ++m)
#pragma unroll
                    for (int n = 0; n < 2; ++n) acc[a][b][m][n] = (f32x4){0.f, 0.f, 0.f, 0.f};
        cur = nxt; cA = nA; cB = nB; ++ui;
        if constexpr (ALIGN_EPI) { if (wr == 1) PG8_BAR; }
    }
    PG8_WAIT_V(0);
    if constexpr (!ALIGN_EPI) { if (wr == 0) PG8_BAR; }
    PG8_BAR;
#undef PG8_SA
#undef PG8_SB
#undef PG8_STAGE
#undef PG8_LDA
#undef PG8_LDB
#undef PG8_MMA
#undef PG8_WAIT_V
#undef PG8_WAIT_L
#undef PG8_BAR
#undef PG8_SCHED
}
}

constexpr float QS64 = 0.125f * 1.4426950408889634f, QS96 = 0.10206207261596575f * 1.4426950408889634f;
typedef f32x4 AccT[2][2][4][2];
__device__ __forceinline__ const float* launder(const float* p) { asm volatile("" : "+s"(p)); return p; }
#define EPI_IDS() int t_ = ltid(); const int fr = t_ & 15, fq = (t_ >> 4) & 3; const int wid_ = __builtin_amdgcn_readfirstlane(t_ >> 6), wr = wid_ >> 2, wc = wid_ & 3; (void)wr; (void)wc; (void)fr; (void)fq
#define ITER_FENCE() do { asm volatile("" ::: "memory"); __builtin_amdgcn_sched_barrier(0); } while (0)
#define EPI_BARRIER() do { asm volatile("s_waitcnt lgkmcnt(0)" ::: "memory"); __builtin_amdgcn_s_barrier(); asm volatile("" ::: "memory"); } while (0)

__device__ __forceinline__ int vcol_of_row(int J) { const int pn = J >> 8, j = J & 255, bj = j >> 7, wc = (j >> 5) & 3, n = (j >> 4) & 1, fq = (j >> 2) & 3, e = j & 3; return 256 * pn + 64 * wc + 32 * bj + 8 * fq + 4 * n + e; }
__device__ __forceinline__ int gmap(int map, int v) {
    if (map == 0) return v;
    if (map == 1) { const int pn = v >> 8, wc = (v >> 6) & 3, bj = (v >> 5) & 1, x = v & 31, h = 128 * pn + 32 * wc + x; return bj ? F_ + h : h; }
    if (map == 2) { if (v < 384) return v; if (v < 512) return 1184 + (v - 384); if (v < 768) return 384 + (v - 512); if (v < 1280) return 672 + (v - 768);
                    if (v < 1408) return 1312 + (v - 1280); if (v < 1440) return 640 + (v - 1408); return -1; }
    { const int hh = v >> 7, y = v & 127; if (y < 64) return hh * 96 + y; const int x = y - 64; if (x >= 32) return -1; const int fq = x >> 3, n = (x >> 2) & 1, e = x & 3; return hh * 96 + 64 + 16 * n + 4 * fq + e; }
}
__device__ __forceinline__ void prep_item(const float* __restrict__ W, int K, int ldw, bf16_t* Bt, int NV, int map, const float* kscale, float* scr, int item, int lane) {
    const int nb32 = NV / 32, kb = item / nb32, nb = item % nb32, k0 = 64 * kb, J0 = 32 * nb;
    const int kk8 = lane >> 3, jq = lane & 7;
    const int col = gmap(map, vcol_of_row(J0 + 4 * jq));
#pragma unroll
    for (int i = 0; i < 8; ++i) {
        const int kk = 8 * i + kk8;
        float4 v = col >= 0 ? *(const float4*)(W + (size_t)(k0 + kk) * ldw + col) : make_float4(0.f, 0.f, 0.f, 0.f);
        if (kscale) { const float sc = kscale[k0 + kk]; v.x *= sc; v.y *= sc; v.z *= sc; v.w *= sc; }
        float* d = scr + kk * 33 + 4 * jq; d[0] = v.x; d[1] = v.y; d[2] = v.z; d[3] = v.w;
    }
    __builtin_amdgcn_wave_barrier();
    asm volatile("s_waitcnt lgkmcnt(0)" ::: "memory");
    const int c = lane & 7;
#pragma unroll
    for (int j = 0; j < 4; ++j) { const int n = (lane >> 3) + 8 * j; const float* s = scr + (8 * c) * 33 + n;
        u32x4 o; o.x = pk2(s[0 * 33], s[1 * 33]); o.y = pk2(s[2 * 33], s[3 * 33]); o.z = pk2(s[4 * 33], s[5 * 33]); o.w = pk2(s[6 * 33], s[7 * 33]);
        *(u32x4*)(Bt + (size_t)(J0 + n) * K + k0 + 8 * c) = o; }
    asm volatile("s_waitcnt lgkmcnt(0)" ::: "memory");
    __builtin_amdgcn_wave_barrier();
}
constexpr int PW_I0 = 16 * 96, PW_I1 = 16 * 32, PW_I2 = 16 * 176, PW_I3 = 44 * 32, PW_I4 = 16 * 48, PW_I5 = 16 * 32, PW_I6 = 6 * 32, PW_I7 = 4 * 32;
constexpr int PW_NIT = PW_I0 + PW_I1 + 2 * PW_I2 + 2 * PW_I3 + PW_I4 + PW_I5 + PW_I6 + PW_I7;
__device__ __forceinline__ void prep_weight_item(const Params& p, const Bufs& B, float* scr, int it, int lane) {
    int r = it;
    if (r < PW_I0) { prep_item(p.in[I_EWIN], 1024, 3072, B.wt + W_EIN, 3072, 0, nullptr, scr, r, lane); return; } r -= PW_I0;
    if (r < PW_I1) { prep_item(p.in[I_EWOUT], 1024, 1024, B.wt + W_EOUT, 1024, 0, nullptr, scr, r, lane); return; } r -= PW_I1;
    if (r < 2 * PW_I2) { const int l = r / PW_I2; prep_item(p.in[I_FUP] + (size_t)l * 1024 * F2_, 1024, F2_, B.wt + W_UP + (size_t)l * F2_ * 1024, F2_, 1, nullptr, scr, r % PW_I2, lane); return; } r -= 2 * PW_I2;
    if (r < 2 * PW_I3) { const int l = r / PW_I3; prep_item(p.in[I_FDOWN] + (size_t)l * F_ * 1024, F_, 1024, B.wt + W_DOWN + (size_t)l * 1024 * F_, 1024, 0, nullptr, scr, r % PW_I3, lane); return; } r -= 2 * PW_I3;
    if (r < PW_I4) { prep_item(p.in[I_OWIN], 1024, 1440, B.wt + W_OIN, 1536, 2, nullptr, scr, r, lane); return; } r -= PW_I4;
    if (r < PW_I5) { prep_item(p.in[I_OWOUT], 1024, 1024, B.wt + W_OOUT, 1024, 0, nullptr, scr, r, lane); return; } r -= PW_I5;
    if (r < PW_I6) { prep_item(p.in[I_CWQB], 384, 768, B.wt + W_QB, 1024, 3, p.in[I_CQAN], scr, r, lane); return; } r -= PW_I6;
    prep_item(p.in[I_CWKVB], 256, 1024, B.wt + W_KVB, 1024, 0, p.in[I_CKVAN], scr, r, lane);
}
__device__ __forceinline__ void phase_prep_weights(const Params& p, char* lds, int bid, int nblk) {
    Bufs B(p);
    const int wid = ltid() >> 6, lane = ltid() & 63;
    float* scr = (float*)lds + wid * (64 * 33 + 16);
    for (int it = bid * 8 + wid; it < PW_I0; it += nblk * 8) prep_weight_item(p, B, scr, it, lane);
}
constexpr int PW_L0 = PW_I1 + PW_I2, PW_L1 = PW_I2 + PW_I3 + PW_I5 + PW_I6 + PW_I7, PW_L2 = PW_I3 + PW_I4;
__device__ __forceinline__ int pw_list_item(int which, int k) {
    constexpr int oEOUT = PW_I0, oUP0 = oEOUT + PW_I1, oUP1 = oUP0 + PW_I2, oDN0 = oUP1 + PW_I2, oDN1 = oDN0 + PW_I3, oOIN = oDN1 + PW_I3, oOOUT = oOIN + PW_I4;
    if (which == 0) { if (k < PW_I1) return oEOUT + k; return oUP0 + (k - PW_I1); }
    if (which == 2) { if (k < PW_I3) return oDN0 + k; return oOIN + (k - PW_I3); }
    if (k < PW_I2) return oUP1 + k; k -= PW_I2; if (k < PW_I3) return oDN1 + k; k -= PW_I3; return oOOUT + k;
}
__device__ __forceinline__ void phase_prep_weights_rest(const Params& p, char* lds, int which) {
    Bufs B(p);
    const int tid = ltid(), wid = tid >> 6, lane = tid & 63;
    float* scr = (float*)lds + wid * (64 * 33 + 16);
    volatile int* slot = (volatile int*)(lds + LDS_BYTES - 32);
    unsigned* ctr = (unsigned*)(p.ws + WS_CTL + 15360) + which;
    const int n = which == 0 ? PW_L0 : which == 1 ? PW_L1 : PW_L2;
    for (;;) {
        __syncthreads();
        if (tid == 0) *slot = (int)__hip_atomic_fetch_add(ctr, 8u, __ATOMIC_RELAXED, __HIP_MEMORY_SCOPE_AGENT);
        __syncthreads();
        const int base = *slot;
        if (base >= n) break;
        if (base + wid < n) prep_weight_item(p, B, scr, pw_list_item(which, base + wid), lane);
    }
}

__device__ __forceinline__ void head64_epi(const AccT& acc, int ai, int m, const float (&gn)[2][2][4], bool rope, const float* tab, int t, int fq, bf16_t* dst, float qscale) {
    float ss = 0.f;
#pragma unroll
    for (int bj = 0; bj < 2; ++bj)
#pragma unroll
        for (int n = 0; n < 2; ++n)
#pragma unroll
            for (int e = 0; e < 4; ++e) { const float v = acc[ai][bj][m][n][e]; ss += v * v; }
    ss += __shfl_xor(ss, 16); ss += __shfl_xor(ss, 32);
    const float rr = rsqrtf(ss * (1.f / 64.f) + EPS_) * qscale;
    float y[2][2][4];
#pragma unroll
    for (int bj = 0; bj < 2; ++bj)
#pragma unroll
        for (int n = 0; n < 2; ++n)
#pragma unroll
            for (int e = 0; e < 4; ++e) y[bj][n][e] = acc[ai][bj][m][n][e] * rr * gn[bj][n][e];
    if (rope) {
        const int pos = fq < 2 ? (t >> 6) : (t & 63);
        const float4* cs = (const float4*)(tab + (pos * 16 + 8 * (fq & 1)) * 2);
#pragma unroll
        for (int n = 0; n < 2; ++n) {
            const float4 c0 = cs[2 * n], c1 = cs[2 * n + 1];
            const float cv[4] = {c0.x, c0.z, c1.x, c1.z}, sv[4] = {c0.y, c0.w, c1.y, c1.w};
#pragma unroll
            for (int e = 0; e < 4; ++e) { const float x1 = y[0][n][e], x2 = y[1][n][e]; y[0][n][e] = x1 * cv[e] - x2 * sv[e]; y[1][n][e] = x1 * sv[e] + x2 * cv[e]; }
        }
    }
#pragma unroll
    for (int bj = 0; bj < 2; ++bj) {
        u32x4 w; w.x = pk2(y[bj][0][0], y[bj][0][1]); w.y = pk2(y[bj][0][2], y[bj][0][3]); w.z = pk2(y[bj][1][0], y[bj][1][1]); w.w = pk2(y[bj][1][2], y[bj][1][3]);
        *(u32x4*)(dst + 32 * bj + 8 * fq) = w;
    }
}
__device__ __forceinline__ void load_gain64(float (&gn)[2][2][4], const float* g, int fq) {
#pragma unroll
    for (int bj = 0; bj < 2; ++bj)
#pragma unroll
        for (int n = 0; n < 2; ++n) { const float4 t = *(const float4*)(g + 32 * bj + 8 * fq + 4 * n); gn[bj][n][0] = t.x; gn[bj][n][1] = t.y; gn[bj][n][2] = t.z; gn[bj][n][3] = t.w; }
}
__device__ __forceinline__ void vt_store(const AccT& acc, int ai, int m, float scale, bf16_t* vt, int fq, int r) {
    const int pos = vpos(r);
#pragma unroll
    for (int bj = 0; bj < 2; ++bj)
#pragma unroll
        for (int n = 0; n < 2; ++n)
#pragma unroll
            for (int e = 0; e < 4; ++e) vt[(size_t)(32 * bj + 8 * fq + 4 * n + e) * R_ + pos] = f2bf(acc[ai][bj][m][n][e] * scale);
}
__device__ __forceinline__ float raw_store(const AccT& acc, int ai, int m, bf16_t* dst, int fq) {
    float ss = 0.f;
#pragma unroll
    for (int bj = 0; bj < 2; ++bj) {
        u32x4 w; const f32x4 a = acc[ai][bj][m][0], b = acc[ai][bj][m][1];
        w.x = pk2(a[0], a[1]); w.y = pk2(a[2], a[3]); w.z = pk2(b[0], b[1]); w.w = pk2(b[2], b[3]);
        *(u32x4*)(dst + 32 * bj + 8 * fq) = w;
        float t[8]; unpack8(w, t);
#pragma unroll
        for (int j = 0; j < 8; ++j) ss += t[j] * t[j];
    }
    return ss;
}

struct EpiQKV0 {
    bf16_t* qkv; const float* rope; const float* gt;
    __device__ __forceinline__ void operator()(const AccT& acc, const pg8::Unit& u, int, int, int, int) const {
        EPI_IDS();
        const int seg = u.pn >> 1, r0 = u.pm * 256 + wr * 64 + fr;
        if (seg == 2 || seg == 5) {
            const size_t vo = seg == 2 ? O_VAT + ((size_t)((u.pn & 1) * 2 + (wc >> 1)) * 128 + 64 * (wc & 1)) * R_ : O_VBT + (size_t)((u.pn & 1) * 4 + wc) * 64 * R_;
            bf16_t* vt = qkv + vo;
#pragma unroll
            for (int ai = 0; ai < 2; ++ai)
#pragma unroll
                for (int m = 0; m < 4; ++m) { vt_store(acc, ai, m, 1.f, vt, fq, r0 + 128 * ai + 16 * m); ITER_FENCE(); }
        } else {
            float gn[2][2][4]; load_gain64(gn, gt + 64 * (seg < 2 ? seg : seg - 1), fq);
            const int head = (u.pn & 1) * 4 + wc;
            const size_t bo = (seg == 0 ? O_QA : seg == 1 ? O_KA : seg == 3 ? O_QB : O_KB) + (size_t)head * R_ * 64;
            bf16_t* base = qkv + bo;
            const bool rp = seg < 2 && u.pm > 0;
#pragma unroll
            for (int ai = 0; ai < 2; ++ai)
#pragma unroll
                for (int m = 0; m < 4; ++m) { const int r = r0 + 128 * ai + 16 * m; head64_epi(acc, ai, m, gn, rp, rope, r - 256, fq, base + (size_t)r * 64, (seg == 0 || seg == 3) ? QS64 : 1.f); ITER_FENCE(); }
        }
    }
};

struct EpiResid {
    const float* resid_lat; float* dst_lat; const float* resid_ctx; float* dst_ctx; const float* gate_lat; const float* gate_ctx;
    __device__ __forceinline__ void rows(const AccT& acc, const float* __restrict__ resid, float* dst, const float* __restrict__ gate, int row0, int col0) const {
        f32x4 gt[2][2];
#pragma unroll
        for (int bj = 0; bj < 2; ++bj)
#pragma unroll
            for (int n = 0; n < 2; ++n) gt[bj][n] = *(const f32x4*)(gate + col0 + 32 * bj + 4 * n);
#pragma unroll
        for (int ai = 0; ai < 2; ++ai)
#pragma unroll
            for (int m = 0; m < 4; ++m) {
                const size_t ro = (size_t)(row0 + 128 * ai + 16 * m) * 1024 + col0;
#pragma unroll
                for (int bj = 0; bj < 2; ++bj)
#pragma unroll
                    for (int n = 0; n < 2; ++n) { const f32x4 x = *(const f32x4*)(resid + ro + 32 * bj + 4 * n); *(f32x4*)(dst + ro + 32 * bj + 4 * n) = x + gt[bj][n] * acc[ai][bj][m][n]; }
                if (m == 3) ITER_FENCE();
            }
    }
    __device__ __forceinline__ void operator()(const AccT& acc, const pg8::Unit& u, int, int, int, int) const {
        EPI_IDS();
        const int col0 = u.pn * 256 + wc * 64 + 8 * fq, rl = 64 * wr + fr;
        if (u.pm == 0) rows(acc, resid_ctx, dst_ctx, gate_ctx, rl, col0);
        else rows(acc, resid_lat, dst_lat, gate_lat, (u.pm - 1) * 256 + rl, col0);
    }
};

struct EpiPartial {
    float* part; const float* gate;
    __device__ __forceinline__ void operator()(const AccT& acc, const pg8::Unit& u, int, int, int, int) const {
        EPI_IDS();
        const int col0 = u.pn * 256 + wc * 64 + 8 * fq, rl = 64 * wr + fr;
        float* base = part + (size_t)(u.koff >> 8) * 256 * 1024;
        f32x4 gt[2][2];
#pragma unroll
        for (int bj = 0; bj < 2; ++bj)
#pragma unroll
            for (int n = 0; n < 2; ++n) gt[bj][n] = *(const f32x4*)(gate + col0 + 32 * bj + 4 * n);
#pragma unroll
        for (int ai = 0; ai < 2; ++ai)
#pragma unroll
            for (int m = 0; m < 4; ++m) {
                float* d = base + (size_t)(rl + 128 * ai + 16 * m) * 1024 + col0;
#pragma unroll
                for (int bj = 0; bj < 2; ++bj)
#pragma unroll
                    for (int n = 0; n < 2; ++n) *(f32x4*)(d + 32 * bj + 4 * n) = gt[bj][n] * acc[ai][bj][m][n];
                ITER_FENCE();
            }
    }
};

#ifndef USE_DPP
#define USE_DPP 1
#endif
__device__ __forceinline__ float rot_prev(float x, int lane) {
#if USE_DPP
    return __builtin_bit_cast(float, __builtin_amdgcn_update_dpp(0, __builtin_bit_cast(int, x), 0x121, 0xf, 0xf, false));
#else
    return __shfl(x, (lane & 48) | ((lane - 1) & 15));
#endif
}
__device__ __forceinline__ float rot_next(float x, int lane) {
#if USE_DPP
    return __builtin_bit_cast(float, __builtin_amdgcn_update_dpp(0, __builtin_bit_cast(int, x), 0x12F, 0xf, 0xf, false));
#else
    return __shfl(x, (lane & 48) | ((lane + 1) & 15));
#endif
}
__device__ __forceinline__ float dpp_shr1(float old, float x) { return __builtin_bit_cast(float, __builtin_amdgcn_update_dpp(__builtin_bit_cast(int, old), __builtin_bit_cast(int, x), 0x111, 0xf, 0xf, false)); }
__device__ __forceinline__ float dpp_shl1(float old, float x) { return __builtin_bit_cast(float, __builtin_amdgcn_update_dpp(__builtin_bit_cast(int, old), __builtin_bit_cast(int, x), 0x101, 0xf, 0xf, false)); }
struct EpiUp {
    bf16_t* act; const float* cw; const float* cb; LAS float* xch;
    __device__ __forceinline__ int xidx(int c, int which, int wc, int fq, int bj, int n) const { return (((c * 2 + which) * 4 + wc) * 64) + fq * 16 + bj * 8 + n * 4; }
    __device__ __forceinline__ void operator()(const AccT& acc, const pg8::Unit& u, int, int, int, int) const {
        EPI_IDS();
        f32x4 wq[2][4][2];
#pragma unroll
        for (int n = 0; n < 2; ++n)
#pragma unroll
            for (int bj = 0; bj < 2; ++bj) { const int c = bj * F_ + 128 * u.pn + 32 * wc + 8 * fq + 4 * n; wq[n][0][bj] = *(const f32x4*)(cw + c); wq[n][1][bj] = *(const f32x4*)(cw + F2_ + c); wq[n][2][bj] = *(const f32x4*)(cw + 2 * F2_ + c); wq[n][3][bj] = *(const f32x4*)(cb + c); }
        if (fr == 0) {
#pragma unroll
            for (int ai = 0; ai < 2; ++ai)
#pragma unroll
                for (int bj = 0; bj < 2; ++bj)
#pragma unroll
                    for (int n = 0; n < 2; ++n) *(LAS f32x4*)(xch + xidx(2 * ai + wr, 0, wc, fq, bj, n)) = acc[ai][bj][0][n];
        }
        if (fr == 15) {
#pragma unroll
            for (int ai = 0; ai < 2; ++ai)
#pragma unroll
                for (int bj = 0; bj < 2; ++bj)
#pragma unroll
                    for (int n = 0; n < 2; ++n) *(LAS f32x4*)(xch + xidx(2 * ai + wr, 1, wc, fq, bj, n)) = acc[ai][bj][3][n];
        }
        EPI_BARRIER();
        const bool isctx = u.pm < 2;
        const int seq0 = isctx ? 254 * u.pm : 254 * (u.pm - 2), lim = isctx ? 256 : T_, rbase = isctx ? 0 : 256;
        const int hc = 128 * u.pn + 32 * wc + 8 * fq;
#pragma unroll
        for (int ai = 0; ai < 2; ++ai) {
            const int c = 2 * ai + wr;
#pragma unroll
            for (int m = 0; m < 4; ++m) {
                float o[2][4];
#pragma unroll
                for (int n = 0; n < 2; ++n) {
                    f32x4 cv[2];
#pragma unroll
                    for (int bj = 0; bj < 2; ++bj) {
                        const f32x4 x = acc[ai][bj][m][n];
                        f32x4 up, dn;
                        if (m > 0) up = acc[ai][bj][m > 0 ? m - 1 : 0][n];
                        else {
                            const f32x4 eup = c > 0 ? *(const LAS f32x4*)(xch + xidx(c - 1, 1, wc, fq, bj, n)) : (f32x4){0.f, 0.f, 0.f, 0.f};
#pragma unroll
                            for (int e = 0; e < 4; ++e) up[e] = dpp_shr1(eup[e], acc[ai][bj][3][n][e]);
                        }
                        if (m < 3) dn = acc[ai][bj][m < 3 ? m + 1 : 3][n];
                        else {
                            const f32x4 edn = c < 3 ? *(const LAS f32x4*)(xch + xidx(c + 1, 0, wc, fq, bj, n)) : (f32x4){0.f, 0.f, 0.f, 0.f};
#pragma unroll
                            for (int e = 0; e < 4; ++e) dn[e] = dpp_shl1(edn[e], acc[ai][bj][0][n][e]);
                        }
                        cv[bj] = wq[n][3][bj] + wq[n][0][bj] * up + wq[n][1][bj] * x + wq[n][2][bj] * dn;
                    }
#pragma unroll
                    for (int e = 0; e < 4; ++e) { const float gg = cv[1][e]; o[n][e] = cv[0][e] * gg * __builtin_amdgcn_rcpf(1.f + __builtin_amdgcn_exp2f(-1.4426950408889634f * gg)); }
                }
                const int j = 128 * ai + 64 * wr + 4 * fr + m, sr = seq0 + j - 1;
                if (j >= 1 && j <= 254 && sr < lim) {
                    u32x4 w; w.x = pk2(o[0][0], o[0][1]); w.y = pk2(o[0][2], o[0][3]); w.z = pk2(o[1][0], o[1][1]); w.w = pk2(o[1][2], o[1][3]);
                    *(u32x4*)(act + (size_t)(rbase + sr) * F_ + hc) = w;
                }
                ITER_FENCE();
            }
        }
    }
};

struct EpiQKV1A {
    bf16_t* qkv; float* part; const float* rope; const float* gt;
    __device__ __forceinline__ void operator()(const AccT& acc, const pg8::Unit& u, int, int, int, int) const {
        EPI_IDS();
        const int r0 = u.pm * 256 + wr * 64 + fr, pn = u.pn;
        const bool rp = u.pm > 0;
        if (pn == 0 || (pn == 1 && wc < 2) || pn == 2) {
            const int chunk = pn == 0 ? wc : pn == 1 ? 4 + wc : wc;
            const size_t bo = pn == 2 ? O_CKV + 64 * wc : O_CQ + 64 * chunk;
            bf16_t* base = qkv + bo;
            const int ld = pn == 2 ? 256 : 384;
            float* pp = part + (pn == 2 ? 8 : 0) + chunk;
#pragma unroll
            for (int ai = 0; ai < 2; ++ai)
#pragma unroll
                for (int m = 0; m < 4; ++m) {
                    const int r = r0 + 128 * ai + 16 * m;
                    float ss = raw_store(acc, ai, m, base + (size_t)r * ld, fq);
                    ss += __shfl_xor(ss, 16); ss += __shfl_xor(ss, 32);
                    if (fq == 0) pp[(size_t)r * 12] = ss;
                    ITER_FENCE();
                }
        } else if (pn == 1 || pn == 3 || pn == 4) {
            const bool isk = pn == 1;
            float gn[2][2][4]; load_gain64(gn, gt + (isk ? 320 : 256), fq);
            const size_t bo = isk ? O_GK + (size_t)(wc - 2) * R_ * 64 : O_GQ + (size_t)(4 * (pn - 3) + wc) * R_ * 64;
            bf16_t* base = qkv + bo;
#pragma unroll
            for (int ai = 0; ai < 2; ++ai)
#pragma unroll
                for (int m = 0; m < 4; ++m) { const int r = r0 + 128 * ai + 16 * m; head64_epi(acc, ai, m, gn, rp, rope, r - 256, fq, base + (size_t)r * 64, isk ? 1.f : QS64); ITER_FENCE(); }
        } else {
            if (wc < 2) {
                bf16_t* vt = qkv + O_GVT + (size_t)wc * 64 * R_;
#pragma unroll
                for (int ai = 0; ai < 2; ++ai)
#pragma unroll
                    for (int m = 0; m < 4; ++m) { vt_store(acc, ai, m, 1.f, vt, fq, r0 + 128 * ai + 16 * m); ITER_FENCE(); }
            } else if (wc == 2) {
#pragma unroll
                for (int ai = 0; ai < 2; ++ai)
#pragma unroll
                    for (int m = 0; m < 4; ++m) {
                        const int r = r0 + 128 * ai + 16 * m; const f32x4 a = acc[ai][0][m][0], b = acc[ai][0][m][1];
                        u32x4 w; w.x = pk2(a[0], a[1]); w.y = pk2(a[2], a[3]); w.z = pk2(b[0], b[1]); w.w = pk2(b[2], b[3]);
                        *(u32x4*)(qkv + O_CKR + (size_t)r * 32 + 8 * fq) = w;
                    }
            }
        }
    }
};

struct EpiQB {
    bf16_t* qkv; const float* part; const float* rope; const float* gq; LAS float* xch;
    __device__ __forceinline__ void operator()(const AccT& acc, const pg8::Unit& u, int, int, int, int) const {
        EPI_IDS();
        const int wid = wr * 4 + wc, head = 2 * u.pn + (wc >> 1), role = wc & 1, r0 = u.pm * 256 + wr * 64 + fr;
        const bool rp = u.pm > 0;
        float ssp[2][4];
#pragma unroll
        for (int ai = 0; ai < 2; ++ai)
#pragma unroll
            for (int m = 0; m < 4; ++m) {
                float ss = 0.f;
#pragma unroll
                for (int bj = 0; bj < 2; ++bj)
#pragma unroll
                    for (int n = 0; n < 2; ++n)
#pragma unroll
                        for (int e = 0; e < 4; ++e) { const float v = acc[ai][bj][m][n][e]; ss += v * v; }
                ss += __shfl_xor(ss, 16); ss += __shfl_xor(ss, 32);
                ssp[ai][m] = ss;
                if (fq == 0) xch[wid * 128 + ai * 64 + m * 16 + fr] = ss;
            }
        EPI_BARRIER();
        float g0[2][2][4];
        const float* gql = launder(gq);
        if (role == 0) load_gain64(g0, gql, fq);
        else {
#pragma unroll
            for (int n = 0; n < 2; ++n) { const float4 t = *(const float4*)(gql + 64 + 16 * n + 4 * fq); g0[0][n][0] = t.x; g0[0][n][1] = t.y; g0[0][n][2] = t.z; g0[0][n][3] = t.w; }
        }
#pragma unroll
        for (int ai = 0; ai < 2; ++ai)
#pragma unroll
            for (int m = 0; m < 4; ++m) {
                const int r = r0 + 128 * ai + 16 * m;
                const float so = xch[(wid ^ 1) * 128 + ai * 64 + m * 16 + fr];
                const float* pp = part + (size_t)r * 12;
                const float rq = rsqrtf((pp[0] + pp[1] + pp[2] + pp[3] + pp[4] + pp[5]) * (1.f / 384.f) + EPS_);
                const float sc = rq * rsqrtf(rq * rq * (ssp[ai][m] + so) * (1.f / 96.f) + EPS_) * QS96;
                bf16_t* dst = qkv + O_MQ + ((size_t)head * R_ + r) * 96;
                if (role == 0) {
#pragma unroll
                    for (int bj = 0; bj < 2; ++bj) {
                        const f32x4 a = acc[ai][bj][m][0], b = acc[ai][bj][m][1];
                        u32x4 w; w.x = pk2(a[0] * sc * g0[bj][0][0], a[1] * sc * g0[bj][0][1]); w.y = pk2(a[2] * sc * g0[bj][0][2], a[3] * sc * g0[bj][0][3]);
                        w.z = pk2(b[0] * sc * g0[bj][1][0], b[1] * sc * g0[bj][1][1]); w.w = pk2(b[2] * sc * g0[bj][1][2], b[3] * sc * g0[bj][1][3]);
                        *(u32x4*)(dst + 32 * bj + 8 * fq) = w;
                    }
                } else {
                    float y1[4], y2[4];
#pragma unroll
                    for (int e = 0; e < 4; ++e) { y1[e] = acc[ai][0][m][0][e] * sc * g0[0][0][e]; y2[e] = acc[ai][0][m][1][e] * sc * g0[0][1][e]; }
                    if (rp) {
                        const int t = r - 256, pos = fq < 2 ? (t >> 6) : (t & 63);
                        const float* tb = rope + (pos * 16 + 8 * (fq & 1)) * 2;
#pragma unroll
                        for (int e = 0; e < 4; ++e) { const float2 cs = *(const float2*)(tb + 4 * e); const float a = y1[e], b = y2[e]; y1[e] = a * cs.x - b * cs.y; y2[e] = a * cs.y + b * cs.x; }
                    }
                    *(uint2*)(dst + 64 + 4 * fq) = make_uint2(pk2(y1[0], y1[1]), pk2(y1[2], y1[3]));
                    *(uint2*)(dst + 80 + 4 * fq) = make_uint2(pk2(y2[0], y2[1]), pk2(y2[2], y2[3]));
                }
                ITER_FENCE();
            }
        EPI_BARRIER();
    }
};

struct EpiKVB {
    bf16_t* qkv; const float* part; const float* rope; const float* gk;
    __device__ __forceinline__ void operator()(const AccT& acc, const pg8::Unit& u, int, int, int, int) const {
        EPI_IDS();
        const int head = 2 * u.pn + (wc >> 1), role = wc & 1, r0 = u.pm * 256 + wr * 64 + fr;
        const bool rp = u.pm > 0;
        if (role == 1) {
            bf16_t* vt = qkv + O_MVT + (size_t)head * 64 * R_;
#pragma unroll
            for (int ai = 0; ai < 2; ++ai)
#pragma unroll
                for (int m = 0; m < 4; ++m) {
                    const int r = r0 + 128 * ai + 16 * m; const float* pp = part + (size_t)r * 12 + 8;
                    const float rk = rsqrtf((pp[0] + pp[1] + pp[2] + pp[3]) * (1.f / 256.f) + EPS_);
                    vt_store(acc, ai, m, rk, vt, fq, r);
                    ITER_FENCE();
                }
        } else {
            const float* gkl = launder(gk);
            float gn[2][2][4]; load_gain64(gn, gkl, fq);
            float gr[2][4];
#pragma unroll
            for (int n = 0; n < 2; ++n) { const float4 t = *(const float4*)(gkl + 64 + 16 * n + 4 * fq); gr[n][0] = t.x; gr[n][1] = t.y; gr[n][2] = t.z; gr[n][3] = t.w; }
#pragma unroll
            for (int ai = 0; ai < 2; ++ai)
#pragma unroll
                for (int m = 0; m < 4; ++m) {
                    const int r = r0 + 128 * ai + 16 * m; const float* pp = part + (size_t)r * 12 + 8;
                    const float rk = rsqrtf((pp[0] + pp[1] + pp[2] + pp[3]) * (1.f / 256.f) + EPS_);
                    const uint2 c1 = *(const uint2*)(qkv + O_CKR + (size_t)r * 32 + 4 * fq), c2 = *(const uint2*)(qkv + O_CKR + (size_t)r * 32 + 16 + 4 * fq);
                    float y1[4] = {__uint_as_float(c1.x << 16), __uint_as_float(c1.x & 0xffff0000u), __uint_as_float(c1.y << 16), __uint_as_float(c1.y & 0xffff0000u)};
                    float y2[4] = {__uint_as_float(c2.x << 16), __uint_as_float(c2.x & 0xffff0000u), __uint_as_float(c2.y << 16), __uint_as_float(c2.y & 0xffff0000u)};
                    float ss = 0.f;
#pragma unroll
                    for (int bj = 0; bj < 2; ++bj)
#pragma unroll
                        for (int n = 0; n < 2; ++n)
#pragma unroll
                            for (int e = 0; e < 4; ++e) { const float v = acc[ai][bj][m][n][e] * rk; ss += v * v; }
#pragma unroll
                    for (int e = 0; e < 4; ++e) ss += y1[e] * y1[e] + y2[e] * y2[e];
                    ss += __shfl_xor(ss, 16); ss += __shfl_xor(ss, 32);
                    const float rr = rsqrtf(ss * (1.f / 96.f) + EPS_), sc = rk * rr;
                    bf16_t* dst = qkv + O_MK + ((size_t)head * R_ + r) * 96;
#pragma unroll
                    for (int bj = 0; bj < 2; ++bj) {
                        const f32x4 a = acc[ai][bj][m][0], b = acc[ai][bj][m][1];
                        u32x4 w; w.x = pk2(a[0] * sc * gn[bj][0][0], a[1] * sc * gn[bj][0][1]); w.y = pk2(a[2] * sc * gn[bj][0][2], a[3] * sc * gn[bj][0][3]);
                        w.z = pk2(b[0] * sc * gn[bj][1][0], b[1] * sc * gn[bj][1][1]); w.w = pk2(b[2] * sc * gn[bj][1][2], b[3] * sc * gn[bj][1][3]);
                        *(u32x4*)(dst + 32 * bj + 8 * fq) = w;
                    }
#pragma unroll
                    for (int e = 0; e < 4; ++e) { y1[e] *= rr * gr[0][e]; y2[e] *= rr * gr[1][e]; }
                    if (rp) {
                        const int t = r - 256, pos = fq < 2 ? (t >> 6) : (t & 63);
                        const float* tb = rope + (pos * 16 + 8 * (fq & 1)) * 2;
#pragma unroll
                        for (int e = 0; e < 4; ++e) { const float2 cs = *(const float2*)(tb + 4 * e); const float a = y1[e], b = y2[e]; y1[e] = a * cs.x - b * cs.y; y2[e] = a * cs.y + b * cs.x; }
                    }
                    *(uint2*)(dst + 64 + 4 * fq) = make_uint2(pk2(y1[0], y1[1]), pk2(y1[2], y1[3]));
                    *(uint2*)(dst + 80 + 4 * fq) = make_uint2(pk2(y2[0], y2[1]), pk2(y2[2], y2[3]));
                    ITER_FENCE();
                }
        }
    }
};

template <int K>
__device__ __forceinline__ void ctx_proj(const bf16_t* __restrict__ A, int lda, const bf16_t* __restrict__ Bt, const float* __restrict__ gate, float* xc, LAS unsigned char* lds, int bid, int nblk) {
    static_assert(K % 256 == 0, "K");
    constexpr int KW = K / 8, NS = KW / 32;
    const int tid = ltid(), wid = tid >> 6, lane = tid & 63, fr = lane & 15, fq = lane >> 4;
    LAS f32x4* red = (LAS f32x4*)lds;
    for (int it = bid; it < 256; it += nblk) {
        const int r0 = 16 * (it & 15), c0 = 64 * (it >> 4);
        const bf16_t* ap = A + (size_t)(r0 + fr) * lda + wid * KW + 8 * fq;
        const bf16_t* bp[4];
#pragma unroll
        for (int cb = 0; cb < 4; ++cb) {
            const int v = c0 + 16 * cb + fr;
            const int J = (v & ~255) + 128 * ((v >> 5) & 1) + 32 * ((v >> 6) & 3) + 16 * ((v >> 2) & 1) + 4 * ((v >> 3) & 3) + (v & 3);
            bp[cb] = Bt + (size_t)J * K + wid * KW + 8 * fq;
        }
        f32x4 d[4];
#pragma unroll
        for (int cb = 0; cb < 4; ++cb) d[cb] = (f32x4){0.f, 0.f, 0.f, 0.f};
#pragma unroll
        for (int st = 0; st < NS; ++st) {
            const bf16x8 a = *(const bf16x8*)(ap + 32 * st);
#pragma unroll
            for (int cb = 0; cb < 4; ++cb) { const bf16x8 b = *(const bf16x8*)(bp[cb] + 32 * st); d[cb] = __builtin_amdgcn_mfma_f32_16x16x32_bf16(b, a, d[cb], 0, 0, 0); }
        }
        __syncthreads();
#pragma unroll
        for (int cb = 0; cb < 4; ++cb) red[(wid * 4 + cb) * 64 + lane] = d[cb];
        __syncthreads();
        if (tid < 256) {
            const int cb = tid >> 6, ln = tid & 63;
            f32x4 t = red[cb * 64 + ln];
#pragma unroll
            for (int w = 1; w < 8; ++w) t += red[(w * 4 + cb) * 64 + ln];
            const int col = c0 + 16 * cb + 4 * (ln >> 4);
            float* dst = xc + (size_t)(r0 + (ln & 15)) * 1024 + col;
            const f32x4 g = *(const f32x4*)(gate + col);
            *(f32x4*)dst = *(const f32x4*)dst + g * t;
        }
    }
    __syncthreads();
}

__device__ __forceinline__ void ctx_kvb(const Bufs& B, const float* __restrict__ gk, LAS unsigned char* lds, int bid, int nblk) {
    const int tid = ltid(), wid = tid >> 6, lane = tid & 63, fr = lane & 15, fq = lane >> 4;
    LAS f32x4* red = (LAS f32x4*)lds;
    LAS float* tile = (LAS float*)(lds + 32768);
    const bf16_t* A = B.qkv + O_CKV; const bf16_t* Bt = B.wt + W_KVB;
    for (int it = bid; it < 256; it += nblk) {
        const int r0 = 16 * (it & 15), c0 = 64 * (it >> 4), head = c0 >> 7, role = (c0 >> 6) & 1;
        const bf16x8 a = *(const bf16x8*)(A + (size_t)(r0 + fr) * 256 + wid * 32 + 8 * fq);
        f32x4 d[4];
#pragma unroll
        for (int cb = 0; cb < 4; ++cb) {
            const int v = c0 + 16 * cb + fr;
            const int J = (v & ~255) + 128 * ((v >> 5) & 1) + 32 * ((v >> 6) & 3) + 16 * ((v >> 2) & 1) + 4 * ((v >> 3) & 3) + (v & 3);
            const bf16x8 b = *(const bf16x8*)(Bt + (size_t)J * 256 + wid * 32 + 8 * fq);
            d[cb] = __builtin_amdgcn_mfma_f32_16x16x32_bf16(b, a, (f32x4){0.f, 0.f, 0.f, 0.f}, 0, 0, 0);
        }
        __syncthreads();
#pragma unroll
        for (int cb = 0; cb < 4; ++cb) red[(wid * 4 + cb) * 64 + lane] = d[cb];
        __syncthreads();
        if (tid < 256) {
            const int cb = tid >> 6, ln = tid & 63, row = ln & 15;
            f32x4 t = red[cb * 64 + ln];
#pragma unroll
            for (int w = 1; w < 8; ++w) t += red[(w * 4 + cb) * 64 + ln];
            const float* pp = B.part + (size_t)(r0 + row) * 12 + 8;
            const float rk = rsqrtf((pp[0] + pp[1] + pp[2] + pp[3]) * (1.f / 256.f) + EPS_);
            *(LAS f32x4*)(tile + row * 64 + 16 * cb + 4 * (ln >> 4)) = t * rk;
        }
        __syncthreads();
        if (tid < 256) {
            const int row = tid >> 4, q = tid & 15, r = r0 + row;
            const f32x4 v = *(const LAS f32x4*)(tile + row * 64 + 4 * q);
            if (role == 1) {
                bf16_t* vt = B.qkv + O_MVT + (size_t)(head * 64 + 4 * q) * R_ + vpos(r);
                const u32 w0 = pk2(v[0], v[1]), w1 = pk2(v[2], v[3]);
                vt[0] = (bf16_t)(w0 & 0xffffu); vt[(size_t)R_] = (bf16_t)(w0 >> 16); vt[(size_t)2 * R_] = (bf16_t)(w1 & 0xffffu); vt[(size_t)3 * R_] = (bf16_t)(w1 >> 16);
            } else {
                const u32 cw = *(const u32*)(B.qkv + O_CKR + (size_t)r * 32 + 2 * q);
                const float y0 = __uint_as_float(cw << 16), y1 = __uint_as_float(cw & 0xffff0000u);
                float ss = v[0] * v[0] + v[1] * v[1] + v[2] * v[2] + v[3] * v[3] + y0 * y0 + y1 * y1;
                ss += __shfl_xor(ss, 1); ss += __shfl_xor(ss, 2); ss += __shfl_xor(ss, 4); ss += __shfl_xor(ss, 8);
                const float rr = rsqrtf(ss * (1.f / 96.f) + EPS_);
                bf16_t* dst = B.qkv + O_MK + ((size_t)head * R_ + r) * 96;
                const f32x4 g = *(const f32x4*)(gk + 4 * q);
                *(uint2*)(dst + 4 * q) = make_uint2(pk2(v[0] * rr * g[0], v[1] * rr * g[1]), pk2(v[2] * rr * g[2], v[3] * rr * g[3]));
                const float2 gr = *(const float2*)(gk + 64 + 2 * q);
                *(u32*)(dst + 64 + 2 * q) = pk2(y0 * rr * gr.x, y1 * rr * gr.y);
            }
        }
    }
    __syncthreads();
}

__device__ __forceinline__ void ctx_qkv0(const Bufs& B, LAS unsigned char* lds, int bid, int nblk) {
    constexpr int K = 1024, KW = K / 8, NS = KW / 32, NCB = 12;
    const int tid = ltid(), wid = tid >> 6, lane = tid & 63, fr = lane & 15, fq = lane >> 4;
    LAS f32x4* red = (LAS f32x4*)lds;
    LAS float* tile = (LAS float*)(lds + 98304);
    const bf16_t* Bt = B.wt + W_EIN;
    for (int it = bid; it < 256; it += nblk) {
        const int r0 = 16 * (it & 15), c00 = 192 * (it >> 4);
        const bf16_t* ap = B.h + (size_t)(r0 + fr + 1) * 1024 + wid * KW + 8 * fq;
        f32x4 d[NCB];
#pragma unroll
        for (int cb = 0; cb < NCB; ++cb) d[cb] = (f32x4){0.f, 0.f, 0.f, 0.f};
#pragma unroll
        for (int st = 0; st < NS; ++st) {
            const bf16x8 a = *(const bf16x8*)(ap + 32 * st);
#pragma unroll
            for (int cb = 0; cb < NCB; ++cb) {
                const int v = c00 + 16 * cb + fr;
                const int J = (v & ~255) + 128 * ((v >> 5) & 1) + 32 * ((v >> 6) & 3) + 16 * ((v >> 2) & 1) + 4 * ((v >> 3) & 3) + (v & 3);
                const bf16x8 b = *(const bf16x8*)(Bt + (size_t)J * K + wid * KW + 8 * fq + 32 * st);
                d[cb] = __builtin_amdgcn_mfma_f32_16x16x32_bf16(b, a, d[cb], 0, 0, 0);
            }
        }
        __syncthreads();
#pragma unroll
        for (int cb = 0; cb < NCB; ++cb) red[(wid * NCB + cb) * 64 + lane] = d[cb];
        __syncthreads();
        for (int e = tid; e < NCB * 64; e += NT) {
            const int cb = e >> 6, ln = e & 63;
            f32x4 t = red[cb * 64 + ln];
#pragma unroll
            for (int w = 1; w < 8; ++w) t += red[(w * NCB + cb) * 64 + ln];
            *(LAS f32x4*)(tile + (ln & 15) * 192 + 16 * cb + 4 * (ln >> 4)) = t;
        }
        __syncthreads();
        if (tid < 256) {
            const int row = tid >> 4, q = tid & 15, r = r0 + row;
#pragma unroll
            for (int gi = 0; gi < 3; ++gi) {
                const int c0 = c00 + 64 * gi, pn = c0 >> 8, wc = (c0 >> 6) & 3, seg = pn >> 1;
                const f32x4 v = *(const LAS f32x4*)(tile + row * 192 + 64 * gi + 4 * q);
                if (seg == 2 || seg == 5) {
                    bf16_t* vt = B.qkv + (seg == 2 ? O_VAT + (size_t)(((pn & 1) * 2 + (wc >> 1)) * 128 + 64 * (wc & 1) + 4 * q) * R_ : O_VBT + (size_t)(((pn & 1) * 4 + wc) * 64 + 4 * q) * R_) + vpos(r);
                    const u32 w0 = pk2(v[0], v[1]), w1 = pk2(v[2], v[3]);
                    vt[0] = (bf16_t)(w0 & 0xffffu); vt[(size_t)R_] = (bf16_t)(w0 >> 16); vt[(size_t)2 * R_] = (bf16_t)(w1 & 0xffffu); vt[(size_t)3 * R_] = (bf16_t)(w1 >> 16);
                } else {
                    float ss = v[0] * v[0] + v[1] * v[1] + v[2] * v[2] + v[3] * v[3];
                    ss += __shfl_xor(ss, 1); ss += __shfl_xor(ss, 2); ss += __shfl_xor(ss, 4); ss += __shfl_xor(ss, 8);
                    const float rr = rsqrtf(ss * (1.f / 64.f) + EPS_) * ((seg == 0 || seg == 3) ? QS64 : 1.f);
                    const f32x4 g = *(const f32x4*)(B.gt + 64 * (seg < 2 ? seg : seg - 1) + 4 * q);
                    const int head = (pn & 1) * 4 + wc;
                    bf16_t* dst = B.qkv + (seg == 0 ? O_QA : seg == 1 ? O_KA : seg == 3 ? O_QB : O_KB) + ((size_t)head * R_ + r) * 64 + 4 * q;
                    *(uint2*)dst = make_uint2(pk2(v[0] * rr * g[0], v[1] * rr * g[1]), pk2(v[2] * rr * g[2], v[3] * rr * g[3]));
                }
            }
        }
    }
    __syncthreads();
}

__device__ __forceinline__ void g_qkv0(const Params& p, LAS unsigned char* lds) {
    Bufs B(p);
    pg8::Gemm g{B.h, B.wt + W_EIN, 1024, 1024}; pg8::Order S; S.init(64, 12, gridDim.x, blockIdx.x, 1, 1);
    EpiQKV0 E{B.qkv, B.rope, B.gt};
    pg8::gemm_phase<EpiQKV0, pg8::Order, true, true>(lds, g, S, E);
    ctx_qkv0(B, lds, blockIdx.x, gridDim.x);
}
__device__ __forceinline__ void g_out(const Params& p, int l, LAS unsigned char* lds) {
    Bufs B(p);
    { pg8::Gemm g{B.mix, B.wt + (l == 0 ? W_EOUT : W_OOUT), 1024, 1024}; pg8::Order S; S.init(64, 4, gridDim.x, blockIdx.x, 1, 0);
      EpiResid E{l == 0 ? p.in[I_X] : p.out, p.out, p.in[I_CTX], B.xc, modp(B, l, 0, 2), modp(B, l, 1, 2)};
      pg8::gemm_phase<EpiResid, pg8::Order, true, true>(lds, g, S, E); }
    if (l == 0) ctx_proj<1024>(B.mix, 1024, B.wt + W_EOUT, modp(B, 0, 1, 2), B.xc, lds, blockIdx.x, gridDim.x);
}
__device__ __forceinline__ void g_up(const Params& p, int l, LAS unsigned char* lds) {
    Bufs B(p);
    pg8::Gemm g{B.h, B.wt + W_UP + (size_t)l * F2_ * 1024, 1024, 1024, 1}; pg8::Order S; S.init(l == 0 ? 67 : 65, 22, gridDim.x, blockIdx.x, l == 0 ? 0 : 2, 2);
    EpiUp E{B.act, p.in[I_FCW] + (size_t)l * 3 * F2_, p.in[I_FCB] + (size_t)l * F2_, (LAS float*)(lds + LDS_XCH)};
    pg8::gemm_phase<EpiUp, pg8::Order, true, true>(lds, g, S, E);
}
__device__ __forceinline__ void g_down(const Params& p, int l, LAS unsigned char* lds) {
    Bufs B(p);
    { pg8::Gemm g{B.act, B.wt + W_DOWN + (size_t)l * 1024 * F_, F_, F_}; pg8::Order S; S.init(64, 4, gridDim.x, blockIdx.x, 1, 0);
      EpiResid E{p.out, p.out, B.xc, B.xc, modp(B, l, 0, 5), modp(B, l, 1, 5)};
      pg8::gemm_phase<EpiResid, pg8::Order, true, true>(lds, g, S, E); }
    if (l == 0) ctx_proj<F_>(B.act, F_, B.wt + W_DOWN, modp(B, 0, 1, 5), B.xc, lds, blockIdx.x, gridDim.x);
}
__device__ __forceinline__ void g_qkv1a(const Params& p, LAS unsigned char* lds) {
    Bufs B(p);
    pg8::Gemm g{B.h, B.wt + W_OIN, 1024, 1024}; pg8::Order S; S.init(65, 6, gridDim.x, blockIdx.x, 0, 1);
    EpiQKV1A E{B.qkv, B.part, B.rope, B.gt};
    pg8::gemm_phase<EpiQKV1A, pg8::Order, true, true>(lds, g, S, E);
}
__device__ __forceinline__ void g_qkv1b(const Params& p, LAS unsigned char* lds) {
    Bufs B(p);
    { pg8::Gemm g{B.qkv + O_CQ, B.wt + W_QB, 384, 384}; pg8::Order S; S.init(64, 4, gridDim.x, blockIdx.x, 1, 0);
      EpiQB E{B.qkv, B.part, B.rope, p.in[I_CQN], (LAS float*)(lds + LDS_XCH)};
      pg8::gemm_phase<EpiQB, pg8::Order, true, true>(lds, g, S, E); }
    { pg8::Gemm g{B.qkv + O_CKV, B.wt + W_KVB, 256, 256}; pg8::Order S; S.init(64, 4, gridDim.x, blockIdx.x, 1, 0);
      EpiKVB E{B.qkv, B.part, B.rope, p.in[I_CKN]};
      pg8::gemm_phase<EpiKVB, pg8::Order, true, true>(lds, g, S, E); }
    ctx_kvb(B, p.in[I_CKN], lds, blockIdx.x, gridDim.x);
}

typedef float f32x16 __attribute__((ext_vector_type(16)));

template <int DQK, int DV, int TK = 64>
struct FlashGeom {
    static constexpr int KP = DQK * 2 + 16, VP = TK * 2 + 16, KBYTES = TK * KP, VBYTES = DV * VP, STAGE = KBYTES + VBYTES;
    static constexpr int KCH = DQK / 8, KN = (TK * KCH + NT - 1) / NT, VCH = TK / 8, VN = DV * VCH / NT;
};

#ifndef FLASH_PRIO
#define FLASH_PRIO 0
#endif
#ifndef DIFF_TK
#define DIFF_TK 64
#endif
#ifndef DIFF_PD
#define DIFF_PD 1
#endif
#ifndef MLA_TK
#define MLA_TK 64
#endif
#ifndef MLA_PD
#define MLA_PD 2
#endif
#ifndef FLASH_ASMLOAD
#define FLASH_ASMLOAD 0
#endif
#ifndef FLASH_SLEEP
#define FLASH_SLEEP 0
#endif
#ifndef FLASH_PD
#define FLASH_PD 2
#endif
#ifndef FLASH_TK
#define FLASH_TK 128
#endif
__device__ __forceinline__ void asm_gload(u32x4& dst, const void* ptr) { if (FLASH_ASMLOAD) asm volatile("global_load_dwordx4 %0, %1, off" : "=v"(dst) : "v"(ptr) : "memory"); else dst = *(const u32x4*)ptr; }
template <int N> __device__ __forceinline__ void asm_vmwait() { if (FLASH_ASMLOAD) asm volatile("s_waitcnt vmcnt(%0)" :: "n"(N) : "memory"); }
template <int DQK, int DV, int QS, int TK, int PD>
__device__ __forceinline__ void flash_dense(LAS char* lds, const bf16_t* __restrict__ qptr, const bf16_t* __restrict__ Kb, const bf16_t* __restrict__ VT, int ntiles,
                                            f32x16 (&O)[QS][DV / 32], float (&lsum)[QS]) {
    typedef FlashGeom<DQK, DV, TK> G;
    constexpr int NL = G::KN + G::VN;
    const int tid = ltid(), lane = tid & 63, r = lane & 31, h = lane >> 5;
    bf16x8 qf[QS][DQK / 16];
#pragma unroll
    for (int qs = 0; qs < QS; ++qs)
#pragma unroll
        for (int ks = 0; ks < DQK / 16; ++ks) qf[qs][ks] = *(const bf16x8*)(qptr + (size_t)qs * 32 * DQK + 16 * ks + 8 * h);
#pragma unroll
    for (int qs = 0; qs < QS; ++qs)
#pragma unroll
        for (int dt = 0; dt < DV / 32; ++dt)
#pragma unroll
            for (int i = 0; i < 16; ++i) O[qs][dt][i] = 0.f;
    float l[QS];
#pragma unroll
    for (int qs = 0; qs < QS; ++qs) l[qs] = 0.f;
    u32x4 kreg[PD][G::KN], vreg[PD][G::VN];
    int kq[G::KN]; const char* kp[G::KN]; const char* vp[G::VN];
#pragma unroll
    for (int i = 0; i < G::KN; ++i) { kq[i] = tid + NT * i; const int qc = kq[i] < TK * G::KCH ? kq[i] : TK * G::KCH - 1; kp[i] = (const char*)Kb + (size_t)qc * 16; }
#pragma unroll
    for (int i = 0; i < G::VN; ++i) { const int q = tid + NT * i; vp[i] = (const char*)VT + ((size_t)(q / G::VCH) * R_ + (q % G::VCH) * 8) * 2; }
#pragma unroll
    for (int qs = 0; qs < QS; ++qs)
#pragma unroll
        for (int ks = 0; ks < DQK / 16; ++ks) asm volatile("" : "+v"(qf[qs][ks]));
    if (FLASH_ASMLOAD) asm volatile("s_waitcnt vmcnt(0)" ::: "memory");
#define FD_LOAD(set, t) do { const int tt_ = (t) < ntiles ? (t) : ntiles - 1; \
        _Pragma("unroll") for (int i_ = 0; i_ < G::KN; ++i_) asm_gload(kreg[set][i_], kp[i_] + (size_t)tt_ * (TK * DQK * 2)); \
        _Pragma("unroll") for (int i_ = 0; i_ < G::VN; ++i_) asm_gload(vreg[set][i_], vp[i_] + (size_t)tt_ * (TK * 2)); } while (0)
#define FD_FENCE(set) do { if (FLASH_ASMLOAD) { _Pragma("unroll") for (int i_ = 0; i_ < G::KN; ++i_) asm volatile("" : "+v"(kreg[set][i_])); _Pragma("unroll") for (int i_ = 0; i_ < G::VN; ++i_) asm volatile("" : "+v"(vreg[set][i_])); } } while (0)
#define FD_STORE(set, buf) do { LAS char* kb_ = lds + (buf) * G::STAGE; LAS char* vb_ = kb_ + G::KBYTES; \
        _Pragma("unroll") for (int i_ = 0; i_ < G::KN; ++i_) { if (kq[i_] < TK * G::KCH) *(LAS u32x4*)(kb_ + (kq[i_] / G::KCH) * G::KP + (kq[i_] % G::KCH) * 16) = kreg[set][i_]; } \
        _Pragma("unroll") for (int i_ = 0; i_ < G::VN; ++i_) { const int q_ = tid + NT * i_; *(LAS u32x4*)(vb_ + (q_ / G::VCH) * G::VP + (q_ % G::VCH) * 16) = vreg[set][i_]; } } while (0)
    FD_LOAD(0, 0);
#pragma unroll
    for (int j = 1; j < PD; ++j) FD_LOAD(j, j);
    asm_vmwait<(PD - 1) * NL>(); FD_FENCE(0); FD_STORE(0, 0);
    FD_LOAD(0, PD);
    __syncthreads();
    for (int t0 = 0; t0 < ntiles; t0 += PD) {
#pragma unroll
        for (int j = 0; j < PD; ++j) {
            const int t = t0 + j;
            if (t >= ntiles) break;
            asm_vmwait<(PD - 1) * NL>(); FD_FENCE((j + 1) % PD);
            FD_STORE((j + 1) % PD, (t + 1) & 1);
            FD_LOAD((j + 1) % PD, t + 1 + PD);
            const LAS char* kb = lds + (t & 1) * G::STAGE; const LAS char* vb = kb + G::KBYTES;
#pragma unroll
            for (int kt = 0; kt < TK / 32; ++kt) {
                f32x16 S[QS];
#pragma unroll
                for (int qs = 0; qs < QS; ++qs)
#pragma unroll
                    for (int i = 0; i < 16; ++i) S[qs][i] = 0.f;
#pragma unroll
                for (int ks = 0; ks < DQK / 16; ++ks) {
                    const bf16x8 a = *(const LAS bf16x8*)(kb + (32 * kt + r) * G::KP + (16 * ks + 8 * h) * 2);
                    if (FLASH_PRIO) __builtin_amdgcn_s_setprio(1);
#pragma unroll
                    for (int qs = 0; qs < QS; ++qs) S[qs] = __builtin_amdgcn_mfma_f32_32x32x16_bf16(a, qf[qs][ks], S[qs], 0, 0, 0);
                    if (FLASH_PRIO) __builtin_amdgcn_s_setprio(0);
                }
                bf16x8 pf[QS][2];
#pragma unroll
                for (int qs = 0; qs < QS; ++qs) {
                    float p[16];
#pragma unroll
                    for (int i = 0; i < 16; ++i) { p[i] = __builtin_amdgcn_exp2f(S[qs][i]); l[qs] += p[i]; }
#pragma unroll
                    for (int s2 = 0; s2 < 2; ++s2) {
                        u32x4 pw; pw.x = cvtpk(p[8 * s2], p[8 * s2 + 1]); pw.y = cvtpk(p[8 * s2 + 2], p[8 * s2 + 3]); pw.z = cvtpk(p[8 * s2 + 4], p[8 * s2 + 5]); pw.w = cvtpk(p[8 * s2 + 6], p[8 * s2 + 7]);
                        pf[qs][s2] = __builtin_bit_cast(bf16x8, pw);
                    }
                }
#pragma unroll
                for (int s2 = 0; s2 < 2; ++s2)
#pragma unroll
                    for (int dt = 0; dt < DV / 32; ++dt) {
                        const bf16x8 a = *(const LAS bf16x8*)(vb + (32 * dt + r) * G::VP + (16 * (2 * kt + s2) + 8 * h) * 2);
                        if (FLASH_PRIO) __builtin_amdgcn_s_setprio(1);
#pragma unroll
                        for (int qs = 0; qs < QS; ++qs) O[qs][dt] = __builtin_amdgcn_mfma_f32_32x32x16_bf16(a, pf[qs][s2], O[qs][dt], 0, 0, 0);
                        if (FLASH_PRIO) __builtin_amdgcn_s_setprio(0);
                    }
            }
            __syncthreads();
        }
    }
    asm_vmwait<0>();
#pragma unroll
    for (int j = 0; j < PD; ++j) FD_FENCE(j);
#undef FD_LOAD
#undef FD_STORE
#undef FD_FENCE
#pragma unroll
    for (int qs = 0; qs < QS; ++qs) lsum[qs] = l[qs] + __shfl_xor(l[qs], 32);
}

__device__ __forceinline__ bf16_t* diff_park(const Params& p, int m, int head) {
    if (m == 0) return (bf16_t*)(p.ws + WS_H) + (size_t)head * R_ * 128;
    if (head == 0) return (bf16_t*)(p.ws + WS_QKV + 6 * E_SEG * 2);
    return (bf16_t*)(p.ws + WS_PARK) + (size_t)(head - 1) * R_ * 128;
}
__device__ __forceinline__ float* diff_ctx_tmp(const Params& p, int head) { return (float*)(p.ws + WS_H + (size_t)4 * R_ * 128 * 2) + (size_t)head * 256 * 128; }
__device__ __forceinline__ void diff_unit(const Params& p, const Bufs& B, LAS char* lds, int head, int qb) {
    const int tid = ltid(), wid = tid >> 6, lane = tid & 63, c = lane & 31, h = lane >> 5;
    const int r = qb * 256 + wid * 32 + c, nt = qb == 0 ? 256 / FLASH_TK : R_ / FLASH_TK;
    const float lam = B.scal[0];
    float* tmp = diff_ctx_tmp(p, head) + (size_t)r * 128 + 4 * h;
    f32x16 Oa[1][4]; float la[1]; f32x16 (&O)[4] = Oa[0];
    flash_dense<64, 128, 1, FLASH_TK, FLASH_PD>(lds, B.qkv + O_QA + ((size_t)(2 * head) * R_ + r) * 64, B.qkv + O_KA + (size_t)(2 * head) * R_ * 64, B.qkv + O_VAT + (size_t)head * 128 * R_, nt, Oa, la);
    {
        const float inv = 1.f / la[0];
#pragma unroll
        for (int dt = 0; dt < 4; ++dt)
#pragma unroll
            for (int q = 0; q < 4; ++q) *(f32x4*)(tmp + 32 * dt + 8 * q) = (f32x4){O[dt][4 * q] * inv, O[dt][4 * q + 1] * inv, O[dt][4 * q + 2] * inv, O[dt][4 * q + 3] * inv};
    }
    flash_dense<64, 128, 1, FLASH_TK, FLASH_PD>(lds, B.qkv + O_QA + ((size_t)(2 * head + 1) * R_ + r) * 64, B.qkv + O_KA + (size_t)(2 * head + 1) * R_ * 64, B.qkv + O_VAT + (size_t)head * 128 * R_, nt, Oa, la);
    {
        const float inv = lam / la[0]; float ss = 0.f;
#pragma unroll
        for (int dt = 0; dt < 4; ++dt)
#pragma unroll
            for (int q = 0; q < 4; ++q) {
                const f32x4 o1 = *(const f32x4*)(tmp + 32 * dt + 8 * q);
#pragma unroll
                for (int e = 0; e < 4; ++e) { const float d = o1[e] - O[dt][4 * q + e] * inv; O[dt][4 * q + e] = d; ss += d * d; }
            }
        ss += __shfl_xor(ss, 32);
        const float rr = rsqrtf(ss * (1.f / 128.f) + EPS_) * 0.8f;
        bf16_t* dst = B.mix + (size_t)r * 1024 + head * 128 + 4 * h;
        const float* g = p.in[I_SUBLN] + 4 * h;
#pragma unroll
        for (int dt = 0; dt < 4; ++dt)
#pragma unroll
            for (int q = 0; q < 4; ++q) {
                const f32x4 gg = *(const f32x4*)(g + 32 * dt + 8 * q);
                *(uint2*)(dst + 32 * dt + 8 * q) = make_uint2(cvtpk(O[dt][4 * q] * rr * gg[0], O[dt][4 * q + 1] * rr * gg[1]), cvtpk(O[dt][4 * q + 2] * rr * gg[2], O[dt][4 * q + 3] * rr * gg[3]));
            }
    }
}
__device__ __forceinline__ void store_o64(bf16_t* dst, const f32x16 (&O)[2], float inv);
__device__ __forceinline__ void mla_unit(const Params& p, const Bufs& B, LAS char* lds, int head, int qb) {
    const int tid = ltid(), wid = tid >> 6, lane = tid & 63, c = lane & 31, h = lane >> 5;
    const int r = 256 + qb * 512 + wid * 64 + c;
    f32x16 O[2][2]; float l[2];
    flash_dense<96, 64, 2, MLA_TK, MLA_PD>(lds, B.qkv + O_MQ + ((size_t)head * R_ + r) * 96, B.qkv + O_MK + (size_t)head * R_ * 96, B.qkv + O_MVT + (size_t)head * 64 * R_, R_ / MLA_TK, O, l);
#pragma unroll
    for (int qs = 0; qs < 2; ++qs) store_o64(B.mix + (size_t)(r + 32 * qs) * 1024 + head * 64 + 4 * h, O[qs], 1.f / l[qs]);
}

__device__ __forceinline__ void diff_half_unit(const Params& p, const Bufs& B, LAS char* lds, int head, int m, int qb512) {
    const int tid = ltid(), wid = tid >> 6, lane = tid & 63, c = lane & 31, h = lane >> 5;
    const int r = 256 + qb512 * 512 + wid * 64 + c, sub = 2 * head + m;
    f32x16 O[2][4]; float l[2];
    flash_dense<64, 128, 2, DIFF_TK, DIFF_PD>(lds, B.qkv + O_QA + ((size_t)sub * R_ + r) * 64, B.qkv + O_KA + (size_t)sub * R_ * 64, B.qkv + O_VAT + (size_t)head * 128 * R_, R_ / DIFF_TK, O, l);
    bf16_t* park = diff_park(p, m, head);
#pragma unroll
    for (int qs = 0; qs < 2; ++qs) {
        const float inv = 1.f / l[qs];
        bf16_t* dst = park + (size_t)(r + 32 * qs) * 128 + 4 * h;
#pragma unroll
        for (int dt = 0; dt < 4; ++dt)
#pragma unroll
            for (int q = 0; q < 4; ++q) *(uint2*)(dst + 32 * dt + 8 * q) = make_uint2(cvtpk(O[qs][dt][4 * q] * inv, O[qs][dt][4 * q + 1] * inv), cvtpk(O[qs][dt][4 * q + 2] * inv, O[qs][dt][4 * q + 3] * inv));
    }
}
__device__ __forceinline__ void phase_diff_combine(const Params& p, int bid, int nblk) {
    Bufs B(p);
    const int tid = ltid(), wid = tid >> 6, lane = tid & 63;
    const float lam = B.scal[0];
    const float2 g = *(const float2*)(p.in[I_SUBLN] + 2 * lane);
    for (int rp = bid * 8 + wid; rp < T_ / 2; rp += nblk * 8) {
        u32 a[8], b[8];
#pragma unroll
        for (int j = 0; j < 8; ++j) {
            const size_t o = (size_t)(256 + 2 * rp + (j >> 2)) * 128 + 2 * lane;
            a[j] = *(const u32*)(diff_park(p, 0, j & 3) + o); b[j] = *(const u32*)(diff_park(p, 1, j & 3) + o);
        }
#pragma unroll
        for (int j = 0; j < 8; ++j) {
            const float d0 = __uint_as_float(a[j] << 16) - lam * __uint_as_float(b[j] << 16), d1 = __uint_as_float(a[j] & 0xffff0000u) - lam * __uint_as_float(b[j] & 0xffff0000u);
            const float ss = wave_sum(d0 * d0 + d1 * d1);
            const float rr = rsqrtf(ss * (1.f / 128.f) + EPS_) * 0.8f;
            *(u32*)(B.mix + (size_t)(256 + 2 * rp + (j >> 2)) * 1024 + (j & 3) * 128 + 2 * lane) = cvtpk(d0 * rr * g.x, d1 * rr * g.y);
        }
    }
}
__device__ __forceinline__ void phase_attn0_dense(const Params& p, LAS char* lds, int bid, int nblk) {
    Bufs B(p);
    for (int u = bid; u < 256; u += nblk) diff_half_unit(p, B, lds, (u & 7) >> 1, u & 1, u >> 3);
}
__device__ __forceinline__ void phase_attn1_dense(const Params& p, LAS char* lds, int bid, int nblk) {
    Bufs B(p);
    for (int u = bid; u < 256; u += nblk) mla_unit(p, B, lds, u & 7, u >> 3);
}

template <int MODE>
__device__ __forceinline__ void flash_win(LAS char* lds, const bf16_t* __restrict__ qptr, const bf16_t* __restrict__ Kb, const bf16_t* __restrict__ VT, int lat0, int nlat, float c2,
                                          int qi  , int qcol, const LAS float* bl, f32x16 (&O)[2][2], float (&lsum)[2]) {
    typedef FlashGeom<64, 64> G;
    const int tid = ltid(), lane = tid & 63, r = lane & 31, h = lane >> 5;
    const int ntiles = 4 + nlat;
    bf16x8 qf[2][4];
#pragma unroll
    for (int qs = 0; qs < 2; ++qs)
#pragma unroll
        for (int ks = 0; ks < 4; ++ks) qf[qs][ks] = *(const bf16x8*)(qptr + qs * 32 * 64 + 16 * ks + 8 * h);
#pragma unroll
    for (int qs = 0; qs < 2; ++qs)
#pragma unroll
        for (int dt = 0; dt < 2; ++dt)
#pragma unroll
            for (int i = 0; i < 16; ++i) O[qs][dt][i] = 0.f;
    float l[2] = {0.f, 0.f};
    constexpr int PD = 3;
    u32x4 kreg[PD], vreg[PD];
    auto load_tile = [&](u32x4& kr, u32x4& vr, int t) { const int tt = t < ntiles ? t : ntiles - 1; const int at = tt < 4 ? tt : lat0 + (tt - 4);
        kr = *(const u32x4*)(Kb + (size_t)at * 64 * 64 + tid * 8); vr = *(const u32x4*)(VT + (size_t)(tid >> 3) * R_ + at * 64 + (tid & 7) * 8); };
    auto store_tile = [&](const u32x4& kr, const u32x4& vr, int buf) { LAS char* kb = lds + buf * G::STAGE; LAS char* vb = kb + G::KBYTES;
        *(LAS u32x4*)(kb + (tid >> 3) * G::KP + (tid & 7) * 16) = kr; *(LAS u32x4*)(vb + (tid >> 3) * G::VP + (tid & 7) * 16) = vr; };
    const int rs = MODE == 1 ? min(max(qi - 4, 0), 248) : 0;
    const int qlo = MODE == 2 ? __builtin_amdgcn_readfirstlane(qi - r) : 0;
#pragma unroll
    for (int qs = 0; qs < 2; ++qs)
#pragma unroll
        for (int ks = 0; ks < 4; ++ks) asm volatile("" : "+v"(qf[qs][ks]));
#pragma unroll
    for (int j = 0; j < PD; ++j) load_tile(kreg[j], vreg[j], j);
    store_tile(kreg[0], vreg[0], 0);
    load_tile(kreg[0], vreg[0], PD);
    __syncthreads();
    for (int t0 = 0; t0 < ntiles; t0 += PD) {
#pragma unroll
      for (int j = 0; j < PD; ++j) {
        const int t = t0 + j;
        if (t >= ntiles) break;
        if (t + 1 < ntiles) store_tile(kreg[(j + 1) % PD], vreg[(j + 1) % PD], (t + 1) & 1);
        load_tile(kreg[(j + 1) % PD], vreg[(j + 1) % PD], t + 1 + PD);
        const LAS char* kb = lds + (t & 1) * G::STAGE; const LAS char* vb = kb + G::KBYTES;
        const int lt = lat0 + (t - 4) - 4;
        bool active = true;
        if (t >= 4) { if (MODE == 1) active = lt >= rs && lt < rs + 8; else active = (64 * lt + 63 >= qlo - 128) && (64 * lt <= qlo + 63 + 128); }
        if (active) {
#pragma unroll
            for (int kt = 0; kt < 2; ++kt) {
                f32x16 S[2];
#pragma unroll
                for (int qs = 0; qs < 2; ++qs)
#pragma unroll
                    for (int i = 0; i < 16; ++i) S[qs][i] = 0.f;
#pragma unroll
                for (int ks = 0; ks < 4; ++ks) {
                    const bf16x8 a = *(const LAS bf16x8*)(kb + (32 * kt + r) * G::KP + (16 * ks + 8 * h) * 2);
#pragma unroll
                    for (int qs = 0; qs < 2; ++qs) S[qs] = __builtin_amdgcn_mfma_f32_32x32x16_bf16(a, qf[qs][ks], S[qs], 0, 0, 0);
                }
                bf16x8 pf[2][2];
#pragma unroll
                for (int qs = 0; qs < 2; ++qs) {
                    float p[16];
                    if (t < 4) {
#pragma unroll
                        for (int i = 0; i < 16; ++i) p[i] = __builtin_amdgcn_exp2f(S[qs][i] - c2);
                    } else if (MODE == 1) {
                        const int qc = qcol + 32 * qs, cs = min(max(qc - 8, 0), 48), vlo = cs - 4 * h;
                        const LAS float* brow = bl + ((lt - qi + 7) * 31 + 4 * h - qc + 15);
#pragma unroll
                        for (int i = 0; i < 16; ++i) {
                            const int kc0 = 32 * kt + (i & 3) + 8 * (i >> 2);
                            const float e = __builtin_amdgcn_exp2f(S[qs][i] + brow[kc0]);
                            p[i] = (unsigned)(kc0 - vlo) < 16u ? e : 0.f;
                        }
                    } else {
                        const int d0 = 64 * lt + 4 * h - (qi + 32 * qs) + 128;
#pragma unroll
                        for (int i = 0; i < 16; ++i) {
                            const int kc0 = 32 * kt + (i & 3) + 8 * (i >> 2);
                            const float e = __builtin_amdgcn_exp2f(S[qs][i] - c2);
                            p[i] = (unsigned)(d0 + kc0) <= 256u ? e : 0.f;
                        }
                    }
#pragma unroll
                    for (int i = 0; i < 16; ++i) l[qs] += p[i];
#pragma unroll
                    for (int s2 = 0; s2 < 2; ++s2) {
                        u32x4 pw; pw.x = cvtpk(p[8 * s2], p[8 * s2 + 1]); pw.y = cvtpk(p[8 * s2 + 2], p[8 * s2 + 3]); pw.z = cvtpk(p[8 * s2 + 4], p[8 * s2 + 5]); pw.w = cvtpk(p[8 * s2 + 6], p[8 * s2 + 7]);
                        pf[qs][s2] = __builtin_bit_cast(bf16x8, pw);
                    }
                }
#pragma unroll
                for (int s2 = 0; s2 < 2; ++s2)
#pragma unroll
                    for (int dt = 0; dt < 2; ++dt) {
                        const bf16x8 a = *(const LAS bf16x8*)(vb + (32 * dt + r) * G::VP + (16 * (2 * kt + s2) + 8 * h) * 2);
#pragma unroll
                        for (int qs = 0; qs < 2; ++qs) O[qs][dt] = __builtin_amdgcn_mfma_f32_32x32x16_bf16(a, pf[qs][s2], O[qs][dt], 0, 0, 0);
                    }
            }
        }
        __syncthreads();
      }
    }
#pragma unroll
    for (int qs = 0; qs < 2; ++qs) lsum[qs] = l[qs] + __shfl_xor(l[qs], 32);
}
__device__ __forceinline__ void store_o64(bf16_t* dst  , const f32x16 (&O)[2], float inv) {
#pragma unroll
    for (int dt = 0; dt < 2; ++dt)
#pragma unroll
        for (int q = 0; q < 4; ++q)
            *(uint2*)(dst + 32 * dt + 8 * q) = make_uint2(cvtpk(O[dt][4 * q] * inv, O[dt][4 * q + 1] * inv), cvtpk(O[dt][4 * q + 2] * inv, O[dt][4 * q + 3] * inv));
}
constexpr int LDS_BIAS = 40960;
__device__ __forceinline__ void na_unit(const Params& p, const Bufs& B, LAS char* lds, int head, int qb) {
    const int tid = ltid(), wid = tid >> 6, lane = tid & 63, c = lane & 31, h = lane >> 5;
    const float nac2 = B.scal[3];
    LAS float* bl = (LAS float*)(lds + LDS_BIAS) + 64;
    __syncthreads();
    for (int e = tid; e < 64 + 465 + 128; e += NT) { const int j = e - 64; bl[j] = (j >= 0 && j < 465) ? p.in[I_RPB][head * 465 + j] * 1.4426950408889634f - nac2 : 0.f; }
    int lat0 = 4, nlat = 0, grow = 0, r;
    if (qb > 0) { const int r0 = 8 * (qb - 1), ra = min(max(r0 - 4, 0), 248), rb = min(max(r0 + 7 - 4, 0), 248) + 8; lat0 = 4 + ra; nlat = rb - ra; grow = r0 + wid; r = 256 + grow * 64 + c; }
    else r = (wid & 3) * 64 + c;
    f32x16 O[2][2]; float l[2];
    flash_win<1>(lds, B.qkv + O_QB + ((size_t)head * R_ + r) * 64, B.qkv + O_KB + (size_t)head * R_ * 64, B.qkv + O_VBT + (size_t)head * 64 * R_, lat0, nlat, B.scal[3], grow, c, bl, O, l);
    if (qb > 0 || wid < 4) {
#pragma unroll
        for (int qs = 0; qs < 2; ++qs) store_o64(B.mix + (size_t)(r + 32 * qs) * 1024 + 512 + head * 64 + 4 * h, O[qs], 1.f / l[qs]);
    }
}
__device__ __forceinline__ void swa_unit(const Params& p, const Bufs& B, LAS char* lds, int hq, int qb) {
    const int tid = ltid(), wid = tid >> 6, lane = tid & 63, c = lane & 31, h = lane >> 5;
    const int t0 = qb * 512, tq = t0 + wid * 64 + c, r = 256 + tq, kvh = hq >> 2;
    const int ta = max(t0 / 64 - 2, 0), tb = min(t0 / 64 + 9, 255);
    f32x16 O[2][2]; float l[2];
    const float c2 = B.scal[4];
    flash_win<2>(lds, B.qkv + O_GQ + ((size_t)hq * R_ + r) * 64, B.qkv + O_GK + (size_t)kvh * R_ * 64, B.qkv + O_GVT + (size_t)kvh * 64 * R_, 4 + ta, tb - ta + 1, c2, tq, 0, nullptr, O, l);
    const float sk = __builtin_amdgcn_exp2f(p.in[I_SINK][hq] * 1.4426950408889634f - c2);
#pragma unroll
    for (int qs = 0; qs < 2; ++qs) store_o64(B.mix + (size_t)(r + 32 * qs) * 1024 + 512 + hq * 64 + 4 * h, O[qs], 1.f / (l[qs] + sk));
}
__device__ __forceinline__ void phase_attn0_win(const Params& p, LAS char* lds, int bid, int nblk) {
    Bufs B(p);
    for (int u = bid; u < 256; u += nblk) na_unit(p, B, lds, u & 7, 1 + (u >> 3));
}
__device__ __forceinline__ void phase_attn1_win(const Params& p, LAS char* lds, int bid, int nblk) {
    Bufs B(p);
    for (int u = bid; u < 256; u += nblk) swa_unit(p, B, lds, u & 7, u >> 3);
}

#define XB_TMO      128
#define XB_XCNT(j)  (256  + 64 * (j))
#define XB_XSUB(j)  (1280 + 64 * (j))
#define XB_XGEN(j)  (2304 + 64 * (j))
#define XB_TOP      3328
#define XB_TOPGEN   3392
#define XCD_BAR_WORDS 3456
#define XB_SPIN_CAP (1u << 20)
__device__ __forceinline__ unsigned xb_ld(unsigned* p)              { return __hip_atomic_load(p, __ATOMIC_RELAXED, __HIP_MEMORY_SCOPE_AGENT); }
__device__ __forceinline__ unsigned xb_add(unsigned* p, unsigned v) { return __hip_atomic_fetch_add(p, v, __ATOMIC_RELAXED, __HIP_MEMORY_SCOPE_AGENT); }
__device__ __forceinline__ unsigned xb_xcc_id() { return (unsigned)__builtin_amdgcn_s_getreg((3 << 11) | 20) & 0xFu; }
#define XB_SPIN(cond, bar) do { unsigned _sp = 0; while (cond) { __builtin_amdgcn_s_sleep(1); \
    if ((++_sp & 255u) == 0u) { if (xb_ld(&(bar)[XB_TMO])) break; if (_sp > XB_SPIN_CAP) { atomicAdd(&(bar)[XB_TMO], 1u); break; } } } } while (0)
struct XcdBarrier { unsigned* bar; unsigned x; volatile LAS unsigned* st; };
__device__ __forceinline__ XcdBarrier xcd_barrier_post(unsigned* bar, volatile LAS unsigned* st) {
    XcdBarrier b; b.bar = bar; b.x = xb_xcc_id(); b.st = st;
    if (threadIdx.x == 0) (void)xb_add(&bar[XB_XCNT(b.x)], 1u);
    return b;
}
__device__ __forceinline__ void xcd_barrier_complete(unsigned* bar, unsigned x, unsigned& nloc, unsigned& nx) {
    const unsigned G = gridDim.x * gridDim.y * gridDim.z;
    unsigned sum, cnt, mine, sp = 0u;
    for (;;) {
        sum = 0u; cnt = 0u; mine = 0u;
#pragma unroll
        for (unsigned j = 0; j < 16; ++j) { const unsigned c = xb_ld(&bar[XB_XCNT(j)]); sum += c; cnt += (c > 0u) ? 1u : 0u; mine = (j == x) ? c : mine; }
        if (sum == G) break;
        __builtin_amdgcn_s_sleep(1);
        if ((++sp & 255u) == 0u) { if (xb_ld(&bar[XB_TMO])) break; if (sp > XB_SPIN_CAP) { atomicAdd(&bar[XB_TMO], 1u); break; } }
    }
    nloc = mine > 0u ? mine : 1u; nx = cnt > 0u ? cnt : 1u;
}
__device__ __forceinline__ void xcd_barrier(const XcdBarrier& b) {
    asm volatile("s_waitcnt vmcnt(0)" ::: "memory");
    __syncthreads();
    if (threadIdx.x == 0) {
        unsigned* bar = b.bar;
        __builtin_amdgcn_s_waitcnt(0);
        unsigned nloc = b.st[0], nx = b.st[1];
        if (nloc == 0u) { xcd_barrier_complete(bar, b.x, nloc, nx); b.st[0] = nloc; b.st[1] = nx; }
        const unsigned old = xb_add(&bar[XB_XSUB(b.x)], 1u);
        const unsigned gen = old / nloc;
        if (old + 1u == (gen + 1u) * nloc) {
            __builtin_amdgcn_fence(__ATOMIC_RELEASE, "agent");
            asm volatile("s_waitcnt vmcnt(0)" ::: "memory");
            const unsigned og = xb_add(&bar[XB_TOP], 1u);
            const unsigned tg = og / nx;
            if (og + 1u == (tg + 1u) * nx) xb_add(&bar[XB_TOPGEN], 1u);
            else XB_SPIN(xb_ld(&bar[XB_TOPGEN]) == tg, bar);
            __builtin_amdgcn_fence(__ATOMIC_ACQUIRE, "agent");
            xb_add(&bar[XB_XGEN(b.x)], 1u);
            asm volatile("s_waitcnt vmcnt(0)" ::: "memory");
        } else {
            XB_SPIN(xb_ld(&bar[XB_XGEN(b.x)]) == gen, bar);
            __builtin_amdgcn_fence(__ATOMIC_ACQUIRE, "agent");
            asm volatile("s_waitcnt vmcnt(0)" ::: "memory");
        }
    }
    __syncthreads();
}

__device__ __forceinline__ void run_phase(int ph, const Params& p0_, char* lds, int bid, int nblk) {
#if defined(__HIP_DEVICE_COMPILE__)
    typedef const Params __attribute__((address_space(4))) KParams;
    KParams* kp_ = (KParams*)__builtin_amdgcn_kernarg_segment_ptr(); asm volatile("" : "+s"(kp_));
    Params p;
#pragma unroll
    for (int i = 0; i < 35; ++i) p.in[i] = kp_->in[i];
    p.out = kp_->out; p.ws = kp_->ws; (void)p0_;
#else
    const Params& p = p0_;
#endif
    LAS unsigned char* l3 = (LAS unsigned char*)lds;
    switch (ph) {
        case 0: phase_prep(p, lds, bid, nblk); __syncthreads();   phase_prep_weights(p, lds, bid, nblk); break;
        case 1: phase_norm(p, 0, 0, bid, nblk); break;
        case 2: g_qkv0(p, l3); phase_prep_weights_rest(p, lds, 0); break;
        case 3: phase_attn0_dense(p, (LAS char*)lds, bid, nblk); break;
        case 16: {
            Bufs B(p);
            if (bid < 4) diff_unit(p, B, (LAS char*)lds, bid, 0);
            else if (bid < 12) na_unit(p, B, (LAS char*)lds, bid - 4, 0);
            else phase_diff_combine(p, bid - 12, nblk - 12);
            phase_attn0_win(p, (LAS char*)lds, bid, nblk); } break;
        case 4: g_out(p, 0, l3); break;
        case 5: phase_norm(p, 0, 1, bid, nblk); break;
        case 6: g_up(p, 0, l3); phase_prep_weights_rest(p, lds, 2); break;
        case 7: g_down(p, 0, l3); break;
        case 8: phase_norm(p, 1, 0, bid, nblk); break;
        case 9: g_qkv1a(p, l3); phase_prep_weights_rest(p, lds, 1); break;
        case 10: g_qkv1b(p, l3); break;
        case 11: phase_attn1_dense(p, (LAS char*)lds, bid, nblk); phase_attn1_win(p, (LAS char*)lds, bid, nblk); break;
        case 12: g_out(p, 1, l3); break;
        case 13: phase_norm(p, 1, 1, bid, nblk); break;
        case 14: g_up(p, 1, l3); break;
        case 15: g_down(p, 1, l3); break;
    }
}

namespace cg = cooperative_groups;
__global__ void __launch_bounds__(NT, 2) k_mega(Params p) {
    extern __shared__ __attribute__((aligned(16))) char smem[];
    cg::grid_group grid = cg::this_grid();
    const int bid = blockIdx.x, nblk = gridDim.x;
    volatile LAS unsigned* st = (volatile LAS unsigned*)((LAS char*)smem + LDS_BYTES - 16);
    if (threadIdx.x < 2) st[threadIdx.x] = 0u;
    __syncthreads();
    const XcdBarrier xb = xcd_barrier_post((unsigned*)(p.ws + WS_CTL), st);
#define SYNC() xcd_barrier(xb)
#define PH(n) run_phase(n, p, smem, bid, nblk)
    PH(0); if (p.out == nullptr) grid.sync(); SYNC(); PH(1); SYNC(); PH(2); SYNC(); PH(3); SYNC(); PH(16); SYNC(); PH(4); SYNC(); PH(5); SYNC(); PH(6); SYNC(); PH(7); SYNC();
    PH(8); SYNC(); PH(9); SYNC(); PH(10); SYNC(); PH(11); SYNC(); PH(12); SYNC(); PH(13); SYNC(); PH(14); SYNC(); PH(15);
#undef PH
}

extern "C" void kernel_launch(void* const* d_in, const int* in_sizes, int n_in, void* d_out, int out_size, void* d_ws, size_t ws_size, hipStream_t stream) {
    Params p{};
    for (int i = 0; i < 35; ++i) p.in[i] = (const float*)d_in[i];
    p.out = (float*)d_out; p.ws = (char*)d_ws;
    if (ws_size < WS_END) { fprintf(stderr, "ws too small: %zu < %zu\n", ws_size, (size_t)WS_END); return; }
    static int grid_blocks = 0;
    if (!grid_blocks) {
        int dev = 0, cus = 0, per_cu = 0;
        hipGetDevice(&dev);
        hipDeviceGetAttribute(&cus, hipDeviceAttributeMultiprocessorCount, dev);
        if (hipFuncSetAttribute((const void*)k_mega, hipFuncAttributeMaxDynamicSharedMemorySize, LDS_BYTES) != hipSuccess) fprintf(stderr, "hipFuncSetAttribute failed\n");
        hipOccupancyMaxActiveBlocksPerMultiprocessor(&per_cu, (const void*)k_mega, NT, LDS_BYTES);
        if (per_cu < 1) { fprintf(stderr, "occupancy query returned %d\n", per_cu); per_cu = 1; }
        if (per_cu > 1) per_cu = 1;
        grid_blocks = cus * per_cu;
    }
    if (hipMemsetAsync((char*)d_ws + WS_CTL, 0, 16384, stream) != hipSuccess) fprintf(stderr, "memset failed\n");
    void* args[] = {&p};
    hipError_t e = hipLaunchCooperativeKernel((const void*)k_mega, dim3(grid_blocks), dim3(NT), args, LDS_BYTES, stream);
    if (e != hipSuccess) fprintf(stderr, "cooperative launch failed: %s (grid %d)\n", hipGetErrorString(e), grid_blocks);
}
```
